# Optimizing an MI355X kernel written in HIP

```python
import functools
import jax
import jax.numpy as jnp
from jax import lax
import numpy as np

D_MODEL = 2048
BATCH = 2
SEQ = 4096
DEPTH = 2

GRID_W = 64
CTX_LEN = 256
N_MOD = 6
NORM_EPS = 1e-6

V_HEAD = 128
MLA_HEADS = D_MODEL // (2 * V_HEAD)
Q_LORA = D_MODEL // 4
KV_LORA = D_MODEL // 4
QK_NOPE = 128
QK_ROPE = 64
ROPE_FREQS = QK_ROPE // 4
ROPE_THETA = 10000.0
Q_BLOCK = 128
MLA_IN = Q_LORA + KV_LORA + QK_ROPE

RWKV_HEAD = 64
RWKV_HEADS = D_MODEL // (2 * RWKV_HEAD)
RWKV_DIM = RWKV_HEADS * RWKV_HEAD
DECAY_LORA = 64
ICLR_LORA = 64
GATE_LORA = 160
LNX_EPS = 64e-5
RWKV_IN = 3 * RWKV_DIM + 2 * DECAY_LORA + 2 * ICLR_LORA + GATE_LORA
EVEN_SPLITS = (Q_LORA, Q_LORA + KV_LORA, MLA_IN)
RWKV_SPLITS = (RWKV_DIM, 2 * RWKV_DIM, 3 * RWKV_DIM, 3 * RWKV_DIM + 2 * DECAY_LORA,
               3 * RWKV_DIM + 2 * DECAY_LORA + 2 * ICLR_LORA)
SCAN_REVERSE = (False, True)
MIX_DIM = MLA_HEADS * V_HEAD + RWKV_DIM

CHUNK = 128
SG_DIM = D_MODEL
SG_GROUPS = 16
SG_CH = SG_DIM // SG_GROUPS

D_FF = 7 * D_MODEL // 2
N_EXPERTS = 8
TOP_K = 2
MOE_BLOCK = 128

kernel_name = 'hybrid_mla_rwkv7_gmlp_moe_dit'


def rms_norm(x, g):
    xf = x.astype(jnp.float32)
    y = xf * lax.rsqrt(jnp.mean(xf * xf, axis=-1, keepdims=True) + NORM_EPS)
    return (y * g.astype(jnp.float32)).astype(x.dtype)


def layer_norm(x, g, b, eps=1e-5):
    xf = x.astype(jnp.float32)
    mu = jnp.mean(xf, axis=-1, keepdims=True)
    var = jnp.mean(jnp.square(xf - mu), axis=-1, keepdims=True)
    return ((xf - mu) * lax.rsqrt(var + eps) * g + b).astype(x.dtype)


def modulate(x, shift, scale):
    return x * (1 + scale) + shift


def ada_mod(cond, w, b):
    return jnp.split(jax.nn.silu(cond) @ w + b, N_MOD, axis=-1)


def axial_rope_tables(n_tokens):
    rows = n_tokens // GRID_W
    row = jnp.repeat(jnp.arange(rows), GRID_W).astype(jnp.float32)
    col = jnp.tile(jnp.arange(GRID_W), rows).astype(jnp.float32)
    inv = ROPE_THETA ** (-jnp.arange(ROPE_FREQS, dtype=jnp.float32) / ROPE_FREQS)
    ang = jnp.stack([row[:, None] * inv, col[:, None] * inv], axis=1)
    return jnp.cos(ang), jnp.sin(ang)


def axial_rope(x, cos, sin):
    xs = x.reshape(x.shape[:-1] + (2, 2, ROPE_FREQS))
    x1, x2 = xs[..., 0, :], xs[..., 1, :]
    out = jnp.stack([x1 * cos - x2 * sin, x2 * cos + x1 * sin], axis=-2)
    return out.reshape(x.shape).astype(x.dtype)


def mla_queries(c_q, q_norm, w_uq):
    B, L, _ = c_q.shape
    q = (rms_norm(c_q, q_norm) @ w_uq).reshape(B, L, MLA_HEADS, QK_NOPE + QK_ROPE)
    return q[..., :QK_NOPE], q[..., QK_NOPE:]


def mla_keys_values(c_kv, kv_norm, w_ukv):
    B, L, _ = c_kv.shape
    kv = (rms_norm(c_kv, kv_norm) @ w_ukv).reshape(B, L, MLA_HEADS, QK_NOPE + V_HEAD)
    return kv[..., :QK_NOPE], kv[..., QK_NOPE:]


def block_attention(q_nope, q_rope, k_nope, k_rope, v):
    B, L, H, _ = q_nope.shape
    nb = L // Q_BLOCK
    scale = (QK_NOPE + QK_ROPE) ** -0.5

    def to_blocks(t):
        return jnp.moveaxis(t.reshape((B, nb, Q_BLOCK) + t.shape[2:]), 1, 0)

    def one_block(qb):
        qn, qr = qb
        s = (jnp.einsum('bqhd,bkhd->bhqk', qn, k_nope)
             + jnp.einsum('bqhr,bkr->bhqk', qr, k_rope))
        prob = jax.nn.softmax(s.astype(jnp.float32) * scale, axis=-1).astype(v.dtype)
        return jnp.einsum('bhqk,bkhd->bqhd', prob, v)

    o = lax.map(one_block, (to_blocks(q_nope), to_blocks(q_rope)))
    return jnp.moveaxis(o, 0, 1).reshape(B, L, H * V_HEAD)


def centred_shift(z, mu_prev, mu_next):
    z_prev = jnp.pad(z, ((0, 0), (1, 0), (0, 0)))[:, :-1]
    z_next = jnp.pad(z, ((0, 0), (0, 1), (0, 0)))[:, 1:]
    return z + mu_prev * (z_prev - z) + mu_next * (z_next - z)


def rwkv_prep(z, p, with_output):
    B, L, _ = z.shape
    z = centred_shift(z, p['mu_prev'], p['mu_next']).astype(jnp.float32)
    r, k, v, wd, ad, gd = jnp.split(z, RWKV_SPLITS, axis=-1)

    def heads(t):
        return t.reshape(B, L, RWKV_HEADS, RWKV_HEAD)

    kk = heads(k * p['k_k'])
    kk = kk / jnp.maximum(jnp.linalg.norm(kk, axis=-1, keepdims=True), 1e-12)
    dirs = []
    for d in range(2):
        w_log = -jax.nn.softplus(-(p['w0'][d] + jnp.tanh(wd[..., d * DECAY_LORA:(d + 1) * DECAY_LORA]) @ p['w_up'][d])) - 0.5
        decay = jnp.exp(-jnp.exp(w_log))
        iclr = jax.nn.sigmoid(p['a0'][d] + ad[..., d * ICLR_LORA:(d + 1) * ICLR_LORA] @ p['a_up'][d])
        k_d = k * (1 + (iclr - 1) * p['k_a'])
        dirs.append((heads(decay), heads(k_d), heads(iclr) * kk))
    extra = None
    if with_output:
        extra = (heads(r), jax.nn.sigmoid(gd) @ p['g_up'])
    return heads(v), -kk, dirs, extra


def wkv_scan(state, decay, k, b, v, a, r, reverse):
    with_out = r is not None
    seqs = (decay, k, b, v, a) + ((r,) if with_out else ())
    xs = tuple(jnp.moveaxis(t, 1, 0) for t in seqs)

    def step(s, inp):
        w_t, k_t, b_t, v_t, a_t = inp[:5]
        sa = jnp.einsum('bhvk,bhk->bhv', s, a_t)
        s = s * w_t[:, :, None, :] + sa[..., None] * b_t[:, :, None, :] + v_t[..., None] * k_t[:, :, None, :]
        return s, (jnp.einsum('bhvk,bhk->bhv', s, inp[5]) if with_out else None)

    s, ys = lax.scan(step, state, xs, reverse=reverse)
    return s, (jnp.moveaxis(ys, 0, 1) if with_out else None)


def rwkv_readout(y, r, k_sum, v, g, p):
    B, L = y.shape[:2]
    mu = jnp.mean(y, axis=-1, keepdims=True)
    var = jnp.mean(jnp.square(y - mu), axis=-1, keepdims=True)
    yn = ((y - mu) * lax.rsqrt(var + LNX_EPS)).reshape(B, L, RWKV_DIM) * p['lnx_w'] + p['lnx_b']
    bonus = jnp.sum(r * k_sum * p['r_k'], axis=-1, keepdims=True) * v
    return (yn + bonus.reshape(B, L, RWKV_DIM)) * g


def mla_rwkv_mixer(xl, xc, p, cos, sin, ctx_out):
    B = xl.shape[0]
    cq_l, ckv_l, kr_l, zr_l = jnp.split(xl @ p['w_in'], EVEN_SPLITS, axis=-1)
    cq_c, ckv_c, kr_c, zr_c = jnp.split(xc @ p['w_in'], EVEN_SPLITS, axis=-1)
    kn_l, va_l = mla_keys_values(ckv_l, p['kv_norm'], p['w_ukv'])
    kn_c, va_c = mla_keys_values(ckv_c, p['kv_norm'], p['w_ukv'])
    qn_l, qr_l = mla_queries(cq_l, p['q_norm'], p['w_uq'])
    qr_l = axial_rope(qr_l, cos[:, None], sin[:, None])
    kr_l = axial_rope(kr_l, cos, sin)
    att_l = block_attention(qn_l, qr_l,
                            jnp.concatenate([kn_c, kn_l], axis=1),
                            jnp.concatenate([kr_c, kr_l], axis=1),
                            jnp.concatenate([va_c, va_l], axis=1))
    vr_l, a_l, dirs_l, (r_l, g_l) = rwkv_prep(zr_l, p, True)
    vr_c, a_c, dirs_c, extra_c = rwkv_prep(zr_c, p, ctx_out)
    r_c = extra_c[0] if ctx_out else None
    s0 = jnp.zeros((B, RWKV_HEADS, RWKV_HEAD, RWKV_HEAD), jnp.float32)
    y_l, y_c = 0.0, 0.0
    for d, rev in enumerate(SCAN_REVERSE):
        s_ctx, yc_d = wkv_scan(s0, *dirs_c[d], vr_c, a_c, r_c, rev)
        _, yl_d = wkv_scan(s_ctx, *dirs_l[d], vr_l, a_l, r_l, rev)
        y_l = y_l + yl_d
        if ctx_out:
            y_c = y_c + yc_d
    rw_l = rwkv_readout(y_l, r_l, dirs_l[0][1] + dirs_l[1][1], vr_l, g_l, p)
    out_l = jnp.concatenate([att_l, rw_l.astype(att_l.dtype)], axis=-1) @ p['w_o']
    out_c = None
    if ctx_out:
        qn_c, qr_c = mla_queries(cq_c, p['q_norm'], p['w_uq'])
        att_c = block_attention(qn_c, qr_c, kn_c, kr_c, va_c)
        rw_c = rwkv_readout(y_c, r_c, dirs_c[0][1] + dirs_c[1][1], vr_c, extra_c[1], p)
        out_c = jnp.concatenate([att_c, rw_c.astype(att_c.dtype)], axis=-1) @ p['w_o']
    return out_l, out_c


def chunk_gmlp(x, p):
    B, L, _ = x.shape
    u, v = jnp.split(jax.nn.gelu(x @ p['w_in'], approximate=False), 2, axis=-1)
    v = layer_norm(v, p['v_ln_w'], p['v_ln_b'])
    vc = v.reshape(B, L // CHUNK, CHUNK, SG_GROUPS, SG_CH)
    vm = jnp.einsum('gpq,bnqgc->bnpgc', p['w_s'], vc) + p['b_s'].T[:, :, None]
    return (u * vm.reshape(B, L, SG_DIM)) @ p['w_o']


def swiglu(x, w1, w3, w2):
    return (jax.nn.silu(x @ w1) * (x @ w3)) @ w2


def moe_swiglu(x, router, w1, w3, w2):
    shape = x.shape
    h = x.reshape(-1, shape[-1])
    n_tok = h.shape[0]
    logits = (h @ router).astype(jnp.float32)
    top_val, top_idx = lax.top_k(logits, TOP_K)
    gate = jax.nn.softmax(top_val, axis=-1)
    n_assign = n_tok * TOP_K
    e_flat = top_idx.reshape(-1)
    tok_flat = jnp.repeat(jnp.arange(n_tok), TOP_K)
    g_flat = gate.reshape(-1)
    order = jnp.argsort(e_flat)
    e_sorted = e_flat[order]
    counts = jnp.bincount(e_flat, length=N_EXPERTS)
    padded = (counts + MOE_BLOCK - 1) // MOE_BLOCK * MOE_BLOCK
    pad_end = jnp.cumsum(padded)
    pad_start = pad_end - padded
    grp_start = jnp.cumsum(counts) - counts
    dest = pad_start[e_sorted] + jnp.arange(n_assign) - grp_start[e_sorted]
    n_blocks = -(-(n_assign + N_EXPERTS * (MOE_BLOCK - 1)) // MOE_BLOCK)
    n_rows = n_blocks * MOE_BLOCK
    row_tok = jnp.zeros((n_rows,), jnp.int32).at[dest].set(tok_flat[order])
    row_gate = jnp.zeros((n_rows,), gate.dtype).at[dest].set(g_flat[order])
    block_exp = jnp.minimum(jnp.searchsorted(pad_end, jnp.arange(n_blocks) * MOE_BLOCK, side='right'), N_EXPERTS - 1)
    xb = h[row_tok].reshape(n_blocks, MOE_BLOCK, shape[-1])

    def expert_block(args):
        xblk, e = args
        return (jax.nn.silu(xblk @ w1[e]) * (xblk @ w3[e])) @ w2[e]

    yb = lax.map(expert_block, (xb, block_exp)).reshape(n_rows, -1)
    y = jax.ops.segment_sum(yb * row_gate[:, None].astype(yb.dtype), row_tok, num_segments=n_tok)
    return y.reshape(shape).astype(x.dtype)


def setup_inputs(seed: int = 0) -> dict:
    key = jax.random.key(seed)
    ks = iter(jax.random.split(key, 64))
    f32 = jnp.float32

    def nrm(shape, s):
        return jax.random.normal(next(ks), shape, f32) * s

    def unif(shape, lo, hi):
        return jax.random.uniform(next(ks), shape, f32, lo, hi)

    def gain(n):
        return 1.0 + nrm((n,), 0.02)

    D = D_MODEL
    return {
        'x': nrm((BATCH, SEQ, D), 1.0),
        'c': nrm((BATCH, D), 1.0),
        'ctx': nrm((BATCH, CTX_LEN, D), 1.0),
        'c_ctx': nrm((D,), 1.0),
        'l0_ada_w': nrm((D, N_MOD * D), 0.5 * D ** -0.5),
        'l0_ada_b': nrm((N_MOD * D,), 0.02),
        'l0_norm1': gain(D),
        'l0_norm2': gain(D),
        'l0_w_in': nrm((D, MLA_IN + RWKV_IN), D ** -0.5),
        'l0_q_norm': gain(Q_LORA),
        'l0_w_uq': nrm((Q_LORA, MLA_HEADS * (QK_NOPE + QK_ROPE)), Q_LORA ** -0.5),
        'l0_kv_norm': gain(KV_LORA),
        'l0_w_ukv': nrm((KV_LORA, MLA_HEADS * (QK_NOPE + V_HEAD)), KV_LORA ** -0.5),
        'l0_mu_prev': unif((RWKV_IN,), 0.0, 0.4),
        'l0_mu_next': unif((RWKV_IN,), 0.0, 0.4),
        'l0_w0': unif((2, RWKV_DIM), -6.0, 1.0),
        'l0_w_up': nrm((2, DECAY_LORA, RWKV_DIM), 0.5 * DECAY_LORA ** -0.5),
        'l0_a0': nrm((2, RWKV_DIM), 0.5),
        'l0_a_up': nrm((2, ICLR_LORA, RWKV_DIM), 0.5 * ICLR_LORA ** -0.5),
        'l0_g_up': nrm((GATE_LORA, RWKV_DIM), GATE_LORA ** -0.5),
        'l0_k_k': 0.85 + nrm((RWKV_DIM,), 0.05),
        'l0_k_a': 1.0 + nrm((RWKV_DIM,), 0.05),
        'l0_r_k': nrm((RWKV_HEADS, RWKV_HEAD), 0.1),
        'l0_lnx_w': gain(RWKV_DIM),
        'l0_lnx_b': nrm((RWKV_DIM,), 0.02),
        'l0_w_o': nrm((MIX_DIM, D), MIX_DIM ** -0.5),
        'l0_ffn_w1': nrm((D, D_FF), D ** -0.5),
        'l0_ffn_w3': nrm((D, D_FF), D ** -0.5),
        'l0_ffn_w2': nrm((D_FF, D), D_FF ** -0.5),
        'l1_ada_w': nrm((D, N_MOD * D), 0.5 * D ** -0.5),
        'l1_ada_b': nrm((N_MOD * D,), 0.02),
        'l1_norm1': gain(D),
        'l1_norm2': gain(D),
        'l1_w_in': nrm((D, 2 * SG_DIM), D ** -0.5),
        'l1_v_ln_w': gain(SG_DIM),
        'l1_v_ln_b': nrm((SG_DIM,), 0.02),
        'l1_w_s': nrm((SG_GROUPS, CHUNK, CHUNK), CHUNK ** -0.5),
        'l1_b_s': 1.0 + nrm((SG_GROUPS, CHUNK), 0.02),
        'l1_w_o': nrm((SG_DIM, D), SG_DIM ** -0.5),
        'l1_router': nrm((D, N_EXPERTS), D ** -0.5),
        'l1_moe_w1': nrm((N_EXPERTS, D, D_FF), D ** -0.5),
        'l1_moe_w3': nrm((N_EXPERTS, D, D_FF), D ** -0.5),
        'l1_moe_w2': nrm((N_EXPERTS, D_FF, D), D_FF ** -0.5),
        'final_norm': gain(D),
    }


def reference(x, c, ctx, c_ctx,
              l0_ada_w, l0_ada_b, l0_norm1, l0_norm2, l0_w_in, l0_q_norm, l0_w_uq, l0_kv_norm, l0_w_ukv,
              l0_mu_prev, l0_mu_next, l0_w0, l0_w_up, l0_a0, l0_a_up, l0_g_up, l0_k_k, l0_k_a, l0_r_k,
              l0_lnx_w, l0_lnx_b, l0_w_o, l0_ffn_w1, l0_ffn_w3, l0_ffn_w2,
              l1_ada_w, l1_ada_b, l1_norm1, l1_norm2, l1_w_in, l1_v_ln_w, l1_v_ln_b, l1_w_s, l1_b_s, l1_w_o,
              l1_router, l1_moe_w1, l1_moe_w3, l1_moe_w2,
              final_norm):
    layers = (
        dict(ada_w=l0_ada_w, ada_b=l0_ada_b, norm1=l0_norm1, norm2=l0_norm2, w_in=l0_w_in,
             q_norm=l0_q_norm, w_uq=l0_w_uq, kv_norm=l0_kv_norm, w_ukv=l0_w_ukv,
             mu_prev=l0_mu_prev, mu_next=l0_mu_next, w0=l0_w0, w_up=l0_w_up, a0=l0_a0, a_up=l0_a_up,
             g_up=l0_g_up, k_k=l0_k_k, k_a=l0_k_a, r_k=l0_r_k, lnx_w=l0_lnx_w, lnx_b=l0_lnx_b,
             w_o=l0_w_o, ffn_w1=l0_ffn_w1, ffn_w3=l0_ffn_w3, ffn_w2=l0_ffn_w2),
        dict(ada_w=l1_ada_w, ada_b=l1_ada_b, norm1=l1_norm1, norm2=l1_norm2, w_in=l1_w_in,
             v_ln_w=l1_v_ln_w, v_ln_b=l1_v_ln_b, w_s=l1_w_s, b_s=l1_b_s, w_o=l1_w_o,
             router=l1_router, moe_w1=l1_moe_w1, moe_w3=l1_moe_w3, moe_w2=l1_moe_w2),
    )
    cos, sin = axial_rope_tables(x.shape[1])
    h_lat, h_ctx = x, ctx
    for i in range(DEPTH):
        p = layers[i]
        even = i % 2 == 0
        ctx_out = any(j % 2 == 0 for j in range(i + 1, DEPTH))
        sh1, sc1, g1, sh2, sc2, g2 = [m[:, None, :] for m in ada_mod(c, p['ada_w'], p['ada_b'])]
        xl = modulate(rms_norm(h_lat, p['norm1']), sh1, sc1)
        xc = None
        if even or ctx_out:
            csh1, csc1, cg1, csh2, csc2, cg2 = ada_mod(c_ctx, p['ada_w'], p['ada_b'])
            xc = modulate(rms_norm(h_ctx, p['norm1']), csh1, csc1)
        if even:
            mix_l, mix_c = mla_rwkv_mixer(xl, xc, p, cos, sin, ctx_out)
            ffn = functools.partial(swiglu, w1=p['ffn_w1'], w3=p['ffn_w3'], w2=p['ffn_w2'])
        else:
            mix_l = chunk_gmlp(xl, p)
            mix_c = chunk_gmlp(xc, p) if ctx_out else None
            ffn = functools.partial(moe_swiglu, router=p['router'], w1=p['moe_w1'], w3=p['moe_w3'], w2=p['moe_w2'])
        h_lat = h_lat + g1 * mix_l.astype(h_lat.dtype)
        h_lat = h_lat + g2 * ffn(modulate(rms_norm(h_lat, p['norm2']), sh2, sc2)).astype(h_lat.dtype)
        if ctx_out:
            h_ctx = h_ctx + cg1 * mix_c.astype(h_ctx.dtype)
            h_ctx = h_ctx + cg2 * ffn(modulate(rms_norm(h_ctx, p['norm2']), csh2, csc2)).astype(h_ctx.dtype)
    return rms_norm(h_lat, final_norm)
```

```cpp
#include <hip/hip_runtime.h>
#include <cstdio>
#include <cstdint>

constexpr int D = 2048, NB = 2, SEQ = 4096, CTX = 256;
constexpr int NL = NB * SEQ;
constexpr int NCX = NB * CTX;
constexpr int MALL = NL + NCX;
constexpr int NMOD = 6 * D;
constexpr int QL = 512, KVL = 512, ROPE = 64, NOPE = 128, VH = 128, HM = 8;
constexpr int MLA_IN = QL + KVL + ROPE;
constexpr int RD = 1024, RH = 16, RN = 64;
constexpr int RWKV_IN = 3 * RD + 128 + 128 + 160;
constexpr int ZW = MLA_IN + RWKV_IN;
constexpr int QW = HM * (NOPE + ROPE);
constexpr int KVW = HM * (NOPE + VH);
constexpr int SK = CTX + SEQ;
constexpr int DFF = 7168, NE = 8;
constexpr int NSLOT = 18432;

constexpr size_t al(size_t x) { return (x + 255) & ~(size_t)255; }
constexpr size_t O_MOD0 = 0;
constexpr size_t O_MOD1 = O_MOD0 + al(3 * NMOD);
constexpr size_t O_MODP = O_MOD1 + al(2 * NMOD);
constexpr size_t O_H = O_MODP + al((size_t)2 * 32 * 3 * NMOD);
constexpr size_t O_XN = O_H + al((size_t)NL * D);
constexpr size_t O_G1 = O_XN + al((size_t)MALL * D);
constexpr size_t O_G3 = O_G1 + al((size_t)NL * DFF);
constexpr size_t O_L = O_G3 + al((size_t)NL * DFF);
constexpr size_t O_Z = O_L;
constexpr size_t O_CQN = O_Z + al((size_t)MALL * ZW);
constexpr size_t O_CKVN = O_CQN + al((size_t)MALL * 512);
constexpr size_t O_Q = O_CKVN + al((size_t)MALL * 512);
constexpr size_t O_KV = O_Q + al((size_t)NL * QW);
constexpr size_t O_QH = O_KV + al((size_t)MALL * KVW);
constexpr size_t O_KH = O_QH + al((size_t)NB * HM * SEQ * 192);
constexpr size_t O_VH = O_KH + al((size_t)NB * HM * SK * 192);
constexpr size_t O_MIX = O_VH + al((size_t)NB * HM * SK * 128);
constexpr size_t O_RR = O_MIX + al((size_t)NL * D);
constexpr size_t O_KR = O_RR + al((size_t)MALL * RD);
constexpr size_t O_VR = O_KR + al((size_t)MALL * RD);
constexpr size_t O_WDT = O_VR + al((size_t)MALL * RD);
constexpr size_t O_AD = O_WDT + al((size_t)MALL * 128);
constexpr size_t O_GS = O_AD + al((size_t)MALL * 128);
constexpr size_t O_WPRE = O_GS + al((size_t)MALL * 160);
constexpr size_t O_APRE = O_WPRE + al((size_t)2 * MALL * RD);
constexpr size_t O_GG = O_APRE + al((size_t)2 * MALL * RD);
constexpr size_t O_AA = O_GG + al((size_t)MALL * RD);
constexpr size_t O_WW = O_AA + al((size_t)MALL * RD);
constexpr size_t O_KD = O_WW + al((size_t)2 * MALL * RD);
constexpr size_t O_BD = O_KD + al((size_t)2 * MALL * RD);
constexpr size_t O_Y = O_BD + al((size_t)2 * MALL * RD);
constexpr size_t O_L0END = O_Y + al((size_t)2 * NL * RD);
constexpr size_t O_UV = O_L;
constexpr size_t O_VLN = O_UV + al((size_t)NL * 4096);
constexpr size_t O_GATED = O_VLN + al((size_t)NL * D);
constexpr size_t O_XG = O_GATED + al((size_t)NL * D);
constexpr size_t O_OUT2 = O_XG + al((size_t)NSLOT * D);
constexpr size_t O_ROUTE = O_OUT2 + al((size_t)NSLOT * D);
constexpr size_t O_L1END = O_ROUTE + al(65536);
constexpr size_t WS_FLOATS = O_L0END > O_L1END ? O_L0END : O_L1END;

struct P {
    const float* in[44];
    float* out;
    float* ws;
};

__device__ __forceinline__ float wave_sum(float v) {
#pragma unroll
    for (int o = 32; o > 0; o >>= 1) v += __shfl_xor(v, o);
    return v;
}
__device__ __forceinline__ float sigmoidf_(float x) { return 1.0f / (1.0f + expf(-x)); }
__device__ __forceinline__ float siluf_(float x) { return x / (1.0f + expf(-x)); }

__global__ void __launch_bounds__(512) k_ada_partial(P p) {
    const int u = blockIdx.x;
    const int l = u / 192, ks = (u % 192) / 6, nb = u % 6;
    const float* W = p.in[l == 0 ? 4 : 29];
    const float* c = p.in[1];
    const float* cc = p.in[3];
    const int n = nb * 2048 + threadIdx.x * 4;
    float4 a0 = {0, 0, 0, 0}, a1 = a0, a2 = a0;
    for (int kk = 0; kk < 64; ++kk) {
        const int k = ks * 64 + kk;
        const float4 w = *(const float4*)(W + (size_t)k * NMOD + n);
        const float s0 = siluf_(c[k]), s1 = siluf_(c[D + k]), s2 = siluf_(cc[k]);
        a0.x += s0 * w.x; a0.y += s0 * w.y; a0.z += s0 * w.z; a0.w += s0 * w.w;
        a1.x += s1 * w.x; a1.y += s1 * w.y; a1.z += s1 * w.z; a1.w += s1 * w.w;
        a2.x += s2 * w.x; a2.y += s2 * w.y; a2.z += s2 * w.z; a2.w += s2 * w.w;
    }
    float* dst = p.ws + O_MODP + ((size_t)(l * 32 + ks) * 3) * NMOD + n;
    *(float4*)(dst) = a0; *(float4*)(dst + NMOD) = a1; *(float4*)(dst + 2 * NMOD) = a2;
}
__global__ void k_ada_reduce(P p) {
    const int i = blockIdx.x * blockDim.x + threadIdx.x;
    if (i >= 2 * 3 * NMOD) return;
    const int l = i / (3 * NMOD), row = (i / NMOD) % 3, n = i % NMOD;
    if (l == 1 && row == 2) return;
    float s = p.in[l == 0 ? 5 : 30][n];
    for (int ks = 0; ks < 32; ++ks) s += p.ws[O_MODP + ((size_t)(l * 32 + ks) * 3 + row) * NMOD + n];
    p.ws[(l == 0 ? O_MOD0 : O_MOD1) + (size_t)row * NMOD + n] = s;
}

__global__ void __launch_bounds__(256) k_norm_mod(const float* srcL, const float* srcC, const float* gain, const float* mod, int chunk_sh, int chunk_sc, float* dst, int nrows) {
    const int row = blockIdx.x * 4 + (threadIdx.x >> 6), lane = threadIdx.x & 63;
    if (row >= nrows) return;
    const float* src = row < NL ? srcL + (size_t)row * D : srcC + (size_t)(row - NL) * D;
    const int mrow = row < NL ? row / SEQ : 2;
    float v[32]; float ss = 0.f;
#pragma unroll
    for (int i = 0; i < 8; ++i) { const float4 x = *(const float4*)(src + i * 256 + lane * 4); v[i * 4] = x.x; v[i * 4 + 1] = x.y; v[i * 4 + 2] = x.z; v[i * 4 + 3] = x.w; ss += x.x * x.x + x.y * x.y + x.z * x.z + x.w * x.w; }
    ss = wave_sum(ss);
    const float rs = rsqrtf(ss * (1.0f / D) + 1e-6f);
    const float* sh = mod + (size_t)mrow * NMOD + chunk_sh * D; const float* sc = mod + (size_t)mrow * NMOD + chunk_sc * D;
#pragma unroll
    for (int i = 0; i < 8; ++i) {
        const int c = i * 256 + lane * 4;
        float4 o;
        o.x = v[i * 4] * rs * gain[c] * (1.f + sc[c]) + sh[c];
        o.y = v[i * 4 + 1] * rs * gain[c + 1] * (1.f + sc[c + 1]) + sh[c + 1];
        o.z = v[i * 4 + 2] * rs * gain[c + 2] * (1.f + sc[c + 2]) + sh[c + 2];
        o.w = v[i * 4 + 3] * rs * gain[c + 3] * (1.f + sc[c + 3]) + sh[c + 3];
        *(float4*)(dst + (size_t)row * D + c) = o;
    }
}

struct GA { const float* A; const float* B; float* C; const float* R; const float* gate; const int* Mdev; const int* offdev; int lda, ldb, ldc, M, N, K, epi, offmode; };
__global__ void __launch_bounds__(256) k_gemm(GA g) {
    __shared__ float As[16][132];
    __shared__ float Bs[16][128];
    int M = g.M; const float* A = g.A; float* C = g.C;
    if (g.Mdev) { M = *g.Mdev; const int off = *g.offdev; if (g.offmode & 1) A += (size_t)off * g.lda; if (g.offmode & 2) C += (size_t)off * g.ldc; }
    const int m0 = blockIdx.y * 128, n0 = blockIdx.x * 128;
    if (m0 >= M) return;
    const int tid = threadIdx.x, ty = tid >> 4, tx = tid & 15;
    float acc[8][8];
#pragma unroll
    for (int i = 0; i < 8; ++i)
#pragma unroll
        for (int j = 0; j < 8; ++j) acc[i][j] = 0.f;
    const int ar = tid >> 1, ak = (tid & 1) * 8;
    const int bk = tid >> 4, bn = (tid & 15) * 8;
    for (int k0 = 0; k0 < g.K; k0 += 16) {
        float4 a0 = {0, 0, 0, 0}, a1 = a0, b0 = a0, b1 = a0;
        if (m0 + ar < M) { const float* ap = A + (size_t)(m0 + ar) * g.lda + k0 + ak; a0 = *(const float4*)ap; a1 = *(const float4*)(ap + 4); }
        if (n0 + bn + 8 <= g.N) { const float* bp = g.B + (size_t)(k0 + bk) * g.ldb + n0 + bn; b0 = *(const float4*)bp; b1 = *(const float4*)(bp + 4); }
        __syncthreads();
        As[ak][ar] = a0.x; As[ak + 1][ar] = a0.y; As[ak + 2][ar] = a0.z; As[ak + 3][ar] = a0.w;
        As[ak + 4][ar] = a1.x; As[ak + 5][ar] = a1.y; As[ak + 6][ar] = a1.z; As[ak + 7][ar] = a1.w;
        *(float4*)&Bs[bk][bn] = b0; *(float4*)&Bs[bk][bn + 4] = b1;
        __syncthreads();
#pragma unroll
        for (int k = 0; k < 16; ++k) {
            float a[8], b[8];
            const float4 x0 = *(const float4*)&As[k][ty * 8], x1 = *(const float4*)&As[k][ty * 8 + 4];
            const float4 y0 = *(const float4*)&Bs[k][tx * 8], y1 = *(const float4*)&Bs[k][tx * 8 + 4];
            a[0] = x0.x; a[1] = x0.y; a[2] = x0.z; a[3] = x0.w; a[4] = x1.x; a[5] = x1.y; a[6] = x1.z; a[7] = x1.w;
            b[0] = y0.x; b[1] = y0.y; b[2] = y0.z; b[3] = y0.w; b[4] = y1.x; b[5] = y1.y; b[6] = y1.z; b[7] = y1.w;
#pragma unroll
            for (int i = 0; i < 8; ++i)
#pragma unroll
                for (int j = 0; j < 8; ++j) acc[i][j] += a[i] * b[j];
        }
    }
    const int cn = n0 + tx * 8;
    if (cn + 8 > g.N) return;
#pragma unroll
    for (int i = 0; i < 8; ++i) {
        const int r = m0 + ty * 8 + i;
        if (r >= M) continue;
        float* cp = C + (size_t)r * g.ldc + cn;
        if (g.epi == 1) {
            const float* rp = g.R + (size_t)r * g.ldc + cn; const float* gp = g.gate + (size_t)(r / SEQ) * NMOD + cn;
#pragma unroll
            for (int j = 0; j < 8; ++j) cp[j] = rp[j] + gp[j] * acc[i][j];
        } else {
#pragma unroll
            for (int j = 0; j < 8; ++j) cp[j] = acc[i][j];
        }
    }
}

__global__ void __launch_bounds__(256) k_rms512(const float* Z, int col0, const float* gain, float* dst, int nrows) {
    const int row = blockIdx.x * 4 + (threadIdx.x >> 6), lane = threadIdx.x & 63;
    if (row >= nrows) return;
    const float* src = Z + (size_t)row * ZW + col0;
    float v[8]; float ss = 0.f;
#pragma unroll
    for (int i = 0; i < 8; ++i) { v[i] = src[i * 64 + lane]; ss += v[i] * v[i]; }
    ss = wave_sum(ss);
    const float rs = rsqrtf(ss * (1.0f / 512.f) + 1e-6f);
#pragma unroll
    for (int i = 0; i < 8; ++i) dst[(size_t)row * 512 + i * 64 + lane] = v[i] * rs * gain[i * 64 + lane];
}

__device__ __forceinline__ float rope_elem(const float* x64, int j, int t) {
    const int a = j >> 5, hf = (j >> 4) & 1, f = j & 15;
    const float pos = (float)(a == 0 ? (t / 64) : (t % 64));
    const float inv = powf(10000.0f, -(float)f / 16.0f);
    const float ang = pos * inv;
    const float cs = cosf(ang), sn = sinf(ang);
    const float x1 = x64[a * 32 + f], x2 = x64[a * 32 + 16 + f];
    return hf == 0 ? x1 * cs - x2 * sn : x2 * cs + x1 * sn;
}
__global__ void k_attn_prep(P p) {
    const float* ws = p.ws;
    const size_t i = (size_t)blockIdx.x * blockDim.x + threadIdx.x;
    const size_t nq = (size_t)NB * HM * SEQ * 192, nk = (size_t)NB * HM * SK * 192, nv = (size_t)NB * HM * SK * 128;
    if (i < nq) {
        const int d = i % 192; const int t = (i / 192) % SEQ; const int h = (i / (192 * SEQ)) % HM; const int b = i / ((size_t)192 * SEQ * HM);
        const float* q = ws + O_Q + (size_t)(b * SEQ + t) * QW + h * 192;
        p.ws[O_QH + i] = d < 128 ? q[d] : rope_elem(q + 128, d - 128, t);
    } else if (i < nq + nk) {
        const size_t j = i - nq;
        const int d = j % 192; const int s = (j / 192) % SK; const int h = (j / (192 * SK)) % HM; const int b = j / ((size_t)192 * SK * HM);
        const int row = s < CTX ? NL + b * CTX + s : b * SEQ + (s - CTX);
        float v;
        if (d < 128) v = ws[O_KV + (size_t)row * KVW + h * 256 + d];
        else { const float* kr = ws + O_Z + (size_t)row * ZW + 1024; v = s < CTX ? kr[d - 128] : rope_elem(kr, d - 128, s - CTX); }
        p.ws[O_KH + j] = v;
    } else if (i < nq + nk + nv) {
        const size_t j = i - nq - nk;
        const int d = j % 128; const int s = (j / 128) % SK; const int h = (j / (128 * SK)) % HM; const int b = j / ((size_t)128 * SK * HM);
        const int row = s < CTX ? NL + b * CTX + s : b * SEQ + (s - CTX);
        p.ws[O_VH + j] = ws[O_KV + (size_t)row * KVW + h * 256 + 128 + d];
    }
}

__global__ void __launch_bounds__(256) k_attn(P p) {
    __shared__ float Qs[16][193];
    __shared__ float Ks[32][193];
    __shared__ float Vs[32][128];
    __shared__ float Ps[16][33];
    const int qt = blockIdx.x, h = blockIdx.y, b = blockIdx.z, tid = threadIdx.x;
    const int q = tid >> 4, kg = tid & 15;
    const float* Qh = p.ws + O_QH + ((size_t)(b * HM + h) * SEQ + qt * 16) * 192;
    const float* Kh = p.ws + O_KH + (size_t)(b * HM + h) * SK * 192;
    const float* Vh = p.ws + O_VH + (size_t)(b * HM + h) * SK * 128;
    for (int i = tid; i < 16 * 192; i += 256) Qs[i / 192][i % 192] = Qh[i];
    const float scale = 0.07216878364870322f;
    float m = -1e30f, l = 0.f, o[8];
#pragma unroll
    for (int j = 0; j < 8; ++j) o[j] = 0.f;
    for (int k0 = 0; k0 < SK; k0 += 32) {
        __syncthreads();
        for (int i = tid; i < 32 * 192; i += 256) Ks[i / 192][i % 192] = Kh[(size_t)k0 * 192 + i];
        for (int i = tid; i < 32 * 128; i += 256) Vs[i / 128][i % 128] = Vh[(size_t)k0 * 128 + i];
        __syncthreads();
        float s0 = 0.f, s1 = 0.f;
        for (int d = 0; d < 192; ++d) { const float qv = Qs[q][d]; s0 += qv * Ks[kg * 2][d]; s1 += qv * Ks[kg * 2 + 1][d]; }
        s0 *= scale; s1 *= scale;
        float mx = fmaxf(s0, s1);
#pragma unroll
        for (int off = 8; off > 0; off >>= 1) mx = fmaxf(mx, __shfl_xor(mx, off));
        const float mn = fmaxf(m, mx);
        const float alpha = expf(m - mn);
        const float p0 = expf(s0 - mn), p1 = expf(s1 - mn);
        float ps = p0 + p1;
#pragma unroll
        for (int off = 8; off > 0; off >>= 1) ps += __shfl_xor(ps, off);
        l = l * alpha + ps; m = mn;
        Ps[q][kg * 2] = p0; Ps[q][kg * 2 + 1] = p1;
        __syncthreads();
#pragma unroll
        for (int j = 0; j < 8; ++j) o[j] *= alpha;
        for (int k = 0; k < 32; ++k) {
            const float pv = Ps[q][k];
#pragma unroll
            for (int j = 0; j < 8; ++j) o[j] += pv * Vs[k][kg * 8 + j];
        }
    }
    float* dst = p.ws + O_MIX + (size_t)(b * SEQ + qt * 16 + q) * D + h * 128 + kg * 8;
    const float il = 1.0f / l;
#pragma unroll
    for (int j = 0; j < 8; ++j) dst[j] = o[j] * il;
}

__global__ void k_rwkv_shift(P p) {
    const size_t i = (size_t)blockIdx.x * blockDim.x + threadIdx.x;
    if (i >= (size_t)MALL * RWKV_IN) return;
    const int row = i / RWKV_IN, j = i % RWKV_IN;
    int t, len;
    if (row < NL) { t = row % SEQ; len = SEQ; } else { t = (row - NL) % CTX; len = CTX; }
    const float* Z = p.ws + O_Z;
    const float z = Z[(size_t)row * ZW + MLA_IN + j];
    const float zp = t > 0 ? Z[(size_t)(row - 1) * ZW + MLA_IN + j] : 0.f;
    const float zn = t < len - 1 ? Z[(size_t)(row + 1) * ZW + MLA_IN + j] : 0.f;
    const float zs = z + p.in[13][j] * (zp - z) + p.in[14][j] * (zn - z);
    float* ws = p.ws;
    if (j < 1024) ws[O_RR + (size_t)row * RD + j] = zs;
    else if (j < 2048) ws[O_KR + (size_t)row * RD + j - 1024] = zs;
    else if (j < 3072) ws[O_VR + (size_t)row * RD + j - 2048] = zs;
    else if (j < 3200) ws[O_WDT + (size_t)row * 128 + j - 3072] = tanhf(zs);
    else if (j < 3328) ws[O_AD + (size_t)row * 128 + j - 3200] = zs;
    else ws[O_GS + (size_t)row * 160 + j - 3328] = sigmoidf_(zs);
}
__global__ void __launch_bounds__(256) k_rwkv_prep2(P p) {
    const int wi = blockIdx.x * 4 + (threadIdx.x >> 6), lane = threadIdx.x & 63;
    if (wi >= MALL * RH) return;
    const int row = wi / RH, h = wi % RH, c = h * 64 + lane;
    float* ws = p.ws;
    const size_t e = (size_t)row * RD + c;
    const float k = ws[O_KR + e];
    const float kk = k * p.in[20][c];
    const float nrm = sqrtf(wave_sum(kk * kk));
    const float kkn = kk / fmaxf(nrm, 1e-12f);
    ws[O_AA + e] = -kkn;
#pragma unroll
    for (int d = 0; d < 2; ++d) {
        const size_t ed = (size_t)d * MALL * RD + e;
        const float x = p.in[15][d * RD + c] + ws[O_WPRE + ed];
        const float y = -x;
        const float sp = fmaxf(y, 0.f) + log1pf(expf(-fabsf(y)));
        const float wlog = -sp - 0.5f;
        const float decay = expf(-expf(wlog));
        const float iclr = sigmoidf_(p.in[17][d * RD + c] + ws[O_APRE + ed]);
        ws[O_WW + ed] = decay;
        ws[O_KD + ed] = k * (1.f + (iclr - 1.f) * p.in[21][c]);
        ws[O_BD + ed] = iclr * kkn;
    }
}
__global__ void __launch_bounds__(64) k_scan(P p) {
    const int b = blockIdx.x / (RH * 2), h = (blockIdx.x / 2) % RH, d = blockIdx.x & 1, lane = threadIdx.x;
    const float* ws = p.ws;
    float S[64];
#pragma unroll
    for (int k = 0; k < 64; ++k) S[k] = 0.f;
    for (int step = 0; step < SK; ++step) {
        int row; bool lat;
        if (step < CTX) { const int s = d == 0 ? step : CTX - 1 - step; row = NL + b * CTX + s; lat = false; }
        else { const int t = d == 0 ? step - CTX : SEQ - 1 - (step - CTX); row = b * SEQ + t; lat = true; }
        const size_t e = (size_t)row * RD + h * 64, ed = (size_t)d * MALL * RD + e;
        const float4* a4 = (const float4*)(ws + O_AA + e); const float4* w4 = (const float4*)(ws + O_WW + ed);
        const float4* b4 = (const float4*)(ws + O_BD + ed); const float4* k4 = (const float4*)(ws + O_KD + ed);
        const float vv = ws[O_VR + e + lane];
        float sa = 0.f;
#pragma unroll
        for (int k = 0; k < 16; ++k) { const float4 a = a4[k]; sa += S[4 * k] * a.x + S[4 * k + 1] * a.y + S[4 * k + 2] * a.z + S[4 * k + 3] * a.w; }
#pragma unroll
        for (int k = 0; k < 16; ++k) {
            const float4 w = w4[k], bb = b4[k], kd = k4[k];
            S[4 * k] = S[4 * k] * w.x + sa * bb.x + vv * kd.x;
            S[4 * k + 1] = S[4 * k + 1] * w.y + sa * bb.y + vv * kd.y;
            S[4 * k + 2] = S[4 * k + 2] * w.z + sa * bb.z + vv * kd.z;
            S[4 * k + 3] = S[4 * k + 3] * w.w + sa * bb.w + vv * kd.w;
        }
        if (lat) {
            const float4* r4 = (const float4*)(ws + O_RR + e);
            float y = 0.f;
#pragma unroll
            for (int k = 0; k < 16; ++k) { const float4 r = r4[k]; y += S[4 * k] * r.x + S[4 * k + 1] * r.y + S[4 * k + 2] * r.z + S[4 * k + 3] * r.w; }
            p.ws[O_Y + (size_t)d * NL * RD + e + lane] = y;
        }
    }
}
__global__ void __launch_bounds__(256) k_readout(P p) {
    const int wi = blockIdx.x * 4 + (threadIdx.x >> 6), lane = threadIdx.x & 63;
    if (wi >= NL * RH) return;
    const int row = wi / RH, h = wi % RH, c = h * 64 + lane;
    const float* ws = p.ws;
    const size_t e = (size_t)row * RD + c;
    const float y = ws[O_Y + e] + ws[O_Y + (size_t)NL * RD + e];
    const float mu = wave_sum(y) * (1.f / 64.f);
    const float dv = y - mu;
    const float var = wave_sum(dv * dv) * (1.f / 64.f);
    const float yn = dv * rsqrtf(var + 64e-5f) * p.in[23][c] + p.in[24][c];
    const float r = ws[O_RR + e], ks = ws[O_KD + e] + ws[O_KD + (size_t)MALL * RD + e];
    const float bonus = wave_sum(r * ks * p.in[22][c]) * ws[O_VR + e];
    p.ws[O_MIX + (size_t)row * D + 1024 + c] = (yn + bonus) * ws[O_GG + e];
}
__global__ void k_swiglu(float* g1, const float* g3, size_t n) {
    const size_t i = (size_t)blockIdx.x * blockDim.x + threadIdx.x;
    if (i < n) g1[i] = siluf_(g1[i]) * g3[i];
}
__global__ void __launch_bounds__(256) k_gelu_ln(P p) {
    const int row = blockIdx.x * 4 + (threadIdx.x >> 6), lane = threadIdx.x & 63;
    if (row >= NL) return;
    float* uv = p.ws + O_UV + (size_t)row * 4096;
    float v[32]; float s = 0.f;
#pragma unroll
    for (int i = 0; i < 32; ++i) {
        const float u = uv[i * 64 + lane]; uv[i * 64 + lane] = 0.5f * u * (1.f + erff(u * 0.70710678118654752f));
        const float x = uv[2048 + i * 64 + lane]; v[i] = 0.5f * x * (1.f + erff(x * 0.70710678118654752f)); s += v[i];
    }
    const float mu = wave_sum(s) * (1.f / 2048.f);
    float q = 0.f;
#pragma unroll
    for (int i = 0; i < 32; ++i) { const float dd = v[i] - mu; q += dd * dd; }
    const float rs = rsqrtf(wave_sum(q) * (1.f / 2048.f) + 1e-5f);
#pragma unroll
    for (int i = 0; i < 32; ++i) { const int c = i * 64 + lane; p.ws[O_VLN + (size_t)row * D + c] = (v[i] - mu) * rs * p.in[34][c] + p.in[35][c]; }
}
__global__ void k_spatial(P p) {
    const size_t i = (size_t)blockIdx.x * blockDim.x + threadIdx.x;
    if (i >= (size_t)NL * D) return;
    const int row = i / D, ch = i % D, g = ch / 128, pp = row % 128, base = row - pp;
    const float* wsm = p.in[36] + ((size_t)g * 128 + pp) * 128;
    float s = 0.f;
    for (int q = 0; q < 128; ++q) s += wsm[q] * p.ws[O_VLN + (size_t)(base + q) * D + ch];
    s += p.in[37][g * 128 + pp];
    p.ws[O_GATED + i] = p.ws[O_UV + (size_t)row * 4096 + ch] * s;
}
__global__ void __launch_bounds__(256) k_route(P p) {
    const int row = blockIdx.x * 4 + (threadIdx.x >> 6), lane = threadIdx.x & 63;
    if (row >= NL) return;
    const float* x = p.ws + O_XN + (size_t)row * D; const float* R = p.in[39];
    float a[8];
#pragma unroll
    for (int e = 0; e < 8; ++e) a[e] = 0.f;
    for (int k = lane; k < D; k += 64) { const float xv = x[k]; const float4 r0 = *(const float4*)(R + (size_t)k * 8), r1 = *(const float4*)(R + (size_t)k * 8 + 4);
        a[0] += xv * r0.x; a[1] += xv * r0.y; a[2] += xv * r0.z; a[3] += xv * r0.w; a[4] += xv * r1.x; a[5] += xv * r1.y; a[6] += xv * r1.z; a[7] += xv * r1.w; }
#pragma unroll
    for (int e = 0; e < 8; ++e) a[e] = wave_sum(a[e]);
    if (lane == 0) {
        int e0 = 0; float v0 = a[0];
#pragma unroll
        for (int e = 1; e < 8; ++e) if (a[e] > v0) { v0 = a[e]; e0 = e; }
        int e1 = -1; float v1 = -3e38f;
#pragma unroll
        for (int e = 0; e < 8; ++e) if (e != e0 && a[e] > v1) { v1 = a[e]; e1 = e; }
        const float ex = expf(v1 - v0);
        int* ri = (int*)(p.ws + O_ROUTE);
        ri[row * 2] = e0; ri[row * 2 + 1] = e1;
        float* rg = p.ws + O_ROUTE + 40000;
        rg[row * 2] = 1.f / (1.f + ex); rg[row * 2 + 1] = ex / (1.f + ex);
    }
}
__global__ void __launch_bounds__(1024) k_moe_plan(P p) {
    __shared__ int cnt[8][1024];
    __shared__ int tot[8], off[8];
    int* ri = (int*)(p.ws + O_ROUTE);
    const int* top_e = ri; int* slot = ri + 16384; int* cntg = ri + 32768; int* offg = ri + 32768 + 8;
    const int tid = threadIdx.x;
    int c[8];
#pragma unroll
    for (int e = 0; e < 8; ++e) c[e] = 0;
    for (int j = 0; j < 16; ++j) { const int e = top_e[tid * 16 + j];
#pragma unroll
        for (int q = 0; q < 8; ++q) c[q] += (e == q) ? 1 : 0; }
#pragma unroll
    for (int e = 0; e < 8; ++e) cnt[e][tid] = c[e];
    __syncthreads();
    if (tid < 8) { int s = 0; for (int i = 0; i < 1024; ++i) { const int v = cnt[tid][i]; cnt[tid][i] = s; s += v; } tot[tid] = s; }
    __syncthreads();
    if (tid == 0) { int s = 0; for (int e = 0; e < 8; ++e) { off[e] = s; cntg[e] = tot[e]; offg[e] = s; s += (tot[e] + 255) / 256 * 256; } }
    __syncthreads();
    int r[8];
#pragma unroll
    for (int e = 0; e < 8; ++e) r[e] = off[e] + cnt[e][tid];
    for (int j = 0; j < 16; ++j) { const int e = top_e[tid * 16 + j]; int s = 0;
#pragma unroll
        for (int q = 0; q < 8; ++q) if (e == q) { s = r[q]; r[q]++; }
        slot[tid * 16 + j] = s; }
}
__global__ void k_moe_gather(P p) {
    const size_t i = (size_t)blockIdx.x * blockDim.x + threadIdx.x;
    if (i >= (size_t)16384 * 512) return;
    const int a = i / 512, c4 = i % 512;
    const int* slot = (const int*)(p.ws + O_ROUTE) + 16384;
    const int s = slot[a], t = a >> 1;
    ((float4*)(p.ws + O_XG + (size_t)s * D))[c4] = ((const float4*)(p.ws + O_XN + (size_t)t * D))[c4];
}
__global__ void __launch_bounds__(256) k_final(P p) {
    const int row = blockIdx.x * 4 + (threadIdx.x >> 6), lane = threadIdx.x & 63;
    if (row >= NL) return;
    const int* slot = (const int*)(p.ws + O_ROUTE) + 16384; const float* rg = p.ws + O_ROUTE + 40000;
    const int s0 = slot[row * 2], s1 = slot[row * 2 + 1]; const float g0 = rg[row * 2], g1 = rg[row * 2 + 1];
    const float* h = p.ws + O_H + (size_t)row * D; const float* o0 = p.ws + O_OUT2 + (size_t)s0 * D; const float* o1 = p.ws + O_OUT2 + (size_t)s1 * D;
    const float* g2 = p.ws + O_MOD1 + (size_t)(row / SEQ) * NMOD + 5 * D;
    float v[32]; float ss = 0.f;
#pragma unroll
    for (int i = 0; i < 32; ++i) { const int c = i * 64 + lane; v[i] = h[c] + g2[c] * (g0 * o0[c] + g1 * o1[c]); ss += v[i] * v[i]; }
    const float rs = rsqrtf(wave_sum(ss) * (1.f / D) + 1e-6f);
#pragma unroll
    for (int i = 0; i < 32; ++i) { const int c = i * 64 + lane; p.out[(size_t)row * D + c] = v[i] * rs * p.in[43][c]; }
}

static void gemm(hipStream_t st, const float* A, int lda, const float* B, int ldb, float* C, int ldc, int M, int N, int K, int epi = 0, const float* R = nullptr, const float* gate = nullptr, const int* Mdev = nullptr, const int* offdev = nullptr, int offmode = 0) {
    GA g{}; g.A = A; g.B = B; g.C = C; g.R = R; g.gate = gate; g.lda = lda; g.ldb = ldb; g.ldc = ldc; g.M = M; g.N = N; g.K = K; g.Mdev = Mdev; g.offdev = offdev; g.epi = epi; g.offmode = offmode;
    dim3 grid((N + 127) / 128, (M + 127) / 128);
    hipLaunchKernelGGL(k_gemm, grid, dim3(256), 0, st, g);
}

extern "C" void kernel_launch(void* const* d_in, const int* in_sizes, int n_in, void* d_out, int out_size, void* d_ws, size_t ws_size, hipStream_t stream) {
    if (n_in != 44 || ws_size < WS_FLOATS * 4) { fprintf(stderr, "kernel_launch: bad n_in %d or ws %zu < %zu\n", n_in, ws_size, (size_t)WS_FLOATS * 4); return; }
    P p{};
    for (int i = 0; i < 44; ++i) p.in[i] = (const float*)d_in[i];
    p.out = (float*)d_out; p.ws = (float*)d_ws;
    float* ws = p.ws;
    const float** in = p.in;
    hipLaunchKernelGGL(k_ada_partial, dim3(384), dim3(512), 0, stream, p);
    hipLaunchKernelGGL(k_ada_reduce, dim3((2 * 3 * NMOD + 255) / 256), dim3(256), 0, stream, p);
    hipLaunchKernelGGL(k_norm_mod, dim3(MALL / 4), dim3(256), 0, stream, in[0], in[2], in[6], ws + O_MOD0, 0, 1, ws + O_XN, MALL);
    gemm(stream, ws + O_XN, D, in[8], ZW, ws + O_Z, ZW, MALL, ZW, D);
    hipLaunchKernelGGL(k_rms512, dim3(MALL / 4), dim3(256), 0, stream, ws + O_Z, 0, in[9], ws + O_CQN, MALL);
    hipLaunchKernelGGL(k_rms512, dim3(MALL / 4), dim3(256), 0, stream, ws + O_Z, 512, in[11], ws + O_CKVN, MALL);
    gemm(stream, ws + O_CQN, 512, in[10], QW, ws + O_Q, QW, NL, QW, 512);
    gemm(stream, ws + O_CKVN, 512, in[12], KVW, ws + O_KV, KVW, MALL, KVW, 512);
    { const size_t n = (size_t)NB * HM * SEQ * 192 + (size_t)NB * HM * SK * 192 + (size_t)NB * HM * SK * 128;
      hipLaunchKernelGGL(k_attn_prep, dim3((unsigned)((n + 255) / 256)), dim3(256), 0, stream, p); }
    hipLaunchKernelGGL(k_attn, dim3(SEQ / 16, HM, NB), dim3(256), 0, stream, p);
    hipLaunchKernelGGL(k_rwkv_shift, dim3((unsigned)(((size_t)MALL * RWKV_IN + 255) / 256)), dim3(256), 0, stream, p);
    for (int d = 0; d < 2; ++d) {
        gemm(stream, ws + O_WDT + d * 64, 128, in[16] + (size_t)d * 64 * RD, RD, ws + O_WPRE + (size_t)d * MALL * RD, RD, MALL, RD, 64);
        gemm(stream, ws + O_AD + d * 64, 128, in[18] + (size_t)d * 64 * RD, RD, ws + O_APRE + (size_t)d * MALL * RD, RD, MALL, RD, 64);
    }
    gemm(stream, ws + O_GS, 160, in[19], RD, ws + O_GG, RD, MALL, RD, 160);
    hipLaunchKernelGGL(k_rwkv_prep2, dim3(MALL * RH / 4), dim3(256), 0, stream, p);
    hipLaunchKernelGGL(k_scan, dim3(NB * RH * 2), dim3(64), 0, stream, p);
    hipLaunchKernelGGL(k_readout, dim3(NL * RH / 4), dim3(256), 0, stream, p);
    gemm(stream, ws + O_MIX, D, in[25], D, ws + O_H, D, NL, D, D, 1, in[0], ws + O_MOD0 + 2 * D);
    hipLaunchKernelGGL(k_norm_mod, dim3(NL / 4), dim3(256), 0, stream, ws + O_H, (const float*)nullptr, in[7], ws + O_MOD0, 3, 4, ws + O_XN, NL);
    gemm(stream, ws + O_XN, D, in[26], DFF, ws + O_G1, DFF, NL, DFF, D);
    gemm(stream, ws + O_XN, D, in[27], DFF, ws + O_G3, DFF, NL, DFF, D);
    hipLaunchKernelGGL(k_swiglu, dim3((unsigned)(((size_t)NL * DFF + 255) / 256)), dim3(256), 0, stream, ws + O_G1, ws + O_G3, (size_t)NL * DFF);
    gemm(stream, ws + O_G1, DFF, in[28], D, ws + O_H, D, NL, D, DFF, 1, ws + O_H, ws + O_MOD0 + 5 * D);
    hipLaunchKernelGGL(k_norm_mod, dim3(NL / 4), dim3(256), 0, stream, ws + O_H, (const float*)nullptr, in[31], ws + O_MOD1, 0, 1, ws + O_XN, NL);
    gemm(stream, ws + O_XN, D, in[33], 4096, ws + O_UV, 4096, NL, 4096, D);
    hipLaunchKernelGGL(k_gelu_ln, dim3(NL / 4), dim3(256), 0, stream, p);
    hipLaunchKernelGGL(k_spatial, dim3((unsigned)(((size_t)NL * D + 255) / 256)), dim3(256), 0, stream, p);
    gemm(stream, ws + O_GATED, D, in[38], D, ws + O_H, D, NL, D, D, 1, ws + O_H, ws + O_MOD1 + 2 * D);
    hipLaunchKernelGGL(k_norm_mod, dim3(NL / 4), dim3(256), 0, stream, ws + O_H, (const float*)nullptr, in[32], ws + O_MOD1, 3, 4, ws + O_XN, NL);
    hipLaunchKernelGGL(k_route, dim3(NL / 4), dim3(256), 0, stream, p);
    hipLaunchKernelGGL(k_moe_plan, dim3(1), dim3(1024), 0, stream, p);
    hipLaunchKernelGGL(k_moe_gather, dim3((16384 * 512 + 255) / 256), dim3(256), 0, stream, p);
    const int* cntg = (const int*)(ws + O_ROUTE) + 32768; const int* offg = cntg + 8;
    for (int e = 0; e < NE; ++e) {
        gemm(stream, ws + O_XG, D, in[40] + (size_t)e * D * DFF, DFF, ws + O_G1, DFF, NL, DFF, D, 0, nullptr, nullptr, cntg + e, offg + e, 1);
        gemm(stream, ws + O_XG, D, in[41] + (size_t)e * D * DFF, DFF, ws + O_G3, DFF, NL, DFF, D, 0, nullptr, nullptr, cntg + e, offg + e, 1);
        hipLaunchKernelGGL(k_swiglu, dim3((unsigned)(((size_t)NL * DFF + 255) / 256)), dim3(256), 0, stream, ws + O_G1, ws + O_G3, (size_t)NL * DFF);
        gemm(stream, ws + O_G1, DFF, in[42] + (size_t)e * DFF * D, D, ws + O_OUT2, D, NL, D, DFF, 0, nullptr, nullptr, cntg + e, offg + e, 2);
    }
    hipLaunchKernelGGL(k_final, dim3(NL / 4), dim3(256), 0, stream, p);
}
```

```cpp
#include <hip/hip_runtime.h>
#include <cstdio>
#include <cstdint>

constexpr int D = 2048, NB = 2, SEQ = 4096, CTX = 256;
constexpr int NL = NB * SEQ;
constexpr int NCX = NB * CTX;
constexpr int MALL = NL + NCX;
constexpr int NMOD = 6 * D;
constexpr int QL = 512, KVL = 512, ROPE = 64, NOPE = 128, VH = 128, HM = 8;
constexpr int MLA_IN = QL + KVL + ROPE;
constexpr int RD = 1024, RH = 16, RN = 64;
constexpr int RWKV_IN = 3 * RD + 128 + 128 + 160;
__device__ __forceinline__ size_t hmi(int row, int col) { return ((size_t)(col >> 6) * (8192 + 2 * 256) + row) * 64 + (col & 63); }
constexpr int ZW = MLA_IN + RWKV_IN;
constexpr int ZLD = 4608;
constexpr int KLD = 1088;
constexpr int QW = HM * (NOPE + ROPE);
constexpr int KVW = HM * (NOPE + VH);
constexpr int SK = CTX + SEQ;
constexpr int DFF = 7168, NE = 8;
constexpr int NSLOT = 18432;

constexpr int LDS_BYTES = 163840, LDS_CTL = 162816;

__device__ __forceinline__ float wave_sum(float v) {
#pragma unroll
    for (int o = 32; o > 0; o >>= 1) v += __shfl_xor(v, o);
    return v;
}
__device__ __forceinline__ float sigmoidf_(float x) { return 1.0f / (1.0f + expf(-x)); }
__device__ __forceinline__ float siluf_(float x) { return x / (1.0f + expf(-x)); }

#define LAS __attribute__((address_space(3)))
typedef unsigned short bf16_t;
typedef short bf16x8 __attribute__((ext_vector_type(8)));
typedef float f32x4 __attribute__((ext_vector_type(4)));
typedef float f32x2 __attribute__((ext_vector_type(2)));
typedef unsigned u32x4 __attribute__((ext_vector_type(4)));
typedef unsigned u32x2 __attribute__((ext_vector_type(2)));
typedef int i32x8 __attribute__((ext_vector_type(8)));

__device__ __forceinline__ unsigned cvt_pk_bf16(float lo, float hi) { unsigned r; asm volatile("v_cvt_pk_bf16_f32 %0, %1, %2" : "=v"(r) : "v"(lo), "v"(hi)); return r; }
__device__ __forceinline__ unsigned pk4_fp8(float a, float b, float c, float d) { int p = __builtin_amdgcn_cvt_pk_fp8_f32(a, b, 0, false); p = __builtin_amdgcn_cvt_pk_fp8_f32(c, d, p, true); return (unsigned)p; }
__device__ __forceinline__ float bf2f(bf16_t b) { return __uint_as_float(((unsigned)b) << 16); }
__device__ __forceinline__ float fexp(float x) { return __builtin_amdgcn_exp2f(x * 1.4426950408889634f); }
__device__ __forceinline__ float flog(float x) { return __builtin_amdgcn_logf(x) * 0.6931471805599453f; }
__device__ __forceinline__ float fsigmoid(float x) { return __builtin_amdgcn_rcpf(1.0f + fexp(-x)); }
__device__ __forceinline__ float ftanh(float x) { return 1.0f - 2.0f * __builtin_amdgcn_rcpf(1.0f + fexp(2.0f * x)); }
__device__ __forceinline__ float rope_inv(int f) { const int q = f >> 2, r = f & 3; const float a = q == 0 ? 1.0f : q == 1 ? 0.1f : q == 2 ? 0.01f : 0.001f;
    const float b = r == 0 ? 1.0f : r == 1 ? 0.5623413251903491f : r == 2 ? 0.31622776601683794f : 0.1778279410038923f; return a * b; }

#define XB_TMO      128
#define XB_XCNT(j)  (256  + 64 * (j))
#define XB_XSUB(j)  (1280 + 64 * (j))
#define XB_XGEN(j)  (2304 + 64 * (j))
#define XB_TOP      3328
#define XB_TOPGEN   3392
#define XCD_BAR_WORDS 3456
#define XB_SPIN_CAP (1u << 18)
__device__ __forceinline__ unsigned xb_ld(unsigned* p)              { return __hip_atomic_load(p, __ATOMIC_RELAXED, __HIP_MEMORY_SCOPE_AGENT); }
__device__ __forceinline__ unsigned xb_add(unsigned* p, unsigned v) { return __hip_atomic_fetch_add(p, v, __ATOMIC_RELAXED, __HIP_MEMORY_SCOPE_AGENT); }
__device__ __forceinline__ unsigned xb_xcc_id() { return (unsigned)__builtin_amdgcn_s_getreg((3 << 11) | 20) & 0xFu; }
#define XB_SPIN(cond, bar) do { unsigned _sp = 0; while (cond) { __builtin_amdgcn_s_sleep(1); \
    if ((++_sp & 255u) == 0u) { if (xb_ld(&(bar)[XB_TMO])) break; if (_sp > XB_SPIN_CAP) { atomicAdd(&(bar)[XB_TMO], 1u); break; } } } } while (0)
struct XcdBarrier { unsigned* bar; unsigned x; volatile LAS unsigned* st; };
__device__ __forceinline__ XcdBarrier xcd_barrier_post(unsigned* bar, volatile LAS unsigned* st) {
    XcdBarrier b; b.bar = bar; b.x = xb_xcc_id(); b.st = st;
    if (threadIdx.x == 0) (void)xb_add(&bar[XB_XCNT(b.x)], 1u);
    return b;
}
__device__ __forceinline__ void xcd_barrier_complete(unsigned* bar, unsigned x, unsigned& nloc, unsigned& nx) {
    const unsigned G = gridDim.x * gridDim.y * gridDim.z;
    unsigned sum, cnt, mine, sp = 0u;
    for (;;) {
        sum = 0u; cnt = 0u; mine = 0u;
#pragma unroll
        for (unsigned j = 0; j < 16; ++j) { const unsigned c = xb_ld(&bar[XB_XCNT(j)]); sum += c; cnt += (c > 0u) ? 1u : 0u; mine = (j == x) ? c : mine; }
        if (sum == G) break;
        __builtin_amdgcn_s_sleep(1);
        if ((++sp & 255u) == 0u) { if (xb_ld(&bar[XB_TMO])) break; if (sp > XB_SPIN_CAP) { atomicAdd(&bar[XB_TMO], 1u); break; } }
    }
    nloc = mine > 0u ? mine : 1u; nx = cnt > 0u ? cnt : 1u;
}
__device__ __forceinline__ void xcd_barrier(const XcdBarrier& b) {
    asm volatile("s_waitcnt vmcnt(0)" ::: "memory");
    __syncthreads();
    if (threadIdx.x == 0) {
        unsigned* bar = b.bar;
        __builtin_amdgcn_s_waitcnt(0);
        unsigned nloc = b.st[0], nx = b.st[1];
        if (nloc == 0u) { xcd_barrier_complete(bar, b.x, nloc, nx); b.st[0] = nloc; b.st[1] = nx; }
        const unsigned old = xb_add(&bar[XB_XSUB(b.x)], 1u);
        const unsigned gen = old / nloc;
        if (old + 1u == (gen + 1u) * nloc) {
            __builtin_amdgcn_fence(__ATOMIC_RELEASE, "agent");
            asm volatile("s_waitcnt vmcnt(0)" ::: "memory");
            const unsigned og = xb_add(&bar[XB_TOP], 1u);
            const unsigned tg = og / nx;
            if (og + 1u == (tg + 1u) * nx) xb_add(&bar[XB_TOPGEN], 1u);
            else XB_SPIN(xb_ld(&bar[XB_TOPGEN]) == tg, bar);
            __builtin_amdgcn_fence(__ATOMIC_ACQUIRE, "agent");
            xb_add(&bar[XB_XGEN(b.x)], 1u);
            asm volatile("s_waitcnt vmcnt(0)" ::: "memory");
        } else {
            XB_SPIN(xb_ld(&bar[XB_XGEN(b.x)]) == gen, bar);
            __builtin_amdgcn_fence(__ATOMIC_ACQUIRE, "agent");
            asm volatile("s_waitcnt vmcnt(0)" ::: "memory");
        }
    }
    __syncthreads();
}

namespace pg8 {
constexpr int BM = 256, BK = 64, HALF = 128, HTB = HALF * BK * 2, STAGE_BYTES = 8 * HTB, NXCD = 8, WGM = 8;
__host__ __device__ __forceinline__ int lds_byte(int r, int c) { const int st = (r >> 4) * 2 + (c >> 5), rr = r & 15, cc = c & 31, ob = rr * 64 + cc * 2; return st * 1024 + (ob ^ (((ob >> 9) & 1) << 5)); }
__host__ __device__ __forceinline__ void stage_rc(int b, int& R, int& C) { const int st = b / 1024, sb = b % 1024, swz = sb ^ (((sb >> 9) & 1) << 5); R = (st >> 1) * 16 + swz / 64; C = (st & 1) * 32 + (swz % 64) / 2; }
__host__ __device__ __forceinline__ int perm32(int rho) { const int n = rho >> 4, i = rho & 15; return 8 * (i >> 2) + 4 * n + (i & 3); }
struct Unit { int pm, pn, kind; const char* a; const char* b; };

struct DenseOrder {
    int nM, nN, nwg, G, c, lda, ldb; const char* A; const char* B;
    __device__ void init(const bf16_t* A_, int lda_, const bf16_t* B_, int ldb_, int M, int N, int G_, int c_) { A = (const char*)A_; B = (const char*)B_; lda = lda_; ldb = ldb_; nM = M / BM; nN = N / BM; nwg = nM * nN; G = G_; c = c_; }
    __device__ bool next(int i, Unit& u) const {
        const long L = (long)i * G + c; if (L >= nwg) return false;
        int wgid = (int)L; { const int q = nwg / NXCD, r = nwg % NXCD, xcd = wgid % NXCD, off = wgid / NXCD; wgid = (xcd < r ? xcd * (q + 1) : r * (q + 1) + (xcd - r) * q) + off; }
        const int nig = WGM * nN, gid = wgid / nig, fm = gid * WGM, gsz = (nM - fm) < WGM ? (nM - fm) : WGM;
        u.pm = fm + ((wgid % nig) % gsz); u.pn = (wgid % nig) / gsz; u.kind = 0;
        u.a = A + (size_t)u.pm * BM * lda * 2; u.b = B + (size_t)u.pn * BM * ldb * 2; return true;
    }
};

template <class Epi, class Sched, bool ALIGN_EPI = false, bool SP2 = false, bool FP8 = false>
__device__ __forceinline__ void gemm_phase(LAS unsigned char* lds, const int K, const int lda, const int ldb, const Sched& S, const Epi& E) {
    const int tid = threadIdx.x, wid = __builtin_amdgcn_readfirstlane(tid >> 6), lane = tid & 63, wr = wid >> 2, wc = wid & 3, fr = lane & 15, fq = lane >> 4;
    const int nt = K / BK;
    unsigned voffA[2], voffB[2];
#pragma unroll
    for (int i = 0; i < 2; ++i) { int R, C; stage_rc(tid * 16 + i * 8192, R, C); const int Rb = Epi::PERM ? ((R & ~31) + perm32(R & 31)) : R;
        voffA[i] = (unsigned)(R * lda + C) * 2u; voffB[i] = (unsigned)(Rb * ldb + C) * 2u; }
    const size_t kstep = (size_t)(BK * 2);
    const size_t hstepA = (size_t)HALF * lda * 2, hstepB = (size_t)HALF * ldb * 2;
    const unsigned ldsw = (unsigned)wid * 1024u;
    const int aoff = lds_byte(wr * 64 + fr, fq * 8), boff = lds_byte(wc * 32 + fr, fq * 8);
#define PG8_SA(b, h) (((b) * 2 + (h)) * HTB)
#define PG8_SB(b, h) ((4 + (b) * 2 + (h)) * HTB)
#define PG8_STAGE(bufoff, gbase, voff) do { _Pragma("unroll") for (int _i = 0; _i < 2; ++_i) \
        __builtin_amdgcn_global_load_lds((const unsigned*)((const char*)(gbase) + (voff)[_i]), (LAS unsigned*)(lds + (bufoff) + ldsw + _i * 8192), 16, 0, 0); } while (0)
#define PG8_LDA(dst, b, h) do { _Pragma("unroll") for (int m = 0; m < 4; ++m) _Pragma("unroll") for (int k = 0; k < 2; ++k) dst[m][k] = *(const LAS bf16x8*)(lds + PG8_SA(b, h) + aoff + m * 2048 + k * 1024); } while (0)
#define PG8_LDB(dst, b, h) do { _Pragma("unroll") for (int n = 0; n < 2; ++n) _Pragma("unroll") for (int k = 0; k < 2; ++k) dst[n][k] = *(const LAS bf16x8*)(lds + PG8_SB(b, h) + boff + n * 2048 + k * 1024); } while (0)
#define PG8_CAT(x) __builtin_bit_cast(i32x8, __builtin_shufflevector((x)[0], (x)[1], 0, 1, 2, 3, 4, 5, 6, 7, 8, 9, 10, 11, 12, 13, 14, 15))
#define PG8_MMA(ai, bj, At, Bt) do { __builtin_amdgcn_s_setprio(1); _Pragma("unroll") for (int m = 0; m < 4; ++m) _Pragma("unroll") for (int n = 0; n < 2; ++n) { \
        if constexpr (FP8) { asm volatile("v_mfma_f32_16x16x128_f8f6f4 %0, %1, %2, %0" : "+v"(acc[ai][bj][m][n]) : "v"(PG8_CAT(Bt[n])), "v"(PG8_CAT(At[m]))); } \
        else { _Pragma("unroll") for (int k = 0; k < 2; ++k) acc[ai][bj][m][n] = __builtin_amdgcn_mfma_f32_16x16x32_bf16(Bt[n][k], At[m][k], acc[ai][bj][m][n], 0, 0, 0); } } \
        __builtin_amdgcn_s_setprio(0); } while (0)
#define PG8_WAIT_V(n) asm volatile("s_waitcnt vmcnt(" #n ")" ::: "memory")
#define PG8_WAIT_L(n) asm volatile("s_waitcnt lgkmcnt(" #n ")" ::: "memory")
#define PG8_BAR __builtin_amdgcn_s_barrier()
#define PG8_SCHED __builtin_amdgcn_sched_barrier(0)
    Unit cur, nxt; int ui = 0;
    if (!S.next(0, cur)) return;
    f32x4 acc[2][2][4][2];
#pragma unroll
    for (int a = 0; a < 2; ++a)
#pragma unroll
        for (int b = 0; b < 2; ++b)
#pragma unroll
            for (int m = 0; m < 4; ++m)
#pragma unroll
                for (int n = 0; n < 2; ++n) acc[a][b][m][n] = (f32x4){0.f, 0.f, 0.f, 0.f};
    bf16x8 At[4][2], B0[2][2], B1[2][2];
    const char* cA = cur.a; const char* cB = cur.b;
    if constexpr (SP2) {
        PG8_STAGE(PG8_SB(0, 0), cB, voffB); PG8_STAGE(PG8_SB(0, 1), cB + hstepB, voffB); PG8_STAGE(PG8_SA(0, 0), cA, voffA); PG8_STAGE(PG8_SA(0, 1), cA + hstepA, voffA);
        if (wr == 1) PG8_BAR;
        PG8_WAIT_V(2); PG8_BAR;
        PG8_STAGE(PG8_SB(1, 0), cB + kstep, voffB); PG8_STAGE(PG8_SA(1, 0), cA + kstep, voffA); PG8_STAGE(PG8_SB(1, 1), cB + hstepB + kstep, voffB);
        PG8_WAIT_V(6); PG8_BAR;
    } else {
        PG8_STAGE(PG8_SB(0, 0), cB, voffB); PG8_STAGE(PG8_SA(0, 0), cA, voffA); PG8_STAGE(PG8_SB(0, 1), cB + hstepB, voffB); PG8_STAGE(PG8_SA(0, 1), cA + hstepA, voffA);
        if (wr == 1) PG8_BAR;
        PG8_WAIT_V(4); PG8_BAR;
        PG8_STAGE(PG8_SB(1, 0), cB + kstep, voffB); PG8_STAGE(PG8_SA(1, 0), cA + kstep, voffA); PG8_STAGE(PG8_SB(1, 1), cB + hstepB + kstep, voffB);
        PG8_WAIT_V(6); PG8_BAR;
    }
    for (;;) {
        const bool has_next = S.next(ui + 1, nxt);
        const char* nA = has_next ? nxt.a : cA; const char* nB = has_next ? nxt.b : cB;
        for (int t = 0; t < nt; t += 2) {
            const bool last = (t == nt - 2);
            const char* a1 = cA + (size_t)(t + 1) * kstep;
            const char* a2 = last ? nA : cA + (size_t)(t + 2) * kstep; const char* b2 = last ? nB : cB + (size_t)(t + 2) * kstep;
            const char* a3 = a2 + kstep; const char* b3 = b2 + kstep;
            if constexpr (SP2) {
            PG8_LDB(B0, 0, 0); PG8_LDB(B1, 0, 1); PG8_SCHED; PG8_LDA(At, 0, 0); PG8_STAGE(PG8_SA(1, 1), a1 + hstepA, voffA);
            PG8_WAIT_V(8); PG8_WAIT_L(0); PG8_BAR; PG8_MMA(0, 0, At, B0); PG8_MMA(0, 1, At, B1); PG8_BAR; PG8_SCHED;
            PG8_LDA(At, 0, 1); PG8_STAGE(PG8_SB(0, 0), b2, voffB); PG8_STAGE(PG8_SB(0, 1), b2 + hstepB, voffB); PG8_STAGE(PG8_SA(0, 0), a2, voffA);
            PG8_WAIT_V(8); PG8_WAIT_L(0); PG8_BAR; PG8_MMA(1, 0, At, B0); PG8_MMA(1, 1, At, B1); PG8_BAR; PG8_SCHED;
            PG8_LDB(B0, 1, 0); PG8_LDB(B1, 1, 1); PG8_SCHED; PG8_LDA(At, 1, 0); PG8_STAGE(PG8_SA(0, 1), a2 + hstepA, voffA);
            PG8_WAIT_V(8); PG8_WAIT_L(0); PG8_BAR; PG8_MMA(0, 0, At, B0); PG8_MMA(0, 1, At, B1); PG8_BAR; PG8_SCHED;
            PG8_LDA(At, 1, 1); PG8_STAGE(PG8_SB(1, 0), b3, voffB); PG8_STAGE(PG8_SB(1, 1), b3 + hstepB, voffB); PG8_STAGE(PG8_SA(1, 0), a3, voffA);
            PG8_WAIT_V(8); PG8_WAIT_L(0); PG8_BAR; PG8_MMA(1, 0, At, B0); PG8_MMA(1, 1, At, B1); PG8_BAR; PG8_SCHED;
            } else {
            PG8_LDB(B0, 0, 0); PG8_SCHED; PG8_LDA(At, 0, 0); PG8_STAGE(PG8_SA(1, 1), a1 + hstepA, voffA);
            PG8_WAIT_L(8); PG8_BAR; PG8_WAIT_L(0); PG8_MMA(0, 0, At, B0); PG8_BAR; PG8_SCHED;
            PG8_LDB(B1, 0, 1); PG8_STAGE(PG8_SB(0, 0), b2, voffB);
            PG8_BAR; PG8_WAIT_L(0); PG8_MMA(0, 1, At, B1); PG8_BAR;
            PG8_LDA(At, 0, 1); PG8_STAGE(PG8_SA(0, 0), a2, voffA);
            PG8_BAR; PG8_WAIT_L(0); PG8_MMA(1, 0, At, B0); PG8_BAR; PG8_SCHED;
            PG8_STAGE(PG8_SB(0, 1), b2 + hstepB, voffB);
            PG8_WAIT_V(6); PG8_BAR; PG8_MMA(1, 1, At, B1); PG8_BAR;
            PG8_LDB(B0, 1, 0); PG8_SCHED; PG8_LDA(At, 1, 0); PG8_STAGE(PG8_SA(0, 1), a2 + hstepA, voffA);
            PG8_WAIT_L(8); PG8_BAR; PG8_WAIT_L(0); PG8_MMA(0, 0, At, B0); PG8_BAR; PG8_SCHED;
            PG8_LDB(B1, 1, 1); PG8_STAGE(PG8_SB(1, 0), b3, voffB);
            PG8_BAR; PG8_WAIT_L(0); PG8_MMA(0, 1, At, B1); PG8_BAR;
            PG8_LDA(At, 1, 1); PG8_STAGE(PG8_SA(1, 0), a3, voffA);
            PG8_BAR; PG8_WAIT_L(0); PG8_MMA(1, 0, At, B0); PG8_BAR; PG8_SCHED;
            PG8_STAGE(PG8_SB(1, 1), b3 + hstepB, voffB);
            PG8_WAIT_V(6); PG8_BAR; PG8_MMA(1, 1, At, B1); PG8_BAR;
            }
        }
        if constexpr (ALIGN_EPI) { if (wr == 0) PG8_BAR; }
        if constexpr (FP8) asm volatile("s_nop 15\n\ts_nop 15\n\ts_nop 7" ::: "memory");
        E(acc, cur, wr, wc, fr, fq);
        if (!has_next) break;
#pragma unroll
        for (int a = 0; a < 2; ++a)
#pragma unroll
            for (int b = 0; b < 2; ++b)
#pragma unroll
                for (int m = 0; m < 4; ++m)
#pragma unroll
                    for (int n = 0; n < 2; ++n) acc[a][b][m][n] = (f32x4){0.f, 0.f, 0.f, 0.f};
        cur = nxt; cA = nA; cB = nB; ++ui;
        if constexpr (ALIGN_EPI) { if (wr == 1) PG8_BAR; }
    }
    PG8_WAIT_V(0);
    if constexpr (!ALIGN_EPI) { if (wr == 0) PG8_BAR; }
    PG8_BAR;
#undef PG8_SA
#undef PG8_SB
#undef PG8_STAGE
#undef PG8_LDA
#undef PG8_LDB
#undef PG8_MMA
#undef PG8_CAT
#undef PG8_WAIT_V
#undef PG8_WAIT_L
#undef PG8_BAR
#undef PG8_SCHED
}
}
using pg8::Unit;

typedef const f32x4 (&AccRef)[2][2][4][2];
struct EpiF32 { static constexpr bool PERM = false; float* C; int ldc;
    __device__ __forceinline__ void operator()(AccRef acc, const Unit& u, int wr, int wc, int fr, int fq) const {
        const int row0 = u.pm * 256 + wr * 64 + fr, col0 = u.pn * 256 + wc * 32 + 4 * fq;
#pragma unroll
        for (int ai = 0; ai < 2; ++ai)
#pragma unroll
            for (int m = 0; m < 4; ++m) { float* rowp = C + (size_t)(row0 + ai * 128 + m * 16) * ldc + col0;
#pragma unroll
                for (int bj = 0; bj < 2; ++bj)
#pragma unroll
                    for (int n = 0; n < 2; ++n) *(f32x4*)(rowp + bj * 128 + n * 16) = acc[ai][bj][m][n]; }
    } };
struct EpiRes { static constexpr bool PERM = false; float* C; const float* R; const float* gate;
    __device__ __forceinline__ void operator()(AccRef acc, const Unit& u, int wr, int wc, int fr, int fq) const {
        const int row0 = u.pm * 256 + wr * 64 + fr, col0 = u.pn * 256 + wc * 32 + 4 * fq;
        const float* gp = gate + (size_t)((u.pm * 256) / SEQ) * NMOD + col0;
        f32x4 gv[2][2];
#pragma unroll
        for (int bj = 0; bj < 2; ++bj)
#pragma unroll
            for (int n = 0; n < 2; ++n) gv[bj][n] = *(const f32x4*)(gp + bj * 128 + n * 16);
#pragma unroll
        for (int ai = 0; ai < 2; ++ai)
#pragma unroll
            for (int m = 0; m < 4; ++m) { const size_t off = (size_t)(row0 + ai * 128 + m * 16) * D + col0;
#pragma unroll
                for (int bj = 0; bj < 2; ++bj)
#pragma unroll
                    for (int n = 0; n < 2; ++n) { const f32x4 r = *(const f32x4*)(R + off + bj * 128 + n * 16); *(f32x4*)(C + off + bj * 128 + n * 16) = r + gv[bj][n] * acc[ai][bj][m][n]; } }
    } };
struct EpiSwiglu { static constexpr bool PERM = true; bf16_t* O; int ldo;
    __device__ __forceinline__ void operator()(AccRef acc, const Unit& u, int wr, int wc, int fr, int fq) const {
        const int row0 = u.pm * 256 + wr * 64 + fr, col0 = u.pn * 128 + wc * 32 + 8 * fq;
#pragma unroll
        for (int ai = 0; ai < 2; ++ai)
#pragma unroll
            for (int m = 0; m < 4; ++m) { bf16_t* rowp = O + (size_t)(row0 + ai * 128 + m * 16) * ldo + col0;
                float o[8];
#pragma unroll
                for (int n = 0; n < 2; ++n)
#pragma unroll
                    for (int j = 0; j < 4; ++j) { const float a = acc[ai][0][m][n][j], b = acc[ai][1][m][n][j]; o[n * 4 + j] = a * __builtin_amdgcn_rcpf(1.0f + __expf(-a)) * b; }
                u32x4 w; w.x = cvt_pk_bf16(o[0], o[1]); w.y = cvt_pk_bf16(o[2], o[3]); w.z = cvt_pk_bf16(o[4], o[5]); w.w = cvt_pk_bf16(o[6], o[7]);
                *(u32x4*)rowp = w; }
    } };

struct EpiSwigluF8 { static constexpr bool PERM = true; unsigned char* O; int ldo; float sc;
    __device__ __forceinline__ void operator()(AccRef acc, const Unit& u, int wr, int wc, int fr, int fq) const {
        const int row0 = u.pm * 256 + wr * 64 + fr, col0 = u.pn * 128 + wc * 32 + 8 * fq;
#pragma unroll
        for (int ai = 0; ai < 2; ++ai)
#pragma unroll
            for (int m = 0; m < 4; ++m) { unsigned char* rowp = O + (size_t)(row0 + ai * 128 + m * 16) * ldo + col0;
                float o[8];
#pragma unroll
                for (int n = 0; n < 2; ++n)
#pragma unroll
                    for (int j = 0; j < 4; ++j) { const float a = acc[ai][0][m][n][j] * sc, b = acc[ai][1][m][n][j] * sc; o[n * 4 + j] = a * __builtin_amdgcn_rcpf(1.0f + __expf(-a)) * b; }
                u32x2 w; w.x = pk4_fp8(o[0], o[1], o[2], o[3]); w.y = pk4_fp8(o[4], o[5], o[6], o[7]);
                *(u32x2*)rowp = w; }
    } };
struct EpiBf16S { static constexpr bool PERM = true; bf16_t* O; int ldo; float sc;
    __device__ __forceinline__ void operator()(AccRef acc, const Unit& u, int wr, int wc, int fr, int fq) const {
        const int row0 = u.pm * 256 + wr * 64 + fr, col0 = u.pn * 256 + wc * 32 + 8 * fq;
#pragma unroll
        for (int ai = 0; ai < 2; ++ai)
#pragma unroll
            for (int m = 0; m < 4; ++m) { bf16_t* rowp = O + (size_t)(row0 + ai * 128 + m * 16) * ldo + col0;
#pragma unroll
                for (int bj = 0; bj < 2; ++bj) { const f32x4 v0 = acc[ai][bj][m][0] * sc, v1 = acc[ai][bj][m][1] * sc;
                    u32x4 w; w.x = cvt_pk_bf16(v0[0], v0[1]); w.y = cvt_pk_bf16(v0[2], v0[3]); w.z = cvt_pk_bf16(v1[0], v1[1]); w.w = cvt_pk_bf16(v1[2], v1[3]);
                    *(u32x4*)(rowp + bj * 128) = w; } }
    } };

struct MapPlain { const float* src; int ld, ncols;
    __device__ __forceinline__ const float* operator()(int n0) const { return n0 < ncols ? src + n0 : nullptr; } __device__ __forceinline__ int stride() const { return ld; } __device__ __forceinline__ bool valid(int n) const { return n < ncols; } };
struct MapIl { const float* s1; long d31; int ld;
    __device__ __forceinline__ const float* operator()(int n0) const { const int t = n0 >> 8, j = n0 & 255; return s1 + (j < 128 ? 0l : d31) + t * 128 + (j & 127); } __device__ __forceinline__ int stride() const { return ld; } __device__ __forceinline__ bool valid(int) const { return true; } };
template <bool FP8, class MAP>
__device__ __forceinline__ void cvt_ring(LAS unsigned char* lds, const MAP& map, void* dstv, int Nd, int K, float scale, int G, int c) {
    constexpr int NS = 4, SLOT = 32768;
    const int tid = threadIdx.x, wave = __builtin_amdgcn_readfirstlane(tid >> 6), lane = tid & 63;
    const int ntk = K / 128, nnt = Nd / 64, ntiles = nnt * ntk;
    if (c >= ntiles) return;
    const int nmine = (ntiles - c + G - 1) / G;
    const int ld = map.stride();
    __syncthreads();
    auto issue = [&](int it) {
        const int itc = it < nmine ? it : nmine - 1, tile = c + itc * G;
        const int n0 = (tile % nnt) * 64, k0 = (tile / nnt) * 128;
        const float* sp = map(n0);
        const int col = (lane & 15) * 4, colc = (sp && map.valid(n0 + col)) ? col : 0;
        const float* base = (sp ? sp : map(0)) + colc;
        LAS unsigned char* sl = lds + (it % NS) * SLOT + wave * 4096;
#pragma unroll
        for (int i = 0; i < 4; ++i)
            __builtin_amdgcn_global_load_lds((const unsigned*)(base + (size_t)(k0 + wave * 16 + i * 4 + (lane >> 4)) * ld), (LAS unsigned*)(sl + i * 1024), 16, 0, 0);
    };
#pragma unroll
    for (int i = 0; i < NS - 1; ++i) issue(i);
    for (int it = 0; it < nmine; ++it) {
        asm volatile("s_waitcnt vmcnt(8)" ::: "memory");
        __syncthreads();
        issue(it + NS - 1);
        const int tile = c + it * G, n0 = (tile % nnt) * 64, k0 = (tile / nnt) * 128;
        const LAS float* T = (const LAS float*)(lds + (it % NS) * SLOT);
        const bool ok = map(n0) != nullptr && map.valid(n0 + lane);
        if constexpr (FP8) {
            float v[16];
#pragma unroll
            for (int j = 0; j < 16; ++j) v[j] = ok ? T[(wave * 16 + j) * 64 + lane] * scale : 0.f;
            u32x4 w; w.x = pk4_fp8(v[0], v[1], v[2], v[3]); w.y = pk4_fp8(v[4], v[5], v[6], v[7]); w.z = pk4_fp8(v[8], v[9], v[10], v[11]); w.w = pk4_fp8(v[12], v[13], v[14], v[15]);
            *(u32x4*)((unsigned char*)dstv + (size_t)(n0 + lane) * K + k0 + wave * 16) = w;
        } else {
#pragma unroll
            for (int h = 0; h < 2; ++h) { const int kg = wave + 8 * h; float v[8];
#pragma unroll
                for (int j = 0; j < 8; ++j) v[j] = ok ? T[(kg * 8 + j) * 64 + lane] : 0.f;
                u32x4 w; w.x = cvt_pk_bf16(v[0], v[1]); w.y = cvt_pk_bf16(v[2], v[3]); w.z = cvt_pk_bf16(v[4], v[5]); w.w = cvt_pk_bf16(v[6], v[7]);
                *(u32x4*)((bf16_t*)dstv + (size_t)(n0 + lane) * K + k0 + kg * 8) = w; }
        }
    }
    asm volatile("s_waitcnt vmcnt(0)" ::: "memory");
    __syncthreads();
}
template <class MAP> __device__ __forceinline__ void cvt_T(LAS unsigned char* lds, const MAP& map, bf16_t* dst, int Nd, int K, int G, int c) { cvt_ring<false>(lds, map, dst, Nd, K, 1.f, G, c); }
template <class MAP> __device__ __forceinline__ void cvt_T8(LAS unsigned char* lds, const MAP& map, unsigned char* dst, int Nd, int K, float scale, int G, int c) { cvt_ring<true>(lds, map, dst, Nd, K, scale, G, c); }
__device__ __forceinline__ void cvt_copy(const float* src, bf16_t* dst, size_t n, int G, int c) {
    for (size_t i = ((size_t)c * 512 + threadIdx.x) * 8; i < n; i += (size_t)G * 512 * 8) {
        const float4 a = *(const float4*)(src + i), b = *(const float4*)(src + i + 4);
        u32x4 w; w.x = cvt_pk_bf16(a.x, a.y); w.y = cvt_pk_bf16(a.z, a.w); w.z = cvt_pk_bf16(b.x, b.y); w.w = cvt_pk_bf16(b.z, b.w);
        *(u32x4*)(dst + i) = w;
    }
}


__device__ __forceinline__ f32x2 gelu_pk(f32x2 v) {
    const f32x2 av = __builtin_elementwise_abs(v), d = av * 0.2316418882f + 1.0f;
    f32x2 t; t.x = __builtin_amdgcn_rcpf(d.x); t.y = __builtin_amdgcn_rcpf(d.y);
    f32x2 q = t * 0.5307027145f + (-0.7265760135f); q = q * t + 0.7107068705f; q = q * t + (-0.142248368f); q = q * t + 0.127414796f; q = q * t;
    const f32x2 s = (v * v) * (-0.72134752044f);
    f32x2 e; e.x = __builtin_amdgcn_exp2f(s.x); e.y = __builtin_amdgcn_exp2f(s.y);
    const f32x2 m = v * (q * e), r = v - m;
    f32x2 o; o.x = v.x < 0.f ? m.x : r.x; o.y = v.y < 0.f ? m.y : r.y; return o;
}
struct EpiGelu { static constexpr bool PERM = false; bf16_t* U; float* VG;
    __device__ __forceinline__ void operator()(AccRef acc, const Unit& u, int wr, int wc, int fr, int fq) const {
        const int row0 = u.pm * 256 + wr * 64 + fr, col0 = (u.pn & 7) * 256 + wc * 32 + 4 * fq;
        const bool isu = u.pn < 8;
#pragma unroll
        for (int ai = 0; ai < 2; ++ai)
#pragma unroll
            for (int m = 0; m < 4; ++m) { const size_t off = (size_t)(row0 + ai * 128 + m * 16) * D + col0;
#pragma unroll
                for (int bj = 0; bj < 2; ++bj)
#pragma unroll
                    for (int n = 0; n < 2; ++n) { const f32x4 v = acc[ai][bj][m][n];
                        const f32x2 a = gelu_pk((f32x2){v[0], v[1]}), b = gelu_pk((f32x2){v[2], v[3]});
                        if (isu) { u32x2 w; w.x = cvt_pk_bf16(a.x, a.y); w.y = cvt_pk_bf16(b.x, b.y); *(u32x2*)(U + off + bj * 128 + n * 16) = w; }
                        else *(f32x4*)(VG + off + bj * 128 + n * 16) = (f32x4){a.x, a.y, b.x, b.y}; } }
    } };

namespace pg8 {
struct MoeOrder {
    int cnt_t[8], off_t[8], nN, G, c, lda, ldb; const char* A; const char* B; size_t bstride;
    __device__ void init(const int* cnt, const int* off, const bf16_t* A_, int lda_, const bf16_t* B_, int ldb_, size_t bstride_bytes, int N, int G_, int c_) {
#pragma unroll
        for (int e = 0; e < 8; ++e) { cnt_t[e] = __builtin_amdgcn_readfirstlane((cnt[e] + 255) >> 8); off_t[e] = __builtin_amdgcn_readfirstlane(off[e] >> 8); }
        A = (const char*)A_; B = (const char*)B_; lda = lda_; ldb = ldb_; bstride = bstride_bytes; nN = N / 256; G = G_; c = c_;
    }
    __device__ bool next(int i, Unit& u) const {
        const int L = i * G + c, x = L & 7; int q = L >> 3; int e = 0; bool found = false; int te = 0, oe = 0;
        const int n8 = nN >> 3;
#pragma unroll
        for (int k = 0; k < 8; ++k) { const int ue = cnt_t[k] * n8; if (!found) { if (q < ue) { found = true; e = k; te = cnt_t[k]; oe = off_t[k]; } else q -= ue; } }
        if (!found) return false;
        const int pml = q % te; u.pn = (q / te) * 8 + x; u.pm = oe + pml; u.kind = e;
        u.a = A + (size_t)u.pm * 256 * lda * 2; u.b = B + (size_t)e * bstride + (size_t)u.pn * 256 * ldb * 2; return true;
    }
};
}

template <bool ROUTE>
__device__ __forceinline__ void ph_norm_mod(LAS unsigned char* lds, const float* srcL, const float* srcC, const float* gain, const float* mod, int chunk_sh, int chunk_sc, bf16_t* dst, int nrows,
                                            const float* router, int* tope, float* topg, int* bcnt, int G, int bid) {
    const int tid = threadIdx.x, wave = tid >> 6, lane = tid & 63;
    const int rpb = (nrows + G - 1) / G, r0 = bid * rpb, r1 = min(nrows, r0 + rpb);
    LAS int* lc = (LAS int*)lds;
    if (ROUTE) { if (tid < 8) lc[tid] = 0; __syncthreads(); }
    int cur_mrow = -1; float gm[32], shv[32];
    for (int row = r0 + wave; row < r1; row += 8) {
        const float* src = row < NL ? srcL + (size_t)row * D : srcC + (size_t)(row - NL) * D;
        const int mrow = row < NL ? row / SEQ : 2;
        if (mrow != cur_mrow) { cur_mrow = mrow;
            const float* sh_ = mod + (size_t)mrow * NMOD + chunk_sh * D; const float* sc_ = mod + (size_t)mrow * NMOD + chunk_sc * D;
#pragma unroll
            for (int i = 0; i < 8; ++i) { const int c = i * 256 + lane * 4; const float4 g4 = *(const float4*)(gain + c), sc4 = *(const float4*)(sc_ + c), sh4 = *(const float4*)(sh_ + c);
                gm[i * 4] = g4.x * (1.f + sc4.x); gm[i * 4 + 1] = g4.y * (1.f + sc4.y); gm[i * 4 + 2] = g4.z * (1.f + sc4.z); gm[i * 4 + 3] = g4.w * (1.f + sc4.w);
                shv[i * 4] = sh4.x; shv[i * 4 + 1] = sh4.y; shv[i * 4 + 2] = sh4.z; shv[i * 4 + 3] = sh4.w; } }
        float v[32]; float ss = 0.f;
#pragma unroll
        for (int i = 0; i < 8; ++i) { const float4 x = *(const float4*)(src + i * 256 + lane * 4); v[i * 4] = x.x; v[i * 4 + 1] = x.y; v[i * 4 + 2] = x.z; v[i * 4 + 3] = x.w; ss += x.x * x.x + x.y * x.y + x.z * x.z + x.w * x.w; }
        ss = wave_sum(ss);
        const float rs = rsqrtf(ss * (1.0f / D) + 1e-6f);
        float a[8];
        if (ROUTE) {
#pragma unroll
            for (int e = 0; e < 8; ++e) a[e] = 0.f;
        }
#pragma unroll
        for (int i = 0; i < 8; ++i) {
            const int c = i * 256 + lane * 4;
            float o[4];
            o[0] = v[i * 4] * rs * gm[i * 4] + shv[i * 4]; o[1] = v[i * 4 + 1] * rs * gm[i * 4 + 1] + shv[i * 4 + 1];
            o[2] = v[i * 4 + 2] * rs * gm[i * 4 + 2] + shv[i * 4 + 2]; o[3] = v[i * 4 + 3] * rs * gm[i * 4 + 3] + shv[i * 4 + 3];
            if (ROUTE) *(unsigned*)((unsigned char*)dst + (size_t)row * D + c) = pk4_fp8(o[0], o[1], o[2], o[3]);
            else { u32x2 w; w.x = cvt_pk_bf16(o[0], o[1]); w.y = cvt_pk_bf16(o[2], o[3]); *(u32x2*)(dst + (size_t)row * D + c) = w; }
            if (ROUTE) {
#pragma unroll
                for (int j = 0; j < 4; ++j) { const float4 ra = *(const float4*)(router + (size_t)(c + j) * 8), rb = *(const float4*)(router + (size_t)(c + j) * 8 + 4);
                    a[0] += o[j] * ra.x; a[1] += o[j] * ra.y; a[2] += o[j] * ra.z; a[3] += o[j] * ra.w; a[4] += o[j] * rb.x; a[5] += o[j] * rb.y; a[6] += o[j] * rb.z; a[7] += o[j] * rb.w; }
            }
        }
        if (ROUTE) {
#pragma unroll
            for (int e = 0; e < 8; ++e) a[e] = wave_sum(a[e]);
            if (lane == 0) {
                int e0 = 0; float v0 = a[0];
#pragma unroll
                for (int e = 1; e < 8; ++e) if (a[e] > v0) { v0 = a[e]; e0 = e; }
                int e1 = 0; float v1 = -3e38f;
#pragma unroll
                for (int e = 0; e < 8; ++e) if (e != e0 && a[e] > v1) { v1 = a[e]; e1 = e; }
                const float ex = fexp(v1 - v0);
                tope[row * 2] = e0; tope[row * 2 + 1] = e1;
                topg[row * 2] = 1.f / (1.f + ex); topg[row * 2 + 1] = ex / (1.f + ex);
                atomicAdd((int*)&lc[e0], 1); atomicAdd((int*)&lc[e1], 1);
            }
        }
    }
    if (ROUTE) { __syncthreads(); if (tid < 8) bcnt[bid * 8 + tid] = lc[tid]; __syncthreads(); }
}

__device__ __forceinline__ void ph_moe_plan(LAS unsigned char* lds, const int* bcnt, const int* tope, int* slot, int* cntoff, const bf16_t* XNB, bf16_t* XG, int G, int bid) {
    const int tid = threadIdx.x;
    LAS int* base = (LAS int*)lds;
    LAS int* sl = base + 8;
    const int rpb = (NL + G - 1) / G, r0 = bid * rpb, r1 = min(NL, r0 + rpb);
    __syncthreads();
    for (int a = tid; a < (r1 - r0) * 2; a += 512) base[48 + 160 + a] = tope[r0 * 2 + a];
    if (tid < 8) {
        int tot = 0, pre = 0;
        for (int b = 0; b < G; ++b) { const int v = bcnt[b * 8 + tid]; tot += v; pre += (b < bid) ? v : 0; }
        base[16 + tid] = tot; base[32 + tid] = pre;
    }
    __syncthreads();
    if (tid == 0) {
        int off = 0;
        for (int e = 0; e < 8; ++e) { const int tot = base[16 + e]; base[e] = off + base[32 + e]; if (bid == 0) { cntoff[e] = tot; cntoff[8 + e] = off; } off += (tot + 255) & ~255; }
        int cur[8];
#pragma unroll
        for (int e = 0; e < 8; ++e) cur[e] = base[e];
        for (int a = r0 * 2; a < r1 * 2; ++a) { const int e = base[48 + 160 + a - r0 * 2]; int s = 0;
#pragma unroll
            for (int q = 0; q < 8; ++q) if (e == q) { s = cur[q]; cur[q]++; }
            slot[a] = s; base[48 + a - r0 * 2] = s; }
    }
    __syncthreads();
    const int na = (r1 - r0) * 2;
    for (int i = tid; i < na * 128; i += 512) { const int a = i >> 7, c16 = i & 127; const int s = base[48 + a], row = r0 + (a >> 1);
        *(u32x4*)((unsigned char*)XG + (size_t)s * D + c16 * 16) = *(const u32x4*)((const unsigned char*)XNB + (size_t)row * D + c16 * 16); }
    __syncthreads();
}

__device__ __forceinline__ void ph_ln_transpose(LAS unsigned char* lds, const float* VG, const float* lnw, const float* lnb, bf16_t* VT, int G, int bid) {
    const int tid = threadIdx.x, wave = tid >> 6, lane = tid & 63;
    LAS bf16_t* T = (LAS bf16_t*)lds;
    for (int unit = bid; unit < NL / 32; unit += G) {
        const int row0 = unit * 32;
        __syncthreads();
        for (int rr = wave; rr < 32; rr += 8) {
            const float* src = VG + (size_t)(row0 + rr) * D;
            float v[32]; float s = 0.f;
#pragma unroll
            for (int i = 0; i < 8; ++i) { const float4 x = *(const float4*)(src + i * 256 + lane * 4); v[i * 4] = x.x; v[i * 4 + 1] = x.y; v[i * 4 + 2] = x.z; v[i * 4 + 3] = x.w; s += (x.x + x.y) + (x.z + x.w); }
            const float mu = wave_sum(s) * (1.f / 2048.f);
            float q = 0.f;
#pragma unroll
            for (int i = 0; i < 32; ++i) { const float dd = v[i] - mu; q += dd * dd; }
            const float rs = rsqrtf(wave_sum(q) * (1.f / 2048.f) + 1e-5f);
#pragma unroll
            for (int i = 0; i < 8; ++i) { const int c = i * 256 + lane * 4;
                const float4 w4 = *(const float4*)(lnw + c), b4 = *(const float4*)(lnb + c);
                u32x2 w; w.x = cvt_pk_bf16((v[i * 4] - mu) * rs * w4.x + b4.x, (v[i * 4 + 1] - mu) * rs * w4.y + b4.y);
                w.y = cvt_pk_bf16((v[i * 4 + 2] - mu) * rs * w4.z + b4.z, (v[i * 4 + 3] - mu) * rs * w4.w + b4.w);
                *(LAS u32x2*)(T + rr * 2048 + c) = w; }
        }
        __syncthreads();
        const int b = row0 / SEQ, n = (row0 % SEQ) / 128, q0 = row0 % 128;
        for (int it = tid; it < 1024 * 4; it += 512) {
            const int qg = it & 3, cp = it >> 2, c = cp * 2;
            unsigned e[8];
#pragma unroll
            for (int j = 0; j < 8; ++j) e[j] = *(const LAS unsigned*)(T + (qg * 8 + j) * 2048 + c);
            u32x4 w0, w1;
            w0.x = (e[0] & 0xffffu) | (e[1] << 16); w0.y = (e[2] & 0xffffu) | (e[3] << 16); w0.z = (e[4] & 0xffffu) | (e[5] << 16); w0.w = (e[6] & 0xffffu) | (e[7] << 16);
            w1.x = (e[0] >> 16) | (e[1] & 0xffff0000u); w1.y = (e[2] >> 16) | (e[3] & 0xffff0000u); w1.z = (e[4] >> 16) | (e[5] & 0xffff0000u); w1.w = (e[6] >> 16) | (e[7] & 0xffff0000u);
            const int g = c >> 7, cl = c & 127;
            bf16_t* dst = VT + ((((size_t)(b * 32 + n) * 16 + g) * 128 + cl) * 128 + q0 + qg * 8);
            *(u32x4*)dst = w0; *(u32x4*)(dst + 128) = w1;
        }
    }
    __syncthreads();
}

__device__ __forceinline__ void ph_spatial(const bf16_t* WS, const bf16_t* VT, const bf16_t* U, const float* bs, bf16_t* GATED, int G, int bid) {
    typedef float f32x16 __attribute__((ext_vector_type(16)));
    const int tid = threadIdx.x, wave = tid >> 6, lane = tid & 63, l32 = lane & 31, half = lane >> 5;
    const int p0 = (wave & 3) * 32, c0 = (wave >> 2) * 64;
    for (int unit = bid; unit < NB * 32 * 16; unit += G) {
        const int g = unit & 15, bn = unit >> 4;
        const bf16_t* Wp = WS + (size_t)g * 128 * 128 + (size_t)(p0 + l32) * 128 + half * 8;
        const bf16_t* Vp = VT + ((size_t)bn * 16 + g) * 128 * 128 + (size_t)(c0 + l32) * 128 + half * 8;
        f32x16 acc0, acc1;
#pragma unroll
        for (int i = 0; i < 16; ++i) { acc0[i] = 0.f; acc1[i] = 0.f; }
#pragma unroll
        for (int ks = 0; ks < 8; ++ks) {
            const bf16x8 w = *(const bf16x8*)(Wp + ks * 16), v0 = *(const bf16x8*)(Vp + ks * 16), v1 = *(const bf16x8*)(Vp + 32 * 128 + ks * 16);
            acc0 = __builtin_amdgcn_mfma_f32_32x32x16_bf16(v0, w, acc0, 0, 0, 0);
            acc1 = __builtin_amdgcn_mfma_f32_32x32x16_bf16(v1, w, acc1, 0, 0, 0);
        }
        const int p = p0 + l32;
        const float bias = bs[g * 128 + p];
        const size_t ob = (size_t)(bn * 128 + p) * D + g * 128 + c0 + 4 * half;
#pragma unroll
        for (int i4 = 0; i4 < 4; ++i4) {
#pragma unroll
            for (int hb = 0; hb < 2; ++hb) {
                const size_t o = ob + hb * 32 + 8 * i4;
                const u32x2 uu = *(const u32x2*)(U + o);
                const float u0 = __uint_as_float(uu.x << 16), u1 = __uint_as_float(uu.x & 0xffff0000u), u2 = __uint_as_float(uu.y << 16), u3 = __uint_as_float(uu.y & 0xffff0000u);
                const f32x16& a = hb == 0 ? acc0 : acc1;
                u32x2 w; w.x = cvt_pk_bf16(u0 * (a[i4 * 4] + bias), u1 * (a[i4 * 4 + 1] + bias)); w.y = cvt_pk_bf16(u2 * (a[i4 * 4 + 2] + bias), u3 * (a[i4 * 4 + 3] + bias));
                *(u32x2*)(GATED + o) = w;
            }
        }
    }
}

__device__ __forceinline__ void ph_final(const float* H, const bf16_t* OUT2, const int* slot, const float* topg, const float* g2, const float* fnorm, float* out, int G, int bid) {
    const int tid = threadIdx.x, wave = tid >> 6, lane = tid & 63;
    float fn[32], gv[32]; int cur_b = -1;
#pragma unroll
    for (int i = 0; i < 8; ++i) { const float4 f = *(const float4*)(fnorm + i * 256 + lane * 4); fn[i * 4] = f.x; fn[i * 4 + 1] = f.y; fn[i * 4 + 2] = f.z; fn[i * 4 + 3] = f.w; }
    for (int row = bid * 8 + wave; row < NL; row += G * 8) {
        const int s0 = slot[row * 2], s1 = slot[row * 2 + 1]; const float g0 = topg[row * 2], g1 = topg[row * 2 + 1];
        const float* h = H + (size_t)row * D; const bf16_t* o0 = OUT2 + (size_t)s0 * D; const bf16_t* o1 = OUT2 + (size_t)s1 * D;
        const int bb = row / SEQ;
        if (bb != cur_b) { cur_b = bb; const float* gg = g2 + (size_t)bb * NMOD;
#pragma unroll
            for (int i = 0; i < 8; ++i) { const float4 g = *(const float4*)(gg + i * 256 + lane * 4); gv[i * 4] = g.x; gv[i * 4 + 1] = g.y; gv[i * 4 + 2] = g.z; gv[i * 4 + 3] = g.w; } }
        float v[32]; float ss = 0.f;
#pragma unroll
        for (int i = 0; i < 8; ++i) { const int c = i * 256 + lane * 4;
            const float4 hv = *(const float4*)(h + c); const u32x2 a = *(const u32x2*)(o0 + c), b = *(const u32x2*)(o1 + c);
            const float a0 = __uint_as_float(a.x << 16), a1 = __uint_as_float(a.x & 0xffff0000u), a2 = __uint_as_float(a.y << 16), a3 = __uint_as_float(a.y & 0xffff0000u);
            const float b0 = __uint_as_float(b.x << 16), b1 = __uint_as_float(b.x & 0xffff0000u), b2 = __uint_as_float(b.y << 16), b3 = __uint_as_float(b.y & 0xffff0000u);
            v[i * 4] = hv.x + gv[i * 4] * (g0 * a0 + g1 * b0); v[i * 4 + 1] = hv.y + gv[i * 4 + 1] * (g0 * a1 + g1 * b1);
            v[i * 4 + 2] = hv.z + gv[i * 4 + 2] * (g0 * a2 + g1 * b2); v[i * 4 + 3] = hv.w + gv[i * 4 + 3] * (g0 * a3 + g1 * b3);
            ss += v[i * 4] * v[i * 4] + v[i * 4 + 1] * v[i * 4 + 1] + v[i * 4 + 2] * v[i * 4 + 2] + v[i * 4 + 3] * v[i * 4 + 3]; }
        const float rs = rsqrtf(wave_sum(ss) * (1.f / D) + 1e-6f);
#pragma unroll
        for (int i = 0; i < 8; ++i) { const int c = i * 256 + lane * 4;
            *(float4*)(out + (size_t)row * D + c) = (float4){v[i * 4] * rs * fn[i * 4], v[i * 4 + 1] * rs * fn[i * 4 + 1], v[i * 4 + 2] * rs * fn[i * 4 + 2], v[i * 4 + 3] * rs * fn[i * 4 + 3]}; }
    }
}

__device__ __forceinline__ void ph_ada(LAS unsigned char* lds, const float* W0, const float* W1, const float* b0, const float* b1, const float* c, const float* cc, float* mod0, float* mod1, int G, int bid) {
    const int tid = threadIdx.x, kq = tid / 24, c4 = tid % 24;
    LAS float* red = (LAS float*)lds;
    for (int u = bid; u < 256; u += G) {
        const int l = u >> 7, col0 = (u & 127) * 96;
        const float* W = (l == 0 ? W0 : W1) + col0 + c4 * 4;
        float a[12];
#pragma unroll
        for (int j = 0; j < 12; ++j) a[j] = 0.f;
        if (kq < 21) {
#pragma unroll 7
            for (int k = kq; k < D; k += 21) {
                const float4 w = *(const float4*)(W + (size_t)k * NMOD);
                const float x0 = c[k], x1 = c[D + k], x2 = cc[k];
                const float s0 = x0 * fsigmoid(x0), s1 = x1 * fsigmoid(x1), s2 = x2 * fsigmoid(x2);
                a[0] += s0 * w.x; a[1] += s0 * w.y; a[2] += s0 * w.z; a[3] += s0 * w.w;
                a[4] += s1 * w.x; a[5] += s1 * w.y; a[6] += s1 * w.z; a[7] += s1 * w.w;
                a[8] += s2 * w.x; a[9] += s2 * w.y; a[10] += s2 * w.z; a[11] += s2 * w.w;
            }
        }
        __syncthreads();
        if (kq < 21) {
#pragma unroll
            for (int j = 0; j < 12; ++j) red[(kq * 24 + c4) * 12 + j] = a[j];
        }
        __syncthreads();
        if (tid < 288) {
            const int cq = tid / 12, rj = tid % 12, row = rj >> 2, j = rj & 3, n = col0 + cq * 4 + j;
            float sum = (l == 0 ? b0 : b1)[n];
            for (int q = 0; q < 21; ++q) sum += red[(q * 24 + cq) * 12 + rj];
            if (!(l == 1 && row == 2)) (l == 0 ? mod0 : mod1)[(size_t)row * NMOD + n] = sum;
        }
    }
    __syncthreads();
}


__device__ __forceinline__ void ph_small_cvt(const float* w_up, const float* a_up, const float* g_up, bf16_t* WLORA, float* ropec, float* ropes, int G, int bid) {
    const int gt = bid * 512 + threadIdx.x, gs = G * 512;
    if (gt < 16) {
        const double x = (double)rope_inv(gt), x2 = x * x;
        double sn = x * (1.0 + x2 * (-1.0 / 6 + x2 * (1.0 / 120 + x2 * (-1.0 / 5040 + x2 * (1.0 / 362880 + x2 * (-1.0 / 39916800 + x2 * (1.0 / 6227020800.0)))))));
        double cs = 1.0 + x2 * (-0.5 + x2 * (1.0 / 24 + x2 * (-1.0 / 720 + x2 * (1.0 / 40320 + x2 * (-1.0 / 3628800 + x2 * (1.0 / 479001600.0 + x2 * (-1.0 / 87178291200.0)))))));
        double c = 1.0, s_ = 0.0;
        for (int pos = 0; pos < 64; ++pos) { ropec[pos * 16 + gt] = (float)c; ropes[pos * 16 + gt] = (float)s_; const double nc = c * cs - s_ * sn, ns = s_ * cs + c * sn; c = nc; s_ = ns; }
    }
    for (int i = gt; i < 5120 * 64; i += gs) {
        const int n = i >> 6, k0 = (i & 63) * 8, g = n >> 10, ch = n & 1023;
        float v[8];
#pragma unroll
        for (int q = 0; q < 8; ++q) { const int k = k0 + q; float x = 0.f;
            if (g < 4) { const int koff = g * 64; if (k >= koff && k < koff + 64) x = (g < 2 ? w_up : a_up)[(size_t)((g & 1) * 64 + (k - koff)) * RD + ch]; }
            else { if (k >= 256 && k < 416) x = g_up[(size_t)(k - 256) * RD + ch]; }
            v[q] = x; }
        u32x4 w; w.x = cvt_pk_bf16(v[0], v[1]); w.y = cvt_pk_bf16(v[2], v[3]); w.z = cvt_pk_bf16(v[4], v[5]); w.w = cvt_pk_bf16(v[6], v[7]);
        *(u32x4*)(WLORA + (size_t)n * 512 + k0) = w;
    }
}
struct MapKV { const float* src; int sel;
    __device__ __forceinline__ const float* operator()(int n0) const { const int h = n0 >> 7, d = n0 & 127; return src + h * 256 + sel * 128 + d; } __device__ __forceinline__ int stride() const { return KVW; } __device__ __forceinline__ bool valid(int) const { return true; } };

__device__ __forceinline__ void ph_prep(const float* Z, const float* qn, const float* kvn, const float* mup, const float* mun, const float* k_k,
                                        bf16_t* CQNB, bf16_t* CKVNB, bf16_t* KRB, bf16_t* LA, float* RR, float* KRf, float* VR, float* AA, const float* ropec, const float* ropes, int G, int bid) {
    const int wave = threadIdx.x >> 6, lane = threadIdx.x & 63;
    for (int row = bid * 8 + wave; row < MALL; row += G * 8) {
        const float* z = Z + (size_t)row * ZLD;
        int t, len; if (row < NL) { t = row % SEQ; len = SEQ; } else { t = (row - NL) % CTX; len = CTX; }
#pragma unroll
        for (int part = 0; part < 2; ++part) {
            const float4 a = *(const float4*)(z + part * 512 + lane * 8), b = *(const float4*)(z + part * 512 + lane * 8 + 4);
            float ss = a.x * a.x + a.y * a.y + a.z * a.z + a.w * a.w + b.x * b.x + b.y * b.y + b.z * b.z + b.w * b.w;
            ss = wave_sum(ss);
            const float rs = rsqrtf(ss * (1.f / 512.f) + 1e-6f);
            const float* gn = (part == 0 ? qn : kvn) + lane * 8;
            const float4 g0 = *(const float4*)gn, g1 = *(const float4*)(gn + 4);
            u32x4 w; w.x = cvt_pk_bf16(a.x * rs * g0.x, a.y * rs * g0.y); w.y = cvt_pk_bf16(a.z * rs * g0.z, a.w * rs * g0.w);
            w.z = cvt_pk_bf16(b.x * rs * g1.x, b.y * rs * g1.y); w.w = cvt_pk_bf16(b.z * rs * g1.z, b.w * rs * g1.w);
            *(u32x4*)((part == 0 ? CQNB : CKVNB) + (size_t)row * 512 + lane * 8) = w;
        }
        {
            const float val = z[1024 + lane]; const float oth = __shfl_xor(val, 16);
            float o = val;
            if (row < NL) {
                const int a = lane >> 5, hf = (lane >> 4) & 1, f = lane & 15;
                const int pos = a == 0 ? (t >> 6) : (t & 63);
                const float cs = ropec[pos * 16 + f], sn = ropes[pos * 16 + f];
                o = hf == 0 ? val * cs - oth * sn : val * cs + oth * sn;
            }
            KRB[(size_t)row * KLD + 1024 + lane] = (bf16_t)(cvt_pk_bf16(o, 0.f) & 0xffffu);
        }
        const float* zc = z + MLA_IN; const float* zp = zc - ZLD; const float* zn = zc + ZLD;
        const bool hp = t > 0, hn = t < len - 1;
#define SHIFT4(jj) ({ const int j_ = (jj); const f32x4 zz = *(const f32x4*)(zc + j_), mp = *(const f32x4*)(mup + j_), mn = *(const f32x4*)(mun + j_); \
            f32x4 pv = {0.f, 0.f, 0.f, 0.f}, nv = pv; if (hp) pv = *(const f32x4*)(zp + j_); if (hn) nv = *(const f32x4*)(zn + j_); zz + mp * (pv - zz) + mn * (nv - zz); })
        { f32x4 a0 = SHIFT4(lane * 4), a1 = SHIFT4((lane + 64) * 4), a2 = SHIFT4((lane + 128) * 4), a3 = SHIFT4((lane + 192) * 4);
          float* dst = RR + hmi(row, lane * 4); *(f32x4*)dst = a0; *(f32x4*)(dst + (size_t)4 * MALL * 64) = a1; *(f32x4*)(dst + (size_t)8 * MALL * 64) = a2; *(f32x4*)(dst + (size_t)12 * MALL * 64) = a3; }
        { f32x4 k[4]; k[0] = SHIFT4(1024 + lane * 4); k[1] = SHIFT4(1024 + (lane + 64) * 4); k[2] = SHIFT4(1024 + (lane + 128) * 4); k[3] = SHIFT4(1024 + (lane + 192) * 4);
#pragma unroll
          for (int i = 0; i < 4; ++i) { const int c = (lane + 64 * i) * 4;
            *(f32x4*)(KRf + hmi(row, c)) = k[i];
            const f32x4 kk = k[i] * *(const f32x4*)(k_k + c);
            float q = kk[0] * kk[0] + kk[1] * kk[1] + kk[2] * kk[2] + kk[3] * kk[3];
            q += __shfl_xor(q, 1); q += __shfl_xor(q, 2); q += __shfl_xor(q, 4); q += __shfl_xor(q, 8);
            const float inv = -1.0f / fmaxf(sqrtf(q), 1e-12f);
            *(f32x4*)(AA + hmi(row, c)) = kk * inv; } }
        { f32x4 a0 = SHIFT4(2048 + lane * 4), a1 = SHIFT4(2048 + (lane + 64) * 4), a2 = SHIFT4(2048 + (lane + 128) * 4), a3 = SHIFT4(2048 + (lane + 192) * 4);
          float* dst = VR + hmi(row, lane * 4); *(f32x4*)dst = a0; *(f32x4*)(dst + (size_t)4 * MALL * 64) = a1; *(f32x4*)(dst + (size_t)8 * MALL * 64) = a2; *(f32x4*)(dst + (size_t)12 * MALL * 64) = a3; }
        {
            const int c0 = lane * 8; f32x4 x0 = {0.f, 0.f, 0.f, 0.f}, x1 = x0;
            if (c0 < 416) { x0 = SHIFT4(3072 + c0); x1 = SHIFT4(3072 + c0 + 4); }
            float o[8];
#pragma unroll
            for (int q = 0; q < 4; ++q) { o[q] = c0 < 128 ? ftanh(x0[q]) : c0 < 256 ? x0[q] : c0 < 416 ? fsigmoid(x0[q]) : 0.f; o[4 + q] = c0 < 128 ? ftanh(x1[q]) : c0 < 256 ? x1[q] : c0 < 416 ? fsigmoid(x1[q]) : 0.f; }
            u32x4 w; w.x = cvt_pk_bf16(o[0], o[1]); w.y = cvt_pk_bf16(o[2], o[3]); w.z = cvt_pk_bf16(o[4], o[5]); w.w = cvt_pk_bf16(o[6], o[7]);
            *(u32x4*)(LA + (size_t)row * 512 + c0) = w;
        }
#undef SHIFT4
    }
}

struct EpiLora { static constexpr bool PERM = false; const float* w0; const float* a0; const float* k_a; const float* KRf; const float* AA; float* WW; float* KD; float* BD; float* GG;
    __device__ __forceinline__ void operator()(AccRef acc, const Unit& u, int wr, int wc, int fr, int fq) const {
        const int g = u.pn >> 2, row0 = u.pm * 256 + wr * 64 + fr, ch0 = (u.pn & 3) * 256 + wc * 32 + 4 * fq;
#pragma unroll
        for (int ai = 0; ai < 2; ++ai)
#pragma unroll
            for (int m = 0; m < 4; ++m) { const int row = row0 + ai * 128 + m * 16;
#pragma unroll
                for (int bj = 0; bj < 2; ++bj)
#pragma unroll
                    for (int n = 0; n < 2; ++n) { const int ch = ch0 + bj * 128 + n * 16; const size_t e = hmi(row, ch); const f32x4 v = acc[ai][bj][m][n];
                        if (g < 2) { const f32x4 b = *(const f32x4*)(w0 + g * RD + ch); f32x4 o;
#pragma unroll
                            for (int j = 0; j < 4; ++j) { const float y = -(b[j] + v[j]); const float sp = fmaxf(y, 0.f) + flog(1.0f + fexp(-fabsf(y))); o[j] = fexp(-fexp(-sp - 0.5f)); }
                            *(f32x4*)(WW + (size_t)g * MALL * RD + e) = o; }
                        else if (g < 4) { const int d = g - 2; const f32x4 b = *(const f32x4*)(a0 + d * RD + ch), ka = *(const f32x4*)(k_a + ch), kv = *(const f32x4*)(KRf + e), aa = *(const f32x4*)(AA + e); f32x4 okd, obd;
#pragma unroll
                            for (int j = 0; j < 4; ++j) { const float ic = fsigmoid(b[j] + v[j]); okd[j] = kv[j] * (1.f + (ic - 1.f) * ka[j]); obd[j] = -ic * aa[j]; }
                            *(f32x4*)(KD + (size_t)d * MALL * RD + e) = okd; *(f32x4*)(BD + (size_t)d * MALL * RD + e) = obd; }
                        else *(f32x4*)(GG + e) = v; } }
    } };
struct EpiQ { static constexpr bool PERM = false; bf16_t* QB; const float* ropec; const float* ropes;
    __device__ __forceinline__ void operator()(AccRef acc, const Unit& u, int wr, int wc, int fr, int fq) const {
        const float qs = 0.07216878364870322f * 1.4426950408889634f;
        const int row0 = u.pm * 256 + wr * 64 + fr;
#pragma unroll
        for (int bj = 0; bj < 2; ++bj) {
            const int cg = u.pn * 256 + bj * 128 + wc * 32, part = (cg >> 5) % 6;
#pragma unroll
            for (int ai = 0; ai < 2; ++ai)
#pragma unroll
                for (int m = 0; m < 4; ++m) { const int row = row0 + ai * 128 + m * 16, t = row & (SEQ - 1);
                    f32x4 x1 = acc[ai][bj][m][0], x2 = acc[ai][bj][m][1];
                    if (part >= 4) { const int pos = part == 4 ? (t >> 6) : (t & 63);
                        const f32x4 c = *(const f32x4*)(ropec + pos * 16 + 4 * fq), sn = *(const f32x4*)(ropes + pos * 16 + 4 * fq);
                        const f32x4 o1 = x1 * c - x2 * sn, o2 = x2 * c + x1 * sn; x1 = o1; x2 = o2; }
                    x1 = x1 * qs; x2 = x2 * qs;
                    bf16_t* dst = QB + (size_t)row * QW + cg + 4 * fq;
                    u32x2 w1, w2; w1.x = cvt_pk_bf16(x1[0], x1[1]); w1.y = cvt_pk_bf16(x1[2], x1[3]); w2.x = cvt_pk_bf16(x2[0], x2[1]); w2.y = cvt_pk_bf16(x2[2], x2[3]);
                    *(u32x2*)dst = w1; *(u32x2*)(dst + 16) = w2; }
        }
    } };
struct EpiBf16 { static constexpr bool PERM = true; bf16_t* O; int ldo;
    __device__ __forceinline__ void operator()(AccRef acc, const Unit& u, int wr, int wc, int fr, int fq) const {
        const int row0 = u.pm * 256 + wr * 64 + fr, col0 = u.pn * 256 + wc * 32 + 8 * fq;
#pragma unroll
        for (int ai = 0; ai < 2; ++ai)
#pragma unroll
            for (int m = 0; m < 4; ++m) { bf16_t* rowp = O + (size_t)(row0 + ai * 128 + m * 16) * ldo + col0;
#pragma unroll
                for (int bj = 0; bj < 2; ++bj) { const f32x4 v0 = acc[ai][bj][m][0], v1 = acc[ai][bj][m][1];
                    u32x4 w; w.x = cvt_pk_bf16(v0[0], v0[1]); w.y = cvt_pk_bf16(v0[2], v0[3]); w.z = cvt_pk_bf16(v1[0], v1[1]); w.w = cvt_pk_bf16(v1[2], v1[3]);
                    *(u32x4*)(rowp + bj * 128) = w; } }
    } };
struct EpiVT { static constexpr bool PERM = false; bf16_t* VT;
    __device__ __forceinline__ void operator()(AccRef acc, const Unit& u, int wr, int wc, int fr, int fq) const {
        const int row0 = u.pm * 256 + wr * 64 + fr, pq = ((fq & 1) << 1) | (fq >> 1), col0 = u.pn * 256 + wc * 32 + 4 * pq;
#pragma unroll
        for (int ai = 0; ai < 2; ++ai)
#pragma unroll
            for (int m = 0; m < 4; ++m) { bf16_t* rowp = VT + (size_t)(row0 + ai * 128 + m * 16) * MALL + col0;
#pragma unroll
                for (int bj = 0; bj < 2; ++bj)
#pragma unroll
                    for (int n = 0; n < 2; ++n) { const f32x4 v = acc[ai][bj][m][n]; u32x2 w; w.x = cvt_pk_bf16(v[0], v[1]); w.y = cvt_pk_bf16(v[2], v[3]); *(u32x2*)(rowp + bj * 128 + n * 16) = w; } }
    } };

__device__ __forceinline__ void ph_attn(LAS unsigned char* lds, const bf16_t* QB, const bf16_t* KNB, const bf16_t* VTB, bf16_t* MIXB, int G, int bid) {
    typedef float f32x16 __attribute__((ext_vector_type(16)));
    constexpr int KP = 400, VP = 144, KBYTES = 64 * KP, BUF = KBYTES + 128 * VP, NT = SK / 64;
    const int tid = threadIdx.x, wave = tid >> 6, lane = tid & 63, l32 = lane & 31, half = lane >> 5;
    for (int unit = bid; unit < NB * HM * (SEQ / 256); unit += G) {
        const int bh = unit & 15, qb = unit >> 4, b = bh >> 3, h = bh & 7;
        const int qrow = b * SEQ + qb * 256 + wave * 32 + l32;
        bf16x8 qf[12];
#pragma unroll
        for (int ks = 0; ks < 12; ++ks) qf[ks] = *(const bf16x8*)(QB + (size_t)qrow * QW + h * 192 + ks * 16 + half * 8);
        f32x16 o[4];
#pragma unroll
        for (int d = 0; d < 4; ++d)
#pragma unroll
            for (int i = 0; i < 16; ++i) o[d][i] = 0.f;
        float mrun = -1e30f, lrun = 0.f;
        int ko[3], kd[3], vo[2], vd[2];
#pragma unroll
        for (int i = 0; i < 3; ++i) { const int id = tid + 512 * i, key = id / 24, cc = id % 24;
            ko[i] = key * KLD + (cc < 16 ? h * 128 + cc * 8 : 1024 + (cc - 16) * 8); kd[i] = key * KP + cc * 16; }
#pragma unroll
        for (int i = 0; i < 2; ++i) { const int id = tid + 512 * i, dv = id >> 3, cc = id & 7;
            vo[i] = (h * 128 + dv) * MALL + cc * 8; vd[i] = KBYTES + dv * VP + cc * 16; }
        u32x4 kr_[3], vr_[2];
        __syncthreads();
        {   const int trow = NL + b * CTX;
#pragma unroll
            for (int i = 0; i < 3; ++i) kr_[i] = *(const u32x4*)(KNB + (size_t)(ko[i] + trow * KLD));
#pragma unroll
            for (int i = 0; i < 2; ++i) vr_[i] = *(const u32x4*)(VTB + (size_t)(vo[i] + trow));
#pragma unroll
            for (int i = 0; i < 3; ++i) *(LAS u32x4*)(lds + kd[i]) = kr_[i];
#pragma unroll
            for (int i = 0; i < 2; ++i) *(LAS u32x4*)(lds + vd[i]) = vr_[i];
        }
        __syncthreads();
        for (int j = 0; j < NT; ++j) {
            LAS unsigned char* cb = lds + (j & 1) * BUF;
            if (j + 1 < NT) {
                const int jn = j + 1, trow = jn < 4 ? NL + b * CTX + 64 * jn : b * SEQ + 64 * (jn - 4);
#pragma unroll
                for (int i = 0; i < 3; ++i) kr_[i] = *(const u32x4*)(KNB + (size_t)(ko[i] + trow * KLD));
#pragma unroll
                for (int i = 0; i < 2; ++i) vr_[i] = *(const u32x4*)(VTB + (size_t)(vo[i] + trow));
            }
            f32x16 s0, s1;
#pragma unroll
            for (int i = 0; i < 16; ++i) { s0[i] = 0.f; s1[i] = 0.f; }
#pragma unroll
            for (int ks = 0; ks < 12; ++ks) {
                const bf16x8 a0 = *(const LAS bf16x8*)(cb + l32 * KP + ks * 32 + half * 16), a1 = *(const LAS bf16x8*)(cb + (32 + l32) * KP + ks * 32 + half * 16);
                s0 = __builtin_amdgcn_mfma_f32_32x32x16_bf16(a0, qf[ks], s0, 0, 0, 0);
                s1 = __builtin_amdgcn_mfma_f32_32x32x16_bf16(a1, qf[ks], s1, 0, 0, 0);
            }
            float mx = s0[0];
#pragma unroll
            for (int i = 1; i < 16; ++i) mx = fmaxf(mx, s0[i]);
#pragma unroll
            for (int i = 0; i < 16; ++i) mx = fmaxf(mx, s1[i]);
            mx = fmaxf(mx, __shfl_xor(mx, 32));
            const float mn = fmaxf(mrun, mx);
            const float alpha = __builtin_amdgcn_exp2f(mrun - mn);
            mrun = mn;
            float ps = 0.f;
#pragma unroll
            for (int i = 0; i < 16; ++i) { s0[i] = __builtin_amdgcn_exp2f(s0[i] - mn); s1[i] = __builtin_amdgcn_exp2f(s1[i] - mn); ps += s0[i] + s1[i]; }
            lrun = lrun * alpha + ps;
#pragma unroll
            for (int d = 0; d < 4; ++d)
#pragma unroll
                for (int i = 0; i < 16; ++i) o[d][i] *= alpha;
            bf16x8 pf[4];
#pragma unroll
            for (int s = 0; s < 4; ++s) {
                u32x4 w;
                if (s < 2) { const int i0 = (s & 1) * 8; w.x = cvt_pk_bf16(s0[i0], s0[i0 + 1]); w.y = cvt_pk_bf16(s0[i0 + 2], s0[i0 + 3]); w.z = cvt_pk_bf16(s0[i0 + 4], s0[i0 + 5]); w.w = cvt_pk_bf16(s0[i0 + 6], s0[i0 + 7]); }
                else { const int i0 = (s & 1) * 8; w.x = cvt_pk_bf16(s1[i0], s1[i0 + 1]); w.y = cvt_pk_bf16(s1[i0 + 2], s1[i0 + 3]); w.z = cvt_pk_bf16(s1[i0 + 4], s1[i0 + 5]); w.w = cvt_pk_bf16(s1[i0 + 6], s1[i0 + 7]); }
                pf[s] = __builtin_bit_cast(bf16x8, w);
            }
#pragma unroll
            for (int s = 0; s < 4; ++s)
#pragma unroll
                for (int d = 0; d < 4; ++d) {
                    const bf16x8 vf = *(const LAS bf16x8*)(cb + KBYTES + (32 * d + l32) * VP + s * 32 + half * 16);
                    o[d] = __builtin_amdgcn_mfma_f32_32x32x16_bf16(vf, pf[s], o[d], 0, 0, 0);
                }
            if (j + 1 < NT) {
                LAS unsigned char* nb = lds + ((j + 1) & 1) * BUF;
#pragma unroll
                for (int i = 0; i < 3; ++i) *(LAS u32x4*)(nb + kd[i]) = kr_[i];
#pragma unroll
                for (int i = 0; i < 2; ++i) *(LAS u32x4*)(nb + vd[i]) = vr_[i];
            }
            __syncthreads();
        }
        lrun += __shfl_xor(lrun, 32);
        const float il = 1.0f / lrun;
        bf16_t* dst = MIXB + (size_t)qrow * D + h * 128 + 4 * half;
#pragma unroll
        for (int d = 0; d < 4; ++d)
#pragma unroll
            for (int i4 = 0; i4 < 4; ++i4) { u32x2 w; w.x = cvt_pk_bf16(o[d][i4 * 4] * il, o[d][i4 * 4 + 1] * il); w.y = cvt_pk_bf16(o[d][i4 * 4 + 2] * il, o[d][i4 * 4 + 3] * il);
                *(u32x2*)(dst + 32 * d + 8 * i4) = w; }
    }
    __syncthreads();
}


constexpr int SC_CL = 272, SC_NC = 16;
__device__ __forceinline__ int scan_row(int b, int d, int g) {
    if (g < CTX) return NL + b * CTX + (d == 0 ? g : CTX - 1 - g);
    const int tp = g - CTX; return b * SEQ + (d == 0 ? tp : SEQ - 1 - tp);
}
#define DPP_FMAC(d, a, b, n) asm volatile("v_fmac_f32_dpp %0, %1, %2 row_newbcast:" #n " row_mask:0xf bank_mask:0xf" : "+v"(d) : "v"(a), "v"(b))
#define DPP_MULD(d, a, n)    asm volatile("v_mul_f32_dpp %0, %1, %0 row_newbcast:" #n " row_mask:0xf bank_mask:0xf" : "+v"(d) : "v"(a))
#define SC_FOR16(X) X(0) X(1) X(2) X(3) X(4) X(5) X(6) X(7) X(8) X(9) X(10) X(11) X(12) X(13) X(14) X(15)
struct MoeCv { const float* w1; long d31; const float* w2; unsigned char* W13E; unsigned char* W2E; };
constexpr int CV_PER_WAVE = 336, CV_ITEMS_W13 = 3584, CV_ITEMS_E = 5376, CV_WLDS = 4096;
static_assert((size_t)NE * CV_ITEMS_E * 8 == (size_t)CV_PER_WAVE * 1024, "MoE conversion tiles must split evenly over 1024 waves");
static_assert(4 * 5 * 6144 + 4 * CV_WLDS <= LDS_CTL, "scan rings + conversion images must fit below the LDS control words");
struct CvItem { const float* sp; unsigned char* dst; int ld, K; float sc; };
__device__ __forceinline__ CvItem cv_item(const MoeCv& mc, int it, int cw) {
    const int I = it * 1024 + cw, e = I / CV_ITEMS_E, r = I - e * CV_ITEMS_E;
    CvItem o;
    if (r < CV_ITEMS_W13) { const int kr = r / 224, nt = r - kr * 224, n0 = nt * 64, jj = n0 & 255;
        o.sp = mc.w1 + (jj < 128 ? 0l : mc.d31) + (size_t)e * D * DFF + (size_t)kr * 128 * DFF + (n0 >> 8) * 128 + (jj & 127); o.ld = DFF;
        o.dst = mc.W13E + (size_t)e * 2 * DFF * D + (size_t)n0 * D + kr * 128; o.K = D; o.sc = 64.f; }
    else { const int r2 = r - CV_ITEMS_W13, kr = r2 >> 5, n0 = (r2 & 31) * 64;
        o.sp = mc.w2 + (size_t)e * DFF * D + (size_t)kr * 128 * D + n0; o.ld = D;
        o.dst = mc.W2E + (size_t)e * D * DFF + (size_t)n0 * DFF + kr * 128; o.K = DFF; o.sc = 128.f; }
    return o;
}
__device__ __forceinline__ void moe_cvt_wave(LAS unsigned char* ct, const MoeCv& mc, int cw, int lane) {
    constexpr int NIT = CV_PER_WAVE / 8;
    const int l15 = lane & 15, l4 = lane >> 4;
    f32x4 buf[8][4];
    CvItem cur = cv_item(mc, 0, cw);
    { const float* lp = cur.sp + (size_t)(l4 * cur.ld + l15 * 4);
#pragma unroll
      for (int s = 0; s < 8; ++s)
#pragma unroll
        for (int q = 0; q < 4; ++q) buf[s][q] = *(const f32x4*)(lp + (size_t)(s * 16 + q * 4) * cur.ld); }
#pragma unroll 1
    for (int it = 0; it < NIT; ++it) {
        const CvItem nxt = cv_item(mc, it + 1 < NIT ? it + 1 : NIT - 1, cw);
        const float* lp = nxt.sp + (size_t)(l4 * nxt.ld + l15 * 4);
        unsigned char* dp = cur.dst + (size_t)lane * cur.K;
        const float sc = cur.sc;
        u32x4 wout[8];
#pragma unroll
        for (int s = 0; s < 8; ++s) {
#pragma unroll
            for (int q = 0; q < 4; ++q) *(LAS f32x4*)(ct + q * 1024 + lane * 16) = buf[s][q];
#pragma unroll
            for (int q = 0; q < 4; ++q) buf[s][q] = *(const f32x4*)(lp + (size_t)(s * 16 + q * 4) * nxt.ld);
            float v[16];
#pragma unroll
            for (int j = 0; j < 16; ++j) v[j] = ((const LAS float*)ct)[j * 64 + lane];
            u32x4 w; w.x = pk4_fp8(v[0] * sc, v[1] * sc, v[2] * sc, v[3] * sc); w.y = pk4_fp8(v[4] * sc, v[5] * sc, v[6] * sc, v[7] * sc);
            w.z = pk4_fp8(v[8] * sc, v[9] * sc, v[10] * sc, v[11] * sc); w.w = pk4_fp8(v[12] * sc, v[13] * sc, v[14] * sc, v[15] * sc);
            wout[s] = w;
        }
#pragma unroll
        for (int s = 0; s < 8; ++s) *(u32x4*)(dp + s * 16) = wout[s];
        cur = nxt;
    }
#pragma unroll
    for (int s = 0; s < 8; ++s) asm volatile("" :: "v"(buf[s][0]), "v"(buf[s][1]), "v"(buf[s][2]), "v"(buf[s][3]));
}
constexpr int SC_NSLOT = 5, SC_SLOTB = 6144, SC_WLDS = SC_NSLOT * SC_SLOTB;
#define SC_VSET(P) f32x4 P##av, P##wv, P##bv, P##kv, P##rv; float P##vv
#define SC_READV(P, sl) do { P##av = *(const LAS f32x4*)((sl) + l15 * 16); P##wv = *(const LAS f32x4*)((sl) + 1024 + l15 * 16); P##bv = *(const LAS f32x4*)((sl) + 2048 + l15 * 16); \
            P##kv = *(const LAS f32x4*)((sl) + 3072 + l15 * 16); P##rv = *(const LAS f32x4*)((sl) + 4096 + l15 * 16); P##vv = *(const LAS float*)((sl) + 5120 + lane * 4); } while (0)
#define SC_STEP(P, i) do { \
            float a0 = P##av[0], a1 = P##av[1], a2 = P##av[2], a3 = P##av[3], w0 = P##wv[0], w1 = P##wv[1], w2 = P##wv[2], w3 = P##wv[3], b0 = P##bv[0], b1 = P##bv[1], b2 = P##bv[2], b3 = P##bv[3]; \
            float k0 = P##kv[0], k1 = P##kv[1], k2 = P##kv[2], k3 = P##kv[3], r0 = P##rv[0], r1 = P##rv[1], r2 = P##rv[2], r3 = P##rv[3], vq = P##vv; \
            asm volatile("s_nop 1" : "+v"(a0), "+v"(a1), "+v"(a2), "+v"(a3)); \
            float c0 = 0.f, c1 = 0.f, c2 = 0.f, c3 = 0.f, e0 = 0.f, e1 = 0.f, e2 = 0.f, e3 = 0.f; \
            SC_FOR16(SC_SA) \
            float saq = (c0 + c1) + (c2 + c3), sap = (e0 + e1) + (e2 + e3); \
            asm volatile("s_nop 1" : "+v"(w0), "+v"(w1), "+v"(w2), "+v"(w3), "+v"(b0), "+v"(b1), "+v"(b2), "+v"(b3), "+v"(saq), "+v"(sap)); \
            SC_FOR16(SC_UP) \
            asm volatile("s_nop 1" : "+v"(k0), "+v"(k1), "+v"(k2), "+v"(k3), "+v"(vq)); \
            SC_FOR16(SC_VK) \
            if (gbase + (i) >= CTX) { \
                float y0 = 0.f, y1 = 0.f, y2 = 0.f, y3 = 0.f, z0 = 0.f, z1 = 0.f, z2 = 0.f, z3 = 0.f; \
                asm volatile("s_nop 1" : "+v"(r0), "+v"(r1), "+v"(r2), "+v"(r3)); \
                SC_FOR16(SC_Y) \
                const size_t yo_ = (size_t)scan_row(b, d, gbase + (i)) * 64; \
                ypq[yo_ + lane] = (y0 + y1) + (y2 + y3); ypp[yo_ + lane] = (z0 + z1) + (z2 + z3); \
            } } while (0)
#define SC_SA(n) DPP_FMAC(c0, a0, SQ[4 * n], n); DPP_FMAC(c1, a1, SQ[4 * n + 1], n); DPP_FMAC(c2, a2, SQ[4 * n + 2], n); DPP_FMAC(c3, a3, SQ[4 * n + 3], n); \
                 DPP_FMAC(e0, a0, SP[4 * n], n); DPP_FMAC(e1, a1, SP[4 * n + 1], n); DPP_FMAC(e2, a2, SP[4 * n + 2], n); DPP_FMAC(e3, a3, SP[4 * n + 3], n);
#define SC_UP(n) DPP_MULD(SQ[4 * n], w0, n); DPP_MULD(SQ[4 * n + 1], w1, n); DPP_MULD(SQ[4 * n + 2], w2, n); DPP_MULD(SQ[4 * n + 3], w3, n); \
                 DPP_MULD(SP[4 * n], w0, n); DPP_MULD(SP[4 * n + 1], w1, n); DPP_MULD(SP[4 * n + 2], w2, n); DPP_MULD(SP[4 * n + 3], w3, n); \
                 DPP_FMAC(SQ[4 * n], b0, saq, n); DPP_FMAC(SQ[4 * n + 1], b1, saq, n); DPP_FMAC(SQ[4 * n + 2], b2, saq, n); DPP_FMAC(SQ[4 * n + 3], b3, saq, n); \
                 DPP_FMAC(SP[4 * n], b0, sap, n); DPP_FMAC(SP[4 * n + 1], b1, sap, n); DPP_FMAC(SP[4 * n + 2], b2, sap, n); DPP_FMAC(SP[4 * n + 3], b3, sap, n);
#define SC_VK(n) DPP_FMAC(SQ[4 * n], k0, vq, n); DPP_FMAC(SQ[4 * n + 1], k1, vq, n); DPP_FMAC(SQ[4 * n + 2], k2, vq, n); DPP_FMAC(SQ[4 * n + 3], k3, vq, n);
#define SC_Y(n) DPP_FMAC(y0, r0, SQ[4 * n], n); DPP_FMAC(y1, r1, SQ[4 * n + 1], n); DPP_FMAC(y2, r2, SQ[4 * n + 2], n); DPP_FMAC(y3, r3, SQ[4 * n + 3], n); \
                DPP_FMAC(z0, r0, SP[4 * n], n); DPP_FMAC(z1, r1, SP[4 * n + 1], n); DPP_FMAC(z2, r2, SP[4 * n + 2], n); DPP_FMAC(z3, r3, SP[4 * n + 3], n);
__device__ __forceinline__ void ph_scan1(LAS unsigned char* lds, const float* wsf, unsigned oAA, unsigned oWW, unsigned oBD, unsigned oKD, unsigned oRR, unsigned oVR, float* YP, float* QP, const MoeCv mc, int G, int bid) {
    const int wave = __builtin_amdgcn_readfirstlane(threadIdx.x >> 6), lane = threadIdx.x & 63, l15 = lane & 15, vi = lane >> 4;
    if (wave >= 4) { for (int pb = bid; pb < 256; pb += G) moe_cvt_wave(lds + 4 * SC_WLDS + (wave - 4) * CV_WLDS, mc, pb * 4 + (wave - 4), lane); return; }
    LAS unsigned char* ring = lds + wave * SC_WLDS;
    for (int pb = bid; pb < 256; pb += G) {
        const int pair = pb * 4 + wave, chain = pair >> 4, chunk = pair & 15;
        const int b = chain >> 5, h = (chain >> 1) & 15, d = chain & 1;
        const unsigned dofs = (unsigned)d * MALL * RD;
        const unsigned oh = (unsigned)h * (MALL * 64), lane4 = lane * 4;
        const unsigned ob0 = oAA + oh, ob1 = oWW + dofs + oh, ob2 = oBD + dofs + oh, ob3 = oKD + dofs + oh, ob4 = oRR + oh, ob5 = oVR + oh;
        float SQ[64], SP[64];
#pragma unroll
        for (int k = 0; k < 64; ++k) { SQ[k] = 0.f; SP[k] = lane == k ? 1.f : 0.f; }
        float* ypq = YP + (size_t)d * NL * RD + (size_t)h * NL * 64;
        float* ypp = YP + (size_t)(2 + d) * NL * RD + (size_t)h * NL * 64;
        const int gbase = chunk * SC_CL;
        constexpr int NGRP = SC_CL / 4;
#define SC_ISSUE(grp, slot) do { const int gq_ = (grp) < NGRP ? (grp) : NGRP - 1; const unsigned ro_ = (unsigned)scan_row(b, d, gbase + 4 * gq_ + (d ? 3 : 0)) * 64; LAS unsigned char* sl_ = ring + (slot) * SC_SLOTB; \
            __builtin_amdgcn_global_load_lds((const unsigned*)(wsf + (ob0 + ro_) + lane4), (LAS unsigned*)sl_, 16, 0, 0); __builtin_amdgcn_global_load_lds((const unsigned*)(wsf + (ob1 + ro_) + lane4), (LAS unsigned*)(sl_ + 1024), 16, 0, 0); \
            __builtin_amdgcn_global_load_lds((const unsigned*)(wsf + (ob2 + ro_) + lane4), (LAS unsigned*)(sl_ + 2048), 16, 0, 0); __builtin_amdgcn_global_load_lds((const unsigned*)(wsf + (ob3 + ro_) + lane4), (LAS unsigned*)(sl_ + 3072), 16, 0, 0); \
            __builtin_amdgcn_global_load_lds((const unsigned*)(wsf + (ob4 + ro_) + lane4), (LAS unsigned*)(sl_ + 4096), 16, 0, 0); __builtin_amdgcn_global_load_lds((const unsigned*)(wsf + (ob5 + ro_) + lane4), (LAS unsigned*)(sl_ + 5120), 16, 0, 0); } while (0)
        SC_ISSUE(0, 0); SC_ISSUE(1, 1); SC_ISSUE(2, 2); SC_ISSUE(3, 3); SC_ISSUE(4, 4);
        SC_VSET(A); SC_VSET(B);
        asm volatile("s_waitcnt vmcnt(24)" ::: "memory");
        const int r0o = d ? 768 : 0, rstep = d ? -256 : 256;
        SC_READV(A, ring + r0o);
        asm volatile("s_waitcnt lgkmcnt(0)" ::: "memory");
        int slot = 0;
#pragma unroll 1
        for (int grp = 0; grp < NGRP; ++grp) {
            const int i = 4 * grp;
            const LAS unsigned char* sl = ring + slot * SC_SLOTB + r0o;
            const int nslot = slot == SC_NSLOT - 1 ? 0 : slot + 1;
            SC_READV(B, sl + rstep);
            SC_STEP(A, i);
            asm volatile("s_waitcnt lgkmcnt(0)" ::: "memory");
            SC_READV(A, sl + 2 * rstep);
            SC_STEP(B, i + 1);
            asm volatile("s_waitcnt lgkmcnt(0)" ::: "memory");
            SC_READV(B, sl + 3 * rstep);
            SC_STEP(A, i + 2);
            asm volatile("s_waitcnt lgkmcnt(0)" ::: "memory");
            SC_ISSUE(grp + SC_NSLOT, slot);
            asm volatile("s_waitcnt vmcnt(24)" ::: "memory");
            SC_READV(A, ring + nslot * SC_SLOTB + r0o);
            SC_STEP(B, i + 3);
            asm volatile("s_waitcnt lgkmcnt(0)" ::: "memory");
            slot = nslot;
        }
        asm volatile("s_waitcnt vmcnt(0)" ::: "memory");
#undef SC_ISSUE
        float* qpq = QP + ((((size_t)chain) * SC_NC + chunk) * 64 + lane) * 64;
        float* qpp = QP + ((((size_t)64 + chain) * SC_NC + chunk) * 64 + lane) * 64;
#pragma unroll
        for (int j = 0; j < 16; ++j) { *(f32x4*)(qpq + 4 * j) = (f32x4){SQ[4 * j], SQ[4 * j + 1], SQ[4 * j + 2], SQ[4 * j + 3]}; *(f32x4*)(qpp + 4 * j) = (f32x4){SP[4 * j], SP[4 * j + 1], SP[4 * j + 2], SP[4 * j + 3]}; }
    }
}
#undef SC_SA
#undef SC_UP
#undef SC_VK
#undef SC_Y
__device__ __forceinline__ void ph_scan_carry(const float* QP, float* SS, int G, int bid) {
    const int wave = threadIdx.x >> 6, lane = threadIdx.x & 63;
    for (int task = bid * 8 + wave; task < 64 * 16; task += G * 8) {
        const int chain = task >> 4, v0 = (task & 15) * 4;
        float s[4] = {0.f, 0.f, 0.f, 0.f};
#pragma unroll 1
        for (int c = 0; c < SC_NC; ++c) {
#pragma unroll
            for (int r = 0; r < 4; ++r) SS[(((size_t)chain * SC_NC + c) * 64 + v0 + r) * 64 + lane] = s[r];
            if (c == SC_NC - 1) break;
            const float* Pc = QP + (((size_t)64 + chain) * SC_NC + c) * 4096 + lane;
            const float* Qc = QP + (((size_t)chain) * SC_NC + c) * 4096 + lane;
            float pcol[64];
#pragma unroll
            for (int k = 0; k < 64; ++k) pcol[k] = Pc[k * 64];
            float nw[4];
#pragma unroll
            for (int r = 0; r < 4; ++r) nw[r] = Qc[(v0 + r) * 64];
#pragma unroll
            for (int k = 0; k < 64; ++k) {
#pragma unroll
                for (int r = 0; r < 4; ++r) nw[r] += __builtin_bit_cast(float, __builtin_amdgcn_readlane(__builtin_bit_cast(int, s[r]), k)) * pcol[k];
            }
#pragma unroll
            for (int r = 0; r < 4; ++r) s[r] = nw[r];
        }
    }
}
struct FixLd { f32x4 p0, p1; float yl, r, ks, vr, gg; };
__device__ __forceinline__ FixLd fix_load(const float* YP, const float* RR, const float* KD, const float* VR, const float* GG, int row, int h, int lane) {
    FixLd x; const int l15 = lane & 15; const size_t e = ((size_t)h * NL + row) * 64, em = ((size_t)h * MALL + row) * 64;
    x.p0 = *(const f32x4*)(YP + (size_t)2 * NL * RD + e + l15 * 4); x.p1 = *(const f32x4*)(YP + (size_t)3 * NL * RD + e + l15 * 4);
    x.yl = YP[e + lane] + YP[(size_t)NL * RD + e + lane];
    x.r = RR[em + lane]; x.ks = KD[em + lane] + KD[(size_t)MALL * RD + em + lane]; x.vr = VR[em + lane]; x.gg = GG[em + lane];
    return x;
}
__device__ __forceinline__ void ph_scan_fix(const float* YP, const float* SS, const float* RR, const float* KD, const float* VR, const float* GG, const float* r_k, const float* lnw, const float* lnb, bf16_t* MIXB, int G, int bid) {
    const int wave = __builtin_amdgcn_readfirstlane(threadIdx.x >> 6), lane = threadIdx.x & 63;
    for (int task = bid * 8 + wave; task < 2048; task += G * 8) {
        const int b = task >> 10, h = (task >> 6) & 15, t0 = (task & 63) * 64, c = h * 64 + lane;
        const int chain0 = (b * 16 + h) * 2;
        float S0[64], S1[64]; int cc0 = -1, cc1 = -1;
        const float rk = r_k[c], lw = lnw[c], lb = lnb[c];
        FixLd nx = fix_load(YP, RR, KD, VR, GG, b * SEQ + t0, h, lane);
#pragma unroll 1
        for (int tt = 0; tt < 64; ++tt) {
            const int t = t0 + tt, row = b * SEQ + t;
            const FixLd cu = nx;
            { const int tn = tt < 63 ? t + 1 : t; nx = fix_load(YP, RR, KD, VR, GG, b * SEQ + tn, h, lane); }
            const int c0 = (CTX + t) / SC_CL, c1 = (CTX + SEQ - 1 - t) / SC_CL;
            if (c0 != cc0) { cc0 = c0; const float* sp = SS + (((size_t)chain0 * SC_NC + c0) * 64 + lane) * 64;
#pragma unroll
                for (int j = 0; j < 16; ++j) { const f32x4 x = *(const f32x4*)(sp + 4 * j); S0[4 * j] = x[0]; S0[4 * j + 1] = x[1]; S0[4 * j + 2] = x[2]; S0[4 * j + 3] = x[3]; } }
            if (c1 != cc1) { cc1 = c1; const float* sp = SS + (((size_t)(chain0 + 1) * SC_NC + c1) * 64 + lane) * 64;
#pragma unroll
                for (int j = 0; j < 16; ++j) { const f32x4 x = *(const f32x4*)(sp + 4 * j); S1[4 * j] = x[0]; S1[4 * j + 1] = x[1]; S1[4 * j + 2] = x[2]; S1[4 * j + 3] = x[3]; } }
            float a0 = cu.p0[0], a1 = cu.p0[1], a2 = cu.p0[2], a3 = cu.p0[3], b0 = cu.p1[0], b1 = cu.p1[1], b2 = cu.p1[2], b3 = cu.p1[3];
            asm volatile("s_nop 1" : "+v"(a0), "+v"(a1), "+v"(a2), "+v"(a3), "+v"(b0), "+v"(b1), "+v"(b2), "+v"(b3));
            float y0 = 0.f, y1 = 0.f, y2 = 0.f, y3 = 0.f, z0 = 0.f, z1 = 0.f, z2 = 0.f, z3 = 0.f;
#define FX_N(n) DPP_FMAC(y0, a0, S0[4 * n], n); DPP_FMAC(y1, a1, S0[4 * n + 1], n); DPP_FMAC(y2, a2, S0[4 * n + 2], n); DPP_FMAC(y3, a3, S0[4 * n + 3], n); \
                DPP_FMAC(z0, b0, S1[4 * n], n); DPP_FMAC(z1, b1, S1[4 * n + 1], n); DPP_FMAC(z2, b2, S1[4 * n + 2], n); DPP_FMAC(z3, b3, S1[4 * n + 3], n);
            SC_FOR16(FX_N)
#undef FX_N
            const float y = cu.yl + ((y0 + y1) + (y2 + y3)) + ((z0 + z1) + (z2 + z3));
            const float mu = wave_sum(y) * (1.f / 64.f);
            const float dv = y - mu;
            const float var = wave_sum(dv * dv) * (1.f / 64.f);
            const float yn = dv * rsqrtf(var + 64e-5f) * lw + lb;
            const float bonus = wave_sum(cu.r * cu.ks * rk) * cu.vr;
            const float o = (yn + bonus) * cu.gg;
            const float on = __shfl_down(o, 1);
            if ((lane & 1) == 0) *(unsigned*)(MIXB + (size_t)row * D + 1024 + c) = cvt_pk_bf16(o, on);
        }
    }
}

constexpr size_t alb(size_t x) { return (x + 4095) & ~(size_t)4095; }
constexpr size_t CTL_BYTES = 65536;
constexpr size_t MB_CTL = 0;
constexpr size_t B_MOD0 = MB_CTL + CTL_BYTES;
constexpr size_t B_MOD1 = B_MOD0 + alb((size_t)3 * NMOD * 4);
constexpr size_t B_MODP = B_MOD1 + alb((size_t)2 * NMOD * 4);
constexpr size_t MB_ROPE = B_MODP + alb((size_t)2 * 32 * 3 * NMOD * 4);
constexpr size_t B_H = MB_ROPE + 8192;
constexpr size_t MB_XNB = B_H + alb((size_t)NL * D * 4);
constexpr size_t MB_WIN0 = MB_XNB + alb((size_t)MALL * D * 2);
constexpr size_t MB_WO0 = MB_WIN0 + alb((size_t)ZLD * D * 2);
constexpr size_t MB_W13 = MB_WO0 + alb((size_t)D * D * 2);
constexpr size_t MB_W2 = MB_W13 + alb((size_t)2 * DFF * D * 2);
constexpr size_t MB_WUQ = MB_W2 + alb((size_t)D * DFF * 2);
constexpr size_t MB_WKN = MB_WUQ + alb((size_t)QW * 512 * 2);
constexpr size_t MB_WV = MB_WKN + alb((size_t)1024 * 512 * 2);
constexpr size_t MB_WLORA = MB_WV + alb((size_t)1024 * 512 * 2);
constexpr size_t MB_WIN1 = MB_WLORA + alb((size_t)5120 * 512 * 2);
constexpr size_t MB_WO1 = MB_WIN1 + alb((size_t)4096 * D * 2);
constexpr size_t MB_WSB = MB_WO1 + alb((size_t)D * D * 2);
constexpr size_t MB_W13E = MB_WSB + alb((size_t)16 * 128 * 128 * 2);
constexpr size_t MB_W2E = MB_W13E + alb((size_t)NE * 2 * DFF * D);
constexpr size_t B_ACTS = MB_W2E + alb((size_t)NE * D * DFF);
constexpr size_t B_Z = B_ACTS;
constexpr size_t MB_CQNB = B_Z + alb((size_t)MALL * ZLD * 4);
constexpr size_t MB_CKVNB = MB_CQNB + alb((size_t)MALL * 512 * 2);
constexpr size_t MB_LA = MB_CKVNB + alb((size_t)MALL * 512 * 2);
constexpr size_t MB_QB = MB_LA + alb((size_t)MALL * 512 * 2);
constexpr size_t MB_KNB = MB_QB + alb((size_t)NL * QW * 2);
constexpr size_t MB_VTB = MB_KNB + alb((size_t)MALL * KLD * 2);
constexpr size_t B_RR = MB_VTB + alb((size_t)RD * MALL * 2);
constexpr size_t B_KR = B_RR + alb((size_t)MALL * RD * 4);
constexpr size_t B_VR = B_KR + alb((size_t)MALL * RD * 4);
constexpr size_t B_AA = B_VR + alb((size_t)MALL * RD * 4);
constexpr size_t B_WW = B_AA + alb((size_t)MALL * RD * 4);
constexpr size_t B_KD = B_WW + alb((size_t)2 * MALL * RD * 4);
constexpr size_t B_BD = B_KD + alb((size_t)2 * MALL * RD * 4);
constexpr size_t B_GG = B_BD + alb((size_t)2 * MALL * RD * 4);
constexpr size_t MB_YP = B_GG + alb((size_t)MALL * RD * 4);
constexpr size_t MB_QP = MB_YP + alb((size_t)4 * NL * RD * 4);
constexpr size_t MB_SS = MB_QP + alb((size_t)2 * 64 * 16 * 4096 * 4);
constexpr size_t MB_MIXB = MB_SS + alb((size_t)64 * 16 * 4096 * 4);
constexpr size_t MB_ACT = MB_MIXB + alb((size_t)NL * D * 2);
constexpr size_t B_L0END = MB_ACT + alb((size_t)NL * DFF * 2);
constexpr size_t MB_U = B_ACTS;
constexpr size_t MB_VG = MB_U + alb((size_t)NL * D * 2);
constexpr size_t MB_VT = MB_VG + alb((size_t)NL * D * 4);
constexpr size_t MB_GATED = MB_VT + alb((size_t)NL * D * 2);
constexpr size_t MB_XG = MB_GATED + alb((size_t)NL * D * 2);
constexpr size_t MB_ACT2 = MB_XG + alb((size_t)NSLOT * D);
constexpr size_t MB_OUT2 = MB_ACT2 + alb((size_t)NSLOT * DFF);
constexpr size_t MB_ROUTE = MB_OUT2 + alb((size_t)NSLOT * D * 4);
constexpr size_t B_L1END = MB_ROUTE + 262144;
constexpr size_t MB_END = B_L0END > B_L1END ? B_L0END : B_L1END;
constexpr size_t O_MOD0 = B_MOD0 / 4, O_MOD1 = B_MOD1 / 4, O_MODP = B_MODP / 4, O_H = B_H / 4, O_Z = B_Z / 4, O_RR = B_RR / 4, O_KR = B_KR / 4, O_VR = B_VR / 4, O_AA = B_AA / 4,
                 O_WW = B_WW / 4, O_KD = B_KD / 4, O_BD = B_BD / 4, O_GG = B_GG / 4;

struct MP { const float* in[44]; float* out; unsigned char* ws; int ph_lo, ph_hi; };

enum { PH_CVT = 0, PH_XN1, PH_GEMM_Z, PH_PREP, PH_GEMM4, PH_ATTN, PH_CARRY, PH_FIX, PH_GEMM_O0, PH_XN2, PH_FFN_UP, PH_FFN_DOWN, PH_XN3, PH_GEMM_IN1, PH_LNT, PH_SPATIAL, PH_GEMM_O1, PH_XN4, PH_PLAN, PH_MOE_UP, PH_MOE_DOWN, PH_FINAL, PH_N };

__global__ void __launch_bounds__(512, 2) mega(MP p) {
    extern __shared__ __attribute__((aligned(16))) unsigned char lds_raw[];
    LAS unsigned char* lds = (LAS unsigned char*)lds_raw;
    const int tid = threadIdx.x, G = gridDim.x, bid = blockIdx.x;
    for (int u = tid; u < (LDS_BYTES - LDS_CTL) / 4; u += 512) ((LAS unsigned*)(lds + LDS_CTL))[u] = 0u;
    __syncthreads();
    XcdBarrier bar = xcd_barrier_post((unsigned*)(p.ws + MB_CTL), (volatile LAS unsigned*)(lds + LDS_CTL + 64));
    float* wsf = (float*)p.ws;
    const int lo = p.ph_lo, hi = p.ph_hi;
#define IN(k) (lo <= (k) && (k) < hi)
#define SEAM(k) do { if (IN(k) && IN((k) + 1)) xcd_barrier(bar); } while (0)
    bf16_t* W13 = (bf16_t*)(p.ws + MB_W13); bf16_t* W2 = (bf16_t*)(p.ws + MB_W2); bf16_t* XNB = (bf16_t*)(p.ws + MB_XNB); bf16_t* ACT = (bf16_t*)(p.ws + MB_ACT);

    bf16_t* WIN0 = (bf16_t*)(p.ws + MB_WIN0); bf16_t* WO0 = (bf16_t*)(p.ws + MB_WO0); bf16_t* MIXB = (bf16_t*)(p.ws + MB_MIXB);
    bf16_t* CQNB = (bf16_t*)(p.ws + MB_CQNB); bf16_t* CKVNB = (bf16_t*)(p.ws + MB_CKVNB); bf16_t* LA = (bf16_t*)(p.ws + MB_LA);
    bf16_t* WLORA = (bf16_t*)(p.ws + MB_WLORA); bf16_t* WUQ = (bf16_t*)(p.ws + MB_WUQ); bf16_t* WKN = (bf16_t*)(p.ws + MB_WKN); bf16_t* WV = (bf16_t*)(p.ws + MB_WV);
    bf16_t* QB = (bf16_t*)(p.ws + MB_QB); bf16_t* KNB = (bf16_t*)(p.ws + MB_KNB); bf16_t* VTB = (bf16_t*)(p.ws + MB_VTB); float* ROPEC = (float*)(p.ws + MB_ROPE); float* ROPES = ROPEC + 1024;
    bf16_t* W13E = (bf16_t*)(p.ws + MB_W13E); bf16_t* W2E = (bf16_t*)(p.ws + MB_W2E); bf16_t* WIN1 = (bf16_t*)(p.ws + MB_WIN1); bf16_t* WO1 = (bf16_t*)(p.ws + MB_WO1); bf16_t* WSB = (bf16_t*)(p.ws + MB_WSB);
    bf16_t* Ub = (bf16_t*)(p.ws + MB_U); float* VG = (float*)(p.ws + MB_VG); bf16_t* VT = (bf16_t*)(p.ws + MB_VT); bf16_t* GATED = (bf16_t*)(p.ws + MB_GATED); bf16_t* XNB2 = (bf16_t*)(p.ws + MB_XNB);
    bf16_t* XG = (bf16_t*)(p.ws + MB_XG); float* OUT2 = (float*)(p.ws + MB_OUT2); bf16_t* ACT2 = (bf16_t*)(p.ws + MB_ACT2);
    int* R_TOPE = (int*)(p.ws + MB_ROUTE); int* R_SLOT = R_TOPE + 16384; float* R_TOPG = (float*)(R_TOPE + 32768); int* R_BCNT = R_TOPE + 49152; int* R_CNTOFF = R_TOPE + 49152 + 4096;
    if (IN(PH_CVT)) {
        ph_small_cvt(p.in[16], p.in[18], p.in[19], WLORA, ROPEC, ROPES, G, bid);
        { MapPlain m{p.in[10], QW, QW}; cvt_T(lds, m, WUQ, QW, 512, G, bid); }
        { MapKV m{p.in[12], 0}; cvt_T(lds, m, WKN, 1024, 512, G, bid); }
        { MapKV m{p.in[12], 1}; cvt_T(lds, m, WV, 1024, 512, G, bid); }
        ph_ada(lds, p.in[4], p.in[29], p.in[5], p.in[30], p.in[1], p.in[3], wsf + O_MOD0, wsf + O_MOD1, G, bid);
        { MapPlain m{p.in[8], ZW, ZW}; cvt_T(lds, m, WIN0, ZLD, D, G, bid); }
        { MapPlain m{p.in[25], D, D}; cvt_T(lds, m, WO0, D, D, G, bid); }
        { MapIl m{p.in[26], (long)(p.in[27] - p.in[26]), DFF}; cvt_T(lds, m, W13, 2 * DFF, D, G, bid); }
        { MapPlain m{p.in[28], D, D}; cvt_T(lds, m, W2, D, DFF, G, bid); }
        { MapPlain m{p.in[33], 4096, 4096}; cvt_T(lds, m, WIN1, 4096, D, G, bid); }
        { MapPlain m{p.in[38], D, D}; cvt_T(lds, m, WO1, D, D, G, bid); }
        cvt_copy(p.in[36], WSB, (size_t)16 * 128 * 128, G, bid);
        __syncthreads();
    }
    SEAM(PH_CVT);
    if (IN(PH_XN1)) ph_norm_mod<false>(lds, p.in[0], p.in[2], p.in[6], wsf + O_MOD0, 0, 1, XNB, MALL, nullptr, nullptr, nullptr, nullptr, G, bid);
    SEAM(PH_XN1);
    if (IN(PH_GEMM_Z)) {
        pg8::DenseOrder S; S.init(XNB, D, WIN0, D, MALL, ZLD, G, bid);
        EpiF32 E{wsf + O_Z, ZLD};
        pg8::gemm_phase<EpiF32, pg8::DenseOrder, true, true>(lds, D, D, D, S, E);
    }
    SEAM(PH_GEMM_Z);
    if (IN(PH_PREP)) {
        ph_prep(wsf + O_Z, p.in[9], p.in[11], p.in[13], p.in[14], p.in[20], CQNB, CKVNB, KNB, LA, wsf + O_RR, wsf + O_KR, wsf + O_VR, wsf + O_AA, ROPEC, ROPES, G, bid);
    }
    SEAM(PH_PREP);
    if (IN(PH_GEMM4)) {
        { pg8::DenseOrder S; S.init(LA, 512, WLORA, 512, MALL, 5120, G, bid);
          EpiLora E{p.in[15], p.in[17], p.in[21], wsf + O_KR, wsf + O_AA, wsf + O_WW, wsf + O_KD, wsf + O_BD, wsf + O_GG};
          pg8::gemm_phase<EpiLora, pg8::DenseOrder, true, true>(lds, 512, 512, 512, S, E); }
        { pg8::DenseOrder S; S.init(CQNB, 512, WUQ, 512, NL, QW, G, (bid + 168) % G);
          EpiQ E{QB, ROPEC, ROPES};
          pg8::gemm_phase<EpiQ, pg8::DenseOrder, true, true>(lds, 512, 512, 512, S, E);
 }
        { pg8::DenseOrder S; S.init(CKVNB, 512, WKN, 512, MALL, 1024, G, (bid + 104) % G);
          EpiBf16 E{KNB, KLD};
          pg8::gemm_phase<EpiBf16, pg8::DenseOrder, true, true>(lds, 512, 512, 512, S, E); }
        { pg8::DenseOrder S; S.init(WV, 512, CKVNB, 512, 1024, MALL, G, (bid + 224) % G);
          EpiVT E{VTB};
          pg8::gemm_phase<EpiVT, pg8::DenseOrder, true, true>(lds, 512, 512, 512, S, E); }
    }
    SEAM(PH_GEMM4);
    float* YP = (float*)(p.ws + MB_YP); float* QP = (float*)(p.ws + MB_QP); float* SS = (float*)(p.ws + MB_SS);
    if (IN(PH_ATTN)) {
        ph_attn(lds, QB, KNB, VTB, MIXB, G, bid);
        { const MoeCv mc{p.in[40], (long)(p.in[41] - p.in[40]), p.in[42], (unsigned char*)W13E, (unsigned char*)W2E};
          ph_scan1(lds, wsf, (unsigned)O_AA, (unsigned)O_WW, (unsigned)O_BD, (unsigned)O_KD, (unsigned)O_RR, (unsigned)O_VR, YP, QP, mc, G, bid); }
        __syncthreads();
    }
    SEAM(PH_ATTN);
    if (IN(PH_CARRY)) ph_scan_carry(QP, SS, G, bid);
    SEAM(PH_CARRY);
    if (IN(PH_FIX)) ph_scan_fix(YP, SS, wsf + O_RR, wsf + O_KD, wsf + O_VR, wsf + O_GG, p.in[22], p.in[23], p.in[24], MIXB, G, bid);
    SEAM(PH_FIX);
    if (IN(PH_GEMM_O0)) {
        pg8::DenseOrder S; S.init(MIXB, D, WO0, D, NL, D, G, bid);
        EpiRes E{wsf + O_H, p.in[0], wsf + O_MOD0 + 2 * D};
        pg8::gemm_phase<EpiRes, pg8::DenseOrder, true, true>(lds, D, D, D, S, E);
    }
    SEAM(PH_GEMM_O0);
    if (IN(PH_XN2)) ph_norm_mod<false>(lds, wsf + O_H, nullptr, p.in[7], wsf + O_MOD0, 3, 4, XNB, NL, nullptr, nullptr, nullptr, nullptr, G, bid);
    SEAM(PH_XN2);
    if (IN(PH_FFN_UP)) {
        pg8::DenseOrder S; S.init(XNB, D, W13, D, NL, 2 * DFF, G, bid);
        EpiSwiglu E{ACT, DFF};
        pg8::gemm_phase<EpiSwiglu, pg8::DenseOrder, false, true>(lds, D, D, D, S, E);
    }
    SEAM(PH_FFN_UP);
    if (IN(PH_FFN_DOWN)) {
        pg8::DenseOrder S; S.init(ACT, DFF, W2, DFF, NL, D, G, bid);
        EpiRes E{wsf + O_H, wsf + O_H, wsf + O_MOD0 + 5 * D};
        pg8::gemm_phase<EpiRes, pg8::DenseOrder, true, true>(lds, DFF, DFF, DFF, S, E);
    }
    SEAM(PH_FFN_DOWN);
    if (IN(PH_XN3)) ph_norm_mod<false>(lds, wsf + O_H, nullptr, p.in[31], wsf + O_MOD1, 0, 1, XNB2, NL, nullptr, nullptr, nullptr, nullptr, G, bid);
    SEAM(PH_XN3);
    if (IN(PH_GEMM_IN1)) {
        pg8::DenseOrder S; S.init(XNB2, D, WIN1, D, NL, 4096, G, bid);
        EpiGelu E{Ub, VG};
        pg8::gemm_phase<EpiGelu, pg8::DenseOrder, true, true>(lds, D, D, D, S, E);
    }
    SEAM(PH_GEMM_IN1);
    if (IN(PH_LNT)) ph_ln_transpose(lds, VG, p.in[34], p.in[35], VT, G, bid);
    SEAM(PH_LNT);
    if (IN(PH_SPATIAL)) ph_spatial(WSB, VT, Ub, p.in[37], GATED, G, bid);
    SEAM(PH_SPATIAL);
    if (IN(PH_GEMM_O1)) {
        pg8::DenseOrder S; S.init(GATED, D, WO1, D, NL, D, G, bid);
        EpiRes E{wsf + O_H, wsf + O_H, wsf + O_MOD1 + 2 * D};
        pg8::gemm_phase<EpiRes, pg8::DenseOrder, true, true>(lds, D, D, D, S, E);
    }
    SEAM(PH_GEMM_O1);
    if (IN(PH_XN4)) ph_norm_mod<true>(lds, wsf + O_H, nullptr, p.in[32], wsf + O_MOD1, 3, 4, XNB2, NL, p.in[39], R_TOPE, R_TOPG, R_BCNT, G, bid);
    SEAM(PH_XN4);
    if (IN(PH_PLAN)) ph_moe_plan(lds, R_BCNT, R_TOPE, R_SLOT, R_CNTOFF, XNB2, XG, G, bid);
    SEAM(PH_PLAN);
    if (IN(PH_MOE_UP)) {
        pg8::MoeOrder S; S.init(R_CNTOFF, R_CNTOFF + 8, XG, D / 2, W13E, D / 2, (size_t)2 * DFF * D, 2 * DFF, G, bid);
        EpiSwigluF8 E{(unsigned char*)ACT2, DFF, 1.0f / 64.f};
        pg8::gemm_phase<EpiSwigluF8, pg8::MoeOrder, false, true, true>(lds, D / 2, D / 2, D / 2, S, E);
    }
    SEAM(PH_MOE_UP);
    if (IN(PH_MOE_DOWN)) {
        pg8::MoeOrder S; S.init(R_CNTOFF, R_CNTOFF + 8, ACT2, DFF / 2, W2E, DFF / 2, (size_t)D * DFF, D, G, bid);
        EpiBf16S E{(bf16_t*)OUT2, D, 1.0f / 128.f};
        pg8::gemm_phase<EpiBf16S, pg8::MoeOrder, true, true, true>(lds, DFF / 2, DFF / 2, DFF / 2, S, E);
    }
    SEAM(PH_MOE_DOWN);
    if (IN(PH_FINAL)) ph_final(wsf + O_H, (const bf16_t*)OUT2, R_SLOT, R_TOPG, wsf + O_MOD1 + 5 * D, p.in[43], p.out, G, bid);
#undef IN
#undef SEAM
}

static void launch_mega(hipStream_t stream, MP mp, int lo, int hi) {
    static int grid = 0;
    if (grid == 0) {
        int dev = 0, cus = 0;
        hipGetDevice(&dev); hipDeviceGetAttribute(&cus, hipDeviceAttributeMultiprocessorCount, dev);
        hipFuncSetAttribute((const void*)mega, hipFuncAttributeMaxDynamicSharedMemorySize, LDS_BYTES);
        int per_cu = 0; hipOccupancyMaxActiveBlocksPerMultiprocessor(&per_cu, (const void*)mega, 512, LDS_BYTES);
        if (per_cu < 1) fprintf(stderr, "mega: occupancy query says %d\n", per_cu);
        (void)hipGetLastError();
        grid = cus > 0 ? cus : 256;
    }
    hipMemsetAsync(mp.ws + MB_CTL, 0, CTL_BYTES, stream);
    mp.ph_lo = lo; mp.ph_hi = hi;
    hipLaunchKernelGGL(mega, dim3(grid), dim3(512), LDS_BYTES, stream, mp);
}
extern "C" void kernel_launch(void* const* d_in, const int* in_sizes, int n_in, void* d_out, int out_size, void* d_ws, size_t ws_size, hipStream_t stream) {
    if (n_in != 44 || ws_size < MB_END) { fprintf(stderr, "kernel_launch: bad n_in %d or ws %zu < %zu\n", n_in, ws_size, (size_t)MB_END); return; }
    MP mp{};
    for (int i = 0; i < 44; ++i) mp.in[i] = (const float*)d_in[i];
    mp.out = (float*)d_out; mp.ws = (unsigned char*)d_ws;
    launch_mega(stream, mp, 0, PH_N);
}
```

```cpp
#include <hip/hip_runtime.h>
#include <cstdio>
#include <cstdint>

constexpr int D = 2048, NB = 2, SEQ = 4096, CTX = 256;
constexpr int NL = NB * SEQ;
constexpr int NCX = NB * CTX;
constexpr int MALL = NL + NCX;
constexpr int NMOD = 6 * D;
constexpr int QL = 512, KVL = 512, ROPE = 64, NOPE = 128, VH = 128, HM = 8;
constexpr int MLA_IN = QL + KVL + ROPE;
constexpr int RD = 1024, RH = 16, RN = 64;
constexpr int RWKV_IN = 3 * RD + 128 + 128 + 160;
__device__ __forceinline__ size_t hmi(int row, int col) { return ((size_t)(col >> 6) * (8192 + 2 * 256) + row) * 64 + (col & 63); }
constexpr int ZW = MLA_IN + RWKV_IN;
constexpr int ZLD = 4608;
constexpr int KLD = 1088;
constexpr int QW = HM * (NOPE + ROPE);
constexpr int KVW = HM * (NOPE + VH);
constexpr int SK = CTX + SEQ;
constexpr int DFF = 7168, NE = 8;
constexpr int NSLOT = 18432;

constexpr int LDS_BYTES = 163840, LDS_CTL = 162816;

__device__ __forceinline__ float wave_sum(float v) {
#pragma unroll
    for (int o = 32; o > 0; o >>= 1) v += __shfl_xor(v, o);
    return v;
}
__device__ __forceinline__ float wave_sum_dpp(float v) {
    v += __builtin_bit_cast(float, __builtin_amdgcn_update_dpp(0, __builtin_bit_cast(int, v), 0xB1, 0xf, 0xf, true));
    v += __builtin_bit_cast(float, __builtin_amdgcn_update_dpp(0, __builtin_bit_cast(int, v), 0x4E, 0xf, 0xf, true));
    v += __builtin_bit_cast(float, __builtin_amdgcn_update_dpp(0, __builtin_bit_cast(int, v), 0x141, 0xf, 0xf, true));
    v += __builtin_bit_cast(float, __builtin_amdgcn_update_dpp(0, __builtin_bit_cast(int, v), 0x140, 0xf, 0xf, true));
    const int vi = __builtin_bit_cast(int, v);
    const float s0 = __builtin_bit_cast(float, __builtin_amdgcn_readlane(vi, 0)), s1 = __builtin_bit_cast(float, __builtin_amdgcn_readlane(vi, 16));
    const float s2 = __builtin_bit_cast(float, __builtin_amdgcn_readlane(vi, 32)), s3 = __builtin_bit_cast(float, __builtin_amdgcn_readlane(vi, 48));
    return (s0 + s1) + (s2 + s3);
}
__device__ __forceinline__ float sigmoidf_(float x) { return 1.0f / (1.0f + expf(-x)); }
__device__ __forceinline__ float siluf_(float x) { return x / (1.0f + expf(-x)); }

#define LAS __attribute__((address_space(3)))
typedef unsigned short bf16_t;
typedef short bf16x8 __attribute__((ext_vector_type(8)));
typedef float f32x4 __attribute__((ext_vector_type(4)));
typedef float f32x2 __attribute__((ext_vector_type(2)));
typedef unsigned u32x4 __attribute__((ext_vector_type(4)));
typedef unsigned u32x2 __attribute__((ext_vector_type(2)));
typedef int i32x8 __attribute__((ext_vector_type(8)));

__device__ __forceinline__ unsigned cvt_pk_bf16(float lo, float hi) { unsigned r; asm volatile("v_cvt_pk_bf16_f32 %0, %1, %2" : "=v"(r) : "v"(lo), "v"(hi)); return r; }
__device__ __forceinline__ unsigned pk4_fp8(float a, float b, float c, float d) { int p = __builtin_amdgcn_cvt_pk_fp8_f32(a, b, 0, false); p = __builtin_amdgcn_cvt_pk_fp8_f32(c, d, p, true); return (unsigned)p; }
__device__ __forceinline__ float bf2f(bf16_t b) { return __uint_as_float(((unsigned)b) << 16); }
__device__ __forceinline__ float fexp(float x) { return __builtin_amdgcn_exp2f(x * 1.4426950408889634f); }
__device__ __forceinline__ float flog(float x) { return __builtin_amdgcn_logf(x) * 0.6931471805599453f; }
__device__ __forceinline__ float fsigmoid(float x) { return __builtin_amdgcn_rcpf(1.0f + fexp(-x)); }
__device__ __forceinline__ float ftanh(float x) { return 1.0f - 2.0f * __builtin_amdgcn_rcpf(1.0f + fexp(2.0f * x)); }
__device__ __forceinline__ float rope_inv(int f) { const int q = f >> 2, r = f & 3; const float a = q == 0 ? 1.0f : q == 1 ? 0.1f : q == 2 ? 0.01f : 0.001f;
    const float b = r == 0 ? 1.0f : r == 1 ? 0.5623413251903491f : r == 2 ? 0.31622776601683794f : 0.1778279410038923f; return a * b; }

#define XB_TMO      128
#define XB_XCNT(j)  (256  + 64 * (j))
#define XB_XSUB(j)  (1280 + 64 * (j))
#define XB_XGEN(j)  (2304 + 64 * (j))
#define XB_TOP      3328
#define XB_TOPGEN   3392
#define XCD_BAR_WORDS 3456
#define XB_SPIN_CAP (1u << 18)
__device__ __forceinline__ unsigned xb_ld(unsigned* p)              { return __hip_atomic_load(p, __ATOMIC_RELAXED, __HIP_MEMORY_SCOPE_AGENT); }
__device__ __forceinline__ unsigned xb_add(unsigned* p, unsigned v) { return __hip_atomic_fetch_add(p, v, __ATOMIC_RELAXED, __HIP_MEMORY_SCOPE_AGENT); }
__device__ __forceinline__ unsigned xb_xcc_id() { return (unsigned)__builtin_amdgcn_s_getreg((3 << 11) | 20) & 0xFu; }
#define XB_SPIN(cond, bar) do { unsigned _sp = 0; while (cond) { __builtin_amdgcn_s_sleep(1); \
    if ((++_sp & 255u) == 0u) { if (xb_ld(&(bar)[XB_TMO])) break; if (_sp > XB_SPIN_CAP) { atomicAdd(&(bar)[XB_TMO], 1u); break; } } } } while (0)
struct XcdBarrier { unsigned* bar; unsigned x; volatile LAS unsigned* st; };
__device__ __forceinline__ XcdBarrier xcd_barrier_post(unsigned* bar, volatile LAS unsigned* st) {
    XcdBarrier b; b.bar = bar; b.x = xb_xcc_id(); b.st = st;
    if (threadIdx.x == 0) (void)xb_add(&bar[XB_XCNT(b.x)], 1u);
    return b;
}
__device__ __forceinline__ void xcd_barrier_complete(unsigned* bar, unsigned x, unsigned& nloc, unsigned& nx) {
    const unsigned G = gridDim.x * gridDim.y * gridDim.z;
    unsigned sum, cnt, mine, sp = 0u;
    for (;;) {
        sum = 0u; cnt = 0u; mine = 0u;
#pragma unroll
        for (unsigned j = 0; j < 16; ++j) { const unsigned c = xb_ld(&bar[XB_XCNT(j)]); sum += c; cnt += (c > 0u) ? 1u : 0u; mine = (j == x) ? c : mine; }
        if (sum == G) break;
        __builtin_amdgcn_s_sleep(1);
        if ((++sp & 255u) == 0u) { if (xb_ld(&bar[XB_TMO])) break; if (sp > XB_SPIN_CAP) { atomicAdd(&bar[XB_TMO], 1u); break; } }
    }
    nloc = mine > 0u ? mine : 1u; nx = cnt > 0u ? cnt : 1u;
}
__device__ __forceinline__ void xcd_barrier(const XcdBarrier& b) {
    asm volatile("s_waitcnt vmcnt(0)" ::: "memory");
    __syncthreads();
    if (threadIdx.x == 0) {
        unsigned* bar = b.bar;
        __builtin_amdgcn_s_waitcnt(0);
        unsigned nloc = b.st[0], nx = b.st[1];
        if (nloc == 0u) { xcd_barrier_complete(bar, b.x, nloc, nx); b.st[0] = nloc; b.st[1] = nx; }
        const unsigned old = xb_add(&bar[XB_XSUB(b.x)], 1u);
        const unsigned gen = old / nloc;
        if (old + 1u == (gen + 1u) * nloc) {
            __builtin_amdgcn_fence(__ATOMIC_RELEASE, "agent");
            asm volatile("s_waitcnt vmcnt(0)" ::: "memory");
            const unsigned og = xb_add(&bar[XB_TOP], 1u);
            const unsigned tg = og / nx;
            if (og + 1u == (tg + 1u) * nx) xb_add(&bar[XB_TOPGEN], 1u);
            else XB_SPIN(xb_ld(&bar[XB_TOPGEN]) == tg, bar);
            __builtin_amdgcn_fence(__ATOMIC_ACQUIRE, "agent");
            xb_add(&bar[XB_XGEN(b.x)], 1u);
            asm volatile("s_waitcnt vmcnt(0)" ::: "memory");
        } else {
            XB_SPIN(xb_ld(&bar[XB_XGEN(b.x)]) == gen, bar);
            __builtin_amdgcn_fence(__ATOMIC_ACQUIRE, "agent");
            asm volatile("s_waitcnt vmcnt(0)" ::: "memory");
        }
    }
    __syncthreads();
}

namespace pg8 {
constexpr int BM = 256, BK = 64, HALF = 128, HTB = HALF * BK * 2, STAGE_BYTES = 8 * HTB, NXCD = 8, WGM = 8;
__host__ __device__ __forceinline__ int lds_byte(int r, int c) { const int st = (r >> 4) * 2 + (c >> 5), rr = r & 15, cc = c & 31, ob = rr * 64 + cc * 2; return st * 1024 + (ob ^ (((ob >> 9) & 1) << 5)); }
__host__ __device__ __forceinline__ void stage_rc(int b, int& R, int& C) { const int st = b / 1024, sb = b % 1024, swz = sb ^ (((sb >> 9) & 1) << 5); R = (st >> 1) * 16 + swz / 64; C = (st & 1) * 32 + (swz % 64) / 2; }
__host__ __device__ __forceinline__ int perm32(int rho) { const int n = rho >> 4, i = rho & 15; return 8 * (i >> 2) + 4 * n + (i & 3); }
struct Unit { int pm, pn, kind; const char* a; const char* b; };

struct DenseOrder {
    int nM, nN, nwg, G, c, lda, ldb; const char* A; const char* B;
    __device__ void init(const bf16_t* A_, int lda_, const bf16_t* B_, int ldb_, int M, int N, int G_, int c_) { A = (const char*)A_; B = (const char*)B_; lda = lda_; ldb = ldb_; nM = M / BM; nN = N / BM; nwg = nM * nN; G = G_; c = c_; }
    __device__ bool next(int i, Unit& u) const {
        const long L = (long)i * G + c; if (L >= nwg) return false;
        int wgid = (int)L; { const int q = nwg / NXCD, r = nwg % NXCD, xcd = wgid % NXCD, off = wgid / NXCD; wgid = (xcd < r ? xcd * (q + 1) : r * (q + 1) + (xcd - r) * q) + off; }
        const int nig = WGM * nN, gid = wgid / nig, fm = gid * WGM, gsz = (nM - fm) < WGM ? (nM - fm) : WGM;
        u.pm = fm + ((wgid % nig) % gsz); u.pn = (wgid % nig) / gsz; u.kind = 0;
        u.a = A + (size_t)u.pm * BM * lda * 2; u.b = B + (size_t)u.pn * BM * ldb * 2; return true;
    }
};

template <class Epi, class Sched, bool ALIGN_EPI = false, bool SP2 = false, bool FP8 = false>
__device__ __forceinline__ void gemm_phase(LAS unsigned char* lds, const int K, const int lda, const int ldb, const Sched& S, const Epi& E) {
    const int tid = threadIdx.x, wid = __builtin_amdgcn_readfirstlane(tid >> 6), lane = tid & 63, wr = wid >> 2, wc = wid & 3, fr = lane & 15, fq = lane >> 4;
    const int nt = K / BK;
    unsigned voffA[2], voffB[2];
#pragma unroll
    for (int i = 0; i < 2; ++i) { int R, C; stage_rc(tid * 16 + i * 8192, R, C); const int Rb = Epi::PERM ? ((R & ~31) + perm32(R & 31)) : R;
        voffA[i] = (unsigned)(R * lda + C) * 2u; voffB[i] = (unsigned)(Rb * ldb + C) * 2u; }
    const size_t kstep = (size_t)(BK * 2);
    const size_t hstepA = (size_t)HALF * lda * 2, hstepB = (size_t)HALF * ldb * 2;
    const unsigned ldsw = (unsigned)wid * 1024u;
    const int aoff = lds_byte(wr * 64 + fr, fq * 8), boff = lds_byte(wc * 32 + fr, fq * 8);
#define PG8_SA(b, h) (((b) * 2 + (h)) * HTB)
#define PG8_SB(b, h) ((4 + (b) * 2 + (h)) * HTB)
#define PG8_STAGE(bufoff, gbase, voff) do { _Pragma("unroll") for (int _i = 0; _i < 2; ++_i) \
        __builtin_amdgcn_global_load_lds((const unsigned*)((const char*)(gbase) + (voff)[_i]), (LAS unsigned*)(lds + (bufoff) + ldsw + _i * 8192), 16, 0, 0); } while (0)
#define PG8_LDA(dst, b, h) do { _Pragma("unroll") for (int m = 0; m < 4; ++m) _Pragma("unroll") for (int k = 0; k < 2; ++k) dst[m][k] = *(const LAS bf16x8*)(lds + PG8_SA(b, h) + aoff + m * 2048 + k * 1024); } while (0)
#define PG8_LDB(dst, b, h) do { _Pragma("unroll") for (int n = 0; n < 2; ++n) _Pragma("unroll") for (int k = 0; k < 2; ++k) dst[n][k] = *(const LAS bf16x8*)(lds + PG8_SB(b, h) + boff + n * 2048 + k * 1024); } while (0)
#define PG8_CAT(x) __builtin_bit_cast(i32x8, __builtin_shufflevector((x)[0], (x)[1], 0, 1, 2, 3, 4, 5, 6, 7, 8, 9, 10, 11, 12, 13, 14, 15))
#define PG8_MMA(ai, bj, At, Bt) do { __builtin_amdgcn_s_setprio(1); _Pragma("unroll") for (int m = 0; m < 4; ++m) _Pragma("unroll") for (int n = 0; n < 2; ++n) { \
        if constexpr (FP8) { asm volatile("v_mfma_f32_16x16x128_f8f6f4 %0, %1, %2, %0" : "+v"(acc[ai][bj][m][n]) : "v"(PG8_CAT(Bt[n])), "v"(PG8_CAT(At[m]))); } \
        else { _Pragma("unroll") for (int k = 0; k < 2; ++k) acc[ai][bj][m][n] = __builtin_amdgcn_mfma_f32_16x16x32_bf16(Bt[n][k], At[m][k], acc[ai][bj][m][n], 0, 0, 0); } } \
        __builtin_amdgcn_s_setprio(0); } while (0)
#define PG8_WAIT_V(n) asm volatile("s_waitcnt vmcnt(" #n ")" ::: "memory")
#define PG8_WAIT_L(n) asm volatile("s_waitcnt lgkmcnt(" #n ")" ::: "memory")
#define PG8_BAR __builtin_amdgcn_s_barrier()
#define PG8_SCHED __builtin_amdgcn_sched_barrier(0)
    Unit cur, nxt; int ui = 0;
    if (!S.next(0, cur)) return;
    f32x4 acc[2][2][4][2];
#pragma unroll
    for (int a = 0; a < 2; ++a)
#pragma unroll
        for (int b = 0; b < 2; ++b)
#pragma unroll
            for (int m = 0; m < 4; ++m)
#pragma unroll
                for (int n = 0; n < 2; ++n) acc[a][b][m][n] = (f32x4){0.f, 0.f, 0.f, 0.f};
    bf16x8 At[4][2], B0[2][2], B1[2][2];
    const char* cA = cur.a; const char* cB = cur.b;
    if constexpr (SP2) {
        PG8_STAGE(PG8_SB(0, 0), cB, voffB); PG8_STAGE(PG8_SB(0, 1), cB + hstepB, voffB); PG8_STAGE(PG8_SA(0, 0), cA, voffA); PG8_STAGE(PG8_SA(0, 1), cA + hstepA, voffA);
        if (wr == 1) PG8_BAR;
        PG8_WAIT_V(2); PG8_BAR;
        PG8_STAGE(PG8_SB(1, 0), cB + kstep, voffB); PG8_STAGE(PG8_SA(1, 0), cA + kstep, voffA); PG8_STAGE(PG8_SB(1, 1), cB + hstepB + kstep, voffB);
        PG8_WAIT_V(6); PG8_BAR;
    } else {
        PG8_STAGE(PG8_SB(0, 0), cB, voffB); PG8_STAGE(PG8_SA(0, 0), cA, voffA); PG8_STAGE(PG8_SB(0, 1), cB + hstepB, voffB); PG8_STAGE(PG8_SA(0, 1), cA + hstepA, voffA);
        if (wr == 1) PG8_BAR;
        PG8_WAIT_V(4); PG8_BAR;
        PG8_STAGE(PG8_SB(1, 0), cB + kstep, voffB); PG8_STAGE(PG8_SA(1, 0), cA + kstep, voffA); PG8_STAGE(PG8_SB(1, 1), cB + hstepB + kstep, voffB);
        PG8_WAIT_V(6); PG8_BAR;
    }
    for (;;) {
        const bool has_next = S.next(ui + 1, nxt);
        const char* nA = has_next ? nxt.a : cA; const char* nB = has_next ? nxt.b : cB;
        for (int t = 0; t < nt; t += 2) {
            const bool last = (t == nt - 2);
            const char* a1 = cA + (size_t)(t + 1) * kstep;
            const char* a2 = last ? nA : cA + (size_t)(t + 2) * kstep; const char* b2 = last ? nB : cB + (size_t)(t + 2) * kstep;
            const char* a3 = a2 + kstep; const char* b3 = b2 + kstep;
            if constexpr (SP2) {
            PG8_LDB(B0, 0, 0); PG8_LDB(B1, 0, 1); PG8_SCHED; PG8_LDA(At, 0, 0); PG8_STAGE(PG8_SA(1, 1), a1 + hstepA, voffA);
            PG8_WAIT_V(8); PG8_WAIT_L(0); PG8_BAR; PG8_MMA(0, 0, At, B0); PG8_MMA(0, 1, At, B1); PG8_BAR; PG8_SCHED;
            PG8_LDA(At, 0, 1); PG8_STAGE(PG8_SB(0, 0), b2, voffB); PG8_STAGE(PG8_SB(0, 1), b2 + hstepB, voffB); PG8_STAGE(PG8_SA(0, 0), a2, voffA);
            PG8_WAIT_V(8); PG8_WAIT_L(0); PG8_BAR; PG8_MMA(1, 0, At, B0); PG8_MMA(1, 1, At, B1); PG8_BAR; PG8_SCHED;
            PG8_LDB(B0, 1, 0); PG8_LDB(B1, 1, 1); PG8_SCHED; PG8_LDA(At, 1, 0); PG8_STAGE(PG8_SA(0, 1), a2 + hstepA, voffA);
            PG8_WAIT_V(8); PG8_WAIT_L(0); PG8_BAR; PG8_MMA(0, 0, At, B0); PG8_MMA(0, 1, At, B1); PG8_BAR; PG8_SCHED;
            PG8_LDA(At, 1, 1); PG8_STAGE(PG8_SB(1, 0), b3, voffB); PG8_STAGE(PG8_SB(1, 1), b3 + hstepB, voffB); PG8_STAGE(PG8_SA(1, 0), a3, voffA);
            PG8_WAIT_V(8); PG8_WAIT_L(0); PG8_BAR; PG8_MMA(1, 0, At, B0); PG8_MMA(1, 1, At, B1); PG8_BAR; PG8_SCHED;
            } else {
            PG8_LDB(B0, 0, 0); PG8_SCHED; PG8_LDA(At, 0, 0); PG8_STAGE(PG8_SA(1, 1), a1 + hstepA, voffA);
            PG8_WAIT_L(8); PG8_BAR; PG8_WAIT_L(0); PG8_MMA(0, 0, At, B0); PG8_BAR; PG8_SCHED;
            PG8_LDB(B1, 0, 1); PG8_STAGE(PG8_SB(0, 0), b2, voffB);
            PG8_BAR; PG8_WAIT_L(0); PG8_MMA(0, 1, At, B1); PG8_BAR;
            PG8_LDA(At, 0, 1); PG8_STAGE(PG8_SA(0, 0), a2, voffA);
            PG8_BAR; PG8_WAIT_L(0); PG8_MMA(1, 0, At, B0); PG8_BAR; PG8_SCHED;
            PG8_STAGE(PG8_SB(0, 1), b2 + hstepB, voffB);
            PG8_WAIT_V(6); PG8_BAR; PG8_MMA(1, 1, At, B1); PG8_BAR;
            PG8_LDB(B0, 1, 0); PG8_SCHED; PG8_LDA(At, 1, 0); PG8_STAGE(PG8_SA(0, 1), a2 + hstepA, voffA);
            PG8_WAIT_L(8); PG8_BAR; PG8_WAIT_L(0); PG8_MMA(0, 0, At, B0); PG8_BAR; PG8_SCHED;
            PG8_LDB(B1, 1, 1); PG8_STAGE(PG8_SB(1, 0), b3, voffB);
            PG8_BAR; PG8_WAIT_L(0); PG8_MMA(0, 1, At, B1); PG8_BAR;
            PG8_LDA(At, 1, 1); PG8_STAGE(PG8_SA(1, 0), a3, voffA);
            PG8_BAR; PG8_WAIT_L(0); PG8_MMA(1, 0, At, B0); PG8_BAR; PG8_SCHED;
            PG8_STAGE(PG8_SB(1, 1), b3 + hstepB, voffB);
            PG8_WAIT_V(6); PG8_BAR; PG8_MMA(1, 1, At, B1); PG8_BAR;
            }
        }
        if constexpr (ALIGN_EPI) { if (wr == 0) PG8_BAR; }
        if constexpr (FP8) asm volatile("s_nop 15\n\ts_nop 15\n\ts_nop 7" ::: "memory");
        E(acc, cur, wr, wc, fr, fq);
        if (!has_next) break;
#pragma unroll
        for (int a = 0; a < 2; ++a)
#pragma unroll
            for (int b = 0; b < 2; ++b)
#pragma unroll
                for (int m = 0; m < 4; ++m)
#pragma unroll
                    for (int n = 0; n < 2; ++n) acc[a][b][m][n] = (f32x4){0.f, 0.f, 0.f, 0.f};
        cur = nxt; cA = nA; cB = nB; ++ui;
        if constexpr (ALIGN_EPI) { if (wr == 1) PG8_BAR; }
    }
    PG8_WAIT_V(0);
    if constexpr (!ALIGN_EPI) { if (wr == 0) PG8_BAR; }
    PG8_BAR;
#undef PG8_SA
#undef PG8_SB
#undef PG8_STAGE
#undef PG8_LDA
#undef PG8_LDB
#undef PG8_MMA
#undef PG8_CAT
#undef PG8_WAIT_V
#undef PG8_WAIT_L
#undef PG8_BAR
#undef PG8_SCHED
}
}
using pg8::Unit;

typedef const f32x4 (&AccRef)[2][2][4][2];
struct EpiF32 { static constexpr bool PERM = false; float* C; int ldc;
    __device__ __forceinline__ void operator()(AccRef acc, const Unit& u, int wr, int wc, int fr, int fq) const {
        const int row0 = u.pm * 256 + wr * 64 + fr, col0 = u.pn * 256 + wc * 32 + 4 * fq;
#pragma unroll
        for (int ai = 0; ai < 2; ++ai)
#pragma unroll
            for (int m = 0; m < 4; ++m) { float* rowp = C + (size_t)(row0 + ai * 128 + m * 16) * ldc + col0;
#pragma unroll
                for (int bj = 0; bj < 2; ++bj)
#pragma unroll
                    for (int n = 0; n < 2; ++n) *(f32x4*)(rowp + bj * 128 + n * 16) = acc[ai][bj][m][n]; }
    } };
struct EpiRes { static constexpr bool PERM = false; float* C; const float* R; const float* gate;
    __device__ __forceinline__ void operator()(AccRef acc, const Unit& u, int wr, int wc, int fr, int fq) const {
        const int row0 = u.pm * 256 + wr * 64 + fr, col0 = u.pn * 256 + wc * 32 + 4 * fq;
        const float* gp = gate + (size_t)((u.pm * 256) / SEQ) * NMOD + col0;
        f32x4 gv[2][2];
#pragma unroll
        for (int bj = 0; bj < 2; ++bj)
#pragma unroll
            for (int n = 0; n < 2; ++n) gv[bj][n] = *(const f32x4*)(gp + bj * 128 + n * 16);
#pragma unroll
        for (int ai = 0; ai < 2; ++ai)
#pragma unroll
          for (int mp = 0; mp < 2; ++mp) {
            f32x4 r[2][2][2];
#pragma unroll
            for (int mm = 0; mm < 2; ++mm) { const size_t off = (size_t)(row0 + ai * 128 + (mp * 2 + mm) * 16) * D + col0;
#pragma unroll
                for (int bj = 0; bj < 2; ++bj)
#pragma unroll
                    for (int n = 0; n < 2; ++n) r[mm][bj][n] = *(const f32x4*)(R + off + bj * 128 + n * 16); }
#pragma unroll
            for (int mm = 0; mm < 2; ++mm) { const size_t off = (size_t)(row0 + ai * 128 + (mp * 2 + mm) * 16) * D + col0;
#pragma unroll
                for (int bj = 0; bj < 2; ++bj)
#pragma unroll
                    for (int n = 0; n < 2; ++n) *(f32x4*)(C + off + bj * 128 + n * 16) = r[mm][bj][n] + gv[bj][n] * acc[ai][bj][mp * 2 + mm][n]; }
          }
    } };
struct EpiSwiglu { static constexpr bool PERM = true; bf16_t* O; int ldo;
    __device__ __forceinline__ void operator()(AccRef acc, const Unit& u, int wr, int wc, int fr, int fq) const {
        const int row0 = u.pm * 256 + wr * 64 + fr, col0 = u.pn * 128 + wc * 32 + 8 * fq;
#pragma unroll
        for (int ai = 0; ai < 2; ++ai)
#pragma unroll
            for (int m = 0; m < 4; ++m) { bf16_t* rowp = O + (size_t)(row0 + ai * 128 + m * 16) * ldo + col0;
                float o[8];
#pragma unroll
                for (int n = 0; n < 2; ++n)
#pragma unroll
                    for (int j = 0; j < 4; ++j) { const float a = acc[ai][0][m][n][j], b = acc[ai][1][m][n][j]; o[n * 4 + j] = a * __builtin_amdgcn_rcpf(1.0f + __expf(-a)) * b; }
                u32x4 w; w.x = cvt_pk_bf16(o[0], o[1]); w.y = cvt_pk_bf16(o[2], o[3]); w.z = cvt_pk_bf16(o[4], o[5]); w.w = cvt_pk_bf16(o[6], o[7]);
                *(u32x4*)rowp = w; }
    } };

struct EpiSwigluF8 { static constexpr bool PERM = true; unsigned char* O; int ldo; float sc;
    __device__ __forceinline__ void operator()(AccRef acc, const Unit& u, int wr, int wc, int fr, int fq) const {
        const int row0 = u.pm * 256 + wr * 64 + fr, col0 = u.pn * 128 + wc * 32 + 8 * fq;
#pragma unroll
        for (int ai = 0; ai < 2; ++ai)
#pragma unroll
            for (int m = 0; m < 4; ++m) { unsigned char* rowp = O + (size_t)(row0 + ai * 128 + m * 16) * ldo + col0;
                float o[8];
#pragma unroll
                for (int n = 0; n < 2; ++n)
#pragma unroll
                    for (int j = 0; j < 4; ++j) { const float a = acc[ai][0][m][n][j] * sc, b = acc[ai][1][m][n][j] * sc; o[n * 4 + j] = a * __builtin_amdgcn_rcpf(1.0f + __expf(-a)) * b; }
                u32x2 w; w.x = pk4_fp8(o[0], o[1], o[2], o[3]); w.y = pk4_fp8(o[4], o[5], o[6], o[7]);
                *(u32x2*)rowp = w; }
    } };
struct EpiBf16S { static constexpr bool PERM = true; bf16_t* O; int ldo; float sc;
    __device__ __forceinline__ void operator()(AccRef acc, const Unit& u, int wr, int wc, int fr, int fq) const {
        const int row0 = u.pm * 256 + wr * 64 + fr, col0 = u.pn * 256 + wc * 32 + 8 * fq;
#pragma unroll
        for (int ai = 0; ai < 2; ++ai)
#pragma unroll
            for (int m = 0; m < 4; ++m) { bf16_t* rowp = O + (size_t)(row0 + ai * 128 + m * 16) * ldo + col0;
#pragma unroll
                for (int bj = 0; bj < 2; ++bj) { const f32x4 v0 = acc[ai][bj][m][0] * sc, v1 = acc[ai][bj][m][1] * sc;
                    u32x4 w; w.x = cvt_pk_bf16(v0[0], v0[1]); w.y = cvt_pk_bf16(v0[2], v0[3]); w.z = cvt_pk_bf16(v1[0], v1[1]); w.w = cvt_pk_bf16(v1[2], v1[3]);
                    *(u32x4*)(rowp + bj * 128) = w; } }
    } };

struct MapPlain { const float* src; int ld, ncols;
    __device__ __forceinline__ const float* operator()(int n0) const { return n0 < ncols ? src + n0 : nullptr; } __device__ __forceinline__ int stride() const { return ld; } __device__ __forceinline__ bool valid(int n) const { return n < ncols; } };
struct MapIl { const float* s1; long d31; int ld;
    __device__ __forceinline__ const float* operator()(int n0) const { const int t = n0 >> 8, j = n0 & 255; return s1 + (j < 128 ? 0l : d31) + t * 128 + (j & 127); } __device__ __forceinline__ int stride() const { return ld; } __device__ __forceinline__ bool valid(int) const { return true; } };
template <bool FP8, class MAP>
__device__ __forceinline__ void cvt_ring(LAS unsigned char* lds, const MAP& map, void* dstv, int Nd, int K, float scale, int G, int c) {
    constexpr int NS = 4, SLOT = 32768;
    const int tid = threadIdx.x, wave = __builtin_amdgcn_readfirstlane(tid >> 6), lane = tid & 63;
    const int ntk = K / 128, nnt = Nd / 64, ntiles = nnt * ntk;
    if (c >= ntiles) return;
    const int nmine = (ntiles - c + G - 1) / G;
    const int ld = map.stride();
    __syncthreads();
    auto issue = [&](int it) {
        const int itc = it < nmine ? it : nmine - 1, tile = c + itc * G;
        const int n0 = (tile % nnt) * 64, k0 = (tile / nnt) * 128;
        const float* sp = map(n0);
        const int col = (lane & 15) * 4, colc = (sp && map.valid(n0 + col)) ? col : 0;
        const float* base = (sp ? sp : map(0)) + colc;
        LAS unsigned char* sl = lds + (it % NS) * SLOT + wave * 4096;
#pragma unroll
        for (int i = 0; i < 4; ++i)
            __builtin_amdgcn_global_load_lds((const unsigned*)(base + (size_t)(k0 + wave * 16 + i * 4 + (lane >> 4)) * ld), (LAS unsigned*)(sl + i * 1024), 16, 0, 0);
    };
#pragma unroll
    for (int i = 0; i < NS - 1; ++i) issue(i);
    for (int it = 0; it < nmine; ++it) {
        asm volatile("s_waitcnt vmcnt(8)" ::: "memory");
        __syncthreads();
        issue(it + NS - 1);
        const int tile = c + it * G, n0 = (tile % nnt) * 64, k0 = (tile / nnt) * 128;
        const LAS float* T = (const LAS float*)(lds + (it % NS) * SLOT);
        const bool ok = map(n0) != nullptr && map.valid(n0 + lane);
        if constexpr (FP8) {
            float v[16];
#pragma unroll
            for (int j = 0; j < 16; ++j) v[j] = ok ? T[(wave * 16 + j) * 64 + lane] * scale : 0.f;
            u32x4 w; w.x = pk4_fp8(v[0], v[1], v[2], v[3]); w.y = pk4_fp8(v[4], v[5], v[6], v[7]); w.z = pk4_fp8(v[8], v[9], v[10], v[11]); w.w = pk4_fp8(v[12], v[13], v[14], v[15]);
            *(u32x4*)((unsigned char*)dstv + (size_t)(n0 + lane) * K + k0 + wave * 16) = w;
        } else {
#pragma unroll
            for (int h = 0; h < 2; ++h) { const int kg = wave + 8 * h; float v[8];
#pragma unroll
                for (int j = 0; j < 8; ++j) v[j] = ok ? T[(kg * 8 + j) * 64 + lane] : 0.f;
                u32x4 w; w.x = cvt_pk_bf16(v[0], v[1]); w.y = cvt_pk_bf16(v[2], v[3]); w.z = cvt_pk_bf16(v[4], v[5]); w.w = cvt_pk_bf16(v[6], v[7]);
                *(u32x4*)((bf16_t*)dstv + (size_t)(n0 + lane) * K + k0 + kg * 8) = w; }
        }
    }
    asm volatile("s_waitcnt vmcnt(0)" ::: "memory");
    __syncthreads();
}
template <class MAP> __device__ __forceinline__ void cvt_T(LAS unsigned char* lds, const MAP& map, bf16_t* dst, int Nd, int K, int G, int c) { cvt_ring<false>(lds, map, dst, Nd, K, 1.f, G, c); }
template <class MAP> __device__ __forceinline__ void cvt_T8(LAS unsigned char* lds, const MAP& map, unsigned char* dst, int Nd, int K, float scale, int G, int c) { cvt_ring<true>(lds, map, dst, Nd, K, scale, G, c); }
__device__ __forceinline__ void cvt_copy(const float* src, bf16_t* dst, size_t n, int G, int c) {
    for (size_t i = ((size_t)c * 512 + threadIdx.x) * 8; i < n; i += (size_t)G * 512 * 8) {
        const float4 a = *(const float4*)(src + i), b = *(const float4*)(src + i + 4);
        u32x4 w; w.x = cvt_pk_bf16(a.x, a.y); w.y = cvt_pk_bf16(a.z, a.w); w.z = cvt_pk_bf16(b.x, b.y); w.w = cvt_pk_bf16(b.z, b.w);
        *(u32x4*)(dst + i) = w;
    }
}


__device__ __forceinline__ f32x2 gelu_pk(f32x2 v) {
    const f32x2 av = __builtin_elementwise_abs(v), d = av * 0.2316418882f + 1.0f;
    f32x2 t; t.x = __builtin_amdgcn_rcpf(d.x); t.y = __builtin_amdgcn_rcpf(d.y);
    f32x2 q = t * 0.5307027145f + (-0.7265760135f); q = q * t + 0.7107068705f; q = q * t + (-0.142248368f); q = q * t + 0.127414796f; q = q * t;
    const f32x2 s = (v * v) * (-0.72134752044f);
    f32x2 e; e.x = __builtin_amdgcn_exp2f(s.x); e.y = __builtin_amdgcn_exp2f(s.y);
    const f32x2 m = v * (q * e), r = v - m;
    f32x2 o; o.x = v.x < 0.f ? m.x : r.x; o.y = v.y < 0.f ? m.y : r.y; return o;
}
struct EpiGelu { static constexpr bool PERM = false; bf16_t* U; float* VG;
    __device__ __forceinline__ void operator()(AccRef acc, const Unit& u, int wr, int wc, int fr, int fq) const {
        const int row0 = u.pm * 256 + wr * 64 + fr, col0 = (u.pn & 7) * 256 + wc * 32 + 4 * fq;
        const bool isu = u.pn < 8;
#pragma unroll
        for (int ai = 0; ai < 2; ++ai)
#pragma unroll
            for (int m = 0; m < 4; ++m) { const size_t off = (size_t)(row0 + ai * 128 + m * 16) * D + col0;
#pragma unroll
                for (int bj = 0; bj < 2; ++bj)
#pragma unroll
                    for (int n = 0; n < 2; ++n) { const f32x4 v = acc[ai][bj][m][n];
                        const f32x2 a = gelu_pk((f32x2){v[0], v[1]}), b = gelu_pk((f32x2){v[2], v[3]});
                        if (isu) { u32x2 w; w.x = cvt_pk_bf16(a.x, a.y); w.y = cvt_pk_bf16(b.x, b.y); *(u32x2*)(U + off + bj * 128 + n * 16) = w; }
                        else *(f32x4*)(VG + off + bj * 128 + n * 16) = (f32x4){a.x, a.y, b.x, b.y}; } }
    } };

namespace pg8 {
struct MoeOrder {
    int cnt_t[8], off_t[8], nN, G, c, lda, ldb; const char* A; const char* B; size_t bstride;
    __device__ void init(const int* cnt, const int* off, const bf16_t* A_, int lda_, const bf16_t* B_, int ldb_, size_t bstride_bytes, int N, int G_, int c_) {
#pragma unroll
        for (int e = 0; e < 8; ++e) { cnt_t[e] = __builtin_amdgcn_readfirstlane((cnt[e] + 255) >> 8); off_t[e] = __builtin_amdgcn_readfirstlane(off[e] >> 8); }
        A = (const char*)A_; B = (const char*)B_; lda = lda_; ldb = ldb_; bstride = bstride_bytes; nN = N / 256; G = G_; c = c_;
    }
    __device__ bool next(int i, Unit& u) const {
        const int L = i * G + c, x = L & 7; int q = L >> 3; int e = 0; bool found = false; int te = 0, oe = 0;
        const int n8 = nN >> 3;
#pragma unroll
        for (int k = 0; k < 8; ++k) { const int ue = cnt_t[k] * n8; if (!found) { if (q < ue) { found = true; e = k; te = cnt_t[k]; oe = off_t[k]; } else q -= ue; } }
        if (!found) return false;
        const int pml = q % te; u.pn = (q / te) * 8 + x; u.pm = oe + pml; u.kind = e;
        u.a = A + (size_t)u.pm * 256 * lda * 2; u.b = B + (size_t)e * bstride + (size_t)u.pn * 256 * ldb * 2; return true;
    }
};
}

template <bool ROUTE>
__device__ __forceinline__ void ph_norm_mod(LAS unsigned char* lds, const float* srcL, const float* srcC, const float* gain, const float* mod, int chunk_sh, int chunk_sc, bf16_t* dst, int nrows,
                                            const float* router, int* tope, float* topg, int* bcnt, int G, int bid) {
    const int tid = threadIdx.x, wave = tid >> 6, lane = tid & 63;
    const int rpb = (nrows + G - 1) / G, r0 = bid * rpb, r1 = min(nrows, r0 + rpb);
    LAS int* lc = (LAS int*)lds;
    if (ROUTE) { if (tid < 8) lc[tid] = 0; __syncthreads(); }
    int cur_mrow = -1; float gm[32], shv[32];
    for (int row = r0 + wave; row < r1; row += 8) {
        const float* src = row < NL ? srcL + (size_t)row * D : srcC + (size_t)(row - NL) * D;
        const int mrow = row < NL ? row / SEQ : 2;
        if (mrow != cur_mrow) { cur_mrow = mrow;
            const float* sh_ = mod + (size_t)mrow * NMOD + chunk_sh * D; const float* sc_ = mod + (size_t)mrow * NMOD + chunk_sc * D;
#pragma unroll
            for (int i = 0; i < 8; ++i) { const int c = i * 256 + lane * 4; const float4 g4 = *(const float4*)(gain + c), sc4 = *(const float4*)(sc_ + c), sh4 = *(const float4*)(sh_ + c);
                gm[i * 4] = g4.x * (1.f + sc4.x); gm[i * 4 + 1] = g4.y * (1.f + sc4.y); gm[i * 4 + 2] = g4.z * (1.f + sc4.z); gm[i * 4 + 3] = g4.w * (1.f + sc4.w);
                shv[i * 4] = sh4.x; shv[i * 4 + 1] = sh4.y; shv[i * 4 + 2] = sh4.z; shv[i * 4 + 3] = sh4.w; } }
        float v[32]; float ss = 0.f;
#pragma unroll
        for (int i = 0; i < 8; ++i) { const float4 x = *(const float4*)(src + i * 256 + lane * 4); v[i * 4] = x.x; v[i * 4 + 1] = x.y; v[i * 4 + 2] = x.z; v[i * 4 + 3] = x.w; ss += x.x * x.x + x.y * x.y + x.z * x.z + x.w * x.w; }
        ss = wave_sum(ss);
        const float rs = rsqrtf(ss * (1.0f / D) + 1e-6f);
        float a[8];
        if (ROUTE) {
#pragma unroll
            for (int e = 0; e < 8; ++e) a[e] = 0.f;
        }
#pragma unroll
        for (int i = 0; i < 8; ++i) {
            const int c = i * 256 + lane * 4;
            float o[4];
            o[0] = v[i * 4] * rs * gm[i * 4] + shv[i * 4]; o[1] = v[i * 4 + 1] * rs * gm[i * 4 + 1] + shv[i * 4 + 1];
            o[2] = v[i * 4 + 2] * rs * gm[i * 4 + 2] + shv[i * 4 + 2]; o[3] = v[i * 4 + 3] * rs * gm[i * 4 + 3] + shv[i * 4 + 3];
            if (ROUTE) *(unsigned*)((unsigned char*)dst + (size_t)row * D + c) = pk4_fp8(o[0], o[1], o[2], o[3]);
            else { u32x2 w; w.x = cvt_pk_bf16(o[0], o[1]); w.y = cvt_pk_bf16(o[2], o[3]); *(u32x2*)(dst + (size_t)row * D + c) = w; }
            if (ROUTE) {
#pragma unroll
                for (int j = 0; j < 4; ++j) { const float4 ra = *(const float4*)(router + (size_t)(c + j) * 8), rb = *(const float4*)(router + (size_t)(c + j) * 8 + 4);
                    a[0] += o[j] * ra.x; a[1] += o[j] * ra.y; a[2] += o[j] * ra.z; a[3] += o[j] * ra.w; a[4] += o[j] * rb.x; a[5] += o[j] * rb.y; a[6] += o[j] * rb.z; a[7] += o[j] * rb.w; }
            }
        }
        if (ROUTE) {
#pragma unroll
            for (int e = 0; e < 8; ++e) a[e] = wave_sum(a[e]);
            if (lane == 0) {
                int e0 = 0; float v0 = a[0];
#pragma unroll
                for (int e = 1; e < 8; ++e) if (a[e] > v0) { v0 = a[e]; e0 = e; }
                int e1 = 0; float v1 = -3e38f;
#pragma unroll
                for (int e = 0; e < 8; ++e) if (e != e0 && a[e] > v1) { v1 = a[e]; e1 = e; }
                const float ex = fexp(v1 - v0);
                tope[row * 2] = e0; tope[row * 2 + 1] = e1;
                topg[row * 2] = 1.f / (1.f + ex); topg[row * 2 + 1] = ex / (1.f + ex);
                atomicAdd((int*)&lc[e0], 1); atomicAdd((int*)&lc[e1], 1);
            }
        }
    }
    if (ROUTE) { __syncthreads(); if (tid < 8) bcnt[bid * 8 + tid] = lc[tid]; __syncthreads(); }
}

__device__ __forceinline__ void ph_moe_plan(LAS unsigned char* lds, const int* bcnt, const int* tope, int* slot, int* cntoff, const bf16_t* XNB, bf16_t* XG, int G, int bid) {
    const int tid = threadIdx.x;
    LAS int* base = (LAS int*)lds;
    LAS int* sl = base + 8;
    const int rpb = (NL + G - 1) / G, r0 = bid * rpb, r1 = min(NL, r0 + rpb);
    __syncthreads();
    for (int a = tid; a < (r1 - r0) * 2; a += 512) base[48 + 160 + a] = tope[r0 * 2 + a];
    if (tid < 8) {
        int tot = 0, pre = 0;
        for (int b = 0; b < G; ++b) { const int v = bcnt[b * 8 + tid]; tot += v; pre += (b < bid) ? v : 0; }
        base[16 + tid] = tot; base[32 + tid] = pre;
    }
    __syncthreads();
    if (tid == 0) {
        int off = 0;
        for (int e = 0; e < 8; ++e) { const int tot = base[16 + e]; base[e] = off + base[32 + e]; if (bid == 0) { cntoff[e] = tot; cntoff[8 + e] = off; } off += (tot + 255) & ~255; }
        int cur[8];
#pragma unroll
        for (int e = 0; e < 8; ++e) cur[e] = base[e];
        for (int a = r0 * 2; a < r1 * 2; ++a) { const int e = base[48 + 160 + a - r0 * 2]; int s = 0;
#pragma unroll
            for (int q = 0; q < 8; ++q) if (e == q) { s = cur[q]; cur[q]++; }
            slot[a] = s; base[48 + a - r0 * 2] = s; }
    }
    __syncthreads();
    const int na = (r1 - r0) * 2;
    for (int i = tid; i < na * 128; i += 512) { const int a = i >> 7, c16 = i & 127; const int s = base[48 + a], row = r0 + (a >> 1);
        *(u32x4*)((unsigned char*)XG + (size_t)s * D + c16 * 16) = *(const u32x4*)((const unsigned char*)XNB + (size_t)row * D + c16 * 16); }
    __syncthreads();
}

__device__ __forceinline__ void ph_ln_transpose(LAS unsigned char* lds, const float* VG, const float* lnw, const float* lnb, bf16_t* VT, int G, int bid) {
    const int tid = threadIdx.x, wave = tid >> 6, lane = tid & 63;
    LAS bf16_t* T = (LAS bf16_t*)lds;
    for (int unit = bid; unit < NL / 32; unit += G) {
        const int row0 = unit * 32;
        __syncthreads();
        for (int rr = wave; rr < 32; rr += 8) {
            const float* src = VG + (size_t)(row0 + rr) * D;
            float v[32]; float s = 0.f;
#pragma unroll
            for (int i = 0; i < 8; ++i) { const float4 x = *(const float4*)(src + i * 256 + lane * 4); v[i * 4] = x.x; v[i * 4 + 1] = x.y; v[i * 4 + 2] = x.z; v[i * 4 + 3] = x.w; s += (x.x + x.y) + (x.z + x.w); }
            const float mu = wave_sum(s) * (1.f / 2048.f);
            float q = 0.f;
#pragma unroll
            for (int i = 0; i < 32; ++i) { const float dd = v[i] - mu; q += dd * dd; }
            const float rs = rsqrtf(wave_sum(q) * (1.f / 2048.f) + 1e-5f);
#pragma unroll
            for (int i = 0; i < 8; ++i) { const int c = i * 256 + lane * 4;
                const float4 w4 = *(const float4*)(lnw + c), b4 = *(const float4*)(lnb + c);
                u32x2 w; w.x = cvt_pk_bf16((v[i * 4] - mu) * rs * w4.x + b4.x, (v[i * 4 + 1] - mu) * rs * w4.y + b4.y);
                w.y = cvt_pk_bf16((v[i * 4 + 2] - mu) * rs * w4.z + b4.z, (v[i * 4 + 3] - mu) * rs * w4.w + b4.w);
                *(LAS u32x2*)(T + rr * 2048 + c) = w; }
        }
        __syncthreads();
        const int b = row0 / SEQ, n = (row0 % SEQ) / 128, q0 = row0 % 128;
        for (int it = tid; it < 1024 * 4; it += 512) {
            const int qg = it & 3, cp = it >> 2, c = cp * 2;
            unsigned e[8];
#pragma unroll
            for (int j = 0; j < 8; ++j) e[j] = *(const LAS unsigned*)(T + (qg * 8 + j) * 2048 + c);
            u32x4 w0, w1;
            w0.x = (e[0] & 0xffffu) | (e[1] << 16); w0.y = (e[2] & 0xffffu) | (e[3] << 16); w0.z = (e[4] & 0xffffu) | (e[5] << 16); w0.w = (e[6] & 0xffffu) | (e[7] << 16);
            w1.x = (e[0] >> 16) | (e[1] & 0xffff0000u); w1.y = (e[2] >> 16) | (e[3] & 0xffff0000u); w1.z = (e[4] >> 16) | (e[5] & 0xffff0000u); w1.w = (e[6] >> 16) | (e[7] & 0xffff0000u);
            const int g = c >> 7, cl = c & 127;
            bf16_t* dst = VT + ((((size_t)(b * 32 + n) * 16 + g) * 128 + cl) * 128 + q0 + qg * 8);
            *(u32x4*)dst = w0; *(u32x4*)(dst + 128) = w1;
        }
    }
    __syncthreads();
}

__device__ __forceinline__ void ph_spatial(const bf16_t* WS, const bf16_t* VT, const bf16_t* U, const float* bs, bf16_t* GATED, int G, int bid) {
    typedef float f32x16 __attribute__((ext_vector_type(16)));
    const int tid = threadIdx.x, wave = tid >> 6, lane = tid & 63, l32 = lane & 31, half = lane >> 5;
    const int p0 = (wave & 3) * 32, c0 = (wave >> 2) * 64;
    for (int unit = bid; unit < NB * 32 * 16; unit += G) {
        const int g = unit & 15, bn = unit >> 4;
        const bf16_t* Wp = WS + (size_t)g * 128 * 128 + (size_t)(p0 + l32) * 128 + half * 8;
        const bf16_t* Vp = VT + ((size_t)bn * 16 + g) * 128 * 128 + (size_t)(c0 + l32) * 128 + half * 8;
        f32x16 acc0, acc1;
#pragma unroll
        for (int i = 0; i < 16; ++i) { acc0[i] = 0.f; acc1[i] = 0.f; }
#pragma unroll
        for (int ks = 0; ks < 8; ++ks) {
            const bf16x8 w = *(const bf16x8*)(Wp + ks * 16), v0 = *(const bf16x8*)(Vp + ks * 16), v1 = *(const bf16x8*)(Vp + 32 * 128 + ks * 16);
            acc0 = __builtin_amdgcn_mfma_f32_32x32x16_bf16(v0, w, acc0, 0, 0, 0);
            acc1 = __builtin_amdgcn_mfma_f32_32x32x16_bf16(v1, w, acc1, 0, 0, 0);
        }
        const int p = p0 + l32;
        const float bias = bs[g * 128 + p];
        const size_t ob = (size_t)(bn * 128 + p) * D + g * 128 + c0 + 4 * half;
#pragma unroll
        for (int i4 = 0; i4 < 4; ++i4) {
#pragma unroll
            for (int hb = 0; hb < 2; ++hb) {
                const size_t o = ob + hb * 32 + 8 * i4;
                const u32x2 uu = *(const u32x2*)(U + o);
                const float u0 = __uint_as_float(uu.x << 16), u1 = __uint_as_float(uu.x & 0xffff0000u), u2 = __uint_as_float(uu.y << 16), u3 = __uint_as_float(uu.y & 0xffff0000u);
                const f32x16& a = hb == 0 ? acc0 : acc1;
                u32x2 w; w.x = cvt_pk_bf16(u0 * (a[i4 * 4] + bias), u1 * (a[i4 * 4 + 1] + bias)); w.y = cvt_pk_bf16(u2 * (a[i4 * 4 + 2] + bias), u3 * (a[i4 * 4 + 3] + bias));
                *(u32x2*)(GATED + o) = w;
            }
        }
    }
}

__device__ __forceinline__ void ph_final(const float* H, const bf16_t* OUT2, const int* slot, const float* topg, const float* g2, const float* fnorm, float* out, int G, int bid) {
    const int tid = threadIdx.x, wave = tid >> 6, lane = tid & 63;
    float fn[32], gv[32]; int cur_b = -1;
#pragma unroll
    for (int i = 0; i < 8; ++i) { const float4 f = *(const float4*)(fnorm + i * 256 + lane * 4); fn[i * 4] = f.x; fn[i * 4 + 1] = f.y; fn[i * 4 + 2] = f.z; fn[i * 4 + 3] = f.w; }
    for (int row = bid * 8 + wave; row < NL; row += G * 8) {
        const int s0 = slot[row * 2], s1 = slot[row * 2 + 1]; const float g0 = topg[row * 2], g1 = topg[row * 2 + 1];
        const float* h = H + (size_t)row * D; const bf16_t* o0 = OUT2 + (size_t)s0 * D; const bf16_t* o1 = OUT2 + (size_t)s1 * D;
        const int bb = row / SEQ;
        if (bb != cur_b) { cur_b = bb; const float* gg = g2 + (size_t)bb * NMOD;
#pragma unroll
            for (int i = 0; i < 8; ++i) { const float4 g = *(const float4*)(gg + i * 256 + lane * 4); gv[i * 4] = g.x; gv[i * 4 + 1] = g.y; gv[i * 4 + 2] = g.z; gv[i * 4 + 3] = g.w; } }
        float v[32]; float ss = 0.f;
#pragma unroll
        for (int i = 0; i < 8; ++i) { const int c = i * 256 + lane * 4;
            const float4 hv = *(const float4*)(h + c); const u32x2 a = *(const u32x2*)(o0 + c), b = *(const u32x2*)(o1 + c);
            const float a0 = __uint_as_float(a.x << 16), a1 = __uint_as_float(a.x & 0xffff0000u), a2 = __uint_as_float(a.y << 16), a3 = __uint_as_float(a.y & 0xffff0000u);
            const float b0 = __uint_as_float(b.x << 16), b1 = __uint_as_float(b.x & 0xffff0000u), b2 = __uint_as_float(b.y << 16), b3 = __uint_as_float(b.y & 0xffff0000u);
            v[i * 4] = hv.x + gv[i * 4] * (g0 * a0 + g1 * b0); v[i * 4 + 1] = hv.y + gv[i * 4 + 1] * (g0 * a1 + g1 * b1);
            v[i * 4 + 2] = hv.z + gv[i * 4 + 2] * (g0 * a2 + g1 * b2); v[i * 4 + 3] = hv.w + gv[i * 4 + 3] * (g0 * a3 + g1 * b3);
            ss += v[i * 4] * v[i * 4] + v[i * 4 + 1] * v[i * 4 + 1] + v[i * 4 + 2] * v[i * 4 + 2] + v[i * 4 + 3] * v[i * 4 + 3]; }
        const float rs = rsqrtf(wave_sum(ss) * (1.f / D) + 1e-6f);
#pragma unroll
        for (int i = 0; i < 8; ++i) { const int c = i * 256 + lane * 4;
            *(float4*)(out + (size_t)row * D + c) = (float4){v[i * 4] * rs * fn[i * 4], v[i * 4 + 1] * rs * fn[i * 4 + 1], v[i * 4 + 2] * rs * fn[i * 4 + 2], v[i * 4 + 3] * rs * fn[i * 4 + 3]}; }
    }
}

__device__ __forceinline__ void ph_ada(LAS unsigned char* lds, const float* W0, const float* W1, const float* b0, const float* b1, const float* c, const float* cc, float* mod0, float* mod1, int G, int bid) {
    const int tid = threadIdx.x, kq = tid / 24, c4 = tid % 24;
    LAS float* red = (LAS float*)lds;
    for (int u = bid; u < 256; u += G) {
        const int l = u >> 7, col0 = (u & 127) * 96;
        const float* W = (l == 0 ? W0 : W1) + col0 + c4 * 4;
        float a[12];
#pragma unroll
        for (int j = 0; j < 12; ++j) a[j] = 0.f;
        if (kq < 21) {
#pragma unroll 7
            for (int k = kq; k < D; k += 21) {
                const float4 w = *(const float4*)(W + (size_t)k * NMOD);
                const float x0 = c[k], x1 = c[D + k], x2 = cc[k];
                const float s0 = x0 * fsigmoid(x0), s1 = x1 * fsigmoid(x1), s2 = x2 * fsigmoid(x2);
                a[0] += s0 * w.x; a[1] += s0 * w.y; a[2] += s0 * w.z; a[3] += s0 * w.w;
                a[4] += s1 * w.x; a[5] += s1 * w.y; a[6] += s1 * w.z; a[7] += s1 * w.w;
                a[8] += s2 * w.x; a[9] += s2 * w.y; a[10] += s2 * w.z; a[11] += s2 * w.w;
            }
        }
        __syncthreads();
        if (kq < 21) {
#pragma unroll
            for (int j = 0; j < 12; ++j) red[(kq * 24 + c4) * 12 + j] = a[j];
        }
        __syncthreads();
        if (tid < 288) {
            const int cq = tid / 12, rj = tid % 12, row = rj >> 2, j = rj & 3, n = col0 + cq * 4 + j;
            float sum = (l == 0 ? b0 : b1)[n];
            for (int q = 0; q < 21; ++q) sum += red[(q * 24 + cq) * 12 + rj];
            if (!(l == 1 && row == 2)) (l == 0 ? mod0 : mod1)[(size_t)row * NMOD + n] = sum;
        }
    }
    __syncthreads();
}


__device__ __forceinline__ void ph_small_cvt(const float* w_up, const float* a_up, const float* g_up, bf16_t* WLORA, float* ropec, float* ropes, int G, int bid) {
    const int gt = bid * 512 + threadIdx.x, gs = G * 512;
    if (gt < 16) {
        const double x = (double)rope_inv(gt), x2 = x * x;
        double sn = x * (1.0 + x2 * (-1.0 / 6 + x2 * (1.0 / 120 + x2 * (-1.0 / 5040 + x2 * (1.0 / 362880 + x2 * (-1.0 / 39916800 + x2 * (1.0 / 6227020800.0)))))));
        double cs = 1.0 + x2 * (-0.5 + x2 * (1.0 / 24 + x2 * (-1.0 / 720 + x2 * (1.0 / 40320 + x2 * (-1.0 / 3628800 + x2 * (1.0 / 479001600.0 + x2 * (-1.0 / 87178291200.0)))))));
        double c = 1.0, s_ = 0.0;
        for (int pos = 0; pos < 64; ++pos) { ropec[pos * 16 + gt] = (float)c; ropes[pos * 16 + gt] = (float)s_; const double nc = c * cs - s_ * sn, ns = s_ * cs + c * sn; c = nc; s_ = ns; }
    }
    for (int i = gt; i < 5120 * 64; i += gs) {
        const int n = i >> 6, k0 = (i & 63) * 8, g = n >> 10, ch = n & 1023;
        float v[8];
#pragma unroll
        for (int q = 0; q < 8; ++q) { const int k = k0 + q; float x = 0.f;
            if (g < 4) { const int koff = g * 64; if (k >= koff && k < koff + 64) x = (g < 2 ? w_up : a_up)[(size_t)((g & 1) * 64 + (k - koff)) * RD + ch]; }
            else { if (k >= 256 && k < 416) x = g_up[(size_t)(k - 256) * RD + ch]; }
            v[q] = x; }
        u32x4 w; w.x = cvt_pk_bf16(v[0], v[1]); w.y = cvt_pk_bf16(v[2], v[3]); w.z = cvt_pk_bf16(v[4], v[5]); w.w = cvt_pk_bf16(v[6], v[7]);
        *(u32x4*)(WLORA + (size_t)n * 512 + k0) = w;
    }
}
struct MapKV { const float* src; int sel;
    __device__ __forceinline__ const float* operator()(int n0) const { const int h = n0 >> 7, d = n0 & 127; return src + h * 256 + sel * 128 + d; } __device__ __forceinline__ int stride() const { return KVW; } __device__ __forceinline__ bool valid(int) const { return true; } };

__device__ __forceinline__ void ph_prep(const float* Z, const float* qn, const float* kvn, const float* mup, const float* mun, const float* k_k,
                                        bf16_t* CQNB, bf16_t* CKVNB, bf16_t* KRB, bf16_t* LA, float* RR, float* KRf, float* VR, float* AA, const float* ropec, const float* ropes, int G, int bid) {
    const int wave = threadIdx.x >> 6, lane = threadIdx.x & 63;
    for (int row = bid * 8 + wave; row < MALL; row += G * 8) {
        const float* z = Z + (size_t)row * ZLD;
        int t, len; if (row < NL) { t = row % SEQ; len = SEQ; } else { t = (row - NL) % CTX; len = CTX; }
#pragma unroll
        for (int part = 0; part < 2; ++part) {
            const float4 a = *(const float4*)(z + part * 512 + lane * 8), b = *(const float4*)(z + part * 512 + lane * 8 + 4);
            float ss = a.x * a.x + a.y * a.y + a.z * a.z + a.w * a.w + b.x * b.x + b.y * b.y + b.z * b.z + b.w * b.w;
            ss = wave_sum(ss);
            const float rs = rsqrtf(ss * (1.f / 512.f) + 1e-6f);
            const float* gn = (part == 0 ? qn : kvn) + lane * 8;
            const float4 g0 = *(const float4*)gn, g1 = *(const float4*)(gn + 4);
            u32x4 w; w.x = cvt_pk_bf16(a.x * rs * g0.x, a.y * rs * g0.y); w.y = cvt_pk_bf16(a.z * rs * g0.z, a.w * rs * g0.w);
            w.z = cvt_pk_bf16(b.x * rs * g1.x, b.y * rs * g1.y); w.w = cvt_pk_bf16(b.z * rs * g1.z, b.w * rs * g1.w);
            *(u32x4*)((part == 0 ? CQNB : CKVNB) + (size_t)row * 512 + lane * 8) = w;
        }
        {
            const float val = z[1024 + lane]; const float oth = __shfl_xor(val, 16);
            float o = val;
            if (row < NL) {
                const int a = lane >> 5, hf = (lane >> 4) & 1, f = lane & 15;
                const int pos = a == 0 ? (t >> 6) : (t & 63);
                const float cs = ropec[pos * 16 + f], sn = ropes[pos * 16 + f];
                o = hf == 0 ? val * cs - oth * sn : val * cs + oth * sn;
            }
            KRB[(size_t)row * KLD + 1024 + lane] = (bf16_t)(cvt_pk_bf16(o, 0.f) & 0xffffu);
        }
        const float* zc = z + MLA_IN; const float* zp = zc - ZLD; const float* zn = zc + ZLD;
        const bool hp = t > 0, hn = t < len - 1;
#define SHIFT4(jj) ({ const int j_ = (jj); const f32x4 zz = *(const f32x4*)(zc + j_), mp = *(const f32x4*)(mup + j_), mn = *(const f32x4*)(mun + j_); \
            f32x4 pv = {0.f, 0.f, 0.f, 0.f}, nv = pv; if (hp) pv = *(const f32x4*)(zp + j_); if (hn) nv = *(const f32x4*)(zn + j_); zz + mp * (pv - zz) + mn * (nv - zz); })
        { f32x4 a0 = SHIFT4(lane * 4), a1 = SHIFT4((lane + 64) * 4), a2 = SHIFT4((lane + 128) * 4), a3 = SHIFT4((lane + 192) * 4);
          float* dst = RR + hmi(row, lane * 4); *(f32x4*)dst = a0; *(f32x4*)(dst + (size_t)4 * MALL * 64) = a1; *(f32x4*)(dst + (size_t)8 * MALL * 64) = a2; *(f32x4*)(dst + (size_t)12 * MALL * 64) = a3; }
        { f32x4 k[4]; k[0] = SHIFT4(1024 + lane * 4); k[1] = SHIFT4(1024 + (lane + 64) * 4); k[2] = SHIFT4(1024 + (lane + 128) * 4); k[3] = SHIFT4(1024 + (lane + 192) * 4);
#pragma unroll
          for (int i = 0; i < 4; ++i) { const int c = (lane + 64 * i) * 4;
            *(f32x4*)(KRf + hmi(row, c)) = k[i];
            const f32x4 kk = k[i] * *(const f32x4*)(k_k + c);
            float q = kk[0] * kk[0] + kk[1] * kk[1] + kk[2] * kk[2] + kk[3] * kk[3];
            q += __shfl_xor(q, 1); q += __shfl_xor(q, 2); q += __shfl_xor(q, 4); q += __shfl_xor(q, 8);
            const float inv = -1.0f / fmaxf(sqrtf(q), 1e-12f);
            *(f32x4*)(AA + hmi(row, c)) = kk * inv; } }
        { f32x4 a0 = SHIFT4(2048 + lane * 4), a1 = SHIFT4(2048 + (lane + 64) * 4), a2 = SHIFT4(2048 + (lane + 128) * 4), a3 = SHIFT4(2048 + (lane + 192) * 4);
          float* dst = VR + hmi(row, lane * 4); *(f32x4*)dst = a0; *(f32x4*)(dst + (size_t)4 * MALL * 64) = a1; *(f32x4*)(dst + (size_t)8 * MALL * 64) = a2; *(f32x4*)(dst + (size_t)12 * MALL * 64) = a3; }
        {
            const int c0 = lane * 8; f32x4 x0 = {0.f, 0.f, 0.f, 0.f}, x1 = x0;
            if (c0 < 416) { x0 = SHIFT4(3072 + c0); x1 = SHIFT4(3072 + c0 + 4); }
            float o[8];
#pragma unroll
            for (int q = 0; q < 4; ++q) { o[q] = c0 < 128 ? ftanh(x0[q]) : c0 < 256 ? x0[q] : c0 < 416 ? fsigmoid(x0[q]) : 0.f; o[4 + q] = c0 < 128 ? ftanh(x1[q]) : c0 < 256 ? x1[q] : c0 < 416 ? fsigmoid(x1[q]) : 0.f; }
            u32x4 w; w.x = cvt_pk_bf16(o[0], o[1]); w.y = cvt_pk_bf16(o[2], o[3]); w.z = cvt_pk_bf16(o[4], o[5]); w.w = cvt_pk_bf16(o[6], o[7]);
            *(u32x4*)(LA + (size_t)row * 512 + c0) = w;
        }
#undef SHIFT4
    }
}

struct EpiLora { static constexpr bool PERM = false; const float* w0; const float* a0; const float* k_a; const float* KRf; const float* AA; float* WW; float* KD; float* BD; float* GG;
    __device__ __forceinline__ void operator()(AccRef acc, const Unit& u, int wr, int wc, int fr, int fq) const {
        const int g = __builtin_amdgcn_readfirstlane(u.pn >> 2), row0 = u.pm * 256 + wr * 64 + fr, ch0 = (u.pn & 3) * 256 + wc * 32 + 4 * fq;
        if (g < 2) {
            f32x4 bb[2][2];
#pragma unroll
            for (int bj = 0; bj < 2; ++bj)
#pragma unroll
                for (int n = 0; n < 2; ++n) bb[bj][n] = *(const f32x4*)(w0 + g * RD + ch0 + bj * 128 + n * 16);
            float* dstp = WW + (size_t)g * MALL * RD;
#pragma unroll
            for (int ai = 0; ai < 2; ++ai)
#pragma unroll
                for (int m = 0; m < 4; ++m) { const int row = row0 + ai * 128 + m * 16;
#pragma unroll
                    for (int bj = 0; bj < 2; ++bj)
#pragma unroll
                        for (int n = 0; n < 2; ++n) { const size_t e = hmi(row, ch0 + bj * 128 + n * 16); const f32x4 v = acc[ai][bj][m][n], b = bb[bj][n]; f32x4 o;
#pragma unroll
                            for (int j = 0; j < 4; ++j) { const float y = -(b[j] + v[j]); const float sp = fmaxf(y, 0.f) + flog(1.0f + fexp(-fabsf(y))); o[j] = fexp(-fexp(-sp - 0.5f)); }
                            *(f32x4*)(dstp + e) = o; } }
        } else if (g < 4) {
            const int d = g - 2;
            f32x4 bb[2][2], ka[2][2];
#pragma unroll
            for (int bj = 0; bj < 2; ++bj)
#pragma unroll
                for (int n = 0; n < 2; ++n) { bb[bj][n] = *(const f32x4*)(a0 + d * RD + ch0 + bj * 128 + n * 16); ka[bj][n] = *(const f32x4*)(k_a + ch0 + bj * 128 + n * 16); }
            float* kdp = KD + (size_t)d * MALL * RD; float* bdp = BD + (size_t)d * MALL * RD;
#pragma unroll
            for (int ai = 0; ai < 2; ++ai)
#pragma unroll
                for (int m = 0; m < 4; ++m) {
                    f32x4 kv[2][2], aa[2][2];
#pragma unroll
                    for (int bj = 0; bj < 2; ++bj)
#pragma unroll
                        for (int n = 0; n < 2; ++n) { const size_t e = hmi(row0 + ai * 128 + m * 16, ch0 + bj * 128 + n * 16); kv[bj][n] = *(const f32x4*)(KRf + e); aa[bj][n] = *(const f32x4*)(AA + e); }
#pragma unroll
                    for (int bj = 0; bj < 2; ++bj)
#pragma unroll
                        for (int n = 0; n < 2; ++n) { const size_t e = hmi(row0 + ai * 128 + m * 16, ch0 + bj * 128 + n * 16); const f32x4 v = acc[ai][bj][m][n]; f32x4 okd, obd;
#pragma unroll
                            for (int j = 0; j < 4; ++j) { const float ic = fsigmoid(bb[bj][n][j] + v[j]); okd[j] = kv[bj][n][j] * (1.f + (ic - 1.f) * ka[bj][n][j]); obd[j] = -ic * aa[bj][n][j]; }
                            *(f32x4*)(kdp + e) = okd; *(f32x4*)(bdp + e) = obd; }
                }
        } else {
#pragma unroll
            for (int ai = 0; ai < 2; ++ai)
#pragma unroll
                for (int m = 0; m < 4; ++m)
#pragma unroll
                    for (int bj = 0; bj < 2; ++bj)
#pragma unroll
                        for (int n = 0; n < 2; ++n) *(f32x4*)(GG + hmi(row0 + ai * 128 + m * 16, ch0 + bj * 128 + n * 16)) = acc[ai][bj][m][n];
        }
    } };
struct EpiQ { static constexpr bool PERM = false; bf16_t* QB; const float* ropec; const float* ropes;
    __device__ __forceinline__ void operator()(AccRef acc, const Unit& u, int wr, int wc, int fr, int fq) const {
        const float qs = 0.07216878364870322f * 1.4426950408889634f;
        const int row0 = u.pm * 256 + wr * 64 + fr;
#pragma unroll
        for (int bj = 0; bj < 2; ++bj) {
            const int cg = u.pn * 256 + bj * 128 + wc * 32, part = (cg >> 5) % 6;
#pragma unroll
            for (int ai = 0; ai < 2; ++ai)
#pragma unroll
                for (int m = 0; m < 4; ++m) { const int row = row0 + ai * 128 + m * 16, t = row & (SEQ - 1);
                    f32x4 x1 = acc[ai][bj][m][0], x2 = acc[ai][bj][m][1];
                    if (part >= 4) { const int pos = part == 4 ? (t >> 6) : (t & 63);
                        const f32x4 c = *(const f32x4*)(ropec + pos * 16 + 4 * fq), sn = *(const f32x4*)(ropes + pos * 16 + 4 * fq);
                        const f32x4 o1 = x1 * c - x2 * sn, o2 = x2 * c + x1 * sn; x1 = o1; x2 = o2; }
                    x1 = x1 * qs; x2 = x2 * qs;
                    bf16_t* dst = QB + (size_t)row * QW + cg + 4 * fq;
                    u32x2 w1, w2; w1.x = cvt_pk_bf16(x1[0], x1[1]); w1.y = cvt_pk_bf16(x1[2], x1[3]); w2.x = cvt_pk_bf16(x2[0], x2[1]); w2.y = cvt_pk_bf16(x2[2], x2[3]);
                    *(u32x2*)dst = w1; *(u32x2*)(dst + 16) = w2; }
        }
    } };
struct EpiBf16 { static constexpr bool PERM = true; bf16_t* O; int ldo;
    __device__ __forceinline__ void operator()(AccRef acc, const Unit& u, int wr, int wc, int fr, int fq) const {
        const int row0 = u.pm * 256 + wr * 64 + fr, col0 = u.pn * 256 + wc * 32 + 8 * fq;
#pragma unroll
        for (int ai = 0; ai < 2; ++ai)
#pragma unroll
            for (int m = 0; m < 4; ++m) { bf16_t* rowp = O + (size_t)(row0 + ai * 128 + m * 16) * ldo + col0;
#pragma unroll
                for (int bj = 0; bj < 2; ++bj) { const f32x4 v0 = acc[ai][bj][m][0], v1 = acc[ai][bj][m][1];
                    u32x4 w; w.x = cvt_pk_bf16(v0[0], v0[1]); w.y = cvt_pk_bf16(v0[2], v0[3]); w.z = cvt_pk_bf16(v1[0], v1[1]); w.w = cvt_pk_bf16(v1[2], v1[3]);
                    *(u32x4*)(rowp + bj * 128) = w; } }
    } };
struct EpiVT { static constexpr bool PERM = false; bf16_t* VT;
    __device__ __forceinline__ void operator()(AccRef acc, const Unit& u, int wr, int wc, int fr, int fq) const {
        const int row0 = u.pm * 256 + wr * 64 + fr, pq = ((fq & 1) << 1) | (fq >> 1), col0 = u.pn * 256 + wc * 32 + 4 * pq;
#pragma unroll
        for (int ai = 0; ai < 2; ++ai)
#pragma unroll
            for (int m = 0; m < 4; ++m) { bf16_t* rowp = VT + (size_t)(row0 + ai * 128 + m * 16) * MALL + col0;
#pragma unroll
                for (int bj = 0; bj < 2; ++bj)
#pragma unroll
                    for (int n = 0; n < 2; ++n) { const f32x4 v = acc[ai][bj][m][n]; u32x2 w; w.x = cvt_pk_bf16(v[0], v[1]); w.y = cvt_pk_bf16(v[2], v[3]); *(u32x2*)(rowp + bj * 128 + n * 16) = w; } }
    } };

__device__ __forceinline__ void ph_attn(LAS unsigned char* lds, const bf16_t* QB, const bf16_t* KNB, const bf16_t* VTB, bf16_t* MIXB, int G, int bid) {
    typedef float f32x16 __attribute__((ext_vector_type(16)));
    constexpr int KP = 400, VP = 144, KBYTES = 64 * KP, BUF = KBYTES + 128 * VP, NT = SK / 64;
    const int tid = threadIdx.x, wave = tid >> 6, lane = tid & 63, l32 = lane & 31, half = lane >> 5;
    for (int unit = bid; unit < NB * HM * (SEQ / 256); unit += G) {
        const int bh = unit & 15, qb = unit >> 4, b = bh >> 3, h = bh & 7;
        const int qrow = b * SEQ + qb * 256 + wave * 32 + l32;
        bf16x8 qf[12];
#pragma unroll
        for (int ks = 0; ks < 12; ++ks) qf[ks] = *(const bf16x8*)(QB + (size_t)qrow * QW + h * 192 + ks * 16 + half * 8);
        f32x16 o[4];
#pragma unroll
        for (int d = 0; d < 4; ++d)
#pragma unroll
            for (int i = 0; i < 16; ++i) o[d][i] = 0.f;
        float mrun = -1e30f, lrun = 0.f;
        int ko[3], kd[3], vo[2], vd[2];
#pragma unroll
        for (int i = 0; i < 3; ++i) { const int id = tid + 512 * i, key = id / 24, cc = id % 24;
            ko[i] = key * KLD + (cc < 16 ? h * 128 + cc * 8 : 1024 + (cc - 16) * 8); kd[i] = key * KP + cc * 16; }
#pragma unroll
        for (int i = 0; i < 2; ++i) { const int id = tid + 512 * i, dv = id >> 3, cc = id & 7;
            vo[i] = (h * 128 + dv) * MALL + cc * 8; vd[i] = KBYTES + dv * VP + cc * 16; }
        u32x4 kr_[3], vr_[2];
        __syncthreads();
        {   const int trow = NL + b * CTX;
#pragma unroll
            for (int i = 0; i < 3; ++i) kr_[i] = *(const u32x4*)(KNB + (size_t)(ko[i] + trow * KLD));
#pragma unroll
            for (int i = 0; i < 2; ++i) vr_[i] = *(const u32x4*)(VTB + (size_t)(vo[i] + trow));
#pragma unroll
            for (int i = 0; i < 3; ++i) *(LAS u32x4*)(lds + kd[i]) = kr_[i];
#pragma unroll
            for (int i = 0; i < 2; ++i) *(LAS u32x4*)(lds + vd[i]) = vr_[i];
        }
        __syncthreads();
        for (int j = 0; j < NT; ++j) {
            LAS unsigned char* cb = lds + (j & 1) * BUF;
            if (j + 1 < NT) {
                const int jn = j + 1, trow = jn < 4 ? NL + b * CTX + 64 * jn : b * SEQ + 64 * (jn - 4);
#pragma unroll
                for (int i = 0; i < 3; ++i) kr_[i] = *(const u32x4*)(KNB + (size_t)(ko[i] + trow * KLD));
#pragma unroll
                for (int i = 0; i < 2; ++i) vr_[i] = *(const u32x4*)(VTB + (size_t)(vo[i] + trow));
            }
            f32x16 s0, s1;
#pragma unroll
            for (int i = 0; i < 16; ++i) { s0[i] = 0.f; s1[i] = 0.f; }
#pragma unroll
            for (int ks = 0; ks < 12; ++ks) {
                const bf16x8 a0 = *(const LAS bf16x8*)(cb + l32 * KP + ks * 32 + half * 16), a1 = *(const LAS bf16x8*)(cb + (32 + l32) * KP + ks * 32 + half * 16);
                s0 = __builtin_amdgcn_mfma_f32_32x32x16_bf16(a0, qf[ks], s0, 0, 0, 0);
                s1 = __builtin_amdgcn_mfma_f32_32x32x16_bf16(a1, qf[ks], s1, 0, 0, 0);
            }
            float mx = s0[0];
#pragma unroll
            for (int i = 1; i < 16; ++i) mx = fmaxf(mx, s0[i]);
#pragma unroll
            for (int i = 0; i < 16; ++i) mx = fmaxf(mx, s1[i]);
            mx = fmaxf(mx, __shfl_xor(mx, 32));
            const float mn = fmaxf(mrun, mx);
            const float alpha = __builtin_amdgcn_exp2f(mrun - mn);
            mrun = mn;
            float ps = 0.f;
#pragma unroll
            for (int i = 0; i < 16; ++i) { s0[i] = __builtin_amdgcn_exp2f(s0[i] - mn); s1[i] = __builtin_amdgcn_exp2f(s1[i] - mn); ps += s0[i] + s1[i]; }
            lrun = lrun * alpha + ps;
#pragma unroll
            for (int d = 0; d < 4; ++d)
#pragma unroll
                for (int i = 0; i < 16; ++i) o[d][i] *= alpha;
            bf16x8 pf[4];
#pragma unroll
            for (int s = 0; s < 4; ++s) {
                u32x4 w;
                if (s < 2) { const int i0 = (s & 1) * 8; w.x = cvt_pk_bf16(s0[i0], s0[i0 + 1]); w.y = cvt_pk_bf16(s0[i0 + 2], s0[i0 + 3]); w.z = cvt_pk_bf16(s0[i0 + 4], s0[i0 + 5]); w.w = cvt_pk_bf16(s0[i0 + 6], s0[i0 + 7]); }
                else { const int i0 = (s & 1) * 8; w.x = cvt_pk_bf16(s1[i0], s1[i0 + 1]); w.y = cvt_pk_bf16(s1[i0 + 2], s1[i0 + 3]); w.z = cvt_pk_bf16(s1[i0 + 4], s1[i0 + 5]); w.w = cvt_pk_bf16(s1[i0 + 6], s1[i0 + 7]); }
                pf[s] = __builtin_bit_cast(bf16x8, w);
            }
#pragma unroll
            for (int s = 0; s < 4; ++s)
#pragma unroll
                for (int d = 0; d < 4; ++d) {
                    const bf16x8 vf = *(const LAS bf16x8*)(cb + KBYTES + (32 * d + l32) * VP + s * 32 + half * 16);
                    o[d] = __builtin_amdgcn_mfma_f32_32x32x16_bf16(vf, pf[s], o[d], 0, 0, 0);
                }
            if (j + 1 < NT) {
                LAS unsigned char* nb = lds + ((j + 1) & 1) * BUF;
#pragma unroll
                for (int i = 0; i < 3; ++i) *(LAS u32x4*)(nb + kd[i]) = kr_[i];
#pragma unroll
                for (int i = 0; i < 2; ++i) *(LAS u32x4*)(nb + vd[i]) = vr_[i];
            }
            __syncthreads();
        }
        lrun += __shfl_xor(lrun, 32);
        const float il = 1.0f / lrun;
        bf16_t* dst = MIXB + (size_t)qrow * D + h * 128 + 4 * half;
#pragma unroll
        for (int d = 0; d < 4; ++d)
#pragma unroll
            for (int i4 = 0; i4 < 4; ++i4) { u32x2 w; w.x = cvt_pk_bf16(o[d][i4 * 4] * il, o[d][i4 * 4 + 1] * il); w.y = cvt_pk_bf16(o[d][i4 * 4 + 2] * il, o[d][i4 * 4 + 3] * il);
                *(u32x2*)(dst + 32 * d + 8 * i4) = w; }
    }
    __syncthreads();
}


constexpr int SC_CL = 272, SC_NC = 16;
__device__ __forceinline__ int scan_row(int b, int d, int g) {
    if (g < CTX) return NL + b * CTX + (d == 0 ? g : CTX - 1 - g);
    const int tp = g - CTX; return b * SEQ + (d == 0 ? tp : SEQ - 1 - tp);
}
#define DPP_FMAC(d, a, b, n) asm volatile("v_fmac_f32_dpp %0, %1, %2 row_newbcast:" #n " row_mask:0xf bank_mask:0xf" : "+v"(d) : "v"(a), "v"(b))
#define DPP_MULD(d, a, n)    asm volatile("v_mul_f32_dpp %0, %1, %0 row_newbcast:" #n " row_mask:0xf bank_mask:0xf" : "+v"(d) : "v"(a))
#define SC_FOR16(X) X(0) X(1) X(2) X(3) X(4) X(5) X(6) X(7) X(8) X(9) X(10) X(11) X(12) X(13) X(14) X(15)
struct MoeCv { const float* w1; long d31; const float* w2; unsigned char* W13E; unsigned char* W2E; };
constexpr int CV_PER_WAVE = 336, CV_ITEMS_W13 = 3584, CV_ITEMS_E = 5376, CV_WLDS = 4096;
static_assert((size_t)NE * CV_ITEMS_E * 8 == (size_t)CV_PER_WAVE * 1024, "MoE conversion tiles must split evenly over 1024 waves");
static_assert(4 * 5 * 6144 + 4 * CV_WLDS <= LDS_CTL, "scan rings + conversion images must fit below the LDS control words");
struct CvItem { const float* sp; unsigned char* dst; int ld, K; float sc; };
__device__ __forceinline__ CvItem cv_item(const MoeCv& mc, int it, int cw) {
    const int I = it * 1024 + cw, e = I / CV_ITEMS_E, r = I - e * CV_ITEMS_E;
    CvItem o;
    if (r < CV_ITEMS_W13) { const int kr = r / 224, nt = r - kr * 224, n0 = nt * 64, jj = n0 & 255;
        o.sp = mc.w1 + (jj < 128 ? 0l : mc.d31) + (size_t)e * D * DFF + (size_t)kr * 128 * DFF + (n0 >> 8) * 128 + (jj & 127); o.ld = DFF;
        o.dst = mc.W13E + (size_t)e * 2 * DFF * D + (size_t)n0 * D + kr * 128; o.K = D; o.sc = 64.f; }
    else { const int r2 = r - CV_ITEMS_W13, kr = r2 >> 5, n0 = (r2 & 31) * 64;
        o.sp = mc.w2 + (size_t)e * DFF * D + (size_t)kr * 128 * D + n0; o.ld = D;
        o.dst = mc.W2E + (size_t)e * D * DFF + (size_t)n0 * DFF + kr * 128; o.K = DFF; o.sc = 128.f; }
    return o;
}
__device__ __forceinline__ void moe_cvt_wave(LAS unsigned char* ct, const MoeCv& mc, int cw, int lane) {
    constexpr int NIT = CV_PER_WAVE / 8;
    const int l15 = lane & 15, l4 = lane >> 4;
    f32x4 buf[8][4];
    CvItem cur = cv_item(mc, 0, cw);
    { const float* lp = cur.sp + (size_t)(l4 * cur.ld + l15 * 4);
#pragma unroll
      for (int s = 0; s < 8; ++s)
#pragma unroll
        for (int q = 0; q < 4; ++q) buf[s][q] = *(const f32x4*)(lp + (size_t)(s * 16 + q * 4) * cur.ld); }
#pragma unroll 1
    for (int it = 0; it < NIT; ++it) {
        const CvItem nxt = cv_item(mc, it + 1 < NIT ? it + 1 : NIT - 1, cw);
        const float* lp = nxt.sp + (size_t)(l4 * nxt.ld + l15 * 4);
        unsigned char* dp = cur.dst + (size_t)lane * cur.K;
        const float sc = cur.sc;
        u32x4 wout[8];
#pragma unroll
        for (int s = 0; s < 8; ++s) {
#pragma unroll
            for (int q = 0; q < 4; ++q) *(LAS f32x4*)(ct + q * 1024 + lane * 16) = buf[s][q];
#pragma unroll
            for (int q = 0; q < 4; ++q) buf[s][q] = *(const f32x4*)(lp + (size_t)(s * 16 + q * 4) * nxt.ld);
            float v[16];
#pragma unroll
            for (int j = 0; j < 16; ++j) v[j] = ((const LAS float*)ct)[j * 64 + lane];
            u32x4 w; w.x = pk4_fp8(v[0] * sc, v[1] * sc, v[2] * sc, v[3] * sc); w.y = pk4_fp8(v[4] * sc, v[5] * sc, v[6] * sc, v[7] * sc);
            w.z = pk4_fp8(v[8] * sc, v[9] * sc, v[10] * sc, v[11] * sc); w.w = pk4_fp8(v[12] * sc, v[13] * sc, v[14] * sc, v[15] * sc);
            wout[s] = w;
        }
#pragma unroll
        for (int s = 0; s < 8; ++s) *(u32x4*)(dp + s * 16) = wout[s];
        cur = nxt;
    }
#pragma unroll
    for (int s = 0; s < 8; ++s) asm volatile("" :: "v"(buf[s][0]), "v"(buf[s][1]), "v"(buf[s][2]), "v"(buf[s][3]));
}
constexpr int SC_NSLOT = 5, SC_SLOTB = 6144, SC_WLDS = SC_NSLOT * SC_SLOTB;
#define SC_VSET(P) f32x4 P##av, P##wv, P##bv, P##kv, P##rv; float P##vv
#define SC_READV(P, sl) do { P##av = *(const LAS f32x4*)((sl) + l15 * 16); P##wv = *(const LAS f32x4*)((sl) + 1024 + l15 * 16); P##bv = *(const LAS f32x4*)((sl) + 2048 + l15 * 16); \
            P##kv = *(const LAS f32x4*)((sl) + 3072 + l15 * 16); P##rv = *(const LAS f32x4*)((sl) + 4096 + l15 * 16); P##vv = *(const LAS float*)((sl) + 5120 + lane * 4); } while (0)
#define SC_STEP(P, i) do { \
            float a0 = P##av[0], a1 = P##av[1], a2 = P##av[2], a3 = P##av[3], w0 = P##wv[0], w1 = P##wv[1], w2 = P##wv[2], w3 = P##wv[3], b0 = P##bv[0], b1 = P##bv[1], b2 = P##bv[2], b3 = P##bv[3]; \
            float k0 = P##kv[0], k1 = P##kv[1], k2 = P##kv[2], k3 = P##kv[3], r0 = P##rv[0], r1 = P##rv[1], r2 = P##rv[2], r3 = P##rv[3], vq = P##vv; \
            asm volatile("s_nop 1" : "+v"(a0), "+v"(a1), "+v"(a2), "+v"(a3)); \
            float c0 = 0.f, c1 = 0.f, c2 = 0.f, c3 = 0.f, e0 = 0.f, e1 = 0.f, e2 = 0.f, e3 = 0.f; \
            SC_FOR16(SC_SA) \
            float saq = (c0 + c1) + (c2 + c3), sap = (e0 + e1) + (e2 + e3); \
            asm volatile("s_nop 1" : "+v"(w0), "+v"(w1), "+v"(w2), "+v"(w3), "+v"(b0), "+v"(b1), "+v"(b2), "+v"(b3), "+v"(saq), "+v"(sap)); \
            SC_FOR16(SC_UP) \
            asm volatile("s_nop 1" : "+v"(k0), "+v"(k1), "+v"(k2), "+v"(k3), "+v"(vq)); \
            SC_FOR16(SC_VK) \
            if (gbase + (i) >= CTX) { \
                float y0 = 0.f, y1 = 0.f, y2 = 0.f, y3 = 0.f, z0 = 0.f, z1 = 0.f, z2 = 0.f, z3 = 0.f; \
                asm volatile("s_nop 1" : "+v"(r0), "+v"(r1), "+v"(r2), "+v"(r3)); \
                SC_FOR16(SC_Y) \
                const size_t yo_ = (size_t)scan_row(b, d, gbase + (i)) * 64; \
                ypq[yo_ + lane] = (y0 + y1) + (y2 + y3); ypp[yo_ + lane] = (z0 + z1) + (z2 + z3); \
            } } while (0)
#define SC_SA(n) DPP_FMAC(c0, a0, SQ[4 * n], n); DPP_FMAC(c1, a1, SQ[4 * n + 1], n); DPP_FMAC(c2, a2, SQ[4 * n + 2], n); DPP_FMAC(c3, a3, SQ[4 * n + 3], n); \
                 DPP_FMAC(e0, a0, SP[4 * n], n); DPP_FMAC(e1, a1, SP[4 * n + 1], n); DPP_FMAC(e2, a2, SP[4 * n + 2], n); DPP_FMAC(e3, a3, SP[4 * n + 3], n);
#define SC_UP(n) DPP_MULD(SQ[4 * n], w0, n); DPP_MULD(SQ[4 * n + 1], w1, n); DPP_MULD(SQ[4 * n + 2], w2, n); DPP_MULD(SQ[4 * n + 3], w3, n); \
                 DPP_MULD(SP[4 * n], w0, n); DPP_MULD(SP[4 * n + 1], w1, n); DPP_MULD(SP[4 * n + 2], w2, n); DPP_MULD(SP[4 * n + 3], w3, n); \
                 DPP_FMAC(SQ[4 * n], b0, saq, n); DPP_FMAC(SQ[4 * n + 1], b1, saq, n); DPP_FMAC(SQ[4 * n + 2], b2, saq, n); DPP_FMAC(SQ[4 * n + 3], b3, saq, n); \
                 DPP_FMAC(SP[4 * n], b0, sap, n); DPP_FMAC(SP[4 * n + 1], b1, sap, n); DPP_FMAC(SP[4 * n + 2], b2, sap, n); DPP_FMAC(SP[4 * n + 3], b3, sap, n);
#define SC_VK(n) DPP_FMAC(SQ[4 * n], k0, vq, n); DPP_FMAC(SQ[4 * n + 1], k1, vq, n); DPP_FMAC(SQ[4 * n + 2], k2, vq, n); DPP_FMAC(SQ[4 * n + 3], k3, vq, n);
#define SC_Y(n) DPP_FMAC(y0, r0, SQ[4 * n], n); DPP_FMAC(y1, r1, SQ[4 * n + 1], n); DPP_FMAC(y2, r2, SQ[4 * n + 2], n); DPP_FMAC(y3, r3, SQ[4 * n + 3], n); \
                DPP_FMAC(z0, r0, SP[4 * n], n); DPP_FMAC(z1, r1, SP[4 * n + 1], n); DPP_FMAC(z2, r2, SP[4 * n + 2], n); DPP_FMAC(z3, r3, SP[4 * n + 3], n);
__device__ __forceinline__ void ph_scan1(LAS unsigned char* lds, const float* wsf, unsigned oAA, unsigned oWW, unsigned oBD, unsigned oKD, unsigned oRR, unsigned oVR, float* YP, float* QP, const MoeCv mc, int G, int bid) {
    const int wave = __builtin_amdgcn_readfirstlane(threadIdx.x >> 6), lane = threadIdx.x & 63, l15 = lane & 15, vi = lane >> 4;
    if (wave >= 4) { for (int pb = bid; pb < 256; pb += G) moe_cvt_wave(lds + 4 * SC_WLDS + (wave - 4) * CV_WLDS, mc, pb * 4 + (wave - 4), lane); return; }
    LAS unsigned char* ring = lds + wave * SC_WLDS;
    for (int pb = bid; pb < 256; pb += G) {
        const int pair = pb * 4 + wave, chain = pair >> 4, chunk = pair & 15;
        const int b = chain >> 5, h = (chain >> 1) & 15, d = chain & 1;
        const unsigned dofs = (unsigned)d * MALL * RD;
        const unsigned oh = (unsigned)h * (MALL * 64), lane4 = lane * 4;
        const unsigned ob0 = oAA + oh, ob1 = oWW + dofs + oh, ob2 = oBD + dofs + oh, ob3 = oKD + dofs + oh, ob4 = oRR + oh, ob5 = oVR + oh;
        float SQ[64], SP[64];
#pragma unroll
        for (int k = 0; k < 64; ++k) { SQ[k] = 0.f; SP[k] = lane == k ? 1.f : 0.f; }
        float* ypq = YP + (size_t)d * NL * RD + (size_t)h * NL * 64;
        float* ypp = YP + (size_t)(2 + d) * NL * RD + (size_t)h * NL * 64;
        const int gbase = chunk * SC_CL;
        constexpr int NGRP = SC_CL / 4;
#define SC_ISSUE(grp, slot) do { const int gq_ = (grp) < NGRP ? (grp) : NGRP - 1; const unsigned ro_ = (unsigned)scan_row(b, d, gbase + 4 * gq_ + (d ? 3 : 0)) * 64; LAS unsigned char* sl_ = ring + (slot) * SC_SLOTB; \
            __builtin_amdgcn_global_load_lds((const unsigned*)(wsf + (ob0 + ro_) + lane4), (LAS unsigned*)sl_, 16, 0, 0); __builtin_amdgcn_global_load_lds((const unsigned*)(wsf + (ob1 + ro_) + lane4), (LAS unsigned*)(sl_ + 1024), 16, 0, 0); \
            __builtin_amdgcn_global_load_lds((const unsigned*)(wsf + (ob2 + ro_) + lane4), (LAS unsigned*)(sl_ + 2048), 16, 0, 0); __builtin_amdgcn_global_load_lds((const unsigned*)(wsf + (ob3 + ro_) + lane4), (LAS unsigned*)(sl_ + 3072), 16, 0, 0); \
            __builtin_amdgcn_global_load_lds((const unsigned*)(wsf + (ob4 + ro_) + lane4), (LAS unsigned*)(sl_ + 4096), 16, 0, 0); __builtin_amdgcn_global_load_lds((const unsigned*)(wsf + (ob5 + ro_) + lane4), (LAS unsigned*)(sl_ + 5120), 16, 0, 0); } while (0)
        SC_ISSUE(0, 0); SC_ISSUE(1, 1); SC_ISSUE(2, 2); SC_ISSUE(3, 3); SC_ISSUE(4, 4);
        SC_VSET(A); SC_VSET(B);
        asm volatile("s_waitcnt vmcnt(24)" ::: "memory");
        const int r0o = d ? 768 : 0, rstep = d ? -256 : 256;
        SC_READV(A, ring + r0o);
        asm volatile("s_waitcnt lgkmcnt(0)" ::: "memory");
        int slot = 0;
#pragma unroll 1
        for (int grp = 0; grp < NGRP; ++grp) {
            const int i = 4 * grp;
            const LAS unsigned char* sl = ring + slot * SC_SLOTB + r0o;
            const int nslot = slot == SC_NSLOT - 1 ? 0 : slot + 1;
            SC_READV(B, sl + rstep);
            SC_STEP(A, i);
            asm volatile("s_waitcnt lgkmcnt(0)" ::: "memory");
            SC_READV(A, sl + 2 * rstep);
            SC_STEP(B, i + 1);
            asm volatile("s_waitcnt lgkmcnt(0)" ::: "memory");
            SC_READV(B, sl + 3 * rstep);
            SC_STEP(A, i + 2);
            asm volatile("s_waitcnt lgkmcnt(0)" ::: "memory");
            SC_ISSUE(grp + SC_NSLOT, slot);
            asm volatile("s_waitcnt vmcnt(24)" ::: "memory");
            SC_READV(A, ring + nslot * SC_SLOTB + r0o);
            SC_STEP(B, i + 3);
            asm volatile("s_waitcnt lgkmcnt(0)" ::: "memory");
            slot = nslot;
        }
        asm volatile("s_waitcnt vmcnt(0)" ::: "memory");
#undef SC_ISSUE
        float* qpq = QP + ((((size_t)chain) * SC_NC + chunk) * 64 + lane) * 64;
        float* qpp = QP + ((((size_t)64 + chain) * SC_NC + chunk) * 64 + lane) * 64;
#pragma unroll
        for (int j = 0; j < 16; ++j) { *(f32x4*)(qpq + 4 * j) = (f32x4){SQ[4 * j], SQ[4 * j + 1], SQ[4 * j + 2], SQ[4 * j + 3]}; *(f32x4*)(qpp + 4 * j) = (f32x4){SP[4 * j], SP[4 * j + 1], SP[4 * j + 2], SP[4 * j + 3]}; }
    }
}
#undef SC_SA
#undef SC_UP
#undef SC_VK
#undef SC_Y
__device__ __forceinline__ void ph_scan_carry(const float* QP, float* SS, int G, int bid) {
    const int wave = threadIdx.x >> 6, lane = threadIdx.x & 63;
    for (int task = bid * 8 + wave; task < 64 * 16; task += G * 8) {
        const int chain = task >> 4, v0 = (task & 15) * 4;
        float s[4] = {0.f, 0.f, 0.f, 0.f};
#pragma unroll 1
        for (int c = 0; c < SC_NC; ++c) {
#pragma unroll
            for (int r = 0; r < 4; ++r) SS[(((size_t)chain * SC_NC + c) * 64 + v0 + r) * 64 + lane] = s[r];
            if (c == SC_NC - 1) break;
            const float* Pc = QP + (((size_t)64 + chain) * SC_NC + c) * 4096 + lane;
            const float* Qc = QP + (((size_t)chain) * SC_NC + c) * 4096 + lane;
            float pcol[64];
#pragma unroll
            for (int k = 0; k < 64; ++k) pcol[k] = Pc[k * 64];
            float nw[4];
#pragma unroll
            for (int r = 0; r < 4; ++r) nw[r] = Qc[(v0 + r) * 64];
#pragma unroll
            for (int k = 0; k < 64; ++k) {
#pragma unroll
                for (int r = 0; r < 4; ++r) nw[r] += __builtin_bit_cast(float, __builtin_amdgcn_readlane(__builtin_bit_cast(int, s[r]), k)) * pcol[k];
            }
#pragma unroll
            for (int r = 0; r < 4; ++r) s[r] = nw[r];
        }
    }
}
struct FixLd { f32x4 p0, p1; float yl, r, ks, vr, gg; };
__device__ __forceinline__ FixLd fix_load(const float* YP, const float* RR, const float* KD, const float* VR, const float* GG, int row, int h, int lane) {
    FixLd x; const int l15 = lane & 15; const size_t e = ((size_t)h * NL + row) * 64, em = ((size_t)h * MALL + row) * 64;
    x.p0 = *(const f32x4*)(YP + (size_t)2 * NL * RD + e + l15 * 4); x.p1 = *(const f32x4*)(YP + (size_t)3 * NL * RD + e + l15 * 4);
    x.yl = YP[e + lane] + YP[(size_t)NL * RD + e + lane];
    x.r = RR[em + lane]; x.ks = KD[em + lane] + KD[(size_t)MALL * RD + em + lane]; x.vr = VR[em + lane]; x.gg = GG[em + lane];
    return x;
}
__device__ __forceinline__ void ph_scan_fix(const float* YP, const float* SS, const float* RR, const float* KD, const float* VR, const float* GG, const float* r_k, const float* lnw, const float* lnb, bf16_t* MIXB, int G, int bid) {
    const int wave = __builtin_amdgcn_readfirstlane(threadIdx.x >> 6), lane = threadIdx.x & 63;
    for (int task = bid * 8 + wave; task < 2048; task += G * 8) {
        const int b = task >> 10, h = (task >> 6) & 15, t0 = (task & 63) * 64, c = h * 64 + lane;
        const int chain0 = (b * 16 + h) * 2;
        float S0[64], S1[64]; int cc0 = -1, cc1 = -1;
        const float rk = r_k[c], lw = lnw[c], lb = lnb[c];
        FixLd ring[4];
#pragma unroll
        for (int k = 0; k < 4; ++k) ring[k] = fix_load(YP, RR, KD, VR, GG, b * SEQ + t0 + k, h, lane);
#pragma unroll 1
        for (int tt0 = 0; tt0 < 64; tt0 += 4)
#pragma unroll
          for (int k = 0; k < 4; ++k) {
            const int tt = tt0 + k, t = t0 + tt, row = b * SEQ + t;
            const FixLd cu = ring[k];
            { const int tn = tt < 60 ? t + 4 : t; ring[k] = fix_load(YP, RR, KD, VR, GG, b * SEQ + tn, h, lane); }
            const int c0 = (CTX + t) / SC_CL, c1 = (CTX + SEQ - 1 - t) / SC_CL;
            if (c0 != cc0) { cc0 = c0; const float* sp = SS + (((size_t)chain0 * SC_NC + c0) * 64 + lane) * 64;
#pragma unroll
                for (int j = 0; j < 16; ++j) { const f32x4 x = *(const f32x4*)(sp + 4 * j); S0[4 * j] = x[0]; S0[4 * j + 1] = x[1]; S0[4 * j + 2] = x[2]; S0[4 * j + 3] = x[3]; } }
            if (c1 != cc1) { cc1 = c1; const float* sp = SS + (((size_t)(chain0 + 1) * SC_NC + c1) * 64 + lane) * 64;
#pragma unroll
                for (int j = 0; j < 16; ++j) { const f32x4 x = *(const f32x4*)(sp + 4 * j); S1[4 * j] = x[0]; S1[4 * j + 1] = x[1]; S1[4 * j + 2] = x[2]; S1[4 * j + 3] = x[3]; } }
            float a0 = cu.p0[0], a1 = cu.p0[1], a2 = cu.p0[2], a3 = cu.p0[3], b0 = cu.p1[0], b1 = cu.p1[1], b2 = cu.p1[2], b3 = cu.p1[3];
            asm volatile("s_nop 1" : "+v"(a0), "+v"(a1), "+v"(a2), "+v"(a3), "+v"(b0), "+v"(b1), "+v"(b2), "+v"(b3));
            float y0 = 0.f, y1 = 0.f, y2 = 0.f, y3 = 0.f, z0 = 0.f, z1 = 0.f, z2 = 0.f, z3 = 0.f;
#define FX_N(n) DPP_FMAC(y0, a0, S0[4 * n], n); DPP_FMAC(y1, a1, S0[4 * n + 1], n); DPP_FMAC(y2, a2, S0[4 * n + 2], n); DPP_FMAC(y3, a3, S0[4 * n + 3], n); \
                DPP_FMAC(z0, b0, S1[4 * n], n); DPP_FMAC(z1, b1, S1[4 * n + 1], n); DPP_FMAC(z2, b2, S1[4 * n + 2], n); DPP_FMAC(z3, b3, S1[4 * n + 3], n);
            SC_FOR16(FX_N)
#undef FX_N
            const float y = cu.yl + ((y0 + y1) + (y2 + y3)) + ((z0 + z1) + (z2 + z3));
            const float mu = wave_sum_dpp(y) * (1.f / 64.f);
            const float dv = y - mu;
            const float var = wave_sum_dpp(dv * dv) * (1.f / 64.f);
            const float yn = dv * rsqrtf(var + 64e-5f) * lw + lb;
            const float bonus = wave_sum_dpp(cu.r * cu.ks * rk) * cu.vr;
            const float o = (yn + bonus) * cu.gg;
            const float on = __shfl_down(o, 1);
            if ((lane & 1) == 0) *(unsigned*)(MIXB + (size_t)row * D + 1024 + c) = cvt_pk_bf16(o, on);
        }
    }
}

constexpr size_t alb(size_t x) { return (x + 4095) & ~(size_t)4095; }
constexpr size_t CTL_BYTES = 65536;
constexpr size_t MB_CTL = 0;
constexpr size_t B_MOD0 = MB_CTL + CTL_BYTES;
constexpr size_t B_MOD1 = B_MOD0 + alb((size_t)3 * NMOD * 4);
constexpr size_t B_MODP = B_MOD1 + alb((size_t)2 * NMOD * 4);
constexpr size_t MB_ROPE = B_MODP + alb((size_t)2 * 32 * 3 * NMOD * 4);
constexpr size_t B_H = MB_ROPE + 8192;
constexpr size_t MB_XNB = B_H + alb((size_t)NL * D * 4);
constexpr size_t MB_WIN0 = MB_XNB + alb((size_t)MALL * D * 2);
constexpr size_t MB_WO0 = MB_WIN0 + alb((size_t)ZLD * D * 2);
constexpr size_t MB_W13 = MB_WO0 + alb((size_t)D * D * 2);
constexpr size_t MB_W2 = MB_W13 + alb((size_t)2 * DFF * D * 2);
constexpr size_t MB_WUQ = MB_W2 + alb((size_t)D * DFF * 2);
constexpr size_t MB_WKN = MB_WUQ + alb((size_t)QW * 512 * 2);
constexpr size_t MB_WV = MB_WKN + alb((size_t)1024 * 512 * 2);
constexpr size_t MB_WLORA = MB_WV + alb((size_t)1024 * 512 * 2);
constexpr size_t MB_WIN1 = MB_WLORA + alb((size_t)5120 * 512 * 2);
constexpr size_t MB_WO1 = MB_WIN1 + alb((size_t)4096 * D * 2);
constexpr size_t MB_WSB = MB_WO1 + alb((size_t)D * D * 2);
constexpr size_t MB_W13E = MB_WSB + alb((size_t)16 * 128 * 128 * 2);
constexpr size_t MB_W2E = MB_W13E + alb((size_t)NE * 2 * DFF * D);
constexpr size_t B_ACTS = MB_W2E + alb((size_t)NE * D * DFF);
constexpr size_t B_Z = B_ACTS;
constexpr size_t MB_CQNB = B_Z + alb((size_t)MALL * ZLD * 4);
constexpr size_t MB_CKVNB = MB_CQNB + alb((size_t)MALL * 512 * 2);
constexpr size_t MB_LA = MB_CKVNB + alb((size_t)MALL * 512 * 2);
constexpr size_t MB_QB = MB_LA + alb((size_t)MALL * 512 * 2);
constexpr size_t MB_KNB = MB_QB + alb((size_t)NL * QW * 2);
constexpr size_t MB_VTB = MB_KNB + alb((size_t)MALL * KLD * 2);
constexpr size_t B_RR = MB_VTB + alb((size_t)RD * MALL * 2);
constexpr size_t B_KR = B_RR + alb((size_t)MALL * RD * 4);
constexpr size_t B_VR = B_KR + alb((size_t)MALL * RD * 4);
constexpr size_t B_AA = B_VR + alb((size_t)MALL * RD * 4);
constexpr size_t B_WW = B_AA + alb((size_t)MALL * RD * 4);
constexpr size_t B_KD = B_WW + alb((size_t)2 * MALL * RD * 4);
constexpr size_t B_BD = B_KD + alb((size_t)2 * MALL * RD * 4);
constexpr size_t B_GG = B_BD + alb((size_t)2 * MALL * RD * 4);
constexpr size_t MB_YP = B_GG + alb((size_t)MALL * RD * 4);
constexpr size_t MB_QP = MB_YP + alb((size_t)4 * NL * RD * 4);
constexpr size_t MB_SS = MB_QP + alb((size_t)2 * 64 * 16 * 4096 * 4);
constexpr size_t MB_MIXB = MB_SS + alb((size_t)64 * 16 * 4096 * 4);
constexpr size_t MB_ACT = MB_MIXB + alb((size_t)NL * D * 2);
constexpr size_t B_L0END = MB_ACT + alb((size_t)NL * DFF * 2);
constexpr size_t MB_U = B_ACTS;
constexpr size_t MB_VG = MB_U + alb((size_t)NL * D * 2);
constexpr size_t MB_VT = MB_VG + alb((size_t)NL * D * 4);
constexpr size_t MB_GATED = MB_VT + alb((size_t)NL * D * 2);
constexpr size_t MB_XG = MB_GATED + alb((size_t)NL * D * 2);
constexpr size_t MB_ACT2 = MB_XG + alb((size_t)NSLOT * D);
constexpr size_t MB_OUT2 = MB_ACT2 + alb((size_t)NSLOT * DFF);
constexpr size_t MB_ROUTE = MB_OUT2 + alb((size_t)NSLOT * D * 4);
constexpr size_t B_L1END = MB_ROUTE + 262144;
constexpr size_t MB_END = B_L0END > B_L1END ? B_L0END : B_L1END;
constexpr size_t O_MOD0 = B_MOD0 / 4, O_MOD1 = B_MOD1 / 4, O_MODP = B_MODP / 4, O_H = B_H / 4, O_Z = B_Z / 4, O_RR = B_RR / 4, O_KR = B_KR / 4, O_VR = B_VR / 4, O_AA = B_AA / 4,
                 O_WW = B_WW / 4, O_KD = B_KD / 4, O_BD = B_BD / 4, O_GG = B_GG / 4;

struct MP { const float* in[44]; float* out; unsigned char* ws; int ph_lo, ph_hi; };

enum { PH_CVT = 0, PH_XN1, PH_GEMM_Z, PH_PREP, PH_GEMM4, PH_ATTN, PH_CARRY, PH_FIX, PH_GEMM_O0, PH_XN2, PH_FFN_UP, PH_FFN_DOWN, PH_XN3, PH_GEMM_IN1, PH_LNT, PH_SPATIAL, PH_GEMM_O1, PH_XN4, PH_PLAN, PH_MOE_UP, PH_MOE_DOWN, PH_FINAL, PH_N };

__global__ void __launch_bounds__(512, 2) mega(MP p) {
    extern __shared__ __attribute__((aligned(16))) unsigned char lds_raw[];
    LAS unsigned char* lds = (LAS unsigned char*)lds_raw;
    const int tid = threadIdx.x, G = gridDim.x, bid = blockIdx.x;
    for (int u = tid; u < (LDS_BYTES - LDS_CTL) / 4; u += 512) ((LAS unsigned*)(lds + LDS_CTL))[u] = 0u;
    __syncthreads();
    XcdBarrier bar = xcd_barrier_post((unsigned*)(p.ws + MB_CTL), (volatile LAS unsigned*)(lds + LDS_CTL + 64));
    float* wsf = (float*)p.ws;
    const int lo = p.ph_lo, hi = p.ph_hi;
#define IN(k) (lo <= (k) && (k) < hi)
#define SEAM(k) do { if (IN(k) && IN((k) + 1)) xcd_barrier(bar); } while (0)
    bf16_t* W13 = (bf16_t*)(p.ws + MB_W13); bf16_t* W2 = (bf16_t*)(p.ws + MB_W2); bf16_t* XNB = (bf16_t*)(p.ws + MB_XNB); bf16_t* ACT = (bf16_t*)(p.ws + MB_ACT);

    bf16_t* WIN0 = (bf16_t*)(p.ws + MB_WIN0); bf16_t* WO0 = (bf16_t*)(p.ws + MB_WO0); bf16_t* MIXB = (bf16_t*)(p.ws + MB_MIXB);
    bf16_t* CQNB = (bf16_t*)(p.ws + MB_CQNB); bf16_t* CKVNB = (bf16_t*)(p.ws + MB_CKVNB); bf16_t* LA = (bf16_t*)(p.ws + MB_LA);
    bf16_t* WLORA = (bf16_t*)(p.ws + MB_WLORA); bf16_t* WUQ = (bf16_t*)(p.ws + MB_WUQ); bf16_t* WKN = (bf16_t*)(p.ws + MB_WKN); bf16_t* WV = (bf16_t*)(p.ws + MB_WV);
    bf16_t* QB = (bf16_t*)(p.ws + MB_QB); bf16_t* KNB = (bf16_t*)(p.ws + MB_KNB); bf16_t* VTB = (bf16_t*)(p.ws + MB_VTB); float* ROPEC = (float*)(p.ws + MB_ROPE); float* ROPES = ROPEC + 1024;
    bf16_t* W13E = (bf16_t*)(p.ws + MB_W13E); bf16_t* W2E = (bf16_t*)(p.ws + MB_W2E); bf16_t* WIN1 = (bf16_t*)(p.ws + MB_WIN1); bf16_t* WO1 = (bf16_t*)(p.ws + MB_WO1); bf16_t* WSB = (bf16_t*)(p.ws + MB_WSB);
    bf16_t* Ub = (bf16_t*)(p.ws + MB_U); float* VG = (float*)(p.ws + MB_VG); bf16_t* VT = (bf16_t*)(p.ws + MB_VT); bf16_t* GATED = (bf16_t*)(p.ws + MB_GATED); bf16_t* XNB2 = (bf16_t*)(p.ws + MB_XNB);
    bf16_t* XG = (bf16_t*)(p.ws + MB_XG); float* OUT2 = (float*)(p.ws + MB_OUT2); bf16_t* ACT2 = (bf16_t*)(p.ws + MB_ACT2);
    int* R_TOPE = (int*)(p.ws + MB_ROUTE); int* R_SLOT = R_TOPE + 16384; float* R_TOPG = (float*)(R_TOPE + 32768); int* R_BCNT = R_TOPE + 49152; int* R_CNTOFF = R_TOPE + 49152 + 4096;
    if (IN(PH_CVT)) {
        ph_small_cvt(p.in[16], p.in[18], p.in[19], WLORA, ROPEC, ROPES, G, bid);
        { MapPlain m{p.in[10], QW, QW}; cvt_T(lds, m, WUQ, QW, 512, G, bid); }
        { MapKV m{p.in[12], 0}; cvt_T(lds, m, WKN, 1024, 512, G, bid); }
        { MapKV m{p.in[12], 1}; cvt_T(lds, m, WV, 1024, 512, G, bid); }
        ph_ada(lds, p.in[4], p.in[29], p.in[5], p.in[30], p.in[1], p.in[3], wsf + O_MOD0, wsf + O_MOD1, G, bid);
        { MapPlain m{p.in[8], ZW, ZW}; cvt_T(lds, m, WIN0, ZLD, D, G, bid); }
        { MapPlain m{p.in[25], D, D}; cvt_T(lds, m, WO0, D, D, G, bid); }
        { MapIl m{p.in[26], (long)(p.in[27] - p.in[26]), DFF}; cvt_T(lds, m, W13, 2 * DFF, D, G, bid); }
        { MapPlain m{p.in[28], D, D}; cvt_T(lds, m, W2, D, DFF, G, bid); }
        { MapPlain m{p.in[33], 4096, 4096}; cvt_T(lds, m, WIN1, 4096, D, G, bid); }
        { MapPlain m{p.in[38], D, D}; cvt_T(lds, m, WO1, D, D, G, bid); }
        cvt_copy(p.in[36], WSB, (size_t)16 * 128 * 128, G, bid);
        __syncthreads();
    }
    SEAM(PH_CVT);
    if (IN(PH_XN1)) ph_norm_mod<false>(lds, p.in[0], p.in[2], p.in[6], wsf + O_MOD0, 0, 1, XNB, MALL, nullptr, nullptr, nullptr, nullptr, G, bid);
    SEAM(PH_XN1);
    if (IN(PH_GEMM_Z)) {
        pg8::DenseOrder S; S.init(XNB, D, WIN0, D, MALL, ZLD, G, bid);
        EpiF32 E{wsf + O_Z, ZLD};
        pg8::gemm_phase<EpiF32, pg8::DenseOrder, true, true>(lds, D, D, D, S, E);
    }
    SEAM(PH_GEMM_Z);
    if (IN(PH_PREP)) {
        ph_prep(wsf + O_Z, p.in[9], p.in[11], p.in[13], p.in[14], p.in[20], CQNB, CKVNB, KNB, LA, wsf + O_RR, wsf + O_KR, wsf + O_VR, wsf + O_AA, ROPEC, ROPES, G, bid);
    }
    SEAM(PH_PREP);
    if (IN(PH_GEMM4)) {
        { pg8::DenseOrder S; S.init(LA, 512, WLORA, 512, MALL, 5120, G, bid);
          EpiLora E{p.in[15], p.in[17], p.in[21], wsf + O_KR, wsf + O_AA, wsf + O_WW, wsf + O_KD, wsf + O_BD, wsf + O_GG};
          pg8::gemm_phase<EpiLora, pg8::DenseOrder, true, true>(lds, 512, 512, 512, S, E); }
        { pg8::DenseOrder S; S.init(CQNB, 512, WUQ, 512, NL, QW, G, (bid + 168) % G);
          EpiQ E{QB, ROPEC, ROPES};
          pg8::gemm_phase<EpiQ, pg8::DenseOrder, true, true>(lds, 512, 512, 512, S, E);
 }
        { pg8::DenseOrder S; S.init(CKVNB, 512, WKN, 512, MALL, 1024, G, (bid + 104) % G);
          EpiBf16 E{KNB, KLD};
          pg8::gemm_phase<EpiBf16, pg8::DenseOrder, true, true>(lds, 512, 512, 512, S, E); }
        { pg8::DenseOrder S; S.init(WV, 512, CKVNB, 512, 1024, MALL, G, (bid + 224) % G);
          EpiVT E{VTB};
          pg8::gemm_phase<EpiVT, pg8::DenseOrder, true, true>(lds, 512, 512, 512, S, E); }
    }
    SEAM(PH_GEMM4);
    float* YP = (float*)(p.ws + MB_YP); float* QP = (float*)(p.ws + MB_QP); float* SS = (float*)(p.ws + MB_SS);
    if (IN(PH_ATTN)) {
        ph_attn(lds, QB, KNB, VTB, MIXB, G, bid);
        { const MoeCv mc{p.in[40], (long)(p.in[41] - p.in[40]), p.in[42], (unsigned char*)W13E, (unsigned char*)W2E};
          ph_scan1(lds, wsf, (unsigned)O_AA, (unsigned)O_WW, (unsigned)O_BD, (unsigned)O_KD, (unsigned)O_RR, (unsigned)O_VR, YP, QP, mc, G, bid); }
        __syncthreads();
    }
    SEAM(PH_ATTN);
    if (IN(PH_CARRY)) ph_scan_carry(QP, SS, G, bid);
    SEAM(PH_CARRY);
    if (IN(PH_FIX)) ph_scan_fix(YP, SS, wsf + O_RR, wsf + O_KD, wsf + O_VR, wsf + O_GG, p.in[22], p.in[23], p.in[24], MIXB, G, bid);
    SEAM(PH_FIX);
    if (IN(PH_GEMM_O0)) {
        pg8::DenseOrder S; S.init(MIXB, D, WO0, D, NL, D, G, bid);
        EpiRes E{wsf + O_H, p.in[0], wsf + O_MOD0 + 2 * D};
        pg8::gemm_phase<EpiRes, pg8::DenseOrder, true, true>(lds, D, D, D, S, E);
    }
    SEAM(PH_GEMM_O0);
    if (IN(PH_XN2)) ph_norm_mod<false>(lds, wsf + O_H, nullptr, p.in[7], wsf + O_MOD0, 3, 4, XNB, NL, nullptr, nullptr, nullptr, nullptr, G, bid);
    SEAM(PH_XN2);
    if (IN(PH_FFN_UP)) {
        pg8::DenseOrder S; S.init(XNB, D, W13, D, NL, 2 * DFF, G, bid);
        EpiSwiglu E{ACT, DFF};
        pg8::gemm_phase<EpiSwiglu, pg8::DenseOrder, false, true>(lds, D, D, D, S, E);
    }
    SEAM(PH_FFN_UP);
    if (IN(PH_FFN_DOWN)) {
        pg8::DenseOrder S; S.init(ACT, DFF, W2, DFF, NL, D, G, bid);
        EpiRes E{wsf + O_H, wsf + O_H, wsf + O_MOD0 + 5 * D};
        pg8::gemm_phase<EpiRes, pg8::DenseOrder, true, true>(lds, DFF, DFF, DFF, S, E);
    }
    SEAM(PH_FFN_DOWN);
    if (IN(PH_XN3)) ph_norm_mod<false>(lds, wsf + O_H, nullptr, p.in[31], wsf + O_MOD1, 0, 1, XNB2, NL, nullptr, nullptr, nullptr, nullptr, G, bid);
    SEAM(PH_XN3);
    if (IN(PH_GEMM_IN1)) {
        pg8::DenseOrder S; S.init(XNB2, D, WIN1, D, NL, 4096, G, bid);
        EpiGelu E{Ub, VG};
        pg8::gemm_phase<EpiGelu, pg8::DenseOrder, true, true>(lds, D, D, D, S, E);
    }
    SEAM(PH_GEMM_IN1);
    if (IN(PH_LNT)) ph_ln_transpose(lds, VG, p.in[34], p.in[35], VT, G, bid);
    SEAM(PH_LNT);
    if (IN(PH_SPATIAL)) ph_spatial(WSB, VT, Ub, p.in[37], GATED, G, bid);
    SEAM(PH_SPATIAL);
    if (IN(PH_GEMM_O1)) {
        pg8::DenseOrder S; S.init(GATED, D, WO1, D, NL, D, G, bid);
        EpiRes E{wsf + O_H, wsf + O_H, wsf + O_MOD1 + 2 * D};
        pg8::gemm_phase<EpiRes, pg8::DenseOrder, true, true>(lds, D, D, D, S, E);
    }
    SEAM(PH_GEMM_O1);
    if (IN(PH_XN4)) ph_norm_mod<true>(lds, wsf + O_H, nullptr, p.in[32], wsf + O_MOD1, 3, 4, XNB2, NL, p.in[39], R_TOPE, R_TOPG, R_BCNT, G, bid);
    SEAM(PH_XN4);
    if (IN(PH_PLAN)) ph_moe_plan(lds, R_BCNT, R_TOPE, R_SLOT, R_CNTOFF, XNB2, XG, G, bid);
    SEAM(PH_PLAN);
    if (IN(PH_MOE_UP)) {
        pg8::MoeOrder S; S.init(R_CNTOFF, R_CNTOFF + 8, XG, D / 2, W13E, D / 2, (size_t)2 * DFF * D, 2 * DFF, G, bid);
        EpiSwigluF8 E{(unsigned char*)ACT2, DFF, 1.0f / 64.f};
        pg8::gemm_phase<EpiSwigluF8, pg8::MoeOrder, false, true, true>(lds, D / 2, D / 2, D / 2, S, E);
    }
    SEAM(PH_MOE_UP);
    if (IN(PH_MOE_DOWN)) {
        pg8::MoeOrder S; S.init(R_CNTOFF, R_CNTOFF + 8, ACT2, DFF / 2, W2E, DFF / 2, (size_t)D * DFF, D, G, bid);
        EpiBf16S E{(bf16_t*)OUT2, D, 1.0f / 128.f};
        pg8::gemm_phase<EpiBf16S, pg8::MoeOrder, true, true, true>(lds, DFF / 2, DFF / 2, DFF / 2, S, E);
    }
    SEAM(PH_MOE_DOWN);
    if (IN(PH_FINAL)) ph_final(wsf + O_H, (const bf16_t*)OUT2, R_SLOT, R_TOPG, wsf + O_MOD1 + 5 * D, p.in[43], p.out, G, bid);
#undef IN
#undef SEAM
}

static void launch_mega(hipStream_t stream, MP mp, int lo, int hi) {
    static int grid = 0;
    if (grid == 0) {
        int dev = 0, cus = 0;
        hipGetDevice(&dev); hipDeviceGetAttribute(&cus, hipDeviceAttributeMultiprocessorCount, dev);
        hipFuncSetAttribute((const void*)mega, hipFuncAttributeMaxDynamicSharedMemorySize, LDS_BYTES);
        int per_cu = 0; hipOccupancyMaxActiveBlocksPerMultiprocessor(&per_cu, (const void*)mega, 512, LDS_BYTES);
        if (per_cu < 1) fprintf(stderr, "mega: occupancy query says %d\n", per_cu);
        (void)hipGetLastError();
        grid = cus > 0 ? cus : 256;
    }
    hipMemsetAsync(mp.ws + MB_CTL, 0, CTL_BYTES, stream);
    mp.ph_lo = lo; mp.ph_hi = hi;
    hipLaunchKernelGGL(mega, dim3(grid), dim3(512), LDS_BYTES, stream, mp);
}
extern "C" void kernel_launch(void* const* d_in, const int* in_sizes, int n_in, void* d_out, int out_size, void* d_ws, size_t ws_size, hipStream_t stream) {
    if (n_in != 44 || ws_size < MB_END) { fprintf(stderr, "kernel_launch: bad n_in %d or ws %zu < %zu\n", n_in, ws_size, (size_t)MB_END); return; }
    MP mp{};
    for (int i = 0; i < 44; ++i) mp.in[i] = (const float*)d_in[i];
    mp.out = (float*)d_out; mp.ws = (unsigned char*)d_ws;
    launch_mega(stream, mp, 0, PH_N);
}
```

```cpp
#include <hip/hip_runtime.h>
#include <cstdio>
#include <cstdint>

constexpr int D = 2048, NB = 2, SEQ = 4096, CTX = 256;
constexpr int NL = NB * SEQ;
constexpr int NCX = NB * CTX;
constexpr int MALL = NL + NCX;
constexpr int NMOD = 6 * D;
constexpr int QL = 512, KVL = 512, ROPE = 64, NOPE = 128, VH = 128, HM = 8;
constexpr int MLA_IN = QL + KVL + ROPE;
constexpr int RD = 1024, RH = 16, RN = 64;
constexpr int RWKV_IN = 3 * RD + 128 + 128 + 160;
__device__ __forceinline__ size_t hmi(int row, int col) { return ((size_t)(col >> 6) * (8192 + 2 * 256) + row) * 64 + (col & 63); }
constexpr int ZW = MLA_IN + RWKV_IN;
constexpr int ZLD = 4608;
constexpr int KLD = 1088;
constexpr int QW = HM * (NOPE + ROPE);
constexpr int KVW = HM * (NOPE + VH);
constexpr int SK = CTX + SEQ;
constexpr int DFF = 7168, NE = 8;
constexpr int NSLOT = 18432;

constexpr int LDS_BYTES = 163840, LDS_CTL = 162816;

__device__ __forceinline__ float wave_sum(float v) {
#pragma unroll
    for (int o = 32; o > 0; o >>= 1) v += __shfl_xor(v, o);
    return v;
}
__device__ __forceinline__ float wave_sum_dpp(float v) {
    v += __builtin_bit_cast(float, __builtin_amdgcn_update_dpp(0, __builtin_bit_cast(int, v), 0xB1, 0xf, 0xf, true));
    v += __builtin_bit_cast(float, __builtin_amdgcn_update_dpp(0, __builtin_bit_cast(int, v), 0x4E, 0xf, 0xf, true));
    v += __builtin_bit_cast(float, __builtin_amdgcn_update_dpp(0, __builtin_bit_cast(int, v), 0x141, 0xf, 0xf, true));
    v += __builtin_bit_cast(float, __builtin_amdgcn_update_dpp(0, __builtin_bit_cast(int, v), 0x140, 0xf, 0xf, true));
    const int vi = __builtin_bit_cast(int, v);
    const float s0 = __builtin_bit_cast(float, __builtin_amdgcn_readlane(vi, 0)), s1 = __builtin_bit_cast(float, __builtin_amdgcn_readlane(vi, 16));
    const float s2 = __builtin_bit_cast(float, __builtin_amdgcn_readlane(vi, 32)), s3 = __builtin_bit_cast(float, __builtin_amdgcn_readlane(vi, 48));
    return (s0 + s1) + (s2 + s3);
}
__device__ __forceinline__ float sigmoidf_(float x) { return 1.0f / (1.0f + expf(-x)); }
__device__ __forceinline__ float siluf_(float x) { return x / (1.0f + expf(-x)); }

#define LAS __attribute__((address_space(3)))
typedef unsigned short bf16_t;
typedef short bf16x8 __attribute__((ext_vector_type(8)));
typedef float f32x4 __attribute__((ext_vector_type(4)));
typedef float f32x2 __attribute__((ext_vector_type(2)));
typedef unsigned u32x4 __attribute__((ext_vector_type(4)));
typedef unsigned u32x2 __attribute__((ext_vector_type(2)));
typedef int i32x8 __attribute__((ext_vector_type(8)));

__device__ __forceinline__ unsigned cvt_pk_bf16(float lo, float hi) { unsigned r; asm volatile("v_cvt_pk_bf16_f32 %0, %1, %2" : "=v"(r) : "v"(lo), "v"(hi)); return r; }
__device__ __forceinline__ unsigned pk4_fp8(float a, float b, float c, float d) { int p = __builtin_amdgcn_cvt_pk_fp8_f32(a, b, 0, false); p = __builtin_amdgcn_cvt_pk_fp8_f32(c, d, p, true); return (unsigned)p; }
__device__ __forceinline__ float bf2f(bf16_t b) { return __uint_as_float(((unsigned)b) << 16); }
__device__ __forceinline__ float fexp(float x) { return __builtin_amdgcn_exp2f(x * 1.4426950408889634f); }
__device__ __forceinline__ float flog(float x) { return __builtin_amdgcn_logf(x) * 0.6931471805599453f; }
__device__ __forceinline__ float fsigmoid(float x) { return __builtin_amdgcn_rcpf(1.0f + fexp(-x)); }
__device__ __forceinline__ float ftanh(float x) { return 1.0f - 2.0f * __builtin_amdgcn_rcpf(1.0f + fexp(2.0f * x)); }
__device__ __forceinline__ float rope_inv(int f) { const int q = f >> 2, r = f & 3; const float a = q == 0 ? 1.0f : q == 1 ? 0.1f : q == 2 ? 0.01f : 0.001f;
    const float b = r == 0 ? 1.0f : r == 1 ? 0.5623413251903491f : r == 2 ? 0.31622776601683794f : 0.1778279410038923f; return a * b; }

#define XB_TMO      128
#define XB_XCNT(j)  (256  + 64 * (j))
#define XB_XSUB(j)  (1280 + 64 * (j))
#define XB_XGEN(j)  (2304 + 64 * (j))
#define XB_TOP      3328
#define XB_TOPGEN   3392
#define XCD_BAR_WORDS 3456
#define XB_SPIN_CAP (1u << 18)
__device__ __forceinline__ unsigned xb_ld(unsigned* p)              { return __hip_atomic_load(p, __ATOMIC_RELAXED, __HIP_MEMORY_SCOPE_AGENT); }
__device__ __forceinline__ unsigned xb_add(unsigned* p, unsigned v) { return __hip_atomic_fetch_add(p, v, __ATOMIC_RELAXED, __HIP_MEMORY_SCOPE_AGENT); }
__device__ __forceinline__ unsigned xb_xcc_id() { return (unsigned)__builtin_amdgcn_s_getreg((3 << 11) | 20) & 0xFu; }
#define XB_SPIN(cond, bar) do { unsigned _sp = 0; while (cond) { __builtin_amdgcn_s_sleep(1); \
    if ((++_sp & 255u) == 0u) { if (xb_ld(&(bar)[XB_TMO])) break; if (_sp > XB_SPIN_CAP) { atomicAdd(&(bar)[XB_TMO], 1u); break; } } } } while (0)
struct XcdBarrier { unsigned* bar; unsigned x; volatile LAS unsigned* st; };
__device__ __forceinline__ XcdBarrier xcd_barrier_post(unsigned* bar, volatile LAS unsigned* st) {
    XcdBarrier b; b.bar = bar; b.x = xb_xcc_id(); b.st = st;
    if (threadIdx.x == 0) (void)xb_add(&bar[XB_XCNT(b.x)], 1u);
    return b;
}
__device__ __forceinline__ void xcd_barrier_complete(unsigned* bar, unsigned x, unsigned& nloc, unsigned& nx) {
    const unsigned G = gridDim.x * gridDim.y * gridDim.z;
    unsigned sum, cnt, mine, sp = 0u;
    for (;;) {
        sum = 0u; cnt = 0u; mine = 0u;
#pragma unroll
        for (unsigned j = 0; j < 16; ++j) { const unsigned c = xb_ld(&bar[XB_XCNT(j)]); sum += c; cnt += (c > 0u) ? 1u : 0u; mine = (j == x) ? c : mine; }
        if (sum == G) break;
        __builtin_amdgcn_s_sleep(1);
        if ((++sp & 255u) == 0u) { if (xb_ld(&bar[XB_TMO])) break; if (sp > XB_SPIN_CAP) { atomicAdd(&bar[XB_TMO], 1u); break; } }
    }
    nloc = mine > 0u ? mine : 1u; nx = cnt > 0u ? cnt : 1u;
}
__device__ __forceinline__ void xcd_barrier(const XcdBarrier& b) {
    asm volatile("s_waitcnt vmcnt(0)" ::: "memory");
    __syncthreads();
    if (threadIdx.x == 0) {
        unsigned* bar = b.bar;
        __builtin_amdgcn_s_waitcnt(0);
        unsigned nloc = b.st[0], nx = b.st[1];
        if (nloc == 0u) { xcd_barrier_complete(bar, b.x, nloc, nx); b.st[0] = nloc; b.st[1] = nx; }
        const unsigned old = xb_add(&bar[XB_XSUB(b.x)], 1u);
        const unsigned gen = old / nloc;
        if (old + 1u == (gen + 1u) * nloc) {
            __builtin_amdgcn_fence(__ATOMIC_RELEASE, "agent");
            asm volatile("s_waitcnt vmcnt(0)" ::: "memory");
            const unsigned og = xb_add(&bar[XB_TOP], 1u);
            const unsigned tg = og / nx;
            if (og + 1u == (tg + 1u) * nx) xb_add(&bar[XB_TOPGEN], 1u);
            else XB_SPIN(xb_ld(&bar[XB_TOPGEN]) == tg, bar);
            __builtin_amdgcn_fence(__ATOMIC_ACQUIRE, "agent");
            xb_add(&bar[XB_XGEN(b.x)], 1u);
            asm volatile("s_waitcnt vmcnt(0)" ::: "memory");
        } else {
            XB_SPIN(xb_ld(&bar[XB_XGEN(b.x)]) == gen, bar);
            __builtin_amdgcn_fence(__ATOMIC_ACQUIRE, "agent");
            asm volatile("s_waitcnt vmcnt(0)" ::: "memory");
        }
    }
    __syncthreads();
}

namespace pg8 {
constexpr int BM = 256, BK = 64, HALF = 128, HTB = HALF * BK * 2, STAGE_BYTES = 8 * HTB, NXCD = 8, WGM = 8;
__host__ __device__ __forceinline__ int lds_byte(int r, int c) { const int st = (r >> 4) * 2 + (c >> 5), rr = r & 15, cc = c & 31, ob = rr * 64 + cc * 2; return st * 1024 + (ob ^ (((ob >> 9) & 1) << 5)); }
__host__ __device__ __forceinline__ void stage_rc(int b, int& R, int& C) { const int st = b / 1024, sb = b % 1024, swz = sb ^ (((sb >> 9) & 1) << 5); R = (st >> 1) * 16 + swz / 64; C = (st & 1) * 32 + (swz % 64) / 2; }
__host__ __device__ __forceinline__ int perm32(int rho) { const int n = rho >> 4, i = rho & 15; return 8 * (i >> 2) + 4 * n + (i & 3); }
struct Unit { int pm, pn, kind; const char* a; const char* b; };

struct DenseOrder {
    int nM, nN, nwg, G, c, lda, ldb; const char* A; const char* B;
    __device__ void init(const bf16_t* A_, int lda_, const bf16_t* B_, int ldb_, int M, int N, int G_, int c_) { A = (const char*)A_; B = (const char*)B_; lda = lda_; ldb = ldb_; nM = M / BM; nN = N / BM; nwg = nM * nN; G = G_; c = c_; }
    __device__ bool next(int i, Unit& u) const {
        const long L = (long)i * G + c; if (L >= nwg) return false;
        int wgid = (int)L; { const int q = nwg / NXCD, r = nwg % NXCD, xcd = wgid % NXCD, off = wgid / NXCD; wgid = (xcd < r ? xcd * (q + 1) : r * (q + 1) + (xcd - r) * q) + off; }
        const int nig = WGM * nN, gid = wgid / nig, fm = gid * WGM, gsz = (nM - fm) < WGM ? (nM - fm) : WGM;
        u.pm = fm + ((wgid % nig) % gsz); u.pn = (wgid % nig) / gsz; u.kind = 0;
        u.a = A + (size_t)u.pm * BM * lda * 2; u.b = B + (size_t)u.pn * BM * ldb * 2; return true;
    }
};

template <class Epi, class Sched, bool ALIGN_EPI = false, bool SP2 = false, bool FP8 = false>
__device__ __forceinline__ void gemm_phase(LAS unsigned char* lds, const int K, const int lda, const int ldb, const Sched& S, const Epi& E) {
    const int tid = threadIdx.x, wid = __builtin_amdgcn_readfirstlane(tid >> 6), lane = tid & 63, wr = wid >> 2, wc = wid & 3, fr = lane & 15, fq = lane >> 4;
    const int nt = K / BK;
    unsigned voffA[2], voffB[2];
#pragma unroll
    for (int i = 0; i < 2; ++i) { int R, C; stage_rc(tid * 16 + i * 8192, R, C); const int Rb = Epi::PERM ? ((R & ~31) + perm32(R & 31)) : R;
        voffA[i] = (unsigned)(R * lda + C) * 2u; voffB[i] = (unsigned)(Rb * ldb + C) * 2u; }
    const size_t kstep = (size_t)(BK * 2);
    const size_t hstepA = (size_t)HALF * lda * 2, hstepB = (size_t)HALF * ldb * 2;
    const unsigned ldsw = (unsigned)wid * 1024u;
    const int aoff = lds_byte(wr * 64 + fr, fq * 8), boff = lds_byte(wc * 32 + fr, fq * 8);
#define PG8_SA(b, h) (((b) * 2 + (h)) * HTB)
#define PG8_SB(b, h) ((4 + (b) * 2 + (h)) * HTB)
#define PG8_STAGE(bufoff, gbase, voff) do { _Pragma("unroll") for (int _i = 0; _i < 2; ++_i) \
        __builtin_amdgcn_global_load_lds((const unsigned*)((const char*)(gbase) + (voff)[_i]), (LAS unsigned*)(lds + (bufoff) + ldsw + _i * 8192), 16, 0, 0); } while (0)
#define PG8_LDA(dst, b, h) do { _Pragma("unroll") for (int m = 0; m < 4; ++m) _Pragma("unroll") for (int k = 0; k < 2; ++k) dst[m][k] = *(const LAS bf16x8*)(lds + PG8_SA(b, h) + aoff + m * 2048 + k * 1024); } while (0)
#define PG8_LDB(dst, b, h) do { _Pragma("unroll") for (int n = 0; n < 2; ++n) _Pragma("unroll") for (int k = 0; k < 2; ++k) dst[n][k] = *(const LAS bf16x8*)(lds + PG8_SB(b, h) + boff + n * 2048 + k * 1024); } while (0)
#define PG8_CAT(x) __builtin_bit_cast(i32x8, __builtin_shufflevector((x)[0], (x)[1], 0, 1, 2, 3, 4, 5, 6, 7, 8, 9, 10, 11, 12, 13, 14, 15))
#define PG8_MMA(ai, bj, At, Bt) do { __builtin_amdgcn_s_setprio(1); _Pragma("unroll") for (int m = 0; m < 4; ++m) _Pragma("unroll") for (int n = 0; n < 2; ++n) { \
        if constexpr (FP8) { asm volatile("v_mfma_f32_16x16x128_f8f6f4 %0, %1, %2, %0" : "+v"(acc[ai][bj][m][n]) : "v"(PG8_CAT(Bt[n])), "v"(PG8_CAT(At[m]))); } \
        else { _Pragma("unroll") for (int k = 0; k < 2; ++k) acc[ai][bj][m][n] = __builtin_amdgcn_mfma_f32_16x16x32_bf16(Bt[n][k], At[m][k], acc[ai][bj][m][n], 0, 0, 0); } } \
        __builtin_amdgcn_s_setprio(0); } while (0)
#define PG8_WAIT_V(n) asm volatile("s_waitcnt vmcnt(" #n ")" ::: "memory")
#define PG8_WAIT_L(n) asm volatile("s_waitcnt lgkmcnt(" #n ")" ::: "memory")
#define PG8_BAR __builtin_amdgcn_s_barrier()
#define PG8_SCHED __builtin_amdgcn_sched_barrier(0)
    Unit cur, nxt; int ui = 0;
    if (!S.next(0, cur)) return;
    f32x4 acc[2][2][4][2];
#pragma unroll
    for (int a = 0; a < 2; ++a)
#pragma unroll
        for (int b = 0; b < 2; ++b)
#pragma unroll
            for (int m = 0; m < 4; ++m)
#pragma unroll
                for (int n = 0; n < 2; ++n) acc[a][b][m][n] = (f32x4){0.f, 0.f, 0.f, 0.f};
    bf16x8 At[4][2], B0[2][2], B1[2][2];
    const char* cA = cur.a; const char* cB = cur.b;
    if constexpr (SP2) {
        PG8_STAGE(PG8_SB(0, 0), cB, voffB); PG8_STAGE(PG8_SB(0, 1), cB + hstepB, voffB); PG8_STAGE(PG8_SA(0, 0), cA, voffA); PG8_STAGE(PG8_SA(0, 1), cA + hstepA, voffA);
        if (wr == 1) PG8_BAR;
        PG8_WAIT_V(2); PG8_BAR;
        PG8_STAGE(PG8_SB(1, 0), cB + kstep, voffB); PG8_STAGE(PG8_SA(1, 0), cA + kstep, voffA); PG8_STAGE(PG8_SB(1, 1), cB + hstepB + kstep, voffB);
        PG8_WAIT_V(6); PG8_BAR;
    } else {
        PG8_STAGE(PG8_SB(0, 0), cB, voffB); PG8_STAGE(PG8_SA(0, 0), cA, voffA); PG8_STAGE(PG8_SB(0, 1), cB + hstepB, voffB); PG8_STAGE(PG8_SA(0, 1), cA + hstepA, voffA);
        if (wr == 1) PG8_BAR;
        PG8_WAIT_V(4); PG8_BAR;
        PG8_STAGE(PG8_SB(1, 0), cB + kstep, voffB); PG8_STAGE(PG8_SA(1, 0), cA + kstep, voffA); PG8_STAGE(PG8_SB(1, 1), cB + hstepB + kstep, voffB);
        PG8_WAIT_V(6); PG8_BAR;
    }
    for (;;) {
        const bool has_next = S.next(ui + 1, nxt);
        const char* nA = has_next ? nxt.a : cA; const char* nB = has_next ? nxt.b : cB;
        for (int t = 0; t < nt; t += 2) {
            const bool last = (t == nt - 2);
            const char* a1 = cA + (size_t)(t + 1) * kstep;
            const char* a2 = last ? nA : cA + (size_t)(t + 2) * kstep; const char* b2 = last ? nB : cB + (size_t)(t + 2) * kstep;
            const char* a3 = a2 + kstep; const char* b3 = b2 + kstep;
            if constexpr (SP2) {
            PG8_LDB(B0, 0, 0); PG8_LDB(B1, 0, 1); PG8_SCHED; PG8_LDA(At, 0, 0); PG8_STAGE(PG8_SA(1, 1), a1 + hstepA, voffA);
            PG8_WAIT_V(8); PG8_WAIT_L(0); PG8_BAR; PG8_MMA(0, 0, At, B0); PG8_MMA(0, 1, At, B1); PG8_BAR; PG8_SCHED;
            PG8_LDA(At, 0, 1); PG8_STAGE(PG8_SB(0, 0), b2, voffB); PG8_STAGE(PG8_SB(0, 1), b2 + hstepB, voffB); PG8_STAGE(PG8_SA(0, 0), a2, voffA);
            PG8_WAIT_V(8); PG8_WAIT_L(0); PG8_BAR; PG8_MMA(1, 0, At, B0); PG8_MMA(1, 1, At, B1); PG8_BAR; PG8_SCHED;
            PG8_LDB(B0, 1, 0); PG8_LDB(B1, 1, 1); PG8_SCHED; PG8_LDA(At, 1, 0); PG8_STAGE(PG8_SA(0, 1), a2 + hstepA, voffA);
            PG8_WAIT_V(8); PG8_WAIT_L(0); PG8_BAR; PG8_MMA(0, 0, At, B0); PG8_MMA(0, 1, At, B1); PG8_BAR; PG8_SCHED;
            PG8_LDA(At, 1, 1); PG8_STAGE(PG8_SB(1, 0), b3, voffB); PG8_STAGE(PG8_SB(1, 1), b3 + hstepB, voffB); PG8_STAGE(PG8_SA(1, 0), a3, voffA);
            PG8_WAIT_V(8); PG8_WAIT_L(0); PG8_BAR; PG8_MMA(1, 0, At, B0); PG8_MMA(1, 1, At, B1); PG8_BAR; PG8_SCHED;
            } else {
            PG8_LDB(B0, 0, 0); PG8_SCHED; PG8_LDA(At, 0, 0); PG8_STAGE(PG8_SA(1, 1), a1 + hstepA, voffA);
            PG8_WAIT_L(8); PG8_BAR; PG8_WAIT_L(0); PG8_MMA(0, 0, At, B0); PG8_BAR; PG8_SCHED;
            PG8_LDB(B1, 0, 1); PG8_STAGE(PG8_SB(0, 0), b2, voffB);
            PG8_BAR; PG8_WAIT_L(0); PG8_MMA(0, 1, At, B1); PG8_BAR;
            PG8_LDA(At, 0, 1); PG8_STAGE(PG8_SA(0, 0), a2, voffA);
            PG8_BAR; PG8_WAIT_L(0); PG8_MMA(1, 0, At, B0); PG8_BAR; PG8_SCHED;
            PG8_STAGE(PG8_SB(0, 1), b2 + hstepB, voffB);
            PG8_WAIT_V(6); PG8_BAR; PG8_MMA(1, 1, At, B1); PG8_BAR;
            PG8_LDB(B0, 1, 0); PG8_SCHED; PG8_LDA(At, 1, 0); PG8_STAGE(PG8_SA(0, 1), a2 + hstepA, voffA);
            PG8_WAIT_L(8); PG8_BAR; PG8_WAIT_L(0); PG8_MMA(0, 0, At, B0); PG8_BAR; PG8_SCHED;
            PG8_LDB(B1, 1, 1); PG8_STAGE(PG8_SB(1, 0), b3, voffB);
            PG8_BAR; PG8_WAIT_L(0); PG8_MMA(0, 1, At, B1); PG8_BAR;
            PG8_LDA(At, 1, 1); PG8_STAGE(PG8_SA(1, 0), a3, voffA);
            PG8_BAR; PG8_WAIT_L(0); PG8_MMA(1, 0, At, B0); PG8_BAR; PG8_SCHED;
            PG8_STAGE(PG8_SB(1, 1), b3 + hstepB, voffB);
            PG8_WAIT_V(6); PG8_BAR; PG8_MMA(1, 1, At, B1); PG8_BAR;
            }
        }
        if constexpr (ALIGN_EPI) { if (wr == 0) PG8_BAR; }
        if constexpr (FP8) asm volatile("s_nop 15\n\ts_nop 15\n\ts_nop 7" ::: "memory");
        E(acc, cur, wr, wc, fr, fq);
        if (!has_next) break;
#pragma unroll
        for (int a = 0; a < 2; ++a)
#pragma unroll
            for (int b = 0; b < 2; ++b)
#pragma unroll
                for (int m = 0; m < 4; ++m)
#pragma unroll
                    for (int n = 0; n < 2; ++n) acc[a][b][m][n] = (f32x4){0.f, 0.f, 0.f, 0.f};
        cur = nxt; cA = nA; cB = nB; ++ui;
        if constexpr (ALIGN_EPI) { if (wr == 1) PG8_BAR; }
    }
    PG8_WAIT_V(0);
    if constexpr (!ALIGN_EPI) { if (wr == 0) PG8_BAR; }
    PG8_BAR;
#undef PG8_SA
#undef PG8_SB
#undef PG8_STAGE
#undef PG8_LDA
#undef PG8_LDB
#undef PG8_MMA
#undef PG8_CAT
#undef PG8_WAIT_V
#undef PG8_WAIT_L
#undef PG8_BAR
#undef PG8_SCHED
}
}
using pg8::Unit;

typedef const f32x4 (&AccRef)[2][2][4][2];
struct EpiF32 { static constexpr bool PERM = false; float* C; int ldc;
    __device__ __forceinline__ void operator()(AccRef acc, const Unit& u, int wr, int wc, int fr, int fq) const {
        const int row0 = u.pm * 256 + wr * 64 + fr, col0 = u.pn * 256 + wc * 32 + 4 * fq;
#pragma unroll
        for (int ai = 0; ai < 2; ++ai)
#pragma unroll
            for (int m = 0; m < 4; ++m) { float* rowp = C + (size_t)(row0 + ai * 128 + m * 16) * ldc + col0;
#pragma unroll
                for (int bj = 0; bj < 2; ++bj)
#pragma unroll
                    for (int n = 0; n < 2; ++n) *(f32x4*)(rowp + bj * 128 + n * 16) = acc[ai][bj][m][n]; }
    } };
struct EpiRes { static constexpr bool PERM = false; float* C; const float* R; const float* gate;
    __device__ __forceinline__ void operator()(AccRef acc, const Unit& u, int wr, int wc, int fr, int fq) const {
        const int row0 = u.pm * 256 + wr * 64 + fr, col0 = u.pn * 256 + wc * 32 + 4 * fq;
        const float* gp = gate + (size_t)((u.pm * 256) / SEQ) * NMOD + col0;
        f32x4 gv[2][2];
#pragma unroll
        for (int bj = 0; bj < 2; ++bj)
#pragma unroll
            for (int n = 0; n < 2; ++n) gv[bj][n] = *(const f32x4*)(gp + bj * 128 + n * 16);
#pragma unroll
        for (int ai = 0; ai < 2; ++ai)
#pragma unroll
          for (int mp = 0; mp < 2; ++mp) {
            f32x4 r[2][2][2];
#pragma unroll
            for (int mm = 0; mm < 2; ++mm) { const size_t off = (size_t)(row0 + ai * 128 + (mp * 2 + mm) * 16) * D + col0;
#pragma unroll
                for (int bj = 0; bj < 2; ++bj)
#pragma unroll
                    for (int n = 0; n < 2; ++n) r[mm][bj][n] = *(const f32x4*)(R + off + bj * 128 + n * 16); }
#pragma unroll
            for (int mm = 0; mm < 2; ++mm) { const size_t off = (size_t)(row0 + ai * 128 + (mp * 2 + mm) * 16) * D + col0;
#pragma unroll
                for (int bj = 0; bj < 2; ++bj)
#pragma unroll
                    for (int n = 0; n < 2; ++n) *(f32x4*)(C + off + bj * 128 + n * 16) = r[mm][bj][n] + gv[bj][n] * acc[ai][bj][mp * 2 + mm][n]; }
          }
    } };
struct EpiSwiglu { static constexpr bool PERM = true; bf16_t* O; int ldo;
    __device__ __forceinline__ void operator()(AccRef acc, const Unit& u, int wr, int wc, int fr, int fq) const {
        const int row0 = u.pm * 256 + wr * 64 + fr, col0 = u.pn * 128 + wc * 32 + 8 * fq;
#pragma unroll
        for (int ai = 0; ai < 2; ++ai)
#pragma unroll
            for (int m = 0; m < 4; ++m) { bf16_t* rowp = O + (size_t)(row0 + ai * 128 + m * 16) * ldo + col0;
                float o[8];
#pragma unroll
                for (int n = 0; n < 2; ++n)
#pragma unroll
                    for (int j = 0; j < 4; ++j) { const float a = acc[ai][0][m][n][j], b = acc[ai][1][m][n][j]; o[n * 4 + j] = a * __builtin_amdgcn_rcpf(1.0f + __expf(-a)) * b; }
                u32x4 w; w.x = cvt_pk_bf16(o[0], o[1]); w.y = cvt_pk_bf16(o[2], o[3]); w.z = cvt_pk_bf16(o[4], o[5]); w.w = cvt_pk_bf16(o[6], o[7]);
                *(u32x4*)rowp = w; }
    } };

struct EpiSwigluF8 { static constexpr bool PERM = true; unsigned char* O; int ldo; float sc;
    __device__ __forceinline__ void operator()(AccRef acc, const Unit& u, int wr, int wc, int fr, int fq) const {
        const int row0 = u.pm * 256 + wr * 64 + fr, col0 = u.pn * 128 + wc * 32 + 8 * fq;
#pragma unroll
        for (int ai = 0; ai < 2; ++ai)
#pragma unroll
            for (int m = 0; m < 4; ++m) { unsigned char* rowp = O + (size_t)(row0 + ai * 128 + m * 16) * ldo + col0;
                float o[8];
#pragma unroll
                for (int n = 0; n < 2; ++n)
#pragma unroll
                    for (int j = 0; j < 4; ++j) { const float a = acc[ai][0][m][n][j] * sc, b = acc[ai][1][m][n][j] * sc; o[n * 4 + j] = a * __builtin_amdgcn_rcpf(1.0f + __expf(-a)) * b; }
                u32x2 w; w.x = pk4_fp8(o[0], o[1], o[2], o[3]); w.y = pk4_fp8(o[4], o[5], o[6], o[7]);
                *(u32x2*)rowp = w; }
    } };
struct EpiBf16S { static constexpr bool PERM = true; bf16_t* O; int ldo; float sc;
    __device__ __forceinline__ void operator()(AccRef acc, const Unit& u, int wr, int wc, int fr, int fq) const {
        const int row0 = u.pm * 256 + wr * 64 + fr, col0 = u.pn * 256 + wc * 32 + 8 * fq;
#pragma unroll
        for (int ai = 0; ai < 2; ++ai)
#pragma unroll
            for (int m = 0; m < 4; ++m) { bf16_t* rowp = O + (size_t)(row0 + ai * 128 + m * 16) * ldo + col0;
#pragma unroll
                for (int bj = 0; bj < 2; ++bj) { const f32x4 v0 = acc[ai][bj][m][0] * sc, v1 = acc[ai][bj][m][1] * sc;
                    u32x4 w; w.x = cvt_pk_bf16(v0[0], v0[1]); w.y = cvt_pk_bf16(v0[2], v0[3]); w.z = cvt_pk_bf16(v1[0], v1[1]); w.w = cvt_pk_bf16(v1[2], v1[3]);
                    *(u32x4*)(rowp + bj * 128) = w; } }
    } };

struct MapPlain { const float* src; int ld, ncols;
    __device__ __forceinline__ const float* operator()(int n0) const { return n0 < ncols ? src + n0 : nullptr; } __device__ __forceinline__ int stride() const { return ld; } __device__ __forceinline__ bool valid(int n) const { return n < ncols; } };
struct MapIl { const float* s1; long d31; int ld;
    __device__ __forceinline__ const float* operator()(int n0) const { const int t = n0 >> 8, j = n0 & 255; return s1 + (j < 128 ? 0l : d31) + t * 128 + (j & 127); } __device__ __forceinline__ int stride() const { return ld; } __device__ __forceinline__ bool valid(int) const { return true; } };
template <bool FP8, class MAP>
__device__ __forceinline__ void cvt_ring(LAS unsigned char* lds, const MAP& map, void* dstv, int Nd, int K, float scale, int G, int c) {
    constexpr int NS = 4, SLOT = 32768;
    const int tid = threadIdx.x, wave = __builtin_amdgcn_readfirstlane(tid >> 6), lane = tid & 63;
    const int ntk = K / 128, nnt = Nd / 64, ntiles = nnt * ntk;
    if (c >= ntiles) return;
    const int nmine = (ntiles - c + G - 1) / G;
    const int ld = map.stride();
    __syncthreads();
    auto issue = [&](int it) {
        const int itc = it < nmine ? it : nmine - 1, tile = c + itc * G;
        const int n0 = (tile % nnt) * 64, k0 = (tile / nnt) * 128;
        const float* sp = map(n0);
        const int col = (lane & 15) * 4, colc = (sp && map.valid(n0 + col)) ? col : 0;
        const float* base = (sp ? sp : map(0)) + colc;
        LAS unsigned char* sl = lds + (it % NS) * SLOT + wave * 4096;
#pragma unroll
        for (int i = 0; i < 4; ++i)
            __builtin_amdgcn_global_load_lds((const unsigned*)(base + (size_t)(k0 + wave * 16 + i * 4 + (lane >> 4)) * ld), (LAS unsigned*)(sl + i * 1024), 16, 0, 0);
    };
#pragma unroll
    for (int i = 0; i < NS - 1; ++i) issue(i);
    for (int it = 0; it < nmine; ++it) {
        asm volatile("s_waitcnt vmcnt(8)" ::: "memory");
        __syncthreads();
        issue(it + NS - 1);
        const int tile = c + it * G, n0 = (tile % nnt) * 64, k0 = (tile / nnt) * 128;
        const LAS float* T = (const LAS float*)(lds + (it % NS) * SLOT);
        const bool ok = map(n0) != nullptr && map.valid(n0 + lane);
        if constexpr (FP8) {
            float v[16];
#pragma unroll
            for (int j = 0; j < 16; ++j) v[j] = ok ? T[(wave * 16 + j) * 64 + lane] * scale : 0.f;
            u32x4 w; w.x = pk4_fp8(v[0], v[1], v[2], v[3]); w.y = pk4_fp8(v[4], v[5], v[6], v[7]); w.z = pk4_fp8(v[8], v[9], v[10], v[11]); w.w = pk4_fp8(v[12], v[13], v[14], v[15]);
            *(u32x4*)((unsigned char*)dstv + (size_t)(n0 + lane) * K + k0 + wave * 16) = w;
        } else {
#pragma unroll
            for (int h = 0; h < 2; ++h) { const int kg = wave + 8 * h; float v[8];
#pragma unroll
                for (int j = 0; j < 8; ++j) v[j] = ok ? T[(kg * 8 + j) * 64 + lane] : 0.f;
                u32x4 w; w.x = cvt_pk_bf16(v[0], v[1]); w.y = cvt_pk_bf16(v[2], v[3]); w.z = cvt_pk_bf16(v[4], v[5]); w.w = cvt_pk_bf16(v[6], v[7]);
                *(u32x4*)((bf16_t*)dstv + (size_t)(n0 + lane) * K + k0 + kg * 8) = w; }
        }
    }
    asm volatile("s_waitcnt vmcnt(0)" ::: "memory");
    __syncthreads();
}
template <class MAP> __device__ __forceinline__ void cvt_T(LAS unsigned char* lds, const MAP& map, bf16_t* dst, int Nd, int K, int G, int c) { cvt_ring<false>(lds, map, dst, Nd, K, 1.f, G, c); }
template <class MAP> __device__ __forceinline__ void cvt_T8(LAS unsigned char* lds, const MAP& map, unsigned char* dst, int Nd, int K, float scale, int G, int c) { cvt_ring<true>(lds, map, dst, Nd, K, scale, G, c); }
__device__ __forceinline__ void cvt_copy(const float* src, bf16_t* dst, size_t n, int G, int c) {
    for (size_t i = ((size_t)c * 512 + threadIdx.x) * 8; i < n; i += (size_t)G * 512 * 8) {
        const float4 a = *(const float4*)(src + i), b = *(const float4*)(src + i + 4);
        u32x4 w; w.x = cvt_pk_bf16(a.x, a.y); w.y = cvt_pk_bf16(a.z, a.w); w.z = cvt_pk_bf16(b.x, b.y); w.w = cvt_pk_bf16(b.z, b.w);
        *(u32x4*)(dst + i) = w;
    }
}


__device__ __forceinline__ f32x2 gelu_pk(f32x2 v) {
    const f32x2 av = __builtin_elementwise_abs(v), d = av * 0.2316418882f + 1.0f;
    f32x2 t; t.x = __builtin_amdgcn_rcpf(d.x); t.y = __builtin_amdgcn_rcpf(d.y);
    f32x2 q = t * 0.5307027145f + (-0.7265760135f); q = q * t + 0.7107068705f; q = q * t + (-0.142248368f); q = q * t + 0.127414796f; q = q * t;
    const f32x2 s = (v * v) * (-0.72134752044f);
    f32x2 e; e.x = __builtin_amdgcn_exp2f(s.x); e.y = __builtin_amdgcn_exp2f(s.y);
    const f32x2 m = v * (q * e), r = v - m;
    f32x2 o; o.x = v.x < 0.f ? m.x : r.x; o.y = v.y < 0.f ? m.y : r.y; return o;
}
struct EpiGelu { static constexpr bool PERM = false; bf16_t* U; float* VG;
    __device__ __forceinline__ void operator()(AccRef acc, const Unit& u, int wr, int wc, int fr, int fq) const {
        const int row0 = u.pm * 256 + wr * 64 + fr, col0 = (u.pn & 7) * 256 + wc * 32 + 4 * fq;
        const bool isu = u.pn < 8;
#pragma unroll
        for (int ai = 0; ai < 2; ++ai)
#pragma unroll
            for (int m = 0; m < 4; ++m) { const size_t off = (size_t)(row0 + ai * 128 + m * 16) * D + col0;
#pragma unroll
                for (int bj = 0; bj < 2; ++bj)
#pragma unroll
                    for (int n = 0; n < 2; ++n) { const f32x4 v = acc[ai][bj][m][n];
                        const f32x2 a = gelu_pk((f32x2){v[0], v[1]}), b = gelu_pk((f32x2){v[2], v[3]});
                        if (isu) { u32x2 w; w.x = cvt_pk_bf16(a.x, a.y); w.y = cvt_pk_bf16(b.x, b.y); *(u32x2*)(U + off + bj * 128 + n * 16) = w; }
                        else *(f32x4*)(VG + off + bj * 128 + n * 16) = (f32x4){a.x, a.y, b.x, b.y}; } }
    } };

namespace pg8 {
struct MoeOrder {
    int cnt_t[8], off_t[8], nN, G, c, lda, ldb; const char* A; const char* B; size_t bstride;
    __device__ void init(const int* cnt, const int* off, const bf16_t* A_, int lda_, const bf16_t* B_, int ldb_, size_t bstride_bytes, int N, int G_, int c_) {
#pragma unroll
        for (int e = 0; e < 8; ++e) { cnt_t[e] = __builtin_amdgcn_readfirstlane((cnt[e] + 255) >> 8); off_t[e] = __builtin_amdgcn_readfirstlane(off[e] >> 8); }
        A = (const char*)A_; B = (const char*)B_; lda = lda_; ldb = ldb_; bstride = bstride_bytes; nN = N / 256; G = G_; c = c_;
    }
    __device__ bool next(int i, Unit& u) const {
        const int L = i * G + c, x = L & 7; int q = L >> 3; int e = 0; bool found = false; int te = 0, oe = 0;
        const int n8 = nN >> 3;
#pragma unroll
        for (int k = 0; k < 8; ++k) { const int ue = cnt_t[k] * n8; if (!found) { if (q < ue) { found = true; e = k; te = cnt_t[k]; oe = off_t[k]; } else q -= ue; } }
        if (!found) return false;
        const int pml = q % te; u.pn = (q / te) * 8 + x; u.pm = oe + pml; u.kind = e;
        u.a = A + (size_t)u.pm * 256 * lda * 2; u.b = B + (size_t)e * bstride + (size_t)u.pn * 256 * ldb * 2; return true;
    }
};
}

template <bool ROUTE>
__device__ __forceinline__ void ph_norm_mod(LAS unsigned char* lds, const float* srcL, const float* srcC, const float* gain, const float* mod, int chunk_sh, int chunk_sc, bf16_t* dst, int nrows,
                                            const float* router, int* tope, float* topg, int* bcnt, int G, int bid) {
    const int tid = threadIdx.x, wave = tid >> 6, lane = tid & 63;
    const int rpb = (nrows + G - 1) / G, r0 = bid * rpb, r1 = min(nrows, r0 + rpb);
    LAS int* lc = (LAS int*)lds;
    if (ROUTE) { if (tid < 8) lc[tid] = 0; __syncthreads(); }
    int cur_mrow = -1; float gm[32], shv[32];
    for (int row = r0 + wave; row < r1; row += 8) {
        const float* src = row < NL ? srcL + (size_t)row * D : srcC + (size_t)(row - NL) * D;
        const int mrow = row < NL ? row / SEQ : 2;
        if (mrow != cur_mrow) { cur_mrow = mrow;
            const float* sh_ = mod + (size_t)mrow * NMOD + chunk_sh * D; const float* sc_ = mod + (size_t)mrow * NMOD + chunk_sc * D;
#pragma unroll
            for (int i = 0; i < 8; ++i) { const int c = i * 256 + lane * 4; const float4 g4 = *(const float4*)(gain + c), sc4 = *(const float4*)(sc_ + c), sh4 = *(const float4*)(sh_ + c);
                gm[i * 4] = g4.x * (1.f + sc4.x); gm[i * 4 + 1] = g4.y * (1.f + sc4.y); gm[i * 4 + 2] = g4.z * (1.f + sc4.z); gm[i * 4 + 3] = g4.w * (1.f + sc4.w);
                shv[i * 4] = sh4.x; shv[i * 4 + 1] = sh4.y; shv[i * 4 + 2] = sh4.z; shv[i * 4 + 3] = sh4.w; } }
        float v[32]; float ss = 0.f;
#pragma unroll
        for (int i = 0; i < 8; ++i) { const float4 x = *(const float4*)(src + i * 256 + lane * 4); v[i * 4] = x.x; v[i * 4 + 1] = x.y; v[i * 4 + 2] = x.z; v[i * 4 + 3] = x.w; ss += x.x * x.x + x.y * x.y + x.z * x.z + x.w * x.w; }
        ss = wave_sum(ss);
        const float rs = rsqrtf(ss * (1.0f / D) + 1e-6f);
        float a[8];
        if (ROUTE) {
#pragma unroll
            for (int e = 0; e < 8; ++e) a[e] = 0.f;
        }
#pragma unroll
        for (int i = 0; i < 8; ++i) {
            const int c = i * 256 + lane * 4;
            float o[4];
            o[0] = v[i * 4] * rs * gm[i * 4] + shv[i * 4]; o[1] = v[i * 4 + 1] * rs * gm[i * 4 + 1] + shv[i * 4 + 1];
            o[2] = v[i * 4 + 2] * rs * gm[i * 4 + 2] + shv[i * 4 + 2]; o[3] = v[i * 4 + 3] * rs * gm[i * 4 + 3] + shv[i * 4 + 3];
            if (ROUTE) *(unsigned*)((unsigned char*)dst + (size_t)row * D + c) = pk4_fp8(o[0], o[1], o[2], o[3]);
            else { u32x2 w; w.x = cvt_pk_bf16(o[0], o[1]); w.y = cvt_pk_bf16(o[2], o[3]); *(u32x2*)(dst + (size_t)row * D + c) = w; }
            if (ROUTE) {
#pragma unroll
                for (int j = 0; j < 4; ++j) { const float4 ra = *(const float4*)(router + (size_t)(c + j) * 8), rb = *(const float4*)(router + (size_t)(c + j) * 8 + 4);
                    a[0] += o[j] * ra.x; a[1] += o[j] * ra.y; a[2] += o[j] * ra.z; a[3] += o[j] * ra.w; a[4] += o[j] * rb.x; a[5] += o[j] * rb.y; a[6] += o[j] * rb.z; a[7] += o[j] * rb.w; }
            }
        }
        if (ROUTE) {
#pragma unroll
            for (int e = 0; e < 8; ++e) a[e] = wave_sum(a[e]);
            if (lane == 0) {
                int e0 = 0; float v0 = a[0];
#pragma unroll
                for (int e = 1; e < 8; ++e) if (a[e] > v0) { v0 = a[e]; e0 = e; }
                int e1 = 0; float v1 = -3e38f;
#pragma unroll
                for (int e = 0; e < 8; ++e) if (e != e0 && a[e] > v1) { v1 = a[e]; e1 = e; }
                const float ex = fexp(v1 - v0);
                tope[row * 2] = e0; tope[row * 2 + 1] = e1;
                topg[row * 2] = 1.f / (1.f + ex); topg[row * 2 + 1] = ex / (1.f + ex);
                atomicAdd((int*)&lc[e0], 1); atomicAdd((int*)&lc[e1], 1);
            }
        }
    }
    if (ROUTE) { __syncthreads(); if (tid < 8) bcnt[bid * 8 + tid] = lc[tid]; __syncthreads(); }
}

__device__ __forceinline__ void ph_moe_plan(LAS unsigned char* lds, const int* bcnt, const int* tope, int* slot, int* cntoff, const bf16_t* XNB, bf16_t* XG, int G, int bid) {
    const int tid = threadIdx.x;
    LAS int* base = (LAS int*)lds;
    LAS int* sl = base + 8;
    const int rpb = (NL + G - 1) / G, r0 = bid * rpb, r1 = min(NL, r0 + rpb);
    __syncthreads();
    for (int a = tid; a < (r1 - r0) * 2; a += 512) base[48 + 160 + a] = tope[r0 * 2 + a];
    if (tid < 8) { base[16 + tid] = 0; base[32 + tid] = 0; }
    __syncthreads();
    for (int bq = tid; bq < G; bq += 512) { const int4 c0 = *(const int4*)(bcnt + bq * 8), c1 = *(const int4*)(bcnt + bq * 8 + 4);
        const int cv[8] = {c0.x, c0.y, c0.z, c0.w, c1.x, c1.y, c1.z, c1.w};
#pragma unroll
        for (int e = 0; e < 8; ++e) { atomicAdd((int*)&base[16 + e], cv[e]); if (bq < bid) atomicAdd((int*)&base[32 + e], cv[e]); } }
    __syncthreads();
    if (tid == 0) {
        int off = 0;
        for (int e = 0; e < 8; ++e) { const int tot = base[16 + e]; base[e] = off + base[32 + e]; if (bid == 0) { cntoff[e] = tot; cntoff[8 + e] = off; } off += (tot + 255) & ~255; }
        int cur[8];
#pragma unroll
        for (int e = 0; e < 8; ++e) cur[e] = base[e];
        for (int a = r0 * 2; a < r1 * 2; ++a) { const int e = base[48 + 160 + a - r0 * 2]; int s = 0;
#pragma unroll
            for (int q = 0; q < 8; ++q) if (e == q) { s = cur[q]; cur[q]++; }
            slot[a] = s; base[48 + a - r0 * 2] = s; }
    }
    __syncthreads();
    const int na = (r1 - r0) * 2;
    for (int i = tid; i < na * 128; i += 512) { const int a = i >> 7, c16 = i & 127; const int s = base[48 + a], row = r0 + (a >> 1);
        *(u32x4*)((unsigned char*)XG + (size_t)s * D + c16 * 16) = *(const u32x4*)((const unsigned char*)XNB + (size_t)row * D + c16 * 16); }
    __syncthreads();
}

__device__ __forceinline__ void ph_ln_transpose(LAS unsigned char* lds, const float* VG, const float* lnw, const float* lnb, bf16_t* VT, int G, int bid) {
    const int tid = threadIdx.x, wave = tid >> 6, lane = tid & 63;
    LAS bf16_t* T = (LAS bf16_t*)lds;
    for (int unit = bid; unit < NL / 32; unit += G) {
        const int row0 = unit * 32;
        __syncthreads();
        for (int rr = wave; rr < 32; rr += 8) {
            const float* src = VG + (size_t)(row0 + rr) * D;
            float v[32]; float s = 0.f;
#pragma unroll
            for (int i = 0; i < 8; ++i) { const float4 x = *(const float4*)(src + i * 256 + lane * 4); v[i * 4] = x.x; v[i * 4 + 1] = x.y; v[i * 4 + 2] = x.z; v[i * 4 + 3] = x.w; s += (x.x + x.y) + (x.z + x.w); }
            const float mu = wave_sum(s) * (1.f / 2048.f);
            float q = 0.f;
#pragma unroll
            for (int i = 0; i < 32; ++i) { const float dd = v[i] - mu; q += dd * dd; }
            const float rs = rsqrtf(wave_sum(q) * (1.f / 2048.f) + 1e-5f);
#pragma unroll
            for (int i = 0; i < 8; ++i) { const int c = i * 256 + lane * 4;
                const float4 w4 = *(const float4*)(lnw + c), b4 = *(const float4*)(lnb + c);
                u32x2 w; w.x = cvt_pk_bf16((v[i * 4] - mu) * rs * w4.x + b4.x, (v[i * 4 + 1] - mu) * rs * w4.y + b4.y);
                w.y = cvt_pk_bf16((v[i * 4 + 2] - mu) * rs * w4.z + b4.z, (v[i * 4 + 3] - mu) * rs * w4.w + b4.w);
                *(LAS u32x2*)(T + rr * 2048 + c) = w; }
        }
        __syncthreads();
        const int b = row0 / SEQ, n = (row0 % SEQ) / 128, q0 = row0 % 128;
        for (int it = tid; it < 1024 * 4; it += 512) {
            const int qg = it & 3, cp = it >> 2, c = cp * 2;
            unsigned e[8];
#pragma unroll
            for (int j = 0; j < 8; ++j) e[j] = *(const LAS unsigned*)(T + (qg * 8 + j) * 2048 + c);
            u32x4 w0, w1;
            w0.x = (e[0] & 0xffffu) | (e[1] << 16); w0.y = (e[2] & 0xffffu) | (e[3] << 16); w0.z = (e[4] & 0xffffu) | (e[5] << 16); w0.w = (e[6] & 0xffffu) | (e[7] << 16);
            w1.x = (e[0] >> 16) | (e[1] & 0xffff0000u); w1.y = (e[2] >> 16) | (e[3] & 0xffff0000u); w1.z = (e[4] >> 16) | (e[5] & 0xffff0000u); w1.w = (e[6] >> 16) | (e[7] & 0xffff0000u);
            const int g = c >> 7, cl = c & 127;
            bf16_t* dst = VT + ((((size_t)(b * 32 + n) * 16 + g) * 128 + cl) * 128 + q0 + qg * 8);
            *(u32x4*)dst = w0; *(u32x4*)(dst + 128) = w1;
        }
    }
    __syncthreads();
}

__device__ __forceinline__ void ph_spatial(const bf16_t* WS, const bf16_t* VT, const bf16_t* U, const float* bs, bf16_t* GATED, int G, int bid) {
    typedef float f32x16 __attribute__((ext_vector_type(16)));
    const int tid = threadIdx.x, wave = tid >> 6, lane = tid & 63, l32 = lane & 31, half = lane >> 5;
    const int p0 = (wave & 3) * 32, c0 = (wave >> 2) * 64;
    for (int unit = bid; unit < NB * 32 * 16; unit += G) {
        const int g = unit & 15, bn = unit >> 4;
        const bf16_t* Wp = WS + (size_t)g * 128 * 128 + (size_t)(p0 + l32) * 128 + half * 8;
        const bf16_t* Vp = VT + ((size_t)bn * 16 + g) * 128 * 128 + (size_t)(c0 + l32) * 128 + half * 8;
        f32x16 acc0, acc1;
#pragma unroll
        for (int i = 0; i < 16; ++i) { acc0[i] = 0.f; acc1[i] = 0.f; }
#pragma unroll
        for (int ks = 0; ks < 8; ++ks) {
            const bf16x8 w = *(const bf16x8*)(Wp + ks * 16), v0 = *(const bf16x8*)(Vp + ks * 16), v1 = *(const bf16x8*)(Vp + 32 * 128 + ks * 16);
            acc0 = __builtin_amdgcn_mfma_f32_32x32x16_bf16(v0, w, acc0, 0, 0, 0);
            acc1 = __builtin_amdgcn_mfma_f32_32x32x16_bf16(v1, w, acc1, 0, 0, 0);
        }
        const int p = p0 + l32;
        const float bias = bs[g * 128 + p];
        const size_t ob = (size_t)(bn * 128 + p) * D + g * 128 + c0 + 4 * half;
#pragma unroll
        for (int i4 = 0; i4 < 4; ++i4) {
#pragma unroll
            for (int hb = 0; hb < 2; ++hb) {
                const size_t o = ob + hb * 32 + 8 * i4;
                const u32x2 uu = *(const u32x2*)(U + o);
                const float u0 = __uint_as_float(uu.x << 16), u1 = __uint_as_float(uu.x & 0xffff0000u), u2 = __uint_as_float(uu.y << 16), u3 = __uint_as_float(uu.y & 0xffff0000u);
                const f32x16& a = hb == 0 ? acc0 : acc1;
                u32x2 w; w.x = cvt_pk_bf16(u0 * (a[i4 * 4] + bias), u1 * (a[i4 * 4 + 1] + bias)); w.y = cvt_pk_bf16(u2 * (a[i4 * 4 + 2] + bias), u3 * (a[i4 * 4 + 3] + bias));
                *(u32x2*)(GATED + o) = w;
            }
        }
    }
}

__device__ __forceinline__ void ph_final(const float* H, const bf16_t* OUT2, const int* slot, const float* topg, const float* g2, const float* fnorm, float* out, int G, int bid) {
    const int tid = threadIdx.x, wave = tid >> 6, lane = tid & 63;
    float fn[32], gv[32]; int cur_b = -1;
#pragma unroll
    for (int i = 0; i < 8; ++i) { const float4 f = *(const float4*)(fnorm + i * 256 + lane * 4); fn[i * 4] = f.x; fn[i * 4 + 1] = f.y; fn[i * 4 + 2] = f.z; fn[i * 4 + 3] = f.w; }
    for (int row = bid * 8 + wave; row < NL; row += G * 8) {
        const int s0 = slot[row * 2], s1 = slot[row * 2 + 1]; const float g0 = topg[row * 2], g1 = topg[row * 2 + 1];
        const float* h = H + (size_t)row * D; const bf16_t* o0 = OUT2 + (size_t)s0 * D; const bf16_t* o1 = OUT2 + (size_t)s1 * D;
        const int bb = row / SEQ;
        if (bb != cur_b) { cur_b = bb; const float* gg = g2 + (size_t)bb * NMOD;
#pragma unroll
            for (int i = 0; i < 8; ++i) { const float4 g = *(const float4*)(gg + i * 256 + lane * 4); gv[i * 4] = g.x; gv[i * 4 + 1] = g.y; gv[i * 4 + 2] = g.z; gv[i * 4 + 3] = g.w; } }
        float v[32]; float ss = 0.f;
#pragma unroll
        for (int i = 0; i < 8; ++i) { const int c = i * 256 + lane * 4;
            const float4 hv = *(const float4*)(h + c); const u32x2 a = *(const u32x2*)(o0 + c), b = *(const u32x2*)(o1 + c);
            const float a0 = __uint_as_float(a.x << 16), a1 = __uint_as_float(a.x & 0xffff0000u), a2 = __uint_as_float(a.y << 16), a3 = __uint_as_float(a.y & 0xffff0000u);
            const float b0 = __uint_as_float(b.x << 16), b1 = __uint_as_float(b.x & 0xffff0000u), b2 = __uint_as_float(b.y << 16), b3 = __uint_as_float(b.y & 0xffff0000u);
            v[i * 4] = hv.x + gv[i * 4] * (g0 * a0 + g1 * b0); v[i * 4 + 1] = hv.y + gv[i * 4 + 1] * (g0 * a1 + g1 * b1);
            v[i * 4 + 2] = hv.z + gv[i * 4 + 2] * (g0 * a2 + g1 * b2); v[i * 4 + 3] = hv.w + gv[i * 4 + 3] * (g0 * a3 + g1 * b3);
            ss += v[i * 4] * v[i * 4] + v[i * 4 + 1] * v[i * 4 + 1] + v[i * 4 + 2] * v[i * 4 + 2] + v[i * 4 + 3] * v[i * 4 + 3]; }
        const float rs = rsqrtf(wave_sum(ss) * (1.f / D) + 1e-6f);
#pragma unroll
        for (int i = 0; i < 8; ++i) { const int c = i * 256 + lane * 4;
            *(float4*)(out + (size_t)row * D + c) = (float4){v[i * 4] * rs * fn[i * 4], v[i * 4 + 1] * rs * fn[i * 4 + 1], v[i * 4 + 2] * rs * fn[i * 4 + 2], v[i * 4 + 3] * rs * fn[i * 4 + 3]}; }
    }
}

__device__ __forceinline__ void ph_ada(LAS unsigned char* lds, const float* W0, const float* W1, const float* b0, const float* b1, const float* c, const float* cc, float* mod0, float* mod1, int G, int bid) {
    const int tid = threadIdx.x, kq = tid / 24, c4 = tid % 24;
    LAS float* red = (LAS float*)lds;
    for (int u = bid; u < 256; u += G) {
        const int l = u >> 7, col0 = (u & 127) * 96;
        const float* W = (l == 0 ? W0 : W1) + col0 + c4 * 4;
        float a[12];
#pragma unroll
        for (int j = 0; j < 12; ++j) a[j] = 0.f;
        if (kq < 21) {
#pragma unroll 7
            for (int k = kq; k < D; k += 21) {
                const float4 w = *(const float4*)(W + (size_t)k * NMOD);
                const float x0 = c[k], x1 = c[D + k], x2 = cc[k];
                const float s0 = x0 * fsigmoid(x0), s1 = x1 * fsigmoid(x1), s2 = x2 * fsigmoid(x2);
                a[0] += s0 * w.x; a[1] += s0 * w.y; a[2] += s0 * w.z; a[3] += s0 * w.w;
                a[4] += s1 * w.x; a[5] += s1 * w.y; a[6] += s1 * w.z; a[7] += s1 * w.w;
                a[8] += s2 * w.x; a[9] += s2 * w.y; a[10] += s2 * w.z; a[11] += s2 * w.w;
            }
        }
        __syncthreads();
        if (kq < 21) {
#pragma unroll
            for (int j = 0; j < 12; ++j) red[(kq * 24 + c4) * 12 + j] = a[j];
        }
        __syncthreads();
        if (tid < 288) {
            const int cq = tid / 12, rj = tid % 12, row = rj >> 2, j = rj & 3, n = col0 + cq * 4 + j;
            float sum = (l == 0 ? b0 : b1)[n];
            for (int q = 0; q < 21; ++q) sum += red[(q * 24 + cq) * 12 + rj];
            if (!(l == 1 && row == 2)) (l == 0 ? mod0 : mod1)[(size_t)row * NMOD + n] = sum;
        }
    }
    __syncthreads();
}


__device__ __forceinline__ void ph_small_cvt(const float* w_up, const float* a_up, const float* g_up, bf16_t* WLORA, float* ropec, float* ropes, int G, int bid) {
    const int gt = bid * 512 + threadIdx.x, gs = G * 512;
    if (gt < 16) {
        const double x = (double)rope_inv(gt), x2 = x * x;
        double sn = x * (1.0 + x2 * (-1.0 / 6 + x2 * (1.0 / 120 + x2 * (-1.0 / 5040 + x2 * (1.0 / 362880 + x2 * (-1.0 / 39916800 + x2 * (1.0 / 6227020800.0)))))));
        double cs = 1.0 + x2 * (-0.5 + x2 * (1.0 / 24 + x2 * (-1.0 / 720 + x2 * (1.0 / 40320 + x2 * (-1.0 / 3628800 + x2 * (1.0 / 479001600.0 + x2 * (-1.0 / 87178291200.0)))))));
        double c = 1.0, s_ = 0.0;
        for (int pos = 0; pos < 64; ++pos) { ropec[pos * 16 + gt] = (float)c; ropes[pos * 16 + gt] = (float)s_; const double nc = c * cs - s_ * sn, ns = s_ * cs + c * sn; c = nc; s_ = ns; }
    }
    for (int i = gt; i < 5120 * 64; i += gs) {
        const int n = i >> 6, k0 = (i & 63) * 8, g = n >> 10, ch = n & 1023;
        float v[8];
#pragma unroll
        for (int q = 0; q < 8; ++q) { const int k = k0 + q; float x = 0.f;
            if (g < 4) { const int koff = g * 64; if (k >= koff && k < koff + 64) x = (g < 2 ? w_up : a_up)[(size_t)((g & 1) * 64 + (k - koff)) * RD + ch]; }
            else { if (k >= 256 && k < 416) x = g_up[(size_t)(k - 256) * RD + ch]; }
            v[q] = x; }
        u32x4 w; w.x = cvt_pk_bf16(v[0], v[1]); w.y = cvt_pk_bf16(v[2], v[3]); w.z = cvt_pk_bf16(v[4], v[5]); w.w = cvt_pk_bf16(v[6], v[7]);
        *(u32x4*)(WLORA + (size_t)n * 512 + k0) = w;
    }
}
struct MapKV { const float* src; int sel;
    __device__ __forceinline__ const float* operator()(int n0) const { const int h = n0 >> 7, d = n0 & 127; return src + h * 256 + sel * 128 + d; } __device__ __forceinline__ int stride() const { return KVW; } __device__ __forceinline__ bool valid(int) const { return true; } };

__device__ __forceinline__ void ph_prep(const float* Z, const float* qn, const float* kvn, const float* mup, const float* mun, const float* k_k,
                                        bf16_t* CQNB, bf16_t* CKVNB, bf16_t* KRB, bf16_t* LA, float* RR, float* KRf, float* VR, float* AA, const float* ropec, const float* ropes, int G, int bid) {
    const int wave = threadIdx.x >> 6, lane = threadIdx.x & 63;
    for (int row = bid * 8 + wave; row < MALL; row += G * 8) {
        const float* z = Z + (size_t)row * ZLD;
        int t, len; if (row < NL) { t = row % SEQ; len = SEQ; } else { t = (row - NL) % CTX; len = CTX; }
#pragma unroll
        for (int part = 0; part < 2; ++part) {
            const float4 a = *(const float4*)(z + part * 512 + lane * 8), b = *(const float4*)(z + part * 512 + lane * 8 + 4);
            float ss = a.x * a.x + a.y * a.y + a.z * a.z + a.w * a.w + b.x * b.x + b.y * b.y + b.z * b.z + b.w * b.w;
            ss = wave_sum(ss);
            const float rs = rsqrtf(ss * (1.f / 512.f) + 1e-6f);
            const float* gn = (part == 0 ? qn : kvn) + lane * 8;
            const float4 g0 = *(const float4*)gn, g1 = *(const float4*)(gn + 4);
            u32x4 w; w.x = cvt_pk_bf16(a.x * rs * g0.x, a.y * rs * g0.y); w.y = cvt_pk_bf16(a.z * rs * g0.z, a.w * rs * g0.w);
            w.z = cvt_pk_bf16(b.x * rs * g1.x, b.y * rs * g1.y); w.w = cvt_pk_bf16(b.z * rs * g1.z, b.w * rs * g1.w);
            *(u32x4*)((part == 0 ? CQNB : CKVNB) + (size_t)row * 512 + lane * 8) = w;
        }
        {
            const float val = z[1024 + lane]; const float oth = __shfl_xor(val, 16);
            float o = val;
            if (row < NL) {
                const int a = lane >> 5, hf = (lane >> 4) & 1, f = lane & 15;
                const int pos = a == 0 ? (t >> 6) : (t & 63);
                const float cs = ropec[pos * 16 + f], sn = ropes[pos * 16 + f];
                o = hf == 0 ? val * cs - oth * sn : val * cs + oth * sn;
            }
            KRB[(size_t)row * KLD + 1024 + lane] = (bf16_t)(cvt_pk_bf16(o, 0.f) & 0xffffu);
        }
        const float* zc = z + MLA_IN; const float* zp = zc - ZLD; const float* zn = zc + ZLD;
        const bool hp = t > 0, hn = t < len - 1;
#define SHIFT4(jj) ({ const int j_ = (jj); const f32x4 zz = *(const f32x4*)(zc + j_), mp = *(const f32x4*)(mup + j_), mn = *(const f32x4*)(mun + j_); \
            f32x4 pv = {0.f, 0.f, 0.f, 0.f}, nv = pv; if (hp) pv = *(const f32x4*)(zp + j_); if (hn) nv = *(const f32x4*)(zn + j_); zz + mp * (pv - zz) + mn * (nv - zz); })
        { f32x4 a0 = SHIFT4(lane * 4), a1 = SHIFT4((lane + 64) * 4), a2 = SHIFT4((lane + 128) * 4), a3 = SHIFT4((lane + 192) * 4);
          float* dst = RR + hmi(row, lane * 4); *(f32x4*)dst = a0; *(f32x4*)(dst + (size_t)4 * MALL * 64) = a1; *(f32x4*)(dst + (size_t)8 * MALL * 64) = a2; *(f32x4*)(dst + (size_t)12 * MALL * 64) = a3; }
        { f32x4 k[4]; k[0] = SHIFT4(1024 + lane * 4); k[1] = SHIFT4(1024 + (lane + 64) * 4); k[2] = SHIFT4(1024 + (lane + 128) * 4); k[3] = SHIFT4(1024 + (lane + 192) * 4);
#pragma unroll
          for (int i = 0; i < 4; ++i) { const int c = (lane + 64 * i) * 4;
            *(f32x4*)(KRf + hmi(row, c)) = k[i];
            const f32x4 kk = k[i] * *(const f32x4*)(k_k + c);
            float q = kk[0] * kk[0] + kk[1] * kk[1] + kk[2] * kk[2] + kk[3] * kk[3];
            q += __shfl_xor(q, 1); q += __shfl_xor(q, 2); q += __shfl_xor(q, 4); q += __shfl_xor(q, 8);
            const float inv = -1.0f / fmaxf(sqrtf(q), 1e-12f);
            *(f32x4*)(AA + hmi(row, c)) = kk * inv; } }
        { f32x4 a0 = SHIFT4(2048 + lane * 4), a1 = SHIFT4(2048 + (lane + 64) * 4), a2 = SHIFT4(2048 + (lane + 128) * 4), a3 = SHIFT4(2048 + (lane + 192) * 4);
          float* dst = VR + hmi(row, lane * 4); *(f32x4*)dst = a0; *(f32x4*)(dst + (size_t)4 * MALL * 64) = a1; *(f32x4*)(dst + (size_t)8 * MALL * 64) = a2; *(f32x4*)(dst + (size_t)12 * MALL * 64) = a3; }
        {
            const int c0 = lane * 8; f32x4 x0 = {0.f, 0.f, 0.f, 0.f}, x1 = x0;
            if (c0 < 416) { x0 = SHIFT4(3072 + c0); x1 = SHIFT4(3072 + c0 + 4); }
            float o[8];
#pragma unroll
            for (int q = 0; q < 4; ++q) { o[q] = c0 < 128 ? ftanh(x0[q]) : c0 < 256 ? x0[q] : c0 < 416 ? fsigmoid(x0[q]) : 0.f; o[4 + q] = c0 < 128 ? ftanh(x1[q]) : c0 < 256 ? x1[q] : c0 < 416 ? fsigmoid(x1[q]) : 0.f; }
            u32x4 w; w.x = cvt_pk_bf16(o[0], o[1]); w.y = cvt_pk_bf16(o[2], o[3]); w.z = cvt_pk_bf16(o[4], o[5]); w.w = cvt_pk_bf16(o[6], o[7]);
            *(u32x4*)(LA + (size_t)row * 512 + c0) = w;
        }
#undef SHIFT4
    }
}

struct EpiLora { static constexpr bool PERM = false; const float* w0; const float* a0; const float* k_a; const float* KRf; const float* AA; float* WW; float* KD; float* BD; float* GG;
    __device__ __forceinline__ void operator()(AccRef acc, const Unit& u, int wr, int wc, int fr, int fq) const {
        const int g = __builtin_amdgcn_readfirstlane(u.pn >> 2), row0 = u.pm * 256 + wr * 64 + fr, ch0 = (u.pn & 3) * 256 + wc * 32 + 4 * fq;
        if (g < 2) {
            f32x4 bb[2][2];
#pragma unroll
            for (int bj = 0; bj < 2; ++bj)
#pragma unroll
                for (int n = 0; n < 2; ++n) bb[bj][n] = *(const f32x4*)(w0 + g * RD + ch0 + bj * 128 + n * 16);
            float* dstp = WW + (size_t)g * MALL * RD;
#pragma unroll
            for (int ai = 0; ai < 2; ++ai)
#pragma unroll
                for (int m = 0; m < 4; ++m) { const int row = row0 + ai * 128 + m * 16;
#pragma unroll
                    for (int bj = 0; bj < 2; ++bj)
#pragma unroll
                        for (int n = 0; n < 2; ++n) { const size_t e = hmi(row, ch0 + bj * 128 + n * 16); const f32x4 v = acc[ai][bj][m][n], b = bb[bj][n]; f32x4 o;
#pragma unroll
                            for (int j = 0; j < 4; ++j) { const float y = -(b[j] + v[j]); const float sp = fmaxf(y, 0.f) + flog(1.0f + fexp(-fabsf(y))); o[j] = fexp(-fexp(-sp - 0.5f)); }
                            *(f32x4*)(dstp + e) = o; } }
        } else if (g < 4) {
            const int d = g - 2;
            f32x4 bb[2][2], ka[2][2];
#pragma unroll
            for (int bj = 0; bj < 2; ++bj)
#pragma unroll
                for (int n = 0; n < 2; ++n) { bb[bj][n] = *(const f32x4*)(a0 + d * RD + ch0 + bj * 128 + n * 16); ka[bj][n] = *(const f32x4*)(k_a + ch0 + bj * 128 + n * 16); }
            float* kdp = KD + (size_t)d * MALL * RD; float* bdp = BD + (size_t)d * MALL * RD;
#pragma unroll
            for (int ai = 0; ai < 2; ++ai)
#pragma unroll
                for (int m = 0; m < 4; ++m) {
                    f32x4 kv[2][2], aa[2][2];
#pragma unroll
                    for (int bj = 0; bj < 2; ++bj)
#pragma unroll
                        for (int n = 0; n < 2; ++n) { const size_t e = hmi(row0 + ai * 128 + m * 16, ch0 + bj * 128 + n * 16); kv[bj][n] = *(const f32x4*)(KRf + e); aa[bj][n] = *(const f32x4*)(AA + e); }
#pragma unroll
                    for (int bj = 0; bj < 2; ++bj)
#pragma unroll
                        for (int n = 0; n < 2; ++n) { const size_t e = hmi(row0 + ai * 128 + m * 16, ch0 + bj * 128 + n * 16); const f32x4 v = acc[ai][bj][m][n]; f32x4 okd, obd;
#pragma unroll
                            for (int j = 0; j < 4; ++j) { const float ic = fsigmoid(bb[bj][n][j] + v[j]); okd[j] = kv[bj][n][j] * (1.f + (ic - 1.f) * ka[bj][n][j]); obd[j] = -ic * aa[bj][n][j]; }
                            *(f32x4*)(kdp + e) = okd; *(f32x4*)(bdp + e) = obd; }
                }
        } else {
#pragma unroll
            for (int ai = 0; ai < 2; ++ai)
#pragma unroll
                for (int m = 0; m < 4; ++m)
#pragma unroll
                    for (int bj = 0; bj < 2; ++bj)
#pragma unroll
                        for (int n = 0; n < 2; ++n) *(f32x4*)(GG + hmi(row0 + ai * 128 + m * 16, ch0 + bj * 128 + n * 16)) = acc[ai][bj][m][n];
        }
    } };
struct EpiQ { static constexpr bool PERM = false; bf16_t* QB; const float* ropec; const float* ropes;
    __device__ __forceinline__ void operator()(AccRef acc, const Unit& u, int wr, int wc, int fr, int fq) const {
        const float qs = 0.07216878364870322f * 1.4426950408889634f;
        const int row0 = u.pm * 256 + wr * 64 + fr;
#pragma unroll
        for (int bj = 0; bj < 2; ++bj) {
            const int cg = u.pn * 256 + bj * 128 + wc * 32, part = (cg >> 5) % 6;
#pragma unroll
            for (int ai = 0; ai < 2; ++ai)
#pragma unroll
                for (int m = 0; m < 4; ++m) { const int row = row0 + ai * 128 + m * 16, t = row & (SEQ - 1);
                    f32x4 x1 = acc[ai][bj][m][0], x2 = acc[ai][bj][m][1];
                    if (part >= 4) { const int pos = part == 4 ? (t >> 6) : (t & 63);
                        const f32x4 c = *(const f32x4*)(ropec + pos * 16 + 4 * fq), sn = *(const f32x4*)(ropes + pos * 16 + 4 * fq);
                        const f32x4 o1 = x1 * c - x2 * sn, o2 = x2 * c + x1 * sn; x1 = o1; x2 = o2; }
                    x1 = x1 * qs; x2 = x2 * qs;
                    bf16_t* dst = QB + (size_t)row * QW + cg + 4 * fq;
                    u32x2 w1, w2; w1.x = cvt_pk_bf16(x1[0], x1[1]); w1.y = cvt_pk_bf16(x1[2], x1[3]); w2.x = cvt_pk_bf16(x2[0], x2[1]); w2.y = cvt_pk_bf16(x2[2], x2[3]);
                    *(u32x2*)dst = w1; *(u32x2*)(dst + 16) = w2; }
        }
    } };
struct EpiBf16 { static constexpr bool PERM = true; bf16_t* O; int ldo;
    __device__ __forceinline__ void operator()(AccRef acc, const Unit& u, int wr, int wc, int fr, int fq) const {
        const int row0 = u.pm * 256 + wr * 64 + fr, col0 = u.pn * 256 + wc * 32 + 8 * fq;
#pragma unroll
        for (int ai = 0; ai < 2; ++ai)
#pragma unroll
            for (int m = 0; m < 4; ++m) { bf16_t* rowp = O + (size_t)(row0 + ai * 128 + m * 16) * ldo + col0;
#pragma unroll
                for (int bj = 0; bj < 2; ++bj) { const f32x4 v0 = acc[ai][bj][m][0], v1 = acc[ai][bj][m][1];
                    u32x4 w; w.x = cvt_pk_bf16(v0[0], v0[1]); w.y = cvt_pk_bf16(v0[2], v0[3]); w.z = cvt_pk_bf16(v1[0], v1[1]); w.w = cvt_pk_bf16(v1[2], v1[3]);
                    *(u32x4*)(rowp + bj * 128) = w; } }
    } };
struct EpiVT { static constexpr bool PERM = false; bf16_t* VT;
    __device__ __forceinline__ void operator()(AccRef acc, const Unit& u, int wr, int wc, int fr, int fq) const {
        const int row0 = u.pm * 256 + wr * 64 + fr, pq = ((fq & 1) << 1) | (fq >> 1), col0 = u.pn * 256 + wc * 32 + 4 * pq;
#pragma unroll
        for (int ai = 0; ai < 2; ++ai)
#pragma unroll
            for (int m = 0; m < 4; ++m) { bf16_t* rowp = VT + (size_t)(row0 + ai * 128 + m * 16) * MALL + col0;
#pragma unroll
                for (int bj = 0; bj < 2; ++bj)
#pragma unroll
                    for (int n = 0; n < 2; ++n) { const f32x4 v = acc[ai][bj][m][n]; u32x2 w; w.x = cvt_pk_bf16(v[0], v[1]); w.y = cvt_pk_bf16(v[2], v[3]); *(u32x2*)(rowp + bj * 128 + n * 16) = w; } }
    } };

__device__ __forceinline__ void ph_attn(LAS unsigned char* lds, const bf16_t* QB, const bf16_t* KNB, const bf16_t* VTB, bf16_t* MIXB, int G, int bid) {
    typedef float f32x16 __attribute__((ext_vector_type(16)));
    constexpr int KP = 400, VP = 144, KBYTES = 64 * KP, BUF = KBYTES + 128 * VP, NT = SK / 64;
    const int tid = threadIdx.x, wave = tid >> 6, lane = tid & 63, l32 = lane & 31, half = lane >> 5;
    for (int unit = bid; unit < NB * HM * (SEQ / 256); unit += G) {
        const int bh = unit & 15, qb = unit >> 4, b = bh >> 3, h = bh & 7;
        const int qrow = b * SEQ + qb * 256 + wave * 32 + l32;
        bf16x8 qf[12];
#pragma unroll
        for (int ks = 0; ks < 12; ++ks) qf[ks] = *(const bf16x8*)(QB + (size_t)qrow * QW + h * 192 + ks * 16 + half * 8);
        f32x16 o[4];
#pragma unroll
        for (int d = 0; d < 4; ++d)
#pragma unroll
            for (int i = 0; i < 16; ++i) o[d][i] = 0.f;
        float mrun = -1e30f, lrun = 0.f;
        int ko[3], kd[3], vo[2], vd[2];
#pragma unroll
        for (int i = 0; i < 3; ++i) { const int id = tid + 512 * i, key = id / 24, cc = id % 24;
            ko[i] = key * KLD + (cc < 16 ? h * 128 + cc * 8 : 1024 + (cc - 16) * 8); kd[i] = key * KP + cc * 16; }
#pragma unroll
        for (int i = 0; i < 2; ++i) { const int id = tid + 512 * i, dv = id >> 3, cc = id & 7;
            vo[i] = (h * 128 + dv) * MALL + cc * 8; vd[i] = KBYTES + dv * VP + cc * 16; }
        u32x4 kr_[3], vr_[2];
        __syncthreads();
        {   const int trow = NL + b * CTX;
#pragma unroll
            for (int i = 0; i < 3; ++i) kr_[i] = *(const u32x4*)(KNB + (size_t)(ko[i] + trow * KLD));
#pragma unroll
            for (int i = 0; i < 2; ++i) vr_[i] = *(const u32x4*)(VTB + (size_t)(vo[i] + trow));
#pragma unroll
            for (int i = 0; i < 3; ++i) *(LAS u32x4*)(lds + kd[i]) = kr_[i];
#pragma unroll
            for (int i = 0; i < 2; ++i) *(LAS u32x4*)(lds + vd[i]) = vr_[i];
        }
        __syncthreads();
        for (int j = 0; j < NT; ++j) {
            LAS unsigned char* cb = lds + (j & 1) * BUF;
            if (j + 1 < NT) {
                const int jn = j + 1, trow = jn < 4 ? NL + b * CTX + 64 * jn : b * SEQ + 64 * (jn - 4);
#pragma unroll
                for (int i = 0; i < 3; ++i) kr_[i] = *(const u32x4*)(KNB + (size_t)(ko[i] + trow * KLD));
#pragma unroll
                for (int i = 0; i < 2; ++i) vr_[i] = *(const u32x4*)(VTB + (size_t)(vo[i] + trow));
            }
            f32x16 s0, s1;
#pragma unroll
            for (int i = 0; i < 16; ++i) { s0[i] = 0.f; s1[i] = 0.f; }
#pragma unroll
            for (int ks = 0; ks < 12; ++ks) {
                const bf16x8 a0 = *(const LAS bf16x8*)(cb + l32 * KP + ks * 32 + half * 16), a1 = *(const LAS bf16x8*)(cb + (32 + l32) * KP + ks * 32 + half * 16);
                s0 = __builtin_amdgcn_mfma_f32_32x32x16_bf16(a0, qf[ks], s0, 0, 0, 0);
                s1 = __builtin_amdgcn_mfma_f32_32x32x16_bf16(a1, qf[ks], s1, 0, 0, 0);
            }
            float mx = s0[0];
#pragma unroll
            for (int i = 1; i < 16; ++i) mx = fmaxf(mx, s0[i]);
#pragma unroll
            for (int i = 0; i < 16; ++i) mx = fmaxf(mx, s1[i]);
            mx = fmaxf(mx, __shfl_xor(mx, 32));
            const float mn = fmaxf(mrun, mx);
            const float alpha = __builtin_amdgcn_exp2f(mrun - mn);
            mrun = mn;
            float ps = 0.f;
#pragma unroll
            for (int i = 0; i < 16; ++i) { s0[i] = __builtin_amdgcn_exp2f(s0[i] - mn); s1[i] = __builtin_amdgcn_exp2f(s1[i] - mn); ps += s0[i] + s1[i]; }
            lrun = lrun * alpha + ps;
#pragma unroll
            for (int d = 0; d < 4; ++d)
#pragma unroll
                for (int i = 0; i < 16; ++i) o[d][i] *= alpha;
            bf16x8 pf[4];
#pragma unroll
            for (int s = 0; s < 4; ++s) {
                u32x4 w;
                if (s < 2) { const int i0 = (s & 1) * 8; w.x = cvt_pk_bf16(s0[i0], s0[i0 + 1]); w.y = cvt_pk_bf16(s0[i0 + 2], s0[i0 + 3]); w.z = cvt_pk_bf16(s0[i0 + 4], s0[i0 + 5]); w.w = cvt_pk_bf16(s0[i0 + 6], s0[i0 + 7]); }
                else { const int i0 = (s & 1) * 8; w.x = cvt_pk_bf16(s1[i0], s1[i0 + 1]); w.y = cvt_pk_bf16(s1[i0 + 2], s1[i0 + 3]); w.z = cvt_pk_bf16(s1[i0 + 4], s1[i0 + 5]); w.w = cvt_pk_bf16(s1[i0 + 6], s1[i0 + 7]); }
                pf[s] = __builtin_bit_cast(bf16x8, w);
            }
#pragma unroll
            for (int s = 0; s < 4; ++s)
#pragma unroll
                for (int d = 0; d < 4; ++d) {
                    const bf16x8 vf = *(const LAS bf16x8*)(cb + KBYTES + (32 * d + l32) * VP + s * 32 + half * 16);
                    o[d] = __builtin_amdgcn_mfma_f32_32x32x16_bf16(vf, pf[s], o[d], 0, 0, 0);
                }
            if (j + 1 < NT) {
                LAS unsigned char* nb = lds + ((j + 1) & 1) * BUF;
#pragma unroll
                for (int i = 0; i < 3; ++i) *(LAS u32x4*)(nb + kd[i]) = kr_[i];
#pragma unroll
                for (int i = 0; i < 2; ++i) *(LAS u32x4*)(nb + vd[i]) = vr_[i];
            }
            __syncthreads();
        }
        lrun += __shfl_xor(lrun, 32);
        const float il = 1.0f / lrun;
        bf16_t* dst = MIXB + (size_t)qrow * D + h * 128 + 4 * half;
#pragma unroll
        for (int d = 0; d < 4; ++d)
#pragma unroll
            for (int i4 = 0; i4 < 4; ++i4) { u32x2 w; w.x = cvt_pk_bf16(o[d][i4 * 4] * il, o[d][i4 * 4 + 1] * il); w.y = cvt_pk_bf16(o[d][i4 * 4 + 2] * il, o[d][i4 * 4 + 3] * il);
                *(u32x2*)(dst + 32 * d + 8 * i4) = w; }
    }
    __syncthreads();
}


constexpr int SC_CL = 272, SC_NC = 16;
__device__ __forceinline__ int scan_row(int b, int d, int g) {
    if (g < CTX) return NL + b * CTX + (d == 0 ? g : CTX - 1 - g);
    const int tp = g - CTX; return b * SEQ + (d == 0 ? tp : SEQ - 1 - tp);
}
#define DPP_FMAC(d, a, b, n) asm volatile("v_fmac_f32_dpp %0, %1, %2 row_newbcast:" #n " row_mask:0xf bank_mask:0xf" : "+v"(d) : "v"(a), "v"(b))
#define DPP_MULD(d, a, n)    asm volatile("v_mul_f32_dpp %0, %1, %0 row_newbcast:" #n " row_mask:0xf bank_mask:0xf" : "+v"(d) : "v"(a))
#define SC_FOR16(X) X(0) X(1) X(2) X(3) X(4) X(5) X(6) X(7) X(8) X(9) X(10) X(11) X(12) X(13) X(14) X(15)
struct MoeCv { const float* w1; long d31; const float* w2; unsigned char* W13E; unsigned char* W2E; };
constexpr int CV_PER_WAVE = 336, CV_ITEMS_W13 = 3584, CV_ITEMS_E = 5376, CV_WLDS = 4096;
static_assert((size_t)NE * CV_ITEMS_E * 8 == (size_t)CV_PER_WAVE * 1024, "MoE conversion tiles must split evenly over 1024 waves");
static_assert(4 * 5 * 6144 + 4 * CV_WLDS <= LDS_CTL, "scan rings + conversion images must fit below the LDS control words");
struct CvItem { const float* sp; unsigned char* dst; int ld, K; float sc; };
__device__ __forceinline__ CvItem cv_item(const MoeCv& mc, int it, int cw) {
    const int I = it * 1024 + cw, e = I / CV_ITEMS_E, r = I - e * CV_ITEMS_E;
    CvItem o;
    if (r < CV_ITEMS_W13) { const int kr = r / 224, nt = r - kr * 224, n0 = nt * 64, jj = n0 & 255;
        o.sp = mc.w1 + (jj < 128 ? 0l : mc.d31) + (size_t)e * D * DFF + (size_t)kr * 128 * DFF + (n0 >> 8) * 128 + (jj & 127); o.ld = DFF;
        o.dst = mc.W13E + (size_t)e * 2 * DFF * D + (size_t)n0 * D + kr * 128; o.K = D; o.sc = 64.f; }
    else { const int r2 = r - CV_ITEMS_W13, kr = r2 >> 5, n0 = (r2 & 31) * 64;
        o.sp = mc.w2 + (size_t)e * DFF * D + (size_t)kr * 128 * D + n0; o.ld = D;
        o.dst = mc.W2E + (size_t)e * D * DFF + (size_t)n0 * DFF + kr * 128; o.K = DFF; o.sc = 128.f; }
    return o;
}
__device__ __forceinline__ void moe_cvt_wave(LAS unsigned char* ct, const MoeCv& mc, int cw, int lane) {
    constexpr int NIT = CV_PER_WAVE / 8;
    const int l15 = lane & 15, l4 = lane >> 4;
    f32x4 buf[8][4];
    CvItem cur = cv_item(mc, 0, cw);
    { const float* lp = cur.sp + (size_t)(l4 * cur.ld + l15 * 4);
#pragma unroll
      for (int s = 0; s < 8; ++s)
#pragma unroll
        for (int q = 0; q < 4; ++q) buf[s][q] = *(const f32x4*)(lp + (size_t)(s * 16 + q * 4) * cur.ld); }
#pragma unroll 1
    for (int it = 0; it < NIT; ++it) {
        const CvItem nxt = cv_item(mc, it + 1 < NIT ? it + 1 : NIT - 1, cw);
        const float* lp = nxt.sp + (size_t)(l4 * nxt.ld + l15 * 4);
        unsigned char* dp = cur.dst + (size_t)lane * cur.K;
        const float sc = cur.sc;
        u32x4 wout[8];
#pragma unroll
        for (int s = 0; s < 8; ++s) {
#pragma unroll
            for (int q = 0; q < 4; ++q) *(LAS f32x4*)(ct + q * 1024 + lane * 16) = buf[s][q];
#pragma unroll
            for (int q = 0; q < 4; ++q) buf[s][q] = *(const f32x4*)(lp + (size_t)(s * 16 + q * 4) * nxt.ld);
            float v[16];
#pragma unroll
            for (int j = 0; j < 16; ++j) v[j] = ((const LAS float*)ct)[j * 64 + lane];
            u32x4 w; w.x = pk4_fp8(v[0] * sc, v[1] * sc, v[2] * sc, v[3] * sc); w.y = pk4_fp8(v[4] * sc, v[5] * sc, v[6] * sc, v[7] * sc);
            w.z = pk4_fp8(v[8] * sc, v[9] * sc, v[10] * sc, v[11] * sc); w.w = pk4_fp8(v[12] * sc, v[13] * sc, v[14] * sc, v[15] * sc);
            wout[s] = w;
        }
#pragma unroll
        for (int s = 0; s < 8; ++s) *(u32x4*)(dp + s * 16) = wout[s];
        cur = nxt;
    }
#pragma unroll
    for (int s = 0; s < 8; ++s) asm volatile("" :: "v"(buf[s][0]), "v"(buf[s][1]), "v"(buf[s][2]), "v"(buf[s][3]));
}
constexpr int SC_NSLOT = 5, SC_SLOTB = 6144, SC_WLDS = SC_NSLOT * SC_SLOTB;
#define SC_VSET(P) f32x4 P##av, P##wv, P##bv, P##kv, P##rv; float P##vv
#define SC_READV(P, sl) do { P##av = *(const LAS f32x4*)((sl) + l15 * 16); P##wv = *(const LAS f32x4*)((sl) + 1024 + l15 * 16); P##bv = *(const LAS f32x4*)((sl) + 2048 + l15 * 16); \
            P##kv = *(const LAS f32x4*)((sl) + 3072 + l15 * 16); P##rv = *(const LAS f32x4*)((sl) + 4096 + l15 * 16); P##vv = *(const LAS float*)((sl) + 5120 + lane * 4); } while (0)
#define SC_STEP(P, i) do { \
            float a0 = P##av[0], a1 = P##av[1], a2 = P##av[2], a3 = P##av[3], w0 = P##wv[0], w1 = P##wv[1], w2 = P##wv[2], w3 = P##wv[3], b0 = P##bv[0], b1 = P##bv[1], b2 = P##bv[2], b3 = P##bv[3]; \
            float k0 = P##kv[0], k1 = P##kv[1], k2 = P##kv[2], k3 = P##kv[3], r0 = P##rv[0], r1 = P##rv[1], r2 = P##rv[2], r3 = P##rv[3], vq = P##vv; \
            asm volatile("s_nop 1" : "+v"(a0), "+v"(a1), "+v"(a2), "+v"(a3)); \
            float c0 = 0.f, c1 = 0.f, c2 = 0.f, c3 = 0.f, e0 = 0.f, e1 = 0.f, e2 = 0.f, e3 = 0.f; \
            SC_FOR16(SC_SA) \
            float saq = (c0 + c1) + (c2 + c3), sap = (e0 + e1) + (e2 + e3); \
            asm volatile("s_nop 1" : "+v"(w0), "+v"(w1), "+v"(w2), "+v"(w3), "+v"(b0), "+v"(b1), "+v"(b2), "+v"(b3), "+v"(saq), "+v"(sap)); \
            SC_FOR16(SC_UP) \
            asm volatile("s_nop 1" : "+v"(k0), "+v"(k1), "+v"(k2), "+v"(k3), "+v"(vq)); \
            SC_FOR16(SC_VK) \
            if (gbase + (i) >= CTX) { \
                float y0 = 0.f, y1 = 0.f, y2 = 0.f, y3 = 0.f, z0 = 0.f, z1 = 0.f, z2 = 0.f, z3 = 0.f; \
                asm volatile("s_nop 1" : "+v"(r0), "+v"(r1), "+v"(r2), "+v"(r3)); \
                SC_FOR16(SC_Y) \
                const size_t yo_ = (size_t)scan_row(b, d, gbase + (i)) * 64; \
                ypq[yo_ + lane] = (y0 + y1) + (y2 + y3); ypp[yo_ + lane] = (z0 + z1) + (z2 + z3); \
            } } while (0)
#define SC_SA(n) DPP_FMAC(c0, a0, SQ[4 * n], n); DPP_FMAC(c1, a1, SQ[4 * n + 1], n); DPP_FMAC(c2, a2, SQ[4 * n + 2], n); DPP_FMAC(c3, a3, SQ[4 * n + 3], n); \
                 DPP_FMAC(e0, a0, SP[4 * n], n); DPP_FMAC(e1, a1, SP[4 * n + 1], n); DPP_FMAC(e2, a2, SP[4 * n + 2], n); DPP_FMAC(e3, a3, SP[4 * n + 3], n);
#define SC_UP(n) DPP_MULD(SQ[4 * n], w0, n); DPP_MULD(SQ[4 * n + 1], w1, n); DPP_MULD(SQ[4 * n + 2], w2, n); DPP_MULD(SQ[4 * n + 3], w3, n); \
                 DPP_MULD(SP[4 * n], w0, n); DPP_MULD(SP[4 * n + 1], w1, n); DPP_MULD(SP[4 * n + 2], w2, n); DPP_MULD(SP[4 * n + 3], w3, n); \
                 DPP_FMAC(SQ[4 * n], b0, saq, n); DPP_FMAC(SQ[4 * n + 1], b1, saq, n); DPP_FMAC(SQ[4 * n + 2], b2, saq, n); DPP_FMAC(SQ[4 * n + 3], b3, saq, n); \
                 DPP_FMAC(SP[4 * n], b0, sap, n); DPP_FMAC(SP[4 * n + 1], b1, sap, n); DPP_FMAC(SP[4 * n + 2], b2, sap, n); DPP_FMAC(SP[4 * n + 3], b3, sap, n);
#define SC_VK(n) DPP_FMAC(SQ[4 * n], k0, vq, n); DPP_FMAC(SQ[4 * n + 1], k1, vq, n); DPP_FMAC(SQ[4 * n + 2], k2, vq, n); DPP_FMAC(SQ[4 * n + 3], k3, vq, n);
#define SC_Y(n) DPP_FMAC(y0, r0, SQ[4 * n], n); DPP_FMAC(y1, r1, SQ[4 * n + 1], n); DPP_FMAC(y2, r2, SQ[4 * n + 2], n); DPP_FMAC(y3, r3, SQ[4 * n + 3], n); \
                DPP_FMAC(z0, r0, SP[4 * n], n); DPP_FMAC(z1, r1, SP[4 * n + 1], n); DPP_FMAC(z2, r2, SP[4 * n + 2], n); DPP_FMAC(z3, r3, SP[4 * n + 3], n);
__device__ __forceinline__ void ph_scan1(LAS unsigned char* lds, const float* wsf, unsigned oAA, unsigned oWW, unsigned oBD, unsigned oKD, unsigned oRR, unsigned oVR, float* YP, float* QP, const MoeCv mc, int G, int bid) {
    const int wave = __builtin_amdgcn_readfirstlane(threadIdx.x >> 6), lane = threadIdx.x & 63, l15 = lane & 15, vi = lane >> 4;
    if (wave >= 4) { for (int pb = bid; pb < 256; pb += G) moe_cvt_wave(lds + 4 * SC_WLDS + (wave - 4) * CV_WLDS, mc, pb * 4 + (wave - 4), lane); return; }
    LAS unsigned char* ring = lds + wave * SC_WLDS;
    for (int pb = bid; pb < 256; pb += G) {
        const int pair = pb * 4 + wave, chain = pair >> 4, chunk = pair & 15;
        const int b = chain >> 5, h = (chain >> 1) & 15, d = chain & 1;
        const unsigned dofs = (unsigned)d * MALL * RD;
        const unsigned oh = (unsigned)h * (MALL * 64), lane4 = lane * 4;
        const unsigned ob0 = oAA + oh, ob1 = oWW + dofs + oh, ob2 = oBD + dofs + oh, ob3 = oKD + dofs + oh, ob4 = oRR + oh, ob5 = oVR + oh;
        float SQ[64], SP[64];
#pragma unroll
        for (int k = 0; k < 64; ++k) { SQ[k] = 0.f; SP[k] = lane == k ? 1.f : 0.f; }
        float* ypq = YP + (size_t)d * NL * RD + (size_t)h * NL * 64;
        float* ypp = YP + (size_t)(2 + d) * NL * RD + (size_t)h * NL * 64;
        const int gbase = chunk * SC_CL;
        constexpr int NGRP = SC_CL / 4;
#define SC_ISSUE(grp, slot) do { const int gq_ = (grp) < NGRP ? (grp) : NGRP - 1; const unsigned ro_ = (unsigned)scan_row(b, d, gbase + 4 * gq_ + (d ? 3 : 0)) * 64; LAS unsigned char* sl_ = ring + (slot) * SC_SLOTB; \
            __builtin_amdgcn_global_load_lds((const unsigned*)(wsf + (ob0 + ro_) + lane4), (LAS unsigned*)sl_, 16, 0, 0); __builtin_amdgcn_global_load_lds((const unsigned*)(wsf + (ob1 + ro_) + lane4), (LAS unsigned*)(sl_ + 1024), 16, 0, 0); \
            __builtin_amdgcn_global_load_lds((const unsigned*)(wsf + (ob2 + ro_) + lane4), (LAS unsigned*)(sl_ + 2048), 16, 0, 0); __builtin_amdgcn_global_load_lds((const unsigned*)(wsf + (ob3 + ro_) + lane4), (LAS unsigned*)(sl_ + 3072), 16, 0, 0); \
            __builtin_amdgcn_global_load_lds((const unsigned*)(wsf + (ob4 + ro_) + lane4), (LAS unsigned*)(sl_ + 4096), 16, 0, 0); __builtin_amdgcn_global_load_lds((const unsigned*)(wsf + (ob5 + ro_) + lane4), (LAS unsigned*)(sl_ + 5120), 16, 0, 0); } while (0)
        SC_ISSUE(0, 0); SC_ISSUE(1, 1); SC_ISSUE(2, 2); SC_ISSUE(3, 3); SC_ISSUE(4, 4);
        SC_VSET(A); SC_VSET(B);
        asm volatile("s_waitcnt vmcnt(24)" ::: "memory");
        const int r0o = d ? 768 : 0, rstep = d ? -256 : 256;
        SC_READV(A, ring + r0o);
        asm volatile("s_waitcnt lgkmcnt(0)" ::: "memory");
        int slot = 0;
#pragma unroll 1
        for (int grp = 0; grp < NGRP; ++grp) {
            const int i = 4 * grp;
            const LAS unsigned char* sl = ring + slot * SC_SLOTB + r0o;
            const int nslot = slot == SC_NSLOT - 1 ? 0 : slot + 1;
            SC_READV(B, sl + rstep);
            SC_STEP(A, i);
            asm volatile("s_waitcnt lgkmcnt(0)" ::: "memory");
            SC_READV(A, sl + 2 * rstep);
            SC_STEP(B, i + 1);
            asm volatile("s_waitcnt lgkmcnt(0)" ::: "memory");
            SC_READV(B, sl + 3 * rstep);
            SC_STEP(A, i + 2);
            asm volatile("s_waitcnt lgkmcnt(0)" ::: "memory");
            SC_ISSUE(grp + SC_NSLOT, slot);
            asm volatile("s_waitcnt vmcnt(24)" ::: "memory");
            SC_READV(A, ring + nslot * SC_SLOTB + r0o);
            SC_STEP(B, i + 3);
            asm volatile("s_waitcnt lgkmcnt(0)" ::: "memory");
            slot = nslot;
        }
        asm volatile("s_waitcnt vmcnt(0)" ::: "memory");
#undef SC_ISSUE
        float* qpq = QP + ((((size_t)chain) * SC_NC + chunk) * 64 + lane) * 64;
        float* qpp = QP + ((((size_t)64 + chain) * SC_NC + chunk) * 64 + lane) * 64;
#pragma unroll
        for (int j = 0; j < 16; ++j) { *(f32x4*)(qpq + 4 * j) = (f32x4){SQ[4 * j], SQ[4 * j + 1], SQ[4 * j + 2], SQ[4 * j + 3]}; *(f32x4*)(qpp + 4 * j) = (f32x4){SP[4 * j], SP[4 * j + 1], SP[4 * j + 2], SP[4 * j + 3]}; }
    }
}
#undef SC_SA
#undef SC_UP
#undef SC_VK
#undef SC_Y
__device__ __forceinline__ void ph_scan_carry(const float* QP, float* SS, int G, int bid) {
    const int wave = __builtin_amdgcn_readfirstlane(threadIdx.x >> 6), lane = threadIdx.x & 63;
    for (int task = bid * 8 + wave; task < 64 * 32; task += G * 8) {
        const int chain = task >> 5, v0 = (task & 31) * 2;
        float s0 = 0.f, s1 = 0.f, P[64];
        const float* Pc = QP + (((size_t)64 + chain) * SC_NC) * 4096 + lane;
        const float* Qc = QP + (((size_t)chain) * SC_NC) * 4096 + v0 * 64 + lane;
        float* Sp = SS + (((size_t)chain * SC_NC) * 64 + v0) * 64 + lane;
#pragma unroll
        for (int k = 0; k < 64; ++k) P[k] = Pc[k * 64];
        float q0 = Qc[0], q1 = Qc[64];
#pragma unroll 1
        for (int c = 0; c < SC_NC - 1; ++c) {
            Sp[0] = s0; Sp[64] = s1; Sp += 4096;
            const int cn = c + 1 < SC_NC - 1 ? 1 : 0;
            Pc += cn * 4096; Qc += cn * 4096;
            float n0 = q0, n1 = q1; const int i0 = __builtin_bit_cast(int, s0), i1 = __builtin_bit_cast(int, s1);
            q0 = Qc[0]; q1 = Qc[64];
#pragma unroll
            for (int k = 0; k < 64; ++k) { const float pk = P[k];
                n0 += __builtin_bit_cast(float, __builtin_amdgcn_readlane(i0, k)) * pk; n1 += __builtin_bit_cast(float, __builtin_amdgcn_readlane(i1, k)) * pk;
                P[k] = Pc[k * 64]; }
            s0 = n0; s1 = n1;
        }
        Sp[0] = s0; Sp[64] = s1;
    }
}
struct FixLd { f32x4 p0, p1; float yl, r, ks, vr, gg; };
__device__ __forceinline__ FixLd fix_load(const float* YP, const float* RR, const float* KD, const float* VR, const float* GG, int row, int h, int lane) {
    FixLd x; const int l15 = lane & 15; const size_t e = ((size_t)h * NL + row) * 64, em = ((size_t)h * MALL + row) * 64;
    x.p0 = *(const f32x4*)(YP + (size_t)2 * NL * RD + e + l15 * 4); x.p1 = *(const f32x4*)(YP + (size_t)3 * NL * RD + e + l15 * 4);
    x.yl = YP[e + lane] + YP[(size_t)NL * RD + e + lane];
    x.r = RR[em + lane]; x.ks = KD[em + lane] + KD[(size_t)MALL * RD + em + lane]; x.vr = VR[em + lane]; x.gg = GG[em + lane];
    return x;
}
__device__ __forceinline__ void ph_scan_fix(const float* YP, const float* SS, const float* RR, const float* KD, const float* VR, const float* GG, const float* r_k, const float* lnw, const float* lnb, bf16_t* MIXB, int G, int bid) {
    const int wave = __builtin_amdgcn_readfirstlane(threadIdx.x >> 6), lane = threadIdx.x & 63;
    for (int task = bid * 8 + wave; task < 2048; task += G * 8) {
        const int b = task >> 10, h = (task >> 6) & 15, t0 = (task & 63) * 64, c = h * 64 + lane;
        const int chain0 = (b * 16 + h) * 2;
        float S0[64], S1[64]; int cc0 = -1, cc1 = -1;
        const float rk = r_k[c], lw = lnw[c], lb = lnb[c];
        FixLd ring[4];
#pragma unroll
        for (int k = 0; k < 4; ++k) ring[k] = fix_load(YP, RR, KD, VR, GG, b * SEQ + t0 + k, h, lane);
#pragma unroll 1
        for (int tt0 = 0; tt0 < 64; tt0 += 4)
#pragma unroll
          for (int k = 0; k < 4; ++k) {
            const int tt = tt0 + k, t = t0 + tt, row = b * SEQ + t;
            const FixLd cu = ring[k];
            { const int tn = tt < 60 ? t + 4 : t; ring[k] = fix_load(YP, RR, KD, VR, GG, b * SEQ + tn, h, lane); }
            const int c0 = (CTX + t) / SC_CL, c1 = (CTX + SEQ - 1 - t) / SC_CL;
            if (c0 != cc0) { cc0 = c0; const float* sp = SS + (((size_t)chain0 * SC_NC + c0) * 64 + lane) * 64;
#pragma unroll
                for (int j = 0; j < 16; ++j) { const f32x4 x = *(const f32x4*)(sp + 4 * j); S0[4 * j] = x[0]; S0[4 * j + 1] = x[1]; S0[4 * j + 2] = x[2]; S0[4 * j + 3] = x[3]; } }
            if (c1 != cc1) { cc1 = c1; const float* sp = SS + (((size_t)(chain0 + 1) * SC_NC + c1) * 64 + lane) * 64;
#pragma unroll
                for (int j = 0; j < 16; ++j) { const f32x4 x = *(const f32x4*)(sp + 4 * j); S1[4 * j] = x[0]; S1[4 * j + 1] = x[1]; S1[4 * j + 2] = x[2]; S1[4 * j + 3] = x[3]; } }
            float a0 = cu.p0[0], a1 = cu.p0[1], a2 = cu.p0[2], a3 = cu.p0[3], b0 = cu.p1[0], b1 = cu.p1[1], b2 = cu.p1[2], b3 = cu.p1[3];
            asm volatile("s_nop 1" : "+v"(a0), "+v"(a1), "+v"(a2), "+v"(a3), "+v"(b0), "+v"(b1), "+v"(b2), "+v"(b3));
            float y0 = 0.f, y1 = 0.f, y2 = 0.f, y3 = 0.f, z0 = 0.f, z1 = 0.f, z2 = 0.f, z3 = 0.f;
#define FX_N(n) DPP_FMAC(y0, a0, S0[4 * n], n); DPP_FMAC(y1, a1, S0[4 * n + 1], n); DPP_FMAC(y2, a2, S0[4 * n + 2], n); DPP_FMAC(y3, a3, S0[4 * n + 3], n); \
                DPP_FMAC(z0, b0, S1[4 * n], n); DPP_FMAC(z1, b1, S1[4 * n + 1], n); DPP_FMAC(z2, b2, S1[4 * n + 2], n); DPP_FMAC(z3, b3, S1[4 * n + 3], n);
            SC_FOR16(FX_N)
#undef FX_N
            const float y = cu.yl + ((y0 + y1) + (y2 + y3)) + ((z0 + z1) + (z2 + z3));
            const float mu = wave_sum_dpp(y) * (1.f / 64.f);
            const float dv = y - mu;
            const float var = wave_sum_dpp(dv * dv) * (1.f / 64.f);
            const float yn = dv * rsqrtf(var + 64e-5f) * lw + lb;
            const float bonus = wave_sum_dpp(cu.r * cu.ks * rk) * cu.vr;
            const float o = (yn + bonus) * cu.gg;
            const float on = __shfl_down(o, 1);
            if ((lane & 1) == 0) *(unsigned*)(MIXB + (size_t)row * D + 1024 + c) = cvt_pk_bf16(o, on);
        }
    }
}

constexpr size_t alb(size_t x) { return (x + 4095) & ~(size_t)4095; }
constexpr size_t CTL_BYTES = 65536;
constexpr size_t MB_CTL = 0;
constexpr size_t B_MOD0 = MB_CTL + CTL_BYTES;
constexpr size_t B_MOD1 = B_MOD0 + alb((size_t)3 * NMOD * 4);
constexpr size_t B_MODP = B_MOD1 + alb((size_t)2 * NMOD * 4);
constexpr size_t MB_ROPE = B_MODP + alb((size_t)2 * 32 * 3 * NMOD * 4);
constexpr size_t B_H = MB_ROPE + 8192;
constexpr size_t MB_XNB = B_H + alb((size_t)NL * D * 4);
constexpr size_t MB_WIN0 = MB_XNB + alb((size_t)MALL * D * 2);
constexpr size_t MB_WO0 = MB_WIN0 + alb((size_t)ZLD * D * 2);
constexpr size_t MB_W13 = MB_WO0 + alb((size_t)D * D * 2);
constexpr size_t MB_W2 = MB_W13 + alb((size_t)2 * DFF * D * 2);
constexpr size_t MB_WUQ = MB_W2 + alb((size_t)D * DFF * 2);
constexpr size_t MB_WKN = MB_WUQ + alb((size_t)QW * 512 * 2);
constexpr size_t MB_WV = MB_WKN + alb((size_t)1024 * 512 * 2);
constexpr size_t MB_WLORA = MB_WV + alb((size_t)1024 * 512 * 2);
constexpr size_t MB_WIN1 = MB_WLORA + alb((size_t)5120 * 512 * 2);
constexpr size_t MB_WO1 = MB_WIN1 + alb((size_t)4096 * D * 2);
constexpr size_t MB_WSB = MB_WO1 + alb((size_t)D * D * 2);
constexpr size_t MB_W13E = MB_WSB + alb((size_t)16 * 128 * 128 * 2);
constexpr size_t MB_W2E = MB_W13E + alb((size_t)NE * 2 * DFF * D);
constexpr size_t B_ACTS = MB_W2E + alb((size_t)NE * D * DFF);
constexpr size_t B_Z = B_ACTS;
constexpr size_t MB_CQNB = B_Z + alb((size_t)MALL * ZLD * 4);
constexpr size_t MB_CKVNB = MB_CQNB + alb((size_t)MALL * 512 * 2);
constexpr size_t MB_LA = MB_CKVNB + alb((size_t)MALL * 512 * 2);
constexpr size_t MB_QB = MB_LA + alb((size_t)MALL * 512 * 2);
constexpr size_t MB_KNB = MB_QB + alb((size_t)NL * QW * 2);
constexpr size_t MB_VTB = MB_KNB + alb((size_t)MALL * KLD * 2);
constexpr size_t B_RR = MB_VTB + alb((size_t)RD * MALL * 2);
constexpr size_t B_KR = B_RR + alb((size_t)MALL * RD * 4);
constexpr size_t B_VR = B_KR + alb((size_t)MALL * RD * 4);
constexpr size_t B_AA = B_VR + alb((size_t)MALL * RD * 4);
constexpr size_t B_WW = B_AA + alb((size_t)MALL * RD * 4);
constexpr size_t B_KD = B_WW + alb((size_t)2 * MALL * RD * 4);
constexpr size_t B_BD = B_KD + alb((size_t)2 * MALL * RD * 4);
constexpr size_t B_GG = B_BD + alb((size_t)2 * MALL * RD * 4);
constexpr size_t MB_YP = B_GG + alb((size_t)MALL * RD * 4);
constexpr size_t MB_QP = MB_YP + alb((size_t)4 * NL * RD * 4);
constexpr size_t MB_SS = MB_QP + alb((size_t)2 * 64 * 16 * 4096 * 4);
constexpr size_t MB_MIXB = MB_SS + alb((size_t)64 * 16 * 4096 * 4);
constexpr size_t MB_ACT = MB_MIXB + alb((size_t)NL * D * 2);
constexpr size_t B_L0END = MB_ACT + alb((size_t)NL * DFF * 2);
constexpr size_t MB_U = B_ACTS;
constexpr size_t MB_VG = MB_U + alb((size_t)NL * D * 2);
constexpr size_t MB_VT = MB_VG + alb((size_t)NL * D * 4);
constexpr size_t MB_GATED = MB_VT + alb((size_t)NL * D * 2);
constexpr size_t MB_XG = MB_GATED + alb((size_t)NL * D * 2);
constexpr size_t MB_ACT2 = MB_XG + alb((size_t)NSLOT * D);
constexpr size_t MB_OUT2 = MB_ACT2 + alb((size_t)NSLOT * DFF);
constexpr size_t MB_ROUTE = MB_OUT2 + alb((size_t)NSLOT * D * 4);
constexpr size_t B_L1END = MB_ROUTE + 262144;
constexpr size_t MB_END = B_L0END > B_L1END ? B_L0END : B_L1END;
constexpr size_t O_MOD0 = B_MOD0 / 4, O_MOD1 = B_MOD1 / 4, O_MODP = B_MODP / 4, O_H = B_H / 4, O_Z = B_Z / 4, O_RR = B_RR / 4, O_KR = B_KR / 4, O_VR = B_VR / 4, O_AA = B_AA / 4,
                 O_WW = B_WW / 4, O_KD = B_KD / 4, O_BD = B_BD / 4, O_GG = B_GG / 4;

struct MP { const float* in[44]; float* out; unsigned char* ws; int ph_lo, ph_hi; };

enum { PH_CVT = 0, PH_XN1, PH_GEMM_Z, PH_PREP, PH_GEMM4, PH_ATTN, PH_CARRY, PH_FIX, PH_GEMM_O0, PH_XN2, PH_FFN_UP, PH_FFN_DOWN, PH_XN3, PH_GEMM_IN1, PH_LNT, PH_SPATIAL, PH_GEMM_O1, PH_XN4, PH_PLAN, PH_MOE_UP, PH_MOE_DOWN, PH_FINAL, PH_N };

__global__ void __launch_bounds__(512, 2) mega(MP p) {
    extern __shared__ __attribute__((aligned(16))) unsigned char lds_raw[];
    LAS unsigned char* lds = (LAS unsigned char*)lds_raw;
    const int tid = threadIdx.x, G = gridDim.x, bid = blockIdx.x;
    for (int u = tid; u < (LDS_BYTES - LDS_CTL) / 4; u += 512) ((LAS unsigned*)(lds + LDS_CTL))[u] = 0u;
    __syncthreads();
    XcdBarrier bar = xcd_barrier_post((unsigned*)(p.ws + MB_CTL), (volatile LAS unsigned*)(lds + LDS_CTL + 64));
    float* wsf = (float*)p.ws;
    const int lo = p.ph_lo, hi = p.ph_hi;
#define IN(k) (lo <= (k) && (k) < hi)
#define SEAM(k) do { if (IN(k) && IN((k) + 1)) xcd_barrier(bar); } while (0)
    bf16_t* W13 = (bf16_t*)(p.ws + MB_W13); bf16_t* W2 = (bf16_t*)(p.ws + MB_W2); bf16_t* XNB = (bf16_t*)(p.ws + MB_XNB); bf16_t* ACT = (bf16_t*)(p.ws + MB_ACT);

    bf16_t* WIN0 = (bf16_t*)(p.ws + MB_WIN0); bf16_t* WO0 = (bf16_t*)(p.ws + MB_WO0); bf16_t* MIXB = (bf16_t*)(p.ws + MB_MIXB);
    bf16_t* CQNB = (bf16_t*)(p.ws + MB_CQNB); bf16_t* CKVNB = (bf16_t*)(p.ws + MB_CKVNB); bf16_t* LA = (bf16_t*)(p.ws + MB_LA);
    bf16_t* WLORA = (bf16_t*)(p.ws + MB_WLORA); bf16_t* WUQ = (bf16_t*)(p.ws + MB_WUQ); bf16_t* WKN = (bf16_t*)(p.ws + MB_WKN); bf16_t* WV = (bf16_t*)(p.ws + MB_WV);
    bf16_t* QB = (bf16_t*)(p.ws + MB_QB); bf16_t* KNB = (bf16_t*)(p.ws + MB_KNB); bf16_t* VTB = (bf16_t*)(p.ws + MB_VTB); float* ROPEC = (float*)(p.ws + MB_ROPE); float* ROPES = ROPEC + 1024;
    bf16_t* W13E = (bf16_t*)(p.ws + MB_W13E); bf16_t* W2E = (bf16_t*)(p.ws + MB_W2E); bf16_t* WIN1 = (bf16_t*)(p.ws + MB_WIN1); bf16_t* WO1 = (bf16_t*)(p.ws + MB_WO1); bf16_t* WSB = (bf16_t*)(p.ws + MB_WSB);
    bf16_t* Ub = (bf16_t*)(p.ws + MB_U); float* VG = (float*)(p.ws + MB_VG); bf16_t* VT = (bf16_t*)(p.ws + MB_VT); bf16_t* GATED = (bf16_t*)(p.ws + MB_GATED); bf16_t* XNB2 = (bf16_t*)(p.ws + MB_XNB);
    bf16_t* XG = (bf16_t*)(p.ws + MB_XG); float* OUT2 = (float*)(p.ws + MB_OUT2); bf16_t* ACT2 = (bf16_t*)(p.ws + MB_ACT2);
    int* R_TOPE = (int*)(p.ws + MB_ROUTE); int* R_SLOT = R_TOPE + 16384; float* R_TOPG = (float*)(R_TOPE + 32768); int* R_BCNT = R_TOPE + 49152; int* R_CNTOFF = R_TOPE + 49152 + 4096;
    if (IN(PH_CVT)) {
        ph_small_cvt(p.in[16], p.in[18], p.in[19], WLORA, ROPEC, ROPES, G, bid);
        { MapPlain m{p.in[10], QW, QW}; cvt_T(lds, m, WUQ, QW, 512, G, bid); }
        { MapKV m{p.in[12], 0}; cvt_T(lds, m, WKN, 1024, 512, G, bid); }
        { MapKV m{p.in[12], 1}; cvt_T(lds, m, WV, 1024, 512, G, bid); }
        ph_ada(lds, p.in[4], p.in[29], p.in[5], p.in[30], p.in[1], p.in[3], wsf + O_MOD0, wsf + O_MOD1, G, bid);
        { MapPlain m{p.in[8], ZW, ZW}; cvt_T(lds, m, WIN0, ZLD, D, G, bid); }
        { MapPlain m{p.in[25], D, D}; cvt_T(lds, m, WO0, D, D, G, bid); }
        { MapIl m{p.in[26], (long)(p.in[27] - p.in[26]), DFF}; cvt_T(lds, m, W13, 2 * DFF, D, G, bid); }
        { MapPlain m{p.in[28], D, D}; cvt_T(lds, m, W2, D, DFF, G, bid); }
        { MapPlain m{p.in[33], 4096, 4096}; cvt_T(lds, m, WIN1, 4096, D, G, bid); }
        { MapPlain m{p.in[38], D, D}; cvt_T(lds, m, WO1, D, D, G, bid); }
        cvt_copy(p.in[36], WSB, (size_t)16 * 128 * 128, G, bid);
        __syncthreads();
    }
    SEAM(PH_CVT);
    if (IN(PH_XN1)) ph_norm_mod<false>(lds, p.in[0], p.in[2], p.in[6], wsf + O_MOD0, 0, 1, XNB, MALL, nullptr, nullptr, nullptr, nullptr, G, bid);
    SEAM(PH_XN1);
    if (IN(PH_GEMM_Z)) {
        pg8::DenseOrder S; S.init(XNB, D, WIN0, D, MALL, ZLD, G, bid);
        EpiF32 E{wsf + O_Z, ZLD};
        pg8::gemm_phase<EpiF32, pg8::DenseOrder, true, true>(lds, D, D, D, S, E);
    }
    SEAM(PH_GEMM_Z);
    if (IN(PH_PREP)) {
        ph_prep(wsf + O_Z, p.in[9], p.in[11], p.in[13], p.in[14], p.in[20], CQNB, CKVNB, KNB, LA, wsf + O_RR, wsf + O_KR, wsf + O_VR, wsf + O_AA, ROPEC, ROPES, G, bid);
    }
    SEAM(PH_PREP);
    if (IN(PH_GEMM4)) {
        { pg8::DenseOrder S; S.init(LA, 512, WLORA, 512, MALL, 5120, G, bid);
          EpiLora E{p.in[15], p.in[17], p.in[21], wsf + O_KR, wsf + O_AA, wsf + O_WW, wsf + O_KD, wsf + O_BD, wsf + O_GG};
          pg8::gemm_phase<EpiLora, pg8::DenseOrder, true, true>(lds, 512, 512, 512, S, E); }
        { pg8::DenseOrder S; S.init(CQNB, 512, WUQ, 512, NL, QW, G, (bid + 168) % G);
          EpiQ E{QB, ROPEC, ROPES};
          pg8::gemm_phase<EpiQ, pg8::DenseOrder, true, true>(lds, 512, 512, 512, S, E);
 }
        { pg8::DenseOrder S; S.init(CKVNB, 512, WKN, 512, MALL, 1024, G, (bid + 104) % G);
          EpiBf16 E{KNB, KLD};
          pg8::gemm_phase<EpiBf16, pg8::DenseOrder, true, true>(lds, 512, 512, 512, S, E); }
        { pg8::DenseOrder S; S.init(WV, 512, CKVNB, 512, 1024, MALL, G, (bid + 224) % G);
          EpiVT E{VTB};
          pg8::gemm_phase<EpiVT, pg8::DenseOrder, true, true>(lds, 512, 512, 512, S, E); }
    }
    SEAM(PH_GEMM4);
    float* YP = (float*)(p.ws + MB_YP); float* QP = (float*)(p.ws + MB_QP); float* SS = (float*)(p.ws + MB_SS);
    if (IN(PH_ATTN)) {
        ph_attn(lds, QB, KNB, VTB, MIXB, G, bid);
        { const MoeCv mc{p.in[40], (long)(p.in[41] - p.in[40]), p.in[42], (unsigned char*)W13E, (unsigned char*)W2E};
          ph_scan1(lds, wsf, (unsigned)O_AA, (unsigned)O_WW, (unsigned)O_BD, (unsigned)O_KD, (unsigned)O_RR, (unsigned)O_VR, YP, QP, mc, G, bid); }
        __syncthreads();
    }
    SEAM(PH_ATTN);
    if (IN(PH_CARRY)) ph_scan_carry(QP, SS, G, bid);
    SEAM(PH_CARRY);
    if (IN(PH_FIX)) ph_scan_fix(YP, SS, wsf + O_RR, wsf + O_KD, wsf + O_VR, wsf + O_GG, p.in[22], p.in[23], p.in[24], MIXB, G, bid);
    SEAM(PH_FIX);
    if (IN(PH_GEMM_O0)) {
        pg8::DenseOrder S; S.init(MIXB, D, WO0, D, NL, D, G, bid);
        EpiRes E{wsf + O_H, p.in[0], wsf + O_MOD0 + 2 * D};
        pg8::gemm_phase<EpiRes, pg8::DenseOrder, true, true>(lds, D, D, D, S, E);
    }
    SEAM(PH_GEMM_O0);
    if (IN(PH_XN2)) ph_norm_mod<false>(lds, wsf + O_H, nullptr, p.in[7], wsf + O_MOD0, 3, 4, XNB, NL, nullptr, nullptr, nullptr, nullptr, G, bid);
    SEAM(PH_XN2);
    if (IN(PH_FFN_UP)) {
        pg8::DenseOrder S; S.init(XNB, D, W13, D, NL, 2 * DFF, G, bid);
        EpiSwiglu E{ACT, DFF};
        pg8::gemm_phase<EpiSwiglu, pg8::DenseOrder, false, true>(lds, D, D, D, S, E);
    }
    SEAM(PH_FFN_UP);
    if (IN(PH_FFN_DOWN)) {
        pg8::DenseOrder S; S.init(ACT, DFF, W2, DFF, NL, D, G, bid);
        EpiRes E{wsf + O_H, wsf + O_H, wsf + O_MOD0 + 5 * D};
        pg8::gemm_phase<EpiRes, pg8::DenseOrder, true, true>(lds, DFF, DFF, DFF, S, E);
    }
    SEAM(PH_FFN_DOWN);
    if (IN(PH_XN3)) ph_norm_mod<false>(lds, wsf + O_H, nullptr, p.in[31], wsf + O_MOD1, 0, 1, XNB2, NL, nullptr, nullptr, nullptr, nullptr, G, bid);
    SEAM(PH_XN3);
    if (IN(PH_GEMM_IN1)) {
        pg8::DenseOrder S; S.init(XNB2, D, WIN1, D, NL, 4096, G, bid);
        EpiGelu E{Ub, VG};
        pg8::gemm_phase<EpiGelu, pg8::DenseOrder, true, true>(lds, D, D, D, S, E);
    }
    SEAM(PH_GEMM_IN1);
    if (IN(PH_LNT)) ph_ln_transpose(lds, VG, p.in[34], p.in[35], VT, G, bid);
    SEAM(PH_LNT);
    if (IN(PH_SPATIAL)) ph_spatial(WSB, VT, Ub, p.in[37], GATED, G, bid);
    SEAM(PH_SPATIAL);
    if (IN(PH_GEMM_O1)) {
        pg8::DenseOrder S; S.init(GATED, D, WO1, D, NL, D, G, bid);
        EpiRes E{wsf + O_H, wsf + O_H, wsf + O_MOD1 + 2 * D};
        pg8::gemm_phase<EpiRes, pg8::DenseOrder, true, true>(lds, D, D, D, S, E);
    }
    SEAM(PH_GEMM_O1);
    if (IN(PH_XN4)) ph_norm_mod<true>(lds, wsf + O_H, nullptr, p.in[32], wsf + O_MOD1, 3, 4, XNB2, NL, p.in[39], R_TOPE, R_TOPG, R_BCNT, G, bid);
    SEAM(PH_XN4);
    if (IN(PH_PLAN)) ph_moe_plan(lds, R_BCNT, R_TOPE, R_SLOT, R_CNTOFF, XNB2, XG, G, bid);
    SEAM(PH_PLAN);
    if (IN(PH_MOE_UP)) {
        pg8::MoeOrder S; S.init(R_CNTOFF, R_CNTOFF + 8, XG, D / 2, W13E, D / 2, (size_t)2 * DFF * D, 2 * DFF, G, bid);
        EpiSwigluF8 E{(unsigned char*)ACT2, DFF, 1.0f / 64.f};
        pg8::gemm_phase<EpiSwigluF8, pg8::MoeOrder, false, true, true>(lds, D / 2, D / 2, D / 2, S, E);
    }
    SEAM(PH_MOE_UP);
    if (IN(PH_MOE_DOWN)) {
        pg8::MoeOrder S; S.init(R_CNTOFF, R_CNTOFF + 8, ACT2, DFF / 2, W2E, DFF / 2, (size_t)D * DFF, D, G, bid);
        EpiBf16S E{(bf16_t*)OUT2, D, 1.0f / 128.f};
        pg8::gemm_phase<EpiBf16S, pg8::MoeOrder, true, true, true>(lds, DFF / 2, DFF / 2, DFF / 2, S, E);
    }
    SEAM(PH_MOE_DOWN);
    if (IN(PH_FINAL)) ph_final(wsf + O_H, (const bf16_t*)OUT2, R_SLOT, R_TOPG, wsf + O_MOD1 + 5 * D, p.in[43], p.out, G, bid);
#undef IN
#undef SEAM
}

static void launch_mega(hipStream_t stream, MP mp, int lo, int hi) {
    static int grid = 0;
    if (grid == 0) {
        int dev = 0, cus = 0;
        hipGetDevice(&dev); hipDeviceGetAttribute(&cus, hipDeviceAttributeMultiprocessorCount, dev);
        hipFuncSetAttribute((const void*)mega, hipFuncAttributeMaxDynamicSharedMemorySize, LDS_BYTES);
        int per_cu = 0; hipOccupancyMaxActiveBlocksPerMultiprocessor(&per_cu, (const void*)mega, 512, LDS_BYTES);
        if (per_cu < 1) fprintf(stderr, "mega: occupancy query says %d\n", per_cu);
        (void)hipGetLastError();
        grid = cus > 0 ? cus : 256;
    }
    hipMemsetAsync(mp.ws + MB_CTL, 0, CTL_BYTES, stream);
    mp.ph_lo = lo; mp.ph_hi = hi;
    hipLaunchKernelGGL(mega, dim3(grid), dim3(512), LDS_BYTES, stream, mp);
}
extern "C" void kernel_launch(void* const* d_in, const int* in_sizes, int n_in, void* d_out, int out_size, void* d_ws, size_t ws_size, hipStream_t stream) {
    if (n_in != 44 || ws_size < MB_END) { fprintf(stderr, "kernel_launch: bad n_in %d or ws %zu < %zu\n", n_in, ws_size, (size_t)MB_END); return; }
    MP mp{};
    for (int i = 0; i < 44; ++i) mp.in[i] = (const float*)d_in[i];
    mp.out = (float*)d_out; mp.ws = (unsigned char*)d_ws;
    launch_mega(stream, mp, 0, PH_N);
}
```

```cpp
#include <hip/hip_runtime.h>
#include <cstdio>
#include <cstdint>

constexpr int D = 2048, NB = 2, SEQ = 4096, CTX = 256;
constexpr int NL = NB * SEQ;
constexpr int NCX = NB * CTX;
constexpr int MALL = NL + NCX;
constexpr int NMOD = 6 * D;
constexpr int QL = 512, KVL = 512, ROPE = 64, NOPE = 128, VH = 128, HM = 8;
constexpr int MLA_IN = QL + KVL + ROPE;
constexpr int RD = 1024, RH = 16, RN = 64;
constexpr int RWKV_IN = 3 * RD + 128 + 128 + 160;
__device__ __forceinline__ size_t hmi(int row, int col) { return ((size_t)(col >> 6) * (8192 + 2 * 256) + row) * 64 + (col & 63); }
constexpr int ZW = MLA_IN + RWKV_IN;
constexpr int ZLD = 4608;
constexpr int KLD = 1088;
constexpr int QW = HM * (NOPE + ROPE);
constexpr int KVW = HM * (NOPE + VH);
constexpr int SK = CTX + SEQ;
constexpr int DFF = 7168, NE = 8;
constexpr int NSLOT = 18432;

constexpr int LDS_BYTES = 163840, LDS_CTL = 162816;

__device__ __forceinline__ float wave_sum(float v) {
#pragma unroll
    for (int o = 32; o > 0; o >>= 1) v += __shfl_xor(v, o);
    return v;
}
__device__ __forceinline__ float wave_sum_dpp(float v) {
    v += __builtin_bit_cast(float, __builtin_amdgcn_update_dpp(0, __builtin_bit_cast(int, v), 0xB1, 0xf, 0xf, true));
    v += __builtin_bit_cast(float, __builtin_amdgcn_update_dpp(0, __builtin_bit_cast(int, v), 0x4E, 0xf, 0xf, true));
    v += __builtin_bit_cast(float, __builtin_amdgcn_update_dpp(0, __builtin_bit_cast(int, v), 0x141, 0xf, 0xf, true));
    v += __builtin_bit_cast(float, __builtin_amdgcn_update_dpp(0, __builtin_bit_cast(int, v), 0x140, 0xf, 0xf, true));
    const int vi = __builtin_bit_cast(int, v);
    const float s0 = __builtin_bit_cast(float, __builtin_amdgcn_readlane(vi, 0)), s1 = __builtin_bit_cast(float, __builtin_amdgcn_readlane(vi, 16));
    const float s2 = __builtin_bit_cast(float, __builtin_amdgcn_readlane(vi, 32)), s3 = __builtin_bit_cast(float, __builtin_amdgcn_readlane(vi, 48));
    return (s0 + s1) + (s2 + s3);
}
__device__ __forceinline__ float sigmoidf_(float x) { return 1.0f / (1.0f + expf(-x)); }
__device__ __forceinline__ float siluf_(float x) { return x / (1.0f + expf(-x)); }

#define LAS __attribute__((address_space(3)))
typedef unsigned short bf16_t;
typedef short bf16x8 __attribute__((ext_vector_type(8)));
typedef float f32x4 __attribute__((ext_vector_type(4)));
typedef float f32x2 __attribute__((ext_vector_type(2)));
typedef unsigned u32x4 __attribute__((ext_vector_type(4)));
typedef unsigned u32x2 __attribute__((ext_vector_type(2)));
typedef int i32x8 __attribute__((ext_vector_type(8)));

__device__ __forceinline__ unsigned cvt_pk_bf16(float lo, float hi) { unsigned r; asm volatile("v_cvt_pk_bf16_f32 %0, %1, %2" : "=v"(r) : "v"(lo), "v"(hi)); return r; }
__device__ __forceinline__ unsigned pk4_fp8(float a, float b, float c, float d) { int p = __builtin_amdgcn_cvt_pk_fp8_f32(a, b, 0, false); p = __builtin_amdgcn_cvt_pk_fp8_f32(c, d, p, true); return (unsigned)p; }
__device__ __forceinline__ float bf2f(bf16_t b) { return __uint_as_float(((unsigned)b) << 16); }
__device__ __forceinline__ float fexp(float x) { return __builtin_amdgcn_exp2f(x * 1.4426950408889634f); }
__device__ __forceinline__ float flog(float x) { return __builtin_amdgcn_logf(x) * 0.6931471805599453f; }
__device__ __forceinline__ float fsigmoid(float x) { return __builtin_amdgcn_rcpf(1.0f + fexp(-x)); }
__device__ __forceinline__ float ftanh(float x) { return 1.0f - 2.0f * __builtin_amdgcn_rcpf(1.0f + fexp(2.0f * x)); }
__device__ __forceinline__ float rope_inv(int f) { const int q = f >> 2, r = f & 3; const float a = q == 0 ? 1.0f : q == 1 ? 0.1f : q == 2 ? 0.01f : 0.001f;
    const float b = r == 0 ? 1.0f : r == 1 ? 0.5623413251903491f : r == 2 ? 0.31622776601683794f : 0.1778279410038923f; return a * b; }

#define XB_TMO      128
#define XB_XCNT(j)  (256  + 64 * (j))
#define XB_XSUB(j)  (1280 + 64 * (j))
#define XB_XGEN(j)  (2304 + 64 * (j))
#define XB_TOP      3328
#define XB_TOPGEN   3392
#define XCD_BAR_WORDS 3456
#define XB_SPIN_CAP (1u << 18)
__device__ __forceinline__ unsigned xb_ld(unsigned* p)              { return __hip_atomic_load(p, __ATOMIC_RELAXED, __HIP_MEMORY_SCOPE_AGENT); }
__device__ __forceinline__ unsigned xb_add(unsigned* p, unsigned v) { return __hip_atomic_fetch_add(p, v, __ATOMIC_RELAXED, __HIP_MEMORY_SCOPE_AGENT); }
__device__ __forceinline__ unsigned xb_xcc_id() { return (unsigned)__builtin_amdgcn_s_getreg((3 << 11) | 20) & 0xFu; }
#define XB_SPIN(cond, bar) do { unsigned _sp = 0; while (cond) { __builtin_amdgcn_s_sleep(1); \
    if ((++_sp & 255u) == 0u) { if (xb_ld(&(bar)[XB_TMO])) break; if (_sp > XB_SPIN_CAP) { atomicAdd(&(bar)[XB_TMO], 1u); break; } } } } while (0)
struct XcdBarrier { unsigned* bar; unsigned x; volatile LAS unsigned* st; };
__device__ __forceinline__ XcdBarrier xcd_barrier_post(unsigned* bar, volatile LAS unsigned* st) {
    XcdBarrier b; b.bar = bar; b.x = xb_xcc_id(); b.st = st;
    if (threadIdx.x == 0) (void)xb_add(&bar[XB_XCNT(b.x)], 1u);
    return b;
}
__device__ __forceinline__ void xcd_barrier_complete(unsigned* bar, unsigned x, unsigned& nloc, unsigned& nx) {
    const unsigned G = gridDim.x * gridDim.y * gridDim.z;
    unsigned sum, cnt, mine, sp = 0u;
    for (;;) {
        sum = 0u; cnt = 0u; mine = 0u;
#pragma unroll
        for (unsigned j = 0; j < 16; ++j) { const unsigned c = xb_ld(&bar[XB_XCNT(j)]); sum += c; cnt += (c > 0u) ? 1u : 0u; mine = (j == x) ? c : mine; }
        if (sum == G) break;
        __builtin_amdgcn_s_sleep(1);
        if ((++sp & 255u) == 0u) { if (xb_ld(&bar[XB_TMO])) break; if (sp > XB_SPIN_CAP) { atomicAdd(&bar[XB_TMO], 1u); break; } }
    }
    nloc = mine > 0u ? mine : 1u; nx = cnt > 0u ? cnt : 1u;
}
__device__ __forceinline__ void xcd_barrier(const XcdBarrier& b) {
    asm volatile("s_waitcnt vmcnt(0)" ::: "memory");
    __syncthreads();
    if (threadIdx.x == 0) {
        unsigned* bar = b.bar;
        __builtin_amdgcn_s_waitcnt(0);
        unsigned nloc = b.st[0], nx = b.st[1];
        if (nloc == 0u) { xcd_barrier_complete(bar, b.x, nloc, nx); b.st[0] = nloc; b.st[1] = nx; }
        const unsigned old = xb_add(&bar[XB_XSUB(b.x)], 1u);
        const unsigned gen = old / nloc;
        if (old + 1u == (gen + 1u) * nloc) {
            __builtin_amdgcn_fence(__ATOMIC_RELEASE, "agent");
            asm volatile("s_waitcnt vmcnt(0)" ::: "memory");
            const unsigned og = xb_add(&bar[XB_TOP], 1u);
            const unsigned tg = og / nx;
            if (og + 1u == (tg + 1u) * nx) xb_add(&bar[XB_TOPGEN], 1u);
            else XB_SPIN(xb_ld(&bar[XB_TOPGEN]) == tg, bar);
            __builtin_amdgcn_fence(__ATOMIC_ACQUIRE, "agent");
            xb_add(&bar[XB_XGEN(b.x)], 1u);
            asm volatile("s_waitcnt vmcnt(0)" ::: "memory");
        } else {
            XB_SPIN(xb_ld(&bar[XB_XGEN(b.x)]) == gen, bar);
            __builtin_amdgcn_fence(__ATOMIC_ACQUIRE, "agent");
            asm volatile("s_waitcnt vmcnt(0)" ::: "memory");
        }
    }
    __syncthreads();
}

namespace pg8 {
constexpr int BM = 256, BK = 64, HALF = 128, HTB = HALF * BK * 2, STAGE_BYTES = 8 * HTB, NXCD = 8, WGM = 8;
__host__ __device__ __forceinline__ int lds_byte(int r, int c) { const int st = (r >> 4) * 2 + (c >> 5), rr = r & 15, cc = c & 31, ob = rr * 64 + cc * 2; return st * 1024 + (ob ^ (((ob >> 9) & 1) << 5)); }
__host__ __device__ __forceinline__ void stage_rc(int b, int& R, int& C) { const int st = b / 1024, sb = b % 1024, swz = sb ^ (((sb >> 9) & 1) << 5); R = (st >> 1) * 16 + swz / 64; C = (st & 1) * 32 + (swz % 64) / 2; }
__host__ __device__ __forceinline__ int perm32(int rho) { const int n = rho >> 4, i = rho & 15; return 8 * (i >> 2) + 4 * n + (i & 3); }
struct Unit { int pm, pn, kind; const char* a; const char* b; };

struct DenseOrder {
    int nM, nN, nwg, G, c, lda, ldb; const char* A; const char* B;
    __device__ void init(const bf16_t* A_, int lda_, const bf16_t* B_, int ldb_, int M, int N, int G_, int c_) { A = (const char*)A_; B = (const char*)B_; lda = lda_; ldb = ldb_; nM = M / BM; nN = N / BM; nwg = nM * nN; G = G_; c = c_; }
    __device__ bool next(int i, Unit& u) const {
        const long L = (long)i * G + c; if (L >= nwg) return false;
        int wgid = (int)L; { const int q = nwg / NXCD, r = nwg % NXCD, xcd = wgid % NXCD, off = wgid / NXCD; wgid = (xcd < r ? xcd * (q + 1) : r * (q + 1) + (xcd - r) * q) + off; }
        const int nig = WGM * nN, gid = wgid / nig, fm = gid * WGM, gsz = (nM - fm) < WGM ? (nM - fm) : WGM;
        u.pm = fm + ((wgid % nig) % gsz); u.pn = (wgid % nig) / gsz; u.kind = 0;
        u.a = A + (size_t)u.pm * BM * lda * 2; u.b = B + (size_t)u.pn * BM * ldb * 2; return true;
    }
};

template <class Epi, class Sched, bool ALIGN_EPI = false, bool SP2 = false, bool FP8 = false>
__device__ __forceinline__ void gemm_phase(LAS unsigned char* lds, const int K, const int lda, const int ldb, const Sched& S, const Epi& E) {
    const int tid = threadIdx.x, wid = __builtin_amdgcn_readfirstlane(tid >> 6), lane = tid & 63, wr = wid >> 2, wc = wid & 3, fr = lane & 15, fq = lane >> 4;
    const int nt = K / BK;
    unsigned voffA[2], voffB[2];
#pragma unroll
    for (int i = 0; i < 2; ++i) { int R, C; stage_rc(tid * 16 + i * 8192, R, C); const int Rb = Epi::PERM ? ((R & ~31) + perm32(R & 31)) : R;
        voffA[i] = (unsigned)(R * lda + C) * 2u; voffB[i] = (unsigned)(Rb * ldb + C) * 2u; }
    const size_t kstep = (size_t)(BK * 2);
    const size_t hstepA = (size_t)HALF * lda * 2, hstepB = (size_t)HALF * ldb * 2;
    const unsigned ldsw = (unsigned)wid * 1024u;
    const int aoff = lds_byte(wr * 64 + fr, fq * 8), boff = lds_byte(wc * 32 + fr, fq * 8);
#define PG8_SA(b, h) (((b) * 2 + (h)) * HTB)
#define PG8_SB(b, h) ((4 + (b) * 2 + (h)) * HTB)
#define PG8_STAGE(bufoff, gbase, voff) do { _Pragma("unroll") for (int _i = 0; _i < 2; ++_i) \
        __builtin_amdgcn_global_load_lds((const unsigned*)((const char*)(gbase) + (voff)[_i]), (LAS unsigned*)(lds + (bufoff) + ldsw + _i * 8192), 16, 0, 0); } while (0)
#define PG8_LDA(dst, b, h) do { _Pragma("unroll") for (int m = 0; m < 4; ++m) _Pragma("unroll") for (int k = 0; k < 2; ++k) dst[m][k] = *(const LAS bf16x8*)(lds + PG8_SA(b, h) + aoff + m * 2048 + k * 1024); } while (0)
#define PG8_LDB(dst, b, h) do { _Pragma("unroll") for (int n = 0; n < 2; ++n) _Pragma("unroll") for (int k = 0; k < 2; ++k) dst[n][k] = *(const LAS bf16x8*)(lds + PG8_SB(b, h) + boff + n * 2048 + k * 1024); } while (0)
#define PG8_CAT(x) __builtin_bit_cast(i32x8, __builtin_shufflevector((x)[0], (x)[1], 0, 1, 2, 3, 4, 5, 6, 7, 8, 9, 10, 11, 12, 13, 14, 15))
#define PG8_MMA(ai, bj, At, Bt) do { __builtin_amdgcn_s_setprio(1); _Pragma("unroll") for (int m = 0; m < 4; ++m) _Pragma("unroll") for (int n = 0; n < 2; ++n) { \
        if constexpr (FP8) { asm volatile("v_mfma_f32_16x16x128_f8f6f4 %0, %1, %2, %0" : "+v"(acc[ai][bj][m][n]) : "v"(PG8_CAT(Bt[n])), "v"(PG8_CAT(At[m]))); } \
        else { _Pragma("unroll") for (int k = 0; k < 2; ++k) acc[ai][bj][m][n] = __builtin_amdgcn_mfma_f32_16x16x32_bf16(Bt[n][k], At[m][k], acc[ai][bj][m][n], 0, 0, 0); } } \
        __builtin_amdgcn_s_setprio(0); } while (0)
#define PG8_WAIT_V(n) asm volatile("s_waitcnt vmcnt(" #n ")" ::: "memory")
#define PG8_WAIT_L(n) asm volatile("s_waitcnt lgkmcnt(" #n ")" ::: "memory")
#define PG8_BAR __builtin_amdgcn_s_barrier()
#define PG8_SCHED __builtin_amdgcn_sched_barrier(0)
    Unit cur, nxt; int ui = 0;
    if (!S.next(0, cur)) return;
    f32x4 acc[2][2][4][2];
#pragma unroll
    for (int a = 0; a < 2; ++a)
#pragma unroll
        for (int b = 0; b < 2; ++b)
#pragma unroll
            for (int m = 0; m < 4; ++m)
#pragma unroll
                for (int n = 0; n < 2; ++n) acc[a][b][m][n] = (f32x4){0.f, 0.f, 0.f, 0.f};
    bf16x8 At[4][2], B0[2][2], B1[2][2];
    const char* cA = cur.a; const char* cB = cur.b;
    if constexpr (SP2) {
        PG8_STAGE(PG8_SB(0, 0), cB, voffB); PG8_STAGE(PG8_SB(0, 1), cB + hstepB, voffB); PG8_STAGE(PG8_SA(0, 0), cA, voffA); PG8_STAGE(PG8_SA(0, 1), cA + hstepA, voffA);
        if (wr == 1) PG8_BAR;
        PG8_WAIT_V(2); PG8_BAR;
        PG8_STAGE(PG8_SB(1, 0), cB + kstep, voffB); PG8_STAGE(PG8_SA(1, 0), cA + kstep, voffA); PG8_STAGE(PG8_SB(1, 1), cB + hstepB + kstep, voffB);
        PG8_WAIT_V(6); PG8_BAR;
    } else {
        PG8_STAGE(PG8_SB(0, 0), cB, voffB); PG8_STAGE(PG8_SA(0, 0), cA, voffA); PG8_STAGE(PG8_SB(0, 1), cB + hstepB, voffB); PG8_STAGE(PG8_SA(0, 1), cA + hstepA, voffA);
        if (wr == 1) PG8_BAR;
        PG8_WAIT_V(4); PG8_BAR;
        PG8_STAGE(PG8_SB(1, 0), cB + kstep, voffB); PG8_STAGE(PG8_SA(1, 0), cA + kstep, voffA); PG8_STAGE(PG8_SB(1, 1), cB + hstepB + kstep, voffB);
        PG8_WAIT_V(6); PG8_BAR;
    }
    for (;;) {
        const bool has_next = S.next(ui + 1, nxt);
        const char* nA = has_next ? nxt.a : cA; const char* nB = has_next ? nxt.b : cB;
        for (int t = 0; t < nt; t += 2) {
            const bool last = (t == nt - 2);
            const char* a1 = cA + (size_t)(t + 1) * kstep;
            const char* a2 = last ? nA : cA + (size_t)(t + 2) * kstep; const char* b2 = last ? nB : cB + (size_t)(t + 2) * kstep;
            const char* a3 = a2 + kstep; const char* b3 = b2 + kstep;
            if constexpr (SP2) {
            PG8_LDB(B0, 0, 0); PG8_LDB(B1, 0, 1); PG8_SCHED; PG8_LDA(At, 0, 0); PG8_STAGE(PG8_SA(1, 1), a1 + hstepA, voffA);
            PG8_WAIT_V(8); PG8_WAIT_L(0); PG8_BAR; PG8_MMA(0, 0, At, B0); PG8_MMA(0, 1, At, B1); PG8_BAR; PG8_SCHED;
            PG8_LDA(At, 0, 1); PG8_STAGE(PG8_SB(0, 0), b2, voffB); PG8_STAGE(PG8_SB(0, 1), b2 + hstepB, voffB); PG8_STAGE(PG8_SA(0, 0), a2, voffA);
            PG8_WAIT_V(8); PG8_WAIT_L(0); PG8_BAR; PG8_MMA(1, 0, At, B0); PG8_MMA(1, 1, At, B1); PG8_BAR; PG8_SCHED;
            PG8_LDB(B0, 1, 0); PG8_LDB(B1, 1, 1); PG8_SCHED; PG8_LDA(At, 1, 0); PG8_STAGE(PG8_SA(0, 1), a2 + hstepA, voffA);
            PG8_WAIT_V(8); PG8_WAIT_L(0); PG8_BAR; PG8_MMA(0, 0, At, B0); PG8_MMA(0, 1, At, B1); PG8_BAR; PG8_SCHED;
            PG8_LDA(At, 1, 1); PG8_STAGE(PG8_SB(1, 0), b3, voffB); PG8_STAGE(PG8_SB(1, 1), b3 + hstepB, voffB); PG8_STAGE(PG8_SA(1, 0), a3, voffA);
            PG8_WAIT_V(8); PG8_WAIT_L(0); PG8_BAR; PG8_MMA(1, 0, At, B0); PG8_MMA(1, 1, At, B1); PG8_BAR; PG8_SCHED;
            } else {
            PG8_LDB(B0, 0, 0); PG8_SCHED; PG8_LDA(At, 0, 0); PG8_STAGE(PG8_SA(1, 1), a1 + hstepA, voffA);
            PG8_WAIT_L(8); PG8_BAR; PG8_WAIT_L(0); PG8_MMA(0, 0, At, B0); PG8_BAR; PG8_SCHED;
            PG8_LDB(B1, 0, 1); PG8_STAGE(PG8_SB(0, 0), b2, voffB);
            PG8_BAR; PG8_WAIT_L(0); PG8_MMA(0, 1, At, B1); PG8_BAR;
            PG8_LDA(At, 0, 1); PG8_STAGE(PG8_SA(0, 0), a2, voffA);
            PG8_BAR; PG8_WAIT_L(0); PG8_MMA(1, 0, At, B0); PG8_BAR; PG8_SCHED;
            PG8_STAGE(PG8_SB(0, 1), b2 + hstepB, voffB);
            PG8_WAIT_V(6); PG8_BAR; PG8_MMA(1, 1, At, B1); PG8_BAR;
            PG8_LDB(B0, 1, 0); PG8_SCHED; PG8_LDA(At, 1, 0); PG8_STAGE(PG8_SA(0, 1), a2 + hstepA, voffA);
            PG8_WAIT_L(8); PG8_BAR; PG8_WAIT_L(0); PG8_MMA(0, 0, At, B0); PG8_BAR; PG8_SCHED;
            PG8_LDB(B1, 1, 1); PG8_STAGE(PG8_SB(1, 0), b3, voffB);
            PG8_BAR; PG8_WAIT_L(0); PG8_MMA(0, 1, At, B1); PG8_BAR;
            PG8_LDA(At, 1, 1); PG8_STAGE(PG8_SA(1, 0), a3, voffA);
            PG8_BAR; PG8_WAIT_L(0); PG8_MMA(1, 0, At, B0); PG8_BAR; PG8_SCHED;
            PG8_STAGE(PG8_SB(1, 1), b3 + hstepB, voffB);
            PG8_WAIT_V(6); PG8_BAR; PG8_MMA(1, 1, At, B1); PG8_BAR;
            }
        }
        if constexpr (ALIGN_EPI) { if (wr == 0) PG8_BAR; }
        if constexpr (FP8) asm volatile("s_nop 15\n\ts_nop 15\n\ts_nop 7" ::: "memory");
        E(acc, cur, wr, wc, fr, fq);
        if (!has_next) break;
#pragma unroll
        for (int a = 0; a < 2; ++a)
#pragma unroll
            for (int b = 0; b < 2; ++b)
#pragma unroll
                for (int m = 0; m < 4; ++m)
#pragma unroll
                    for (int n = 0; n < 2; ++n) acc[a][b][m][n] = (f32x4){0.f, 0.f, 0.f, 0.f};
        cur = nxt; cA = nA; cB = nB; ++ui;
        if constexpr (ALIGN_EPI) { if (wr == 1) PG8_BAR; }
    }
    PG8_WAIT_V(0);
    if constexpr (!ALIGN_EPI) { if (wr == 0) PG8_BAR; }
    PG8_BAR;
#undef PG8_SA
#undef PG8_SB
#undef PG8_STAGE
#undef PG8_LDA
#undef PG8_LDB
#undef PG8_MMA
#undef PG8_CAT
#undef PG8_WAIT_V
#undef PG8_WAIT_L
#undef PG8_BAR
#undef PG8_SCHED
}
}
using pg8::Unit;

typedef const f32x4 (&AccRef)[2][2][4][2];
struct EpiF32 { static constexpr bool PERM = false; float* C; int ldc;
    __device__ __forceinline__ void operator()(AccRef acc, const Unit& u, int wr, int wc, int fr, int fq) const {
        const int row0 = u.pm * 256 + wr * 64 + fr, col0 = u.pn * 256 + wc * 32 + 4 * fq;
#pragma unroll
        for (int ai = 0; ai < 2; ++ai)
#pragma unroll
            for (int m = 0; m < 4; ++m) { float* rowp = C + (size_t)(row0 + ai * 128 + m * 16) * ldc + col0;
#pragma unroll
                for (int bj = 0; bj < 2; ++bj)
#pragma unroll
                    for (int n = 0; n < 2; ++n) *(f32x4*)(rowp + bj * 128 + n * 16) = acc[ai][bj][m][n]; }
    } };
struct EpiRes { static constexpr bool PERM = false; float* C; const float* R; const float* gate;
    __device__ __forceinline__ void operator()(AccRef acc, const Unit& u, int wr, int wc, int fr, int fq) const {
        const int row0 = u.pm * 256 + wr * 64 + fr, col0 = u.pn * 256 + wc * 32 + 4 * fq;
        const float* gp = gate + (size_t)((u.pm * 256) / SEQ) * NMOD + col0;
        f32x4 gv[2][2];
#pragma unroll
        for (int bj = 0; bj < 2; ++bj)
#pragma unroll
            for (int n = 0; n < 2; ++n) gv[bj][n] = *(const f32x4*)(gp + bj * 128 + n * 16);
#pragma unroll
        for (int ai = 0; ai < 2; ++ai)
#pragma unroll
          for (int mp = 0; mp < 2; ++mp) {
            f32x4 r[2][2][2];
#pragma unroll
            for (int mm = 0; mm < 2; ++mm) { const size_t off = (size_t)(row0 + ai * 128 + (mp * 2 + mm) * 16) * D + col0;
#pragma unroll
                for (int bj = 0; bj < 2; ++bj)
#pragma unroll
                    for (int n = 0; n < 2; ++n) r[mm][bj][n] = *(const f32x4*)(R + off + bj * 128 + n * 16); }
#pragma unroll
            for (int mm = 0; mm < 2; ++mm) { const size_t off = (size_t)(row0 + ai * 128 + (mp * 2 + mm) * 16) * D + col0;
#pragma unroll
                for (int bj = 0; bj < 2; ++bj)
#pragma unroll
                    for (int n = 0; n < 2; ++n) *(f32x4*)(C + off + bj * 128 + n * 16) = r[mm][bj][n] + gv[bj][n] * acc[ai][bj][mp * 2 + mm][n]; }
          }
    } };
struct EpiSwiglu { static constexpr bool PERM = true; bf16_t* O; int ldo;
    __device__ __forceinline__ void operator()(AccRef acc, const Unit& u, int wr, int wc, int fr, int fq) const {
        const int row0 = u.pm * 256 + wr * 64 + fr, col0 = u.pn * 128 + wc * 32 + 8 * fq;
#pragma unroll
        for (int ai = 0; ai < 2; ++ai)
#pragma unroll
            for (int m = 0; m < 4; ++m) { bf16_t* rowp = O + (size_t)(row0 + ai * 128 + m * 16) * ldo + col0;
                float o[8];
#pragma unroll
                for (int n = 0; n < 2; ++n)
#pragma unroll
                    for (int j = 0; j < 4; ++j) { const float a = acc[ai][0][m][n][j], b = acc[ai][1][m][n][j]; o[n * 4 + j] = a * __builtin_amdgcn_rcpf(1.0f + __expf(-a)) * b; }
                u32x4 w; w.x = cvt_pk_bf16(o[0], o[1]); w.y = cvt_pk_bf16(o[2], o[3]); w.z = cvt_pk_bf16(o[4], o[5]); w.w = cvt_pk_bf16(o[6], o[7]);
                *(u32x4*)rowp = w; }
    } };

struct EpiSwigluF8 { static constexpr bool PERM = true; unsigned char* O; int ldo; float sc;
    __device__ __forceinline__ void operator()(AccRef acc, const Unit& u, int wr, int wc, int fr, int fq) const {
        const int row0 = u.pm * 256 + wr * 64 + fr, col0 = u.pn * 128 + wc * 32 + 8 * fq;
#pragma unroll
        for (int ai = 0; ai < 2; ++ai)
#pragma unroll
            for (int m = 0; m < 4; ++m) { unsigned char* rowp = O + (size_t)(row0 + ai * 128 + m * 16) * ldo + col0;
                float o[8];
#pragma unroll
                for (int n = 0; n < 2; ++n)
#pragma unroll
                    for (int j = 0; j < 4; ++j) { const float a = acc[ai][0][m][n][j] * sc, b = acc[ai][1][m][n][j] * sc; o[n * 4 + j] = a * __builtin_amdgcn_rcpf(1.0f + __expf(-a)) * b; }
                u32x2 w; w.x = pk4_fp8(o[0], o[1], o[2], o[3]); w.y = pk4_fp8(o[4], o[5], o[6], o[7]);
                *(u32x2*)rowp = w; }
    } };
struct EpiBf16S { static constexpr bool PERM = true; bf16_t* O; int ldo; float sc;
    __device__ __forceinline__ void operator()(AccRef acc, const Unit& u, int wr, int wc, int fr, int fq) const {
        const int row0 = u.pm * 256 + wr * 64 + fr, col0 = u.pn * 256 + wc * 32 + 8 * fq;
#pragma unroll
        for (int ai = 0; ai < 2; ++ai)
#pragma unroll
            for (int m = 0; m < 4; ++m) { bf16_t* rowp = O + (size_t)(row0 + ai * 128 + m * 16) * ldo + col0;
#pragma unroll
                for (int bj = 0; bj < 2; ++bj) { const f32x4 v0 = acc[ai][bj][m][0] * sc, v1 = acc[ai][bj][m][1] * sc;
                    u32x4 w; w.x = cvt_pk_bf16(v0[0], v0[1]); w.y = cvt_pk_bf16(v0[2], v0[3]); w.z = cvt_pk_bf16(v1[0], v1[1]); w.w = cvt_pk_bf16(v1[2], v1[3]);
                    *(u32x4*)(rowp + bj * 128) = w; } }
    } };

struct MapPlain { const float* src; int ld, ncols;
    __device__ __forceinline__ const float* operator()(int n0) const { return n0 < ncols ? src + n0 : nullptr; } __device__ __forceinline__ int stride() const { return ld; } __device__ __forceinline__ bool valid(int n) const { return n < ncols; } };
struct MapIl { const float* s1; long d31; int ld;
    __device__ __forceinline__ const float* operator()(int n0) const { const int t = n0 >> 8, j = n0 & 255; return s1 + (j < 128 ? 0l : d31) + t * 128 + (j & 127); } __device__ __forceinline__ int stride() const { return ld; } __device__ __forceinline__ bool valid(int) const { return true; } };
template <bool FP8, class MAP>
__device__ __forceinline__ void cvt_ring(LAS unsigned char* lds, const MAP& map, void* dstv, int Nd, int K, float scale, int G, int c) {
    constexpr int NS = 4, SLOT = 32768;
    const int tid = threadIdx.x, wave = __builtin_amdgcn_readfirstlane(tid >> 6), lane = tid & 63;
    const int ntk = K / 128, nnt = Nd / 64, ntiles = nnt * ntk;
    if (c >= ntiles) return;
    const int nmine = (ntiles - c + G - 1) / G;
    const int ld = map.stride();
    __syncthreads();
    auto issue = [&](int it) {
        const int itc = it < nmine ? it : nmine - 1, tile = c + itc * G;
        const int n0 = (tile % nnt) * 64, k0 = (tile / nnt) * 128;
        const float* sp = map(n0);
        const int col = (lane & 15) * 4, colc = (sp && map.valid(n0 + col)) ? col : 0;
        const float* base = (sp ? sp : map(0)) + colc;
        LAS unsigned char* sl = lds + (it % NS) * SLOT + wave * 4096;
#pragma unroll
        for (int i = 0; i < 4; ++i)
            __builtin_amdgcn_global_load_lds((const unsigned*)(base + (size_t)(k0 + wave * 16 + i * 4 + (lane >> 4)) * ld), (LAS unsigned*)(sl + i * 1024), 16, 0, 0);
    };
#pragma unroll
    for (int i = 0; i < NS - 1; ++i) issue(i);
    for (int it = 0; it < nmine; ++it) {
        asm volatile("s_waitcnt vmcnt(8)" ::: "memory");
        __syncthreads();
        issue(it + NS - 1);
        const int tile = c + it * G, n0 = (tile % nnt) * 64, k0 = (tile / nnt) * 128;
        const LAS float* T = (const LAS float*)(lds + (it % NS) * SLOT);
        const bool ok = map(n0) != nullptr && map.valid(n0 + lane);
        if constexpr (FP8) {
            float v[16];
#pragma unroll
            for (int j = 0; j < 16; ++j) v[j] = ok ? T[(wave * 16 + j) * 64 + lane] * scale : 0.f;
            u32x4 w; w.x = pk4_fp8(v[0], v[1], v[2], v[3]); w.y = pk4_fp8(v[4], v[5], v[6], v[7]); w.z = pk4_fp8(v[8], v[9], v[10], v[11]); w.w = pk4_fp8(v[12], v[13], v[14], v[15]);
            *(u32x4*)((unsigned char*)dstv + (size_t)(n0 + lane) * K + k0 + wave * 16) = w;
        } else {
#pragma unroll
            for (int h = 0; h < 2; ++h) { const int kg = wave + 8 * h; float v[8];
#pragma unroll
                for (int j = 0; j < 8; ++j) v[j] = ok ? T[(kg * 8 + j) * 64 + lane] : 0.f;
                u32x4 w; w.x = cvt_pk_bf16(v[0], v[1]); w.y = cvt_pk_bf16(v[2], v[3]); w.z = cvt_pk_bf16(v[4], v[5]); w.w = cvt_pk_bf16(v[6], v[7]);
                *(u32x4*)((bf16_t*)dstv + (size_t)(n0 + lane) * K + k0 + kg * 8) = w; }
        }
    }
    asm volatile("s_waitcnt vmcnt(0)" ::: "memory");
    __syncthreads();
}
template <class MAP> __device__ __forceinline__ void cvt_T(LAS unsigned char* lds, const MAP& map, bf16_t* dst, int Nd, int K, int G, int c) { cvt_ring<false>(lds, map, dst, Nd, K, 1.f, G, c); }
template <class MAP> __device__ __forceinline__ void cvt_T8(LAS unsigned char* lds, const MAP& map, unsigned char* dst, int Nd, int K, float scale, int G, int c) { cvt_ring<true>(lds, map, dst, Nd, K, scale, G, c); }
__device__ __forceinline__ void cvt_copy(const float* src, bf16_t* dst, size_t n, int G, int c) {
    for (size_t i = ((size_t)c * 512 + threadIdx.x) * 8; i < n; i += (size_t)G * 512 * 8) {
        const float4 a = *(const float4*)(src + i), b = *(const float4*)(src + i + 4);
        u32x4 w; w.x = cvt_pk_bf16(a.x, a.y); w.y = cvt_pk_bf16(a.z, a.w); w.z = cvt_pk_bf16(b.x, b.y); w.w = cvt_pk_bf16(b.z, b.w);
        *(u32x4*)(dst + i) = w;
    }
}


__device__ __forceinline__ f32x2 gelu_pk(f32x2 v) {
    const f32x2 av = __builtin_elementwise_abs(v), d = av * 0.2316418882f + 1.0f;
    f32x2 t; t.x = __builtin_amdgcn_rcpf(d.x); t.y = __builtin_amdgcn_rcpf(d.y);
    f32x2 q = t * 0.5307027145f + (-0.7265760135f); q = q * t + 0.7107068705f; q = q * t + (-0.142248368f); q = q * t + 0.127414796f; q = q * t;
    const f32x2 s = (v * v) * (-0.72134752044f);
    f32x2 e; e.x = __builtin_amdgcn_exp2f(s.x); e.y = __builtin_amdgcn_exp2f(s.y);
    const f32x2 m = v * (q * e), r = v - m;
    f32x2 o; o.x = v.x < 0.f ? m.x : r.x; o.y = v.y < 0.f ? m.y : r.y; return o;
}
struct EpiGelu { static constexpr bool PERM = false; bf16_t* U; float* VG;
    __device__ __forceinline__ void operator()(AccRef acc, const Unit& u, int wr, int wc, int fr, int fq) const {
        const int row0 = u.pm * 256 + wr * 64 + fr, col0 = (u.pn & 7) * 256 + wc * 32 + 4 * fq;
        const bool isu = u.pn < 8;
#pragma unroll
        for (int ai = 0; ai < 2; ++ai)
#pragma unroll
            for (int m = 0; m < 4; ++m) { const size_t off = (size_t)(row0 + ai * 128 + m * 16) * D + col0;
#pragma unroll
                for (int bj = 0; bj < 2; ++bj)
#pragma unroll
                    for (int n = 0; n < 2; ++n) { const f32x4 v = acc[ai][bj][m][n];
                        const f32x2 a = gelu_pk((f32x2){v[0], v[1]}), b = gelu_pk((f32x2){v[2], v[3]});
                        if (isu) { u32x2 w; w.x = cvt_pk_bf16(a.x, a.y); w.y = cvt_pk_bf16(b.x, b.y); *(u32x2*)(U + off + bj * 128 + n * 16) = w; }
                        else *(f32x4*)(VG + off + bj * 128 + n * 16) = (f32x4){a.x, a.y, b.x, b.y}; } }
    } };

namespace pg8 {
struct MoeOrder {
    int cnt_t[8], off_t[8], nN, G, c, lda, ldb; const char* A; const char* B; size_t bstride;
    __device__ void init(const int* cnt, const int* off, const bf16_t* A_, int lda_, const bf16_t* B_, int ldb_, size_t bstride_bytes, int N, int G_, int c_) {
#pragma unroll
        for (int e = 0; e < 8; ++e) { cnt_t[e] = __builtin_amdgcn_readfirstlane((cnt[e] + 255) >> 8); off_t[e] = __builtin_amdgcn_readfirstlane(off[e] >> 8); }
        A = (const char*)A_; B = (const char*)B_; lda = lda_; ldb = ldb_; bstride = bstride_bytes; nN = N / 256; G = G_; c = c_;
    }
    __device__ bool next(int i, Unit& u) const {
        const int L = i * G + c, x = L & 7; int q = L >> 3; int e = 0; bool found = false; int te = 0, oe = 0;
        const int n8 = nN >> 3;
#pragma unroll
        for (int k = 0; k < 8; ++k) { const int ue = cnt_t[k] * n8; if (!found) { if (q < ue) { found = true; e = k; te = cnt_t[k]; oe = off_t[k]; } else q -= ue; } }
        if (!found) return false;
        const int pml = q % te; u.pn = (q / te) * 8 + x; u.pm = oe + pml; u.kind = e;
        u.a = A + (size_t)u.pm * 256 * lda * 2; u.b = B + (size_t)e * bstride + (size_t)u.pn * 256 * ldb * 2; return true;
    }
};
}

template <bool ROUTE>
__device__ __forceinline__ void ph_norm_mod(LAS unsigned char* lds, const float* srcL, const float* srcC, const float* gain, const float* mod, int chunk_sh, int chunk_sc, bf16_t* dst, int nrows,
                                            const float* router, int* tope, float* topg, int* bcnt, int G, int bid) {
    const int tid = threadIdx.x, wave = tid >> 6, lane = tid & 63;
    const int rpb = (nrows + G - 1) / G, r0 = bid * rpb, r1 = min(nrows, r0 + rpb);
    LAS int* lc = (LAS int*)lds;
    if (ROUTE) { if (tid < 8) lc[tid] = 0; __syncthreads(); }
    int cur_mrow = -1; float gm[32], shv[32];
    float4 xn[8];
    { const int rw = r0 + wave < r1 ? r0 + wave : r0; const float* s0_ = rw < NL ? srcL + (size_t)rw * D : srcC + (size_t)(rw - NL) * D;
#pragma unroll
      for (int i = 0; i < 8; ++i) xn[i] = *(const float4*)(s0_ + i * 256 + lane * 4); }
    for (int row = r0 + wave; row < r1; row += 8) {
        const int mrow = row < NL ? row / SEQ : 2;
        if (mrow != cur_mrow) { cur_mrow = mrow;
            const float* sh_ = mod + (size_t)mrow * NMOD + chunk_sh * D; const float* sc_ = mod + (size_t)mrow * NMOD + chunk_sc * D;
#pragma unroll
            for (int i = 0; i < 8; ++i) { const int c = i * 256 + lane * 4; const float4 g4 = *(const float4*)(gain + c), sc4 = *(const float4*)(sc_ + c), sh4 = *(const float4*)(sh_ + c);
                gm[i * 4] = g4.x * (1.f + sc4.x); gm[i * 4 + 1] = g4.y * (1.f + sc4.y); gm[i * 4 + 2] = g4.z * (1.f + sc4.z); gm[i * 4 + 3] = g4.w * (1.f + sc4.w);
                shv[i * 4] = sh4.x; shv[i * 4 + 1] = sh4.y; shv[i * 4 + 2] = sh4.z; shv[i * 4 + 3] = sh4.w; } }
        float v[32]; float ss = 0.f;
#pragma unroll
        for (int i = 0; i < 8; ++i) { const float4 x = xn[i]; v[i * 4] = x.x; v[i * 4 + 1] = x.y; v[i * 4 + 2] = x.z; v[i * 4 + 3] = x.w; ss += x.x * x.x + x.y * x.y + x.z * x.z + x.w * x.w; }
        { const int rn = row + 8 < r1 ? row + 8 : row; const float* sn_ = rn < NL ? srcL + (size_t)rn * D : srcC + (size_t)(rn - NL) * D;
#pragma unroll
          for (int i = 0; i < 8; ++i) xn[i] = *(const float4*)(sn_ + i * 256 + lane * 4); }
        ss = wave_sum_dpp(ss);
        const float rs = rsqrtf(ss * (1.0f / D) + 1e-6f);
        float a[8];
        if (ROUTE) {
#pragma unroll
            for (int e = 0; e < 8; ++e) a[e] = 0.f;
        }
#pragma unroll
        for (int i = 0; i < 8; ++i) {
            const int c = i * 256 + lane * 4;
            float o[4];
            o[0] = v[i * 4] * rs * gm[i * 4] + shv[i * 4]; o[1] = v[i * 4 + 1] * rs * gm[i * 4 + 1] + shv[i * 4 + 1];
            o[2] = v[i * 4 + 2] * rs * gm[i * 4 + 2] + shv[i * 4 + 2]; o[3] = v[i * 4 + 3] * rs * gm[i * 4 + 3] + shv[i * 4 + 3];
            if (ROUTE) *(unsigned*)((unsigned char*)dst + (size_t)row * D + c) = pk4_fp8(o[0], o[1], o[2], o[3]);
            else { u32x2 w; w.x = cvt_pk_bf16(o[0], o[1]); w.y = cvt_pk_bf16(o[2], o[3]); *(u32x2*)(dst + (size_t)row * D + c) = w; }
            if (ROUTE) {
#pragma unroll
                for (int j = 0; j < 4; ++j) { const float4 ra = *(const float4*)(router + (size_t)(c + j) * 8), rb = *(const float4*)(router + (size_t)(c + j) * 8 + 4);
                    a[0] += o[j] * ra.x; a[1] += o[j] * ra.y; a[2] += o[j] * ra.z; a[3] += o[j] * ra.w; a[4] += o[j] * rb.x; a[5] += o[j] * rb.y; a[6] += o[j] * rb.z; a[7] += o[j] * rb.w; }
            }
        }
        if (ROUTE) {
#pragma unroll
            for (int e = 0; e < 8; ++e) a[e] = wave_sum(a[e]);
            if (lane == 0) {
                int e0 = 0; float v0 = a[0];
#pragma unroll
                for (int e = 1; e < 8; ++e) if (a[e] > v0) { v0 = a[e]; e0 = e; }
                int e1 = 0; float v1 = -3e38f;
#pragma unroll
                for (int e = 0; e < 8; ++e) if (e != e0 && a[e] > v1) { v1 = a[e]; e1 = e; }
                const float ex = fexp(v1 - v0);
                tope[row * 2] = e0; tope[row * 2 + 1] = e1;
                topg[row * 2] = 1.f / (1.f + ex); topg[row * 2 + 1] = ex / (1.f + ex);
                atomicAdd((int*)&lc[e0], 1); atomicAdd((int*)&lc[e1], 1);
            }
        }
    }
    if (ROUTE) { __syncthreads(); if (tid < 8) bcnt[bid * 8 + tid] = lc[tid]; __syncthreads(); }
}

__device__ __forceinline__ void ph_moe_plan(LAS unsigned char* lds, const int* bcnt, const int* tope, int* slot, int* cntoff, const bf16_t* XNB, bf16_t* XG, int G, int bid) {
    const int tid = threadIdx.x;
    LAS int* base = (LAS int*)lds;
    LAS int* sl = base + 8;
    const int rpb = (NL + G - 1) / G, r0 = bid * rpb, r1 = min(NL, r0 + rpb);
    __syncthreads();
    for (int a = tid; a < (r1 - r0) * 2; a += 512) base[48 + 160 + a] = tope[r0 * 2 + a];
    if (tid < 8) { base[16 + tid] = 0; base[32 + tid] = 0; }
    __syncthreads();
    for (int bq = tid; bq < G; bq += 512) { const int4 c0 = *(const int4*)(bcnt + bq * 8), c1 = *(const int4*)(bcnt + bq * 8 + 4);
        const int cv[8] = {c0.x, c0.y, c0.z, c0.w, c1.x, c1.y, c1.z, c1.w};
#pragma unroll
        for (int e = 0; e < 8; ++e) { atomicAdd((int*)&base[16 + e], cv[e]); if (bq < bid) atomicAdd((int*)&base[32 + e], cv[e]); } }
    __syncthreads();
    if (tid == 0) {
        int off = 0;
        for (int e = 0; e < 8; ++e) { const int tot = base[16 + e]; base[e] = off + base[32 + e]; if (bid == 0) { cntoff[e] = tot; cntoff[8 + e] = off; } off += (tot + 255) & ~255; }
        int cur[8];
#pragma unroll
        for (int e = 0; e < 8; ++e) cur[e] = base[e];
        for (int a = r0 * 2; a < r1 * 2; ++a) { const int e = base[48 + 160 + a - r0 * 2]; int s = 0;
#pragma unroll
            for (int q = 0; q < 8; ++q) if (e == q) { s = cur[q]; cur[q]++; }
            slot[a] = s; base[48 + a - r0 * 2] = s; }
    }
    __syncthreads();
    const int na = (r1 - r0) * 2;
    for (int i = tid; i < na * 128; i += 512) { const int a = i >> 7, c16 = i & 127; const int s = base[48 + a], row = r0 + (a >> 1);
        *(u32x4*)((unsigned char*)XG + (size_t)s * D + c16 * 16) = *(const u32x4*)((const unsigned char*)XNB + (size_t)row * D + c16 * 16); }
    __syncthreads();
}

__device__ __forceinline__ void ph_ln_transpose(LAS unsigned char* lds, const float* VG, const float* lnw, const float* lnb, bf16_t* VT, int G, int bid) {
    const int tid = threadIdx.x, wave = tid >> 6, lane = tid & 63;
    LAS bf16_t* T = (LAS bf16_t*)lds;
    for (int unit = bid; unit < NL / 32; unit += G) {
        const int row0 = unit * 32;
        __syncthreads();
        for (int rr = wave; rr < 32; rr += 8) {
            const float* src = VG + (size_t)(row0 + rr) * D;
            float v[32]; float s = 0.f;
#pragma unroll
            for (int i = 0; i < 8; ++i) { const float4 x = *(const float4*)(src + i * 256 + lane * 4); v[i * 4] = x.x; v[i * 4 + 1] = x.y; v[i * 4 + 2] = x.z; v[i * 4 + 3] = x.w; s += (x.x + x.y) + (x.z + x.w); }
            const float mu = wave_sum(s) * (1.f / 2048.f);
            float q = 0.f;
#pragma unroll
            for (int i = 0; i < 32; ++i) { const float dd = v[i] - mu; q += dd * dd; }
            const float rs = rsqrtf(wave_sum(q) * (1.f / 2048.f) + 1e-5f);
#pragma unroll
            for (int i = 0; i < 8; ++i) { const int c = i * 256 + lane * 4;
                const float4 w4 = *(const float4*)(lnw + c), b4 = *(const float4*)(lnb + c);
                u32x2 w; w.x = cvt_pk_bf16((v[i * 4] - mu) * rs * w4.x + b4.x, (v[i * 4 + 1] - mu) * rs * w4.y + b4.y);
                w.y = cvt_pk_bf16((v[i * 4 + 2] - mu) * rs * w4.z + b4.z, (v[i * 4 + 3] - mu) * rs * w4.w + b4.w);
                *(LAS u32x2*)(T + rr * 2048 + c) = w; }
        }
        __syncthreads();
        const int b = row0 / SEQ, n = (row0 % SEQ) / 128, q0 = row0 % 128;
        for (int it = tid; it < 1024 * 4; it += 512) {
            const int qg = it & 3, cp = it >> 2, c = cp * 2;
            unsigned e[8];
#pragma unroll
            for (int j = 0; j < 8; ++j) e[j] = *(const LAS unsigned*)(T + (qg * 8 + j) * 2048 + c);
            u32x4 w0, w1;
            w0.x = (e[0] & 0xffffu) | (e[1] << 16); w0.y = (e[2] & 0xffffu) | (e[3] << 16); w0.z = (e[4] & 0xffffu) | (e[5] << 16); w0.w = (e[6] & 0xffffu) | (e[7] << 16);
            w1.x = (e[0] >> 16) | (e[1] & 0xffff0000u); w1.y = (e[2] >> 16) | (e[3] & 0xffff0000u); w1.z = (e[4] >> 16) | (e[5] & 0xffff0000u); w1.w = (e[6] >> 16) | (e[7] & 0xffff0000u);
            const int g = c >> 7, cl = c & 127;
            bf16_t* dst = VT + ((((size_t)(b * 32 + n) * 16 + g) * 128 + cl) * 128 + q0 + qg * 8);
            *(u32x4*)dst = w0; *(u32x4*)(dst + 128) = w1;
        }
    }
    __syncthreads();
}

__device__ __forceinline__ void ph_spatial(const bf16_t* WS, const bf16_t* VT, const bf16_t* U, const float* bs, bf16_t* GATED, int G, int bid) {
    typedef float f32x16 __attribute__((ext_vector_type(16)));
    const int tid = threadIdx.x, wave = tid >> 6, lane = tid & 63, l32 = lane & 31, half = lane >> 5;
    const int p0 = (wave & 3) * 32, c0 = (wave >> 2) * 64;
    for (int unit = bid; unit < NB * 32 * 16; unit += G) {
        const int g = unit & 15, bn = unit >> 4;
        const bf16_t* Wp = WS + (size_t)g * 128 * 128 + (size_t)(p0 + l32) * 128 + half * 8;
        const bf16_t* Vp = VT + ((size_t)bn * 16 + g) * 128 * 128 + (size_t)(c0 + l32) * 128 + half * 8;
        f32x16 acc0, acc1;
#pragma unroll
        for (int i = 0; i < 16; ++i) { acc0[i] = 0.f; acc1[i] = 0.f; }
#pragma unroll
        for (int ks = 0; ks < 8; ++ks) {
            const bf16x8 w = *(const bf16x8*)(Wp + ks * 16), v0 = *(const bf16x8*)(Vp + ks * 16), v1 = *(const bf16x8*)(Vp + 32 * 128 + ks * 16);
            acc0 = __builtin_amdgcn_mfma_f32_32x32x16_bf16(v0, w, acc0, 0, 0, 0);
            acc1 = __builtin_amdgcn_mfma_f32_32x32x16_bf16(v1, w, acc1, 0, 0, 0);
        }
        const int p = p0 + l32;
        const float bias = bs[g * 128 + p];
        const size_t ob = (size_t)(bn * 128 + p) * D + g * 128 + c0 + 4 * half;
#pragma unroll
        for (int i4 = 0; i4 < 4; ++i4) {
#pragma unroll
            for (int hb = 0; hb < 2; ++hb) {
                const size_t o = ob + hb * 32 + 8 * i4;
                const u32x2 uu = *(const u32x2*)(U + o);
                const float u0 = __uint_as_float(uu.x << 16), u1 = __uint_as_float(uu.x & 0xffff0000u), u2 = __uint_as_float(uu.y << 16), u3 = __uint_as_float(uu.y & 0xffff0000u);
                const f32x16& a = hb == 0 ? acc0 : acc1;
                u32x2 w; w.x = cvt_pk_bf16(u0 * (a[i4 * 4] + bias), u1 * (a[i4 * 4 + 1] + bias)); w.y = cvt_pk_bf16(u2 * (a[i4 * 4 + 2] + bias), u3 * (a[i4 * 4 + 3] + bias));
                *(u32x2*)(GATED + o) = w;
            }
        }
    }
}

__device__ __forceinline__ void ph_final(const float* H, const bf16_t* OUT2, const int* slot, const float* topg, const float* g2, const float* fnorm, float* out, int G, int bid) {
    const int tid = threadIdx.x, wave = tid >> 6, lane = tid & 63;
    float fn[32], gv[32]; int cur_b = -1;
#pragma unroll
    for (int i = 0; i < 8; ++i) { const float4 f = *(const float4*)(fnorm + i * 256 + lane * 4); fn[i * 4] = f.x; fn[i * 4 + 1] = f.y; fn[i * 4 + 2] = f.z; fn[i * 4 + 3] = f.w; }
    for (int row = bid * 8 + wave; row < NL; row += G * 8) {
        const int s0 = slot[row * 2], s1 = slot[row * 2 + 1]; const float g0 = topg[row * 2], g1 = topg[row * 2 + 1];
        const float* h = H + (size_t)row * D; const bf16_t* o0 = OUT2 + (size_t)s0 * D; const bf16_t* o1 = OUT2 + (size_t)s1 * D;
        const int bb = row / SEQ;
        if (bb != cur_b) { cur_b = bb; const float* gg = g2 + (size_t)bb * NMOD;
#pragma unroll
            for (int i = 0; i < 8; ++i) { const float4 g = *(const float4*)(gg + i * 256 + lane * 4); gv[i * 4] = g.x; gv[i * 4 + 1] = g.y; gv[i * 4 + 2] = g.z; gv[i * 4 + 3] = g.w; } }
        float v[32]; float ss = 0.f;
#pragma unroll
        for (int i = 0; i < 8; ++i) { const int c = i * 256 + lane * 4;
            const float4 hv = *(const float4*)(h + c); const u32x2 a = *(const u32x2*)(o0 + c), b = *(const u32x2*)(o1 + c);
            const float a0 = __uint_as_float(a.x << 16), a1 = __uint_as_float(a.x & 0xffff0000u), a2 = __uint_as_float(a.y << 16), a3 = __uint_as_float(a.y & 0xffff0000u);
            const float b0 = __uint_as_float(b.x << 16), b1 = __uint_as_float(b.x & 0xffff0000u), b2 = __uint_as_float(b.y << 16), b3 = __uint_as_float(b.y & 0xffff0000u);
            v[i * 4] = hv.x + gv[i * 4] * (g0 * a0 + g1 * b0); v[i * 4 + 1] = hv.y + gv[i * 4 + 1] * (g0 * a1 + g1 * b1);
            v[i * 4 + 2] = hv.z + gv[i * 4 + 2] * (g0 * a2 + g1 * b2); v[i * 4 + 3] = hv.w + gv[i * 4 + 3] * (g0 * a3 + g1 * b3);
            ss += v[i * 4] * v[i * 4] + v[i * 4 + 1] * v[i * 4 + 1] + v[i * 4 + 2] * v[i * 4 + 2] + v[i * 4 + 3] * v[i * 4 + 3]; }
        const float rs = rsqrtf(wave_sum(ss) * (1.f / D) + 1e-6f);
#pragma unroll
        for (int i = 0; i < 8; ++i) { const int c = i * 256 + lane * 4;
            *(float4*)(out + (size_t)row * D + c) = (float4){v[i * 4] * rs * fn[i * 4], v[i * 4 + 1] * rs * fn[i * 4 + 1], v[i * 4 + 2] * rs * fn[i * 4 + 2], v[i * 4 + 3] * rs * fn[i * 4 + 3]}; }
    }
}

__device__ __forceinline__ void ph_ada(LAS unsigned char* lds, const float* W0, const float* W1, const float* b0, const float* b1, const float* c, const float* cc, float* mod0, float* mod1, int G, int bid) {
    const int tid = threadIdx.x, kq = tid / 24, c4 = tid % 24;
    LAS float* red = (LAS float*)lds;
    for (int u = bid; u < 256; u += G) {
        const int l = u >> 7, col0 = (u & 127) * 96;
        const float* W = (l == 0 ? W0 : W1) + col0 + c4 * 4;
        float a[12];
#pragma unroll
        for (int j = 0; j < 12; ++j) a[j] = 0.f;
        if (kq < 21) {
#pragma unroll 7
            for (int k = kq; k < D; k += 21) {
                const float4 w = *(const float4*)(W + (size_t)k * NMOD);
                const float x0 = c[k], x1 = c[D + k], x2 = cc[k];
                const float s0 = x0 * fsigmoid(x0), s1 = x1 * fsigmoid(x1), s2 = x2 * fsigmoid(x2);
                a[0] += s0 * w.x; a[1] += s0 * w.y; a[2] += s0 * w.z; a[3] += s0 * w.w;
                a[4] += s1 * w.x; a[5] += s1 * w.y; a[6] += s1 * w.z; a[7] += s1 * w.w;
                a[8] += s2 * w.x; a[9] += s2 * w.y; a[10] += s2 * w.z; a[11] += s2 * w.w;
            }
        }
        __syncthreads();
        if (kq < 21) {
#pragma unroll
            for (int j = 0; j < 12; ++j) red[(kq * 24 + c4) * 12 + j] = a[j];
        }
        __syncthreads();
        if (tid < 288) {
            const int cq = tid / 12, rj = tid % 12, row = rj >> 2, j = rj & 3, n = col0 + cq * 4 + j;
            float sum = (l == 0 ? b0 : b1)[n];
            for (int q = 0; q < 21; ++q) sum += red[(q * 24 + cq) * 12 + rj];
            if (!(l == 1 && row == 2)) (l == 0 ? mod0 : mod1)[(size_t)row * NMOD + n] = sum;
        }
    }
    __syncthreads();
}


__device__ __forceinline__ void ph_small_cvt(const float* w_up, const float* a_up, const float* g_up, bf16_t* WLORA, float* ropec, float* ropes, int G, int bid) {
    const int gt = bid * 512 + threadIdx.x, gs = G * 512;
    if (gt < 16) {
        const double x = (double)rope_inv(gt), x2 = x * x;
        double sn = x * (1.0 + x2 * (-1.0 / 6 + x2 * (1.0 / 120 + x2 * (-1.0 / 5040 + x2 * (1.0 / 362880 + x2 * (-1.0 / 39916800 + x2 * (1.0 / 6227020800.0)))))));
        double cs = 1.0 + x2 * (-0.5 + x2 * (1.0 / 24 + x2 * (-1.0 / 720 + x2 * (1.0 / 40320 + x2 * (-1.0 / 3628800 + x2 * (1.0 / 479001600.0 + x2 * (-1.0 / 87178291200.0)))))));
        double c = 1.0, s_ = 0.0;
        for (int pos = 0; pos < 64; ++pos) { ropec[pos * 16 + gt] = (float)c; ropes[pos * 16 + gt] = (float)s_; const double nc = c * cs - s_ * sn, ns = s_ * cs + c * sn; c = nc; s_ = ns; }
    }
    for (int i = gt; i < 5120 * 64; i += gs) {
        const int n = i >> 6, k0 = (i & 63) * 8, g = n >> 10, ch = n & 1023;
        float v[8];
#pragma unroll
        for (int q = 0; q < 8; ++q) { const int k = k0 + q; float x = 0.f;
            if (g < 4) { const int koff = g * 64; if (k >= koff && k < koff + 64) x = (g < 2 ? w_up : a_up)[(size_t)((g & 1) * 64 + (k - koff)) * RD + ch]; }
            else { if (k >= 256 && k < 416) x = g_up[(size_t)(k - 256) * RD + ch]; }
            v[q] = x; }
        u32x4 w; w.x = cvt_pk_bf16(v[0], v[1]); w.y = cvt_pk_bf16(v[2], v[3]); w.z = cvt_pk_bf16(v[4], v[5]); w.w = cvt_pk_bf16(v[6], v[7]);
        *(u32x4*)(WLORA + (size_t)n * 512 + k0) = w;
    }
}
struct MapKV { const float* src; int sel;
    __device__ __forceinline__ const float* operator()(int n0) const { const int h = n0 >> 7, d = n0 & 127; return src + h * 256 + sel * 128 + d; } __device__ __forceinline__ int stride() const { return KVW; } __device__ __forceinline__ bool valid(int) const { return true; } };

__device__ __forceinline__ void ph_prep(const float* Z, const float* qn, const float* kvn, const float* mup, const float* mun, const float* k_k,
                                        bf16_t* CQNB, bf16_t* CKVNB, bf16_t* KRB, bf16_t* LA, float* RR, float* KRf, float* VR, float* AA, const float* ropec, const float* ropes, int G, int bid) {
    const int wave = threadIdx.x >> 6, lane = threadIdx.x & 63;
    for (int row = bid * 8 + wave; row < MALL; row += G * 8) {
        const float* z = Z + (size_t)row * ZLD;
        int t, len; if (row < NL) { t = row % SEQ; len = SEQ; } else { t = (row - NL) % CTX; len = CTX; }
#pragma unroll
        for (int part = 0; part < 2; ++part) {
            const float4 a = *(const float4*)(z + part * 512 + lane * 8), b = *(const float4*)(z + part * 512 + lane * 8 + 4);
            float ss = a.x * a.x + a.y * a.y + a.z * a.z + a.w * a.w + b.x * b.x + b.y * b.y + b.z * b.z + b.w * b.w;
            ss = wave_sum(ss);
            const float rs = rsqrtf(ss * (1.f / 512.f) + 1e-6f);
            const float* gn = (part == 0 ? qn : kvn) + lane * 8;
            const float4 g0 = *(const float4*)gn, g1 = *(const float4*)(gn + 4);
            u32x4 w; w.x = cvt_pk_bf16(a.x * rs * g0.x, a.y * rs * g0.y); w.y = cvt_pk_bf16(a.z * rs * g0.z, a.w * rs * g0.w);
            w.z = cvt_pk_bf16(b.x * rs * g1.x, b.y * rs * g1.y); w.w = cvt_pk_bf16(b.z * rs * g1.z, b.w * rs * g1.w);
            *(u32x4*)((part == 0 ? CQNB : CKVNB) + (size_t)row * 512 + lane * 8) = w;
        }
        {
            const float val = z[1024 + lane]; const float oth = __shfl_xor(val, 16);
            float o = val;
            if (row < NL) {
                const int a = lane >> 5, hf = (lane >> 4) & 1, f = lane & 15;
                const int pos = a == 0 ? (t >> 6) : (t & 63);
                const float cs = ropec[pos * 16 + f], sn = ropes[pos * 16 + f];
                o = hf == 0 ? val * cs - oth * sn : val * cs + oth * sn;
            }
            KRB[(size_t)row * KLD + 1024 + lane] = (bf16_t)(cvt_pk_bf16(o, 0.f) & 0xffffu);
        }
        const float* zc = z + MLA_IN; const float* zp = zc - ZLD; const float* zn = zc + ZLD;
        const bool hp = t > 0, hn = t < len - 1;
#define SHIFT4(jj) ({ const int j_ = (jj); const f32x4 zz = *(const f32x4*)(zc + j_), mp = *(const f32x4*)(mup + j_), mn = *(const f32x4*)(mun + j_); \
            f32x4 pv = {0.f, 0.f, 0.f, 0.f}, nv = pv; if (hp) pv = *(const f32x4*)(zp + j_); if (hn) nv = *(const f32x4*)(zn + j_); zz + mp * (pv - zz) + mn * (nv - zz); })
        { f32x4 a0 = SHIFT4(lane * 4), a1 = SHIFT4((lane + 64) * 4), a2 = SHIFT4((lane + 128) * 4), a3 = SHIFT4((lane + 192) * 4);
          float* dst = RR + hmi(row, lane * 4); *(f32x4*)dst = a0; *(f32x4*)(dst + (size_t)4 * MALL * 64) = a1; *(f32x4*)(dst + (size_t)8 * MALL * 64) = a2; *(f32x4*)(dst + (size_t)12 * MALL * 64) = a3; }
        { f32x4 k[4]; k[0] = SHIFT4(1024 + lane * 4); k[1] = SHIFT4(1024 + (lane + 64) * 4); k[2] = SHIFT4(1024 + (lane + 128) * 4); k[3] = SHIFT4(1024 + (lane + 192) * 4);
#pragma unroll
          for (int i = 0; i < 4; ++i) { const int c = (lane + 64 * i) * 4;
            *(f32x4*)(KRf + hmi(row, c)) = k[i];
            const f32x4 kk = k[i] * *(const f32x4*)(k_k + c);
            float q = kk[0] * kk[0] + kk[1] * kk[1] + kk[2] * kk[2] + kk[3] * kk[3];
            q += __shfl_xor(q, 1); q += __shfl_xor(q, 2); q += __shfl_xor(q, 4); q += __shfl_xor(q, 8);
            const float inv = -1.0f / fmaxf(sqrtf(q), 1e-12f);
            *(f32x4*)(AA + hmi(row, c)) = kk * inv; } }
        { f32x4 a0 = SHIFT4(2048 + lane * 4), a1 = SHIFT4(2048 + (lane + 64) * 4), a2 = SHIFT4(2048 + (lane + 128) * 4), a3 = SHIFT4(2048 + (lane + 192) * 4);
          float* dst = VR + hmi(row, lane * 4); *(f32x4*)dst = a0; *(f32x4*)(dst + (size_t)4 * MALL * 64) = a1; *(f32x4*)(dst + (size_t)8 * MALL * 64) = a2; *(f32x4*)(dst + (size_t)12 * MALL * 64) = a3; }
        {
            const int c0 = lane * 8; f32x4 x0 = {0.f, 0.f, 0.f, 0.f}, x1 = x0;
            if (c0 < 416) { x0 = SHIFT4(3072 + c0); x1 = SHIFT4(3072 + c0 + 4); }
            float o[8];
#pragma unroll
            for (int q = 0; q < 4; ++q) { o[q] = c0 < 128 ? ftanh(x0[q]) : c0 < 256 ? x0[q] : c0 < 416 ? fsigmoid(x0[q]) : 0.f; o[4 + q] = c0 < 128 ? ftanh(x1[q]) : c0 < 256 ? x1[q] : c0 < 416 ? fsigmoid(x1[q]) : 0.f; }
            u32x4 w; w.x = cvt_pk_bf16(o[0], o[1]); w.y = cvt_pk_bf16(o[2], o[3]); w.z = cvt_pk_bf16(o[4], o[5]); w.w = cvt_pk_bf16(o[6], o[7]);
            *(u32x4*)(LA + (size_t)row * 512 + c0) = w;
        }
#undef SHIFT4
    }
}

struct EpiLora { static constexpr bool PERM = false; const float* w0; const float* a0; const float* k_a; const float* KRf; const float* AA; float* WW; float* KD; float* BD; float* GG; int pn0;
    __device__ __forceinline__ void operator()(AccRef acc, const Unit& u, int wr, int wc, int fr, int fq) const {
        const int png = u.pn + pn0, g = __builtin_amdgcn_readfirstlane(png >> 2), row0 = u.pm * 256 + wr * 64 + fr, ch0 = (png & 3) * 256 + wc * 32 + 4 * fq;
        if (g < 2) {
            f32x4 bb[2][2];
#pragma unroll
            for (int bj = 0; bj < 2; ++bj)
#pragma unroll
                for (int n = 0; n < 2; ++n) bb[bj][n] = *(const f32x4*)(w0 + g * RD + ch0 + bj * 128 + n * 16);
            float* dstp = WW + (size_t)g * MALL * RD;
#pragma unroll
            for (int ai = 0; ai < 2; ++ai)
#pragma unroll
                for (int m = 0; m < 4; ++m) { const int row = row0 + ai * 128 + m * 16;
#pragma unroll
                    for (int bj = 0; bj < 2; ++bj)
#pragma unroll
                        for (int n = 0; n < 2; ++n) { const size_t e = hmi(row, ch0 + bj * 128 + n * 16); const f32x4 v = acc[ai][bj][m][n], b = bb[bj][n]; f32x4 o;
#pragma unroll
                            for (int j = 0; j < 4; ++j) { const float y = -(b[j] + v[j]); const float sp = fmaxf(y, 0.f) + flog(1.0f + fexp(-fabsf(y))); o[j] = fexp(-fexp(-sp - 0.5f)); }
                            *(f32x4*)(dstp + e) = o; } }
        } else if (g < 4) {
            const int d = g - 2;
            f32x4 bb[2][2], ka[2][2];
#pragma unroll
            for (int bj = 0; bj < 2; ++bj)
#pragma unroll
                for (int n = 0; n < 2; ++n) { bb[bj][n] = *(const f32x4*)(a0 + d * RD + ch0 + bj * 128 + n * 16); ka[bj][n] = *(const f32x4*)(k_a + ch0 + bj * 128 + n * 16); }
            float* kdp = KD + (size_t)d * MALL * RD; float* bdp = BD + (size_t)d * MALL * RD;
#pragma unroll
            for (int ai = 0; ai < 2; ++ai)
#pragma unroll
                for (int m = 0; m < 4; ++m) {
                    f32x4 kv[2][2], aa[2][2];
#pragma unroll
                    for (int bj = 0; bj < 2; ++bj)
#pragma unroll
                        for (int n = 0; n < 2; ++n) { const size_t e = hmi(row0 + ai * 128 + m * 16, ch0 + bj * 128 + n * 16); kv[bj][n] = *(const f32x4*)(KRf + e); aa[bj][n] = *(const f32x4*)(AA + e); }
#pragma unroll
                    for (int bj = 0; bj < 2; ++bj)
#pragma unroll
                        for (int n = 0; n < 2; ++n) { const size_t e = hmi(row0 + ai * 128 + m * 16, ch0 + bj * 128 + n * 16); const f32x4 v = acc[ai][bj][m][n]; f32x4 okd, obd;
#pragma unroll
                            for (int j = 0; j < 4; ++j) { const float ic = fsigmoid(bb[bj][n][j] + v[j]); okd[j] = kv[bj][n][j] * (1.f + (ic - 1.f) * ka[bj][n][j]); obd[j] = -ic * aa[bj][n][j]; }
                            *(f32x4*)(kdp + e) = okd; *(f32x4*)(bdp + e) = obd; }
                }
        } else {
#pragma unroll
            for (int ai = 0; ai < 2; ++ai)
#pragma unroll
                for (int m = 0; m < 4; ++m)
#pragma unroll
                    for (int bj = 0; bj < 2; ++bj)
#pragma unroll
                        for (int n = 0; n < 2; ++n) *(f32x4*)(GG + hmi(row0 + ai * 128 + m * 16, ch0 + bj * 128 + n * 16)) = acc[ai][bj][m][n];
        }
    } };
struct EpiQ { static constexpr bool PERM = false; bf16_t* QB; const float* ropec; const float* ropes;
    __device__ __forceinline__ void operator()(AccRef acc, const Unit& u, int wr, int wc, int fr, int fq) const {
        const float qs = 0.07216878364870322f * 1.4426950408889634f;
        const int row0 = u.pm * 256 + wr * 64 + fr;
#pragma unroll
        for (int bj = 0; bj < 2; ++bj) {
            const int cg = u.pn * 256 + bj * 128 + wc * 32, part = (cg >> 5) % 6;
#pragma unroll
            for (int ai = 0; ai < 2; ++ai)
#pragma unroll
                for (int m = 0; m < 4; ++m) { const int row = row0 + ai * 128 + m * 16, t = row & (SEQ - 1);
                    f32x4 x1 = acc[ai][bj][m][0], x2 = acc[ai][bj][m][1];
                    if (part >= 4) { const int pos = part == 4 ? (t >> 6) : (t & 63);
                        const f32x4 c = *(const f32x4*)(ropec + pos * 16 + 4 * fq), sn = *(const f32x4*)(ropes + pos * 16 + 4 * fq);
                        const f32x4 o1 = x1 * c - x2 * sn, o2 = x2 * c + x1 * sn; x1 = o1; x2 = o2; }
                    x1 = x1 * qs; x2 = x2 * qs;
                    bf16_t* dst = QB + (size_t)row * QW + cg + 4 * fq;
                    u32x2 w1, w2; w1.x = cvt_pk_bf16(x1[0], x1[1]); w1.y = cvt_pk_bf16(x1[2], x1[3]); w2.x = cvt_pk_bf16(x2[0], x2[1]); w2.y = cvt_pk_bf16(x2[2], x2[3]);
                    *(u32x2*)dst = w1; *(u32x2*)(dst + 16) = w2; }
        }
    } };
struct EpiBf16 { static constexpr bool PERM = true; bf16_t* O; int ldo;
    __device__ __forceinline__ void operator()(AccRef acc, const Unit& u, int wr, int wc, int fr, int fq) const {
        const int row0 = u.pm * 256 + wr * 64 + fr, col0 = u.pn * 256 + wc * 32 + 8 * fq;
#pragma unroll
        for (int ai = 0; ai < 2; ++ai)
#pragma unroll
            for (int m = 0; m < 4; ++m) { bf16_t* rowp = O + (size_t)(row0 + ai * 128 + m * 16) * ldo + col0;
#pragma unroll
                for (int bj = 0; bj < 2; ++bj) { const f32x4 v0 = acc[ai][bj][m][0], v1 = acc[ai][bj][m][1];
                    u32x4 w; w.x = cvt_pk_bf16(v0[0], v0[1]); w.y = cvt_pk_bf16(v0[2], v0[3]); w.z = cvt_pk_bf16(v1[0], v1[1]); w.w = cvt_pk_bf16(v1[2], v1[3]);
                    *(u32x4*)(rowp + bj * 128) = w; } }
    } };
struct EpiVT { static constexpr bool PERM = false; bf16_t* VT;
    __device__ __forceinline__ void operator()(AccRef acc, const Unit& u, int wr, int wc, int fr, int fq) const {
        const int row0 = u.pm * 256 + wr * 64 + fr, pq = ((fq & 1) << 1) | (fq >> 1), col0 = u.pn * 256 + wc * 32 + 4 * pq;
#pragma unroll
        for (int ai = 0; ai < 2; ++ai)
#pragma unroll
            for (int m = 0; m < 4; ++m) { bf16_t* rowp = VT + (size_t)(row0 + ai * 128 + m * 16) * MALL + col0;
#pragma unroll
                for (int bj = 0; bj < 2; ++bj)
#pragma unroll
                    for (int n = 0; n < 2; ++n) { const f32x4 v = acc[ai][bj][m][n]; u32x2 w; w.x = cvt_pk_bf16(v[0], v[1]); w.y = cvt_pk_bf16(v[2], v[3]); *(u32x2*)(rowp + bj * 128 + n * 16) = w; } }
    } };

__device__ __forceinline__ void ph_attn(LAS unsigned char* lds, const bf16_t* QB, const bf16_t* KNB, const bf16_t* VTB, bf16_t* MIXB, int G, int bid) {
    typedef float f32x16 __attribute__((ext_vector_type(16)));
    constexpr int KP = 400, VP = 144, KBYTES = 64 * KP, BUF = KBYTES + 128 * VP, NT = SK / 64;
    const int tid = threadIdx.x, wave = tid >> 6, lane = tid & 63, l32 = lane & 31, half = lane >> 5;
    for (int unit = bid; unit < NB * HM * (SEQ / 256); unit += G) {
        const int bh = unit & 15, qb = unit >> 4, b = bh >> 3, h = bh & 7;
        const int qrow = b * SEQ + qb * 256 + wave * 32 + l32;
        bf16x8 qf[12];
#pragma unroll
        for (int ks = 0; ks < 12; ++ks) qf[ks] = *(const bf16x8*)(QB + (size_t)qrow * QW + h * 192 + ks * 16 + half * 8);
        f32x16 o[4];
#pragma unroll
        for (int d = 0; d < 4; ++d)
#pragma unroll
            for (int i = 0; i < 16; ++i) o[d][i] = 0.f;
        float mrun = -1e30f, lrun = 0.f;
        int ko[3], kd[3], vo[2], vd[2];
#pragma unroll
        for (int i = 0; i < 3; ++i) { const int id = tid + 512 * i, key = id / 24, cc = id % 24;
            ko[i] = key * KLD + (cc < 16 ? h * 128 + cc * 8 : 1024 + (cc - 16) * 8); kd[i] = key * KP + cc * 16; }
#pragma unroll
        for (int i = 0; i < 2; ++i) { const int id = tid + 512 * i, dv = id >> 3, cc = id & 7;
            vo[i] = (h * 128 + dv) * MALL + cc * 8; vd[i] = KBYTES + dv * VP + cc * 16; }
        u32x4 kr_[3], vr_[2];
        __syncthreads();
        {   const int trow = NL + b * CTX;
#pragma unroll
            for (int i = 0; i < 3; ++i) kr_[i] = *(const u32x4*)(KNB + (size_t)(ko[i] + trow * KLD));
#pragma unroll
            for (int i = 0; i < 2; ++i) vr_[i] = *(const u32x4*)(VTB + (size_t)(vo[i] + trow));
#pragma unroll
            for (int i = 0; i < 3; ++i) *(LAS u32x4*)(lds + kd[i]) = kr_[i];
#pragma unroll
            for (int i = 0; i < 2; ++i) *(LAS u32x4*)(lds + vd[i]) = vr_[i];
        }
        __syncthreads();
        for (int j = 0; j < NT; ++j) {
            LAS unsigned char* cb = lds + (j & 1) * BUF;
            if (j + 1 < NT) {
                const int jn = j + 1, trow = jn < 4 ? NL + b * CTX + 64 * jn : b * SEQ + 64 * (jn - 4);
#pragma unroll
                for (int i = 0; i < 3; ++i) kr_[i] = *(const u32x4*)(KNB + (size_t)(ko[i] + trow * KLD));
#pragma unroll
                for (int i = 0; i < 2; ++i) vr_[i] = *(const u32x4*)(VTB + (size_t)(vo[i] + trow));
            }
            f32x16 s0, s1;
#pragma unroll
            for (int i = 0; i < 16; ++i) { s0[i] = 0.f; s1[i] = 0.f; }
#pragma unroll
            for (int ks = 0; ks < 12; ++ks) {
                const bf16x8 a0 = *(const LAS bf16x8*)(cb + l32 * KP + ks * 32 + half * 16), a1 = *(const LAS bf16x8*)(cb + (32 + l32) * KP + ks * 32 + half * 16);
                s0 = __builtin_amdgcn_mfma_f32_32x32x16_bf16(a0, qf[ks], s0, 0, 0, 0);
                s1 = __builtin_amdgcn_mfma_f32_32x32x16_bf16(a1, qf[ks], s1, 0, 0, 0);
            }
            float mx = s0[0];
#pragma unroll
            for (int i = 1; i < 16; ++i) mx = fmaxf(mx, s0[i]);
#pragma unroll
            for (int i = 0; i < 16; ++i) mx = fmaxf(mx, s1[i]);
            mx = fmaxf(mx, __shfl_xor(mx, 32));
            const float mn = fmaxf(mrun, mx);
            const float alpha = __builtin_amdgcn_exp2f(mrun - mn);
            mrun = mn;
            float ps = 0.f;
#pragma unroll
            for (int i = 0; i < 16; ++i) { s0[i] = __builtin_amdgcn_exp2f(s0[i] - mn); s1[i] = __builtin_amdgcn_exp2f(s1[i] - mn); ps += s0[i] + s1[i]; }
            lrun = lrun * alpha + ps;
#pragma unroll
            for (int d = 0; d < 4; ++d)
#pragma unroll
                for (int i = 0; i < 16; ++i) o[d][i] *= alpha;
            bf16x8 pf[4];
#pragma unroll
            for (int s = 0; s < 4; ++s) {
                u32x4 w;
                if (s < 2) { const int i0 = (s & 1) * 8; w.x = cvt_pk_bf16(s0[i0], s0[i0 + 1]); w.y = cvt_pk_bf16(s0[i0 + 2], s0[i0 + 3]); w.z = cvt_pk_bf16(s0[i0 + 4], s0[i0 + 5]); w.w = cvt_pk_bf16(s0[i0 + 6], s0[i0 + 7]); }
                else { const int i0 = (s & 1) * 8; w.x = cvt_pk_bf16(s1[i0], s1[i0 + 1]); w.y = cvt_pk_bf16(s1[i0 + 2], s1[i0 + 3]); w.z = cvt_pk_bf16(s1[i0 + 4], s1[i0 + 5]); w.w = cvt_pk_bf16(s1[i0 + 6], s1[i0 + 7]); }
                pf[s] = __builtin_bit_cast(bf16x8, w);
            }
#pragma unroll
            for (int s = 0; s < 4; ++s)
#pragma unroll
                for (int d = 0; d < 4; ++d) {
                    const bf16x8 vf = *(const LAS bf16x8*)(cb + KBYTES + (32 * d + l32) * VP + s * 32 + half * 16);
                    o[d] = __builtin_amdgcn_mfma_f32_32x32x16_bf16(vf, pf[s], o[d], 0, 0, 0);
                }
            if (j + 1 < NT) {
                LAS unsigned char* nb = lds + ((j + 1) & 1) * BUF;
#pragma unroll
                for (int i = 0; i < 3; ++i) *(LAS u32x4*)(nb + kd[i]) = kr_[i];
#pragma unroll
                for (int i = 0; i < 2; ++i) *(LAS u32x4*)(nb + vd[i]) = vr_[i];
            }
            __syncthreads();
        }
        lrun += __shfl_xor(lrun, 32);
        const float il = 1.0f / lrun;
        bf16_t* dst = MIXB + (size_t)qrow * D + h * 128 + 4 * half;
#pragma unroll
        for (int d = 0; d < 4; ++d)
#pragma unroll
            for (int i4 = 0; i4 < 4; ++i4) { u32x2 w; w.x = cvt_pk_bf16(o[d][i4 * 4] * il, o[d][i4 * 4 + 1] * il); w.y = cvt_pk_bf16(o[d][i4 * 4 + 2] * il, o[d][i4 * 4 + 3] * il);
                *(u32x2*)(dst + 32 * d + 8 * i4) = w; }
    }
    __syncthreads();
}


constexpr int SC_CL = 272, SC_NC = 16;
__device__ __forceinline__ int scan_row(int b, int d, int g) {
    if (g < CTX) return NL + b * CTX + (d == 0 ? g : CTX - 1 - g);
    const int tp = g - CTX; return b * SEQ + (d == 0 ? tp : SEQ - 1 - tp);
}
#define DPP_FMAC(d, a, b, n) asm volatile("v_fmac_f32_dpp %0, %1, %2 row_newbcast:" #n " row_mask:0xf bank_mask:0xf" : "+v"(d) : "v"(a), "v"(b))
#define DPP_MULD(d, a, n)    asm volatile("v_mul_f32_dpp %0, %1, %0 row_newbcast:" #n " row_mask:0xf bank_mask:0xf" : "+v"(d) : "v"(a))
#define SC_FOR16(X) X(0) X(1) X(2) X(3) X(4) X(5) X(6) X(7) X(8) X(9) X(10) X(11) X(12) X(13) X(14) X(15)
struct MoeCv { const float* w1; long d31; const float* w2; unsigned char* W13E; unsigned char* W2E; };
constexpr int CV_PER_WAVE = 336, CV_ITEMS_W13 = 3584, CV_ITEMS_E = 5376, CV_WLDS = 4096;
static_assert((size_t)NE * CV_ITEMS_E * 8 == (size_t)CV_PER_WAVE * 1024, "MoE conversion tiles must split evenly over 1024 waves");
static_assert(4 * 5 * 6144 + 4 * CV_WLDS <= LDS_CTL, "scan rings + conversion images must fit below the LDS control words");
struct CvItem { const float* sp; unsigned char* dst; int ld, K; float sc; };
__device__ __forceinline__ CvItem cv_item(const MoeCv& mc, int it, int cw) {
    const int I = it * 1024 + cw, e = I / CV_ITEMS_E, r = I - e * CV_ITEMS_E;
    CvItem o;
    if (r < CV_ITEMS_W13) { const int kr = r / 224, nt = r - kr * 224, n0 = nt * 64, jj = n0 & 255;
        o.sp = mc.w1 + (jj < 128 ? 0l : mc.d31) + (size_t)e * D * DFF + (size_t)kr * 128 * DFF + (n0 >> 8) * 128 + (jj & 127); o.ld = DFF;
        o.dst = mc.W13E + (size_t)e * 2 * DFF * D + (size_t)n0 * D + kr * 128; o.K = D; o.sc = 64.f; }
    else { const int r2 = r - CV_ITEMS_W13, kr = r2 >> 5, n0 = (r2 & 31) * 64;
        o.sp = mc.w2 + (size_t)e * DFF * D + (size_t)kr * 128 * D + n0; o.ld = D;
        o.dst = mc.W2E + (size_t)e * D * DFF + (size_t)n0 * DFF + kr * 128; o.K = DFF; o.sc = 128.f; }
    return o;
}
__device__ __forceinline__ void moe_cvt_wave(LAS unsigned char* ct, const MoeCv& mc, int cw, int lane) {
    constexpr int NIT = CV_PER_WAVE / 8;
    const int l15 = lane & 15, l4 = lane >> 4;
    f32x4 buf[8][4];
    CvItem cur = cv_item(mc, 0, cw);
    { const float* lp = cur.sp + (size_t)(l4 * cur.ld + l15 * 4);
#pragma unroll
      for (int s = 0; s < 8; ++s)
#pragma unroll
        for (int q = 0; q < 4; ++q) buf[s][q] = *(const f32x4*)(lp + (size_t)(s * 16 + q * 4) * cur.ld); }
#pragma unroll 1
    for (int it = 0; it < NIT; ++it) {
        const CvItem nxt = cv_item(mc, it + 1 < NIT ? it + 1 : NIT - 1, cw);
        const float* lp = nxt.sp + (size_t)(l4 * nxt.ld + l15 * 4);
        unsigned char* dp = cur.dst + (size_t)lane * cur.K;
        const float sc = cur.sc;
        u32x4 wout[8];
#pragma unroll
        for (int s = 0; s < 8; ++s) {
#pragma unroll
            for (int q = 0; q < 4; ++q) *(LAS f32x4*)(ct + q * 1024 + lane * 16) = buf[s][q];
#pragma unroll
            for (int q = 0; q < 4; ++q) buf[s][q] = *(const f32x4*)(lp + (size_t)(s * 16 + q * 4) * nxt.ld);
            float v[16];
#pragma unroll
            for (int j = 0; j < 16; ++j) v[j] = ((const LAS float*)ct)[j * 64 + lane];
            u32x4 w; w.x = pk4_fp8(v[0] * sc, v[1] * sc, v[2] * sc, v[3] * sc); w.y = pk4_fp8(v[4] * sc, v[5] * sc, v[6] * sc, v[7] * sc);
            w.z = pk4_fp8(v[8] * sc, v[9] * sc, v[10] * sc, v[11] * sc); w.w = pk4_fp8(v[12] * sc, v[13] * sc, v[14] * sc, v[15] * sc);
            wout[s] = w;
        }
#pragma unroll
        for (int s = 0; s < 8; ++s) *(u32x4*)(dp + s * 16) = wout[s];
        cur = nxt;
    }
#pragma unroll
    for (int s = 0; s < 8; ++s) asm volatile("" :: "v"(buf[s][0]), "v"(buf[s][1]), "v"(buf[s][2]), "v"(buf[s][3]));
}
constexpr int SC_NSLOT = 5, SC_SLOTB = 6144, SC_WLDS = SC_NSLOT * SC_SLOTB;
#define SC_VSET(P) f32x4 P##av, P##wv, P##bv, P##kv, P##rv; float P##vv
#define SC_READV(P, sl) do { P##av = *(const LAS f32x4*)((sl) + l15 * 16); P##wv = *(const LAS f32x4*)((sl) + 1024 + l15 * 16); P##bv = *(const LAS f32x4*)((sl) + 2048 + l15 * 16); \
            P##kv = *(const LAS f32x4*)((sl) + 3072 + l15 * 16); P##rv = *(const LAS f32x4*)((sl) + 4096 + l15 * 16); P##vv = *(const LAS float*)((sl) + 5120 + lane * 4); } while (0)
#define SC_STEP(P, i) do { \
            float a0 = P##av[0], a1 = P##av[1], a2 = P##av[2], a3 = P##av[3], w0 = P##wv[0], w1 = P##wv[1], w2 = P##wv[2], w3 = P##wv[3], b0 = P##bv[0], b1 = P##bv[1], b2 = P##bv[2], b3 = P##bv[3]; \
            float k0 = P##kv[0], k1 = P##kv[1], k2 = P##kv[2], k3 = P##kv[3], r0 = P##rv[0], r1 = P##rv[1], r2 = P##rv[2], r3 = P##rv[3], vq = P##vv; \
            asm volatile("s_nop 1" : "+v"(a0), "+v"(a1), "+v"(a2), "+v"(a3)); \
            float c0 = 0.f, c1 = 0.f, c2 = 0.f, c3 = 0.f, e0 = 0.f, e1 = 0.f, e2 = 0.f, e3 = 0.f; \
            SC_FOR16(SC_SA) \
            float saq = (c0 + c1) + (c2 + c3), sap = (e0 + e1) + (e2 + e3); \
            asm volatile("s_nop 1" : "+v"(w0), "+v"(w1), "+v"(w2), "+v"(w3), "+v"(b0), "+v"(b1), "+v"(b2), "+v"(b3), "+v"(saq), "+v"(sap)); \
            SC_FOR16(SC_UP) \
            asm volatile("s_nop 1" : "+v"(k0), "+v"(k1), "+v"(k2), "+v"(k3), "+v"(vq)); \
            SC_FOR16(SC_VK) \
            if (gbase + (i) >= CTX) { \
                float y0 = 0.f, y1 = 0.f, y2 = 0.f, y3 = 0.f, z0 = 0.f, z1 = 0.f, z2 = 0.f, z3 = 0.f; \
                asm volatile("s_nop 1" : "+v"(r0), "+v"(r1), "+v"(r2), "+v"(r3)); \
                SC_FOR16(SC_Y) \
                const size_t yo_ = (size_t)scan_row(b, d, gbase + (i)) * 64; \
                ypq[yo_ + lane] = (y0 + y1) + (y2 + y3); ypp[yo_ + lane] = (z0 + z1) + (z2 + z3); \
            } } while (0)
#define SC_SA(n) DPP_FMAC(c0, a0, SQ[4 * n], n); DPP_FMAC(c1, a1, SQ[4 * n + 1], n); DPP_FMAC(c2, a2, SQ[4 * n + 2], n); DPP_FMAC(c3, a3, SQ[4 * n + 3], n); \
                 DPP_FMAC(e0, a0, SP[4 * n], n); DPP_FMAC(e1, a1, SP[4 * n + 1], n); DPP_FMAC(e2, a2, SP[4 * n + 2], n); DPP_FMAC(e3, a3, SP[4 * n + 3], n);
#define SC_UP(n) DPP_MULD(SQ[4 * n], w0, n); DPP_MULD(SQ[4 * n + 1], w1, n); DPP_MULD(SQ[4 * n + 2], w2, n); DPP_MULD(SQ[4 * n + 3], w3, n); \
                 DPP_MULD(SP[4 * n], w0, n); DPP_MULD(SP[4 * n + 1], w1, n); DPP_MULD(SP[4 * n + 2], w2, n); DPP_MULD(SP[4 * n + 3], w3, n); \
                 DPP_FMAC(SQ[4 * n], b0, saq, n); DPP_FMAC(SQ[4 * n + 1], b1, saq, n); DPP_FMAC(SQ[4 * n + 2], b2, saq, n); DPP_FMAC(SQ[4 * n + 3], b3, saq, n); \
                 DPP_FMAC(SP[4 * n], b0, sap, n); DPP_FMAC(SP[4 * n + 1], b1, sap, n); DPP_FMAC(SP[4 * n + 2], b2, sap, n); DPP_FMAC(SP[4 * n + 3], b3, sap, n);
#define SC_VK(n) DPP_FMAC(SQ[4 * n], k0, vq, n); DPP_FMAC(SQ[4 * n + 1], k1, vq, n); DPP_FMAC(SQ[4 * n + 2], k2, vq, n); DPP_FMAC(SQ[4 * n + 3], k3, vq, n);
#define SC_Y(n) DPP_FMAC(y0, r0, SQ[4 * n], n); DPP_FMAC(y1, r1, SQ[4 * n + 1], n); DPP_FMAC(y2, r2, SQ[4 * n + 2], n); DPP_FMAC(y3, r3, SQ[4 * n + 3], n); \
                DPP_FMAC(z0, r0, SP[4 * n], n); DPP_FMAC(z1, r1, SP[4 * n + 1], n); DPP_FMAC(z2, r2, SP[4 * n + 2], n); DPP_FMAC(z3, r3, SP[4 * n + 3], n);
__device__ __forceinline__ void ph_scan1(LAS unsigned char* lds, const float* wsf, unsigned oAA, unsigned oWW, unsigned oBD, unsigned oKD, unsigned oRR, unsigned oVR, float* YP, float* QP, const MoeCv mc, int G, int bid) {
    const int wave = __builtin_amdgcn_readfirstlane(threadIdx.x >> 6), lane = threadIdx.x & 63, l15 = lane & 15, vi = lane >> 4;
    if (wave >= 4) { for (int pb = bid; pb < 256; pb += G) moe_cvt_wave(lds + 4 * SC_WLDS + (wave - 4) * CV_WLDS, mc, pb * 4 + (wave - 4), lane); return; }
    LAS unsigned char* ring = lds + wave * SC_WLDS;
    for (int pb = bid; pb < 256; pb += G) {
        const int pair = pb * 4 + wave, chain = pair >> 4, chunk = pair & 15;
        const int b = chain >> 5, h = (chain >> 1) & 15, d = chain & 1;
        const unsigned dofs = (unsigned)d * MALL * RD;
        const unsigned oh = (unsigned)h * (MALL * 64), lane4 = lane * 4;
        const unsigned ob0 = oAA + oh, ob1 = oWW + dofs + oh, ob2 = oBD + dofs + oh, ob3 = oKD + dofs + oh, ob4 = oRR + oh, ob5 = oVR + oh;
        float SQ[64], SP[64];
#pragma unroll
        for (int k = 0; k < 64; ++k) { SQ[k] = 0.f; SP[k] = lane == k ? 1.f : 0.f; }
        float* ypq = YP + (size_t)d * NL * RD + (size_t)h * NL * 64;
        float* ypp = YP + (size_t)(2 + d) * NL * RD + (size_t)h * NL * 64;
        const int gbase = chunk * SC_CL;
        constexpr int NGRP = SC_CL / 4;
#define SC_ISSUE(grp, slot) do { const int gq_ = (grp) < NGRP ? (grp) : NGRP - 1; const unsigned ro_ = (unsigned)scan_row(b, d, gbase + 4 * gq_ + (d ? 3 : 0)) * 64; LAS unsigned char* sl_ = ring + (slot) * SC_SLOTB; \
            __builtin_amdgcn_global_load_lds((const unsigned*)(wsf + (ob0 + ro_) + lane4), (LAS unsigned*)sl_, 16, 0, 0); __builtin_amdgcn_global_load_lds((const unsigned*)(wsf + (ob1 + ro_) + lane4), (LAS unsigned*)(sl_ + 1024), 16, 0, 0); \
            __builtin_amdgcn_global_load_lds((const unsigned*)(wsf + (ob2 + ro_) + lane4), (LAS unsigned*)(sl_ + 2048), 16, 0, 0); __builtin_amdgcn_global_load_lds((const unsigned*)(wsf + (ob3 + ro_) + lane4), (LAS unsigned*)(sl_ + 3072), 16, 0, 0); \
            __builtin_amdgcn_global_load_lds((const unsigned*)(wsf + (ob4 + ro_) + lane4), (LAS unsigned*)(sl_ + 4096), 16, 0, 0); __builtin_amdgcn_global_load_lds((const unsigned*)(wsf + (ob5 + ro_) + lane4), (LAS unsigned*)(sl_ + 5120), 16, 0, 0); } while (0)
        SC_ISSUE(0, 0); SC_ISSUE(1, 1); SC_ISSUE(2, 2); SC_ISSUE(3, 3); SC_ISSUE(4, 4);
        SC_VSET(A); SC_VSET(B);
        asm volatile("s_waitcnt vmcnt(24)" ::: "memory");
        const int r0o = d ? 768 : 0, rstep = d ? -256 : 256;
        SC_READV(A, ring + r0o);
        asm volatile("s_waitcnt lgkmcnt(0)" ::: "memory");
        int slot = 0;
#pragma unroll 1
        for (int grp = 0; grp < NGRP; ++grp) {
            const int i = 4 * grp;
            const LAS unsigned char* sl = ring + slot * SC_SLOTB + r0o;
            const int nslot = slot == SC_NSLOT - 1 ? 0 : slot + 1;
            SC_READV(B, sl + rstep);
            SC_STEP(A, i);
            asm volatile("s_waitcnt lgkmcnt(0)" ::: "memory");
            SC_READV(A, sl + 2 * rstep);
            SC_STEP(B, i + 1);
            asm volatile("s_waitcnt lgkmcnt(0)" ::: "memory");
            SC_READV(B, sl + 3 * rstep);
            SC_STEP(A, i + 2);
            asm volatile("s_waitcnt lgkmcnt(0)" ::: "memory");
            SC_ISSUE(grp + SC_NSLOT, slot);
            asm volatile("s_waitcnt vmcnt(24)" ::: "memory");
            SC_READV(A, ring + nslot * SC_SLOTB + r0o);
            SC_STEP(B, i + 3);
            asm volatile("s_waitcnt lgkmcnt(0)" ::: "memory");
            slot = nslot;
        }
        asm volatile("s_waitcnt vmcnt(0)" ::: "memory");
#undef SC_ISSUE
        float* qpq = QP + ((((size_t)chain) * SC_NC + chunk) * 64 + lane) * 64;
        float* qpp = QP + ((((size_t)64 + chain) * SC_NC + chunk) * 64 + lane) * 64;
#pragma unroll
        for (int j = 0; j < 16; ++j) { *(f32x4*)(qpq + 4 * j) = (f32x4){SQ[4 * j], SQ[4 * j + 1], SQ[4 * j + 2], SQ[4 * j + 3]}; *(f32x4*)(qpp + 4 * j) = (f32x4){SP[4 * j], SP[4 * j + 1], SP[4 * j + 2], SP[4 * j + 3]}; }
    }
}
#undef SC_SA
#undef SC_UP
#undef SC_VK
#undef SC_Y
__device__ __forceinline__ void ph_scan_carry(const float* QP, float* SS, int G, int bid) {
    const int wave = __builtin_amdgcn_readfirstlane(threadIdx.x >> 6), lane = threadIdx.x & 63;
    for (int task = bid * 8 + wave; task < 64 * 32; task += G * 8) {
        const int chain = task >> 5, v0 = (task & 31) * 2;
        float s0 = 0.f, s1 = 0.f, P[64];
        const float* Pc = QP + (((size_t)64 + chain) * SC_NC) * 4096 + lane;
        const float* Qc = QP + (((size_t)chain) * SC_NC) * 4096 + v0 * 64 + lane;
        float* Sp = SS + (((size_t)chain * SC_NC) * 64 + v0) * 64 + lane;
#pragma unroll
        for (int k = 0; k < 64; ++k) P[k] = Pc[k * 64];
        float q0 = Qc[0], q1 = Qc[64];
#pragma unroll 1
        for (int c = 0; c < SC_NC - 1; ++c) {
            Sp[0] = s0; Sp[64] = s1; Sp += 4096;
            const int cn = c + 1 < SC_NC - 1 ? 1 : 0;
            Pc += cn * 4096; Qc += cn * 4096;
            float n0 = q0, n1 = q1; const int i0 = __builtin_bit_cast(int, s0), i1 = __builtin_bit_cast(int, s1);
            q0 = Qc[0]; q1 = Qc[64];
#pragma unroll
            for (int k = 0; k < 64; ++k) { const float pk = P[k];
                n0 += __builtin_bit_cast(float, __builtin_amdgcn_readlane(i0, k)) * pk; n1 += __builtin_bit_cast(float, __builtin_amdgcn_readlane(i1, k)) * pk;
                P[k] = Pc[k * 64]; }
            s0 = n0; s1 = n1;
        }
        Sp[0] = s0; Sp[64] = s1;
    }
}
struct FixLd { f32x4 p0, p1; float yl, r, ks, vr, gg; };
__device__ __forceinline__ FixLd fix_load(const float* YP, const float* RR, const float* KD, const float* VR, const float* GG, int row, int h, int lane) {
    FixLd x; const int l15 = lane & 15; const size_t e = ((size_t)h * NL + row) * 64, em = ((size_t)h * MALL + row) * 64;
    x.p0 = *(const f32x4*)(YP + (size_t)2 * NL * RD + e + l15 * 4); x.p1 = *(const f32x4*)(YP + (size_t)3 * NL * RD + e + l15 * 4);
    x.yl = YP[e + lane] + YP[(size_t)NL * RD + e + lane];
    x.r = RR[em + lane]; x.ks = KD[em + lane] + KD[(size_t)MALL * RD + em + lane]; x.vr = VR[em + lane]; x.gg = GG[em + lane];
    return x;
}
__device__ __forceinline__ void ph_scan_fix(const float* YP, const float* SS, const float* RR, const float* KD, const float* VR, const float* GG, const float* r_k, const float* lnw, const float* lnb, bf16_t* MIXB, int G, int bid) {
    const int wave = __builtin_amdgcn_readfirstlane(threadIdx.x >> 6), lane = threadIdx.x & 63;
    for (int task = bid * 8 + wave; task < 2048; task += G * 8) {
        const int b = task >> 10, h = (task >> 6) & 15, t0 = (task & 63) * 64, c = h * 64 + lane;
        const int chain0 = (b * 16 + h) * 2;
        float S0[64], S1[64]; int cc0 = -1, cc1 = -1;
        const float rk = r_k[c], lw = lnw[c], lb = lnb[c];
        FixLd ring[4];
#pragma unroll
        for (int k = 0; k < 4; ++k) ring[k] = fix_load(YP, RR, KD, VR, GG, b * SEQ + t0 + k, h, lane);
#pragma unroll 1
        for (int tt0 = 0; tt0 < 64; tt0 += 4)
#pragma unroll
          for (int k = 0; k < 4; ++k) {
            const int tt = tt0 + k, t = t0 + tt, row = b * SEQ + t;
            const FixLd cu = ring[k];
            { const int tn = tt < 60 ? t + 4 : t; ring[k] = fix_load(YP, RR, KD, VR, GG, b * SEQ + tn, h, lane); }
            const int c0 = (CTX + t) / SC_CL, c1 = (CTX + SEQ - 1 - t) / SC_CL;
            if (c0 != cc0) { cc0 = c0; const float* sp = SS + (((size_t)chain0 * SC_NC + c0) * 64 + lane) * 64;
#pragma unroll
                for (int j = 0; j < 16; ++j) { const f32x4 x = *(const f32x4*)(sp + 4 * j); S0[4 * j] = x[0]; S0[4 * j + 1] = x[1]; S0[4 * j + 2] = x[2]; S0[4 * j + 3] = x[3]; } }
            if (c1 != cc1) { cc1 = c1; const float* sp = SS + (((size_t)(chain0 + 1) * SC_NC + c1) * 64 + lane) * 64;
#pragma unroll
                for (int j = 0; j < 16; ++j) { const f32x4 x = *(const f32x4*)(sp + 4 * j); S1[4 * j] = x[0]; S1[4 * j + 1] = x[1]; S1[4 * j + 2] = x[2]; S1[4 * j + 3] = x[3]; } }
            float a0 = cu.p0[0], a1 = cu.p0[1], a2 = cu.p0[2], a3 = cu.p0[3], b0 = cu.p1[0], b1 = cu.p1[1], b2 = cu.p1[2], b3 = cu.p1[3];
            asm volatile("s_nop 1" : "+v"(a0), "+v"(a1), "+v"(a2), "+v"(a3), "+v"(b0), "+v"(b1), "+v"(b2), "+v"(b3));
            float y0 = 0.f, y1 = 0.f, y2 = 0.f, y3 = 0.f, z0 = 0.f, z1 = 0.f, z2 = 0.f, z3 = 0.f;
#define FX_N(n) DPP_FMAC(y0, a0, S0[4 * n], n); DPP_FMAC(y1, a1, S0[4 * n + 1], n); DPP_FMAC(y2, a2, S0[4 * n + 2], n); DPP_FMAC(y3, a3, S0[4 * n + 3], n); \
                DPP_FMAC(z0, b0, S1[4 * n], n); DPP_FMAC(z1, b1, S1[4 * n + 1], n); DPP_FMAC(z2, b2, S1[4 * n + 2], n); DPP_FMAC(z3, b3, S1[4 * n + 3], n);
            SC_FOR16(FX_N)
#undef FX_N
            const float y = cu.yl + ((y0 + y1) + (y2 + y3)) + ((z0 + z1) + (z2 + z3));
            const float mu = wave_sum_dpp(y) * (1.f / 64.f);
            const float dv = y - mu;
            const float var = wave_sum_dpp(dv * dv) * (1.f / 64.f);
            const float yn = dv * rsqrtf(var + 64e-5f) * lw + lb;
            const float bonus = wave_sum_dpp(cu.r * cu.ks * rk) * cu.vr;
            const float o = (yn + bonus) * cu.gg;
            const float on = __shfl_down(o, 1);
            if ((lane & 1) == 0) *(unsigned*)(MIXB + (size_t)row * D + 1024 + c) = cvt_pk_bf16(o, on);
        }
    }
}

constexpr size_t alb(size_t x) { return (x + 4095) & ~(size_t)4095; }
constexpr size_t CTL_BYTES = 65536;
constexpr size_t MB_CTL = 0;
constexpr size_t B_MOD0 = MB_CTL + CTL_BYTES;
constexpr size_t B_MOD1 = B_MOD0 + alb((size_t)3 * NMOD * 4);
constexpr size_t B_MODP = B_MOD1 + alb((size_t)2 * NMOD * 4);
constexpr size_t MB_ROPE = B_MODP + alb((size_t)2 * 32 * 3 * NMOD * 4);
constexpr size_t B_H = MB_ROPE + 8192;
constexpr size_t MB_XNB = B_H + alb((size_t)NL * D * 4);
constexpr size_t MB_WIN0 = MB_XNB + alb((size_t)MALL * D * 2);
constexpr size_t MB_WO0 = MB_WIN0 + alb((size_t)ZLD * D * 2);
constexpr size_t MB_W13 = MB_WO0 + alb((size_t)D * D * 2);
constexpr size_t MB_W2 = MB_W13 + alb((size_t)2 * DFF * D * 2);
constexpr size_t MB_WUQ = MB_W2 + alb((size_t)D * DFF * 2);
constexpr size_t MB_WKN = MB_WUQ + alb((size_t)QW * 512 * 2);
constexpr size_t MB_WV = MB_WKN + alb((size_t)1024 * 512 * 2);
constexpr size_t MB_WLORA = MB_WV + alb((size_t)1024 * 512 * 2);
constexpr size_t MB_WIN1 = MB_WLORA + alb((size_t)5120 * 512 * 2);
constexpr size_t MB_WO1 = MB_WIN1 + alb((size_t)4096 * D * 2);
constexpr size_t MB_WSB = MB_WO1 + alb((size_t)D * D * 2);
constexpr size_t MB_W13E = MB_WSB + alb((size_t)16 * 128 * 128 * 2);
constexpr size_t MB_W2E = MB_W13E + alb((size_t)NE * 2 * DFF * D);
constexpr size_t B_ACTS = MB_W2E + alb((size_t)NE * D * DFF);
constexpr size_t B_Z = B_ACTS;
constexpr size_t MB_CQNB = B_Z + alb((size_t)MALL * ZLD * 4);
constexpr size_t MB_CKVNB = MB_CQNB + alb((size_t)MALL * 512 * 2);
constexpr size_t MB_LA = MB_CKVNB + alb((size_t)MALL * 512 * 2);
constexpr size_t MB_QB = MB_LA + alb((size_t)MALL * 512 * 2);
constexpr size_t MB_KNB = MB_QB + alb((size_t)NL * QW * 2);
constexpr size_t MB_VTB = MB_KNB + alb((size_t)MALL * KLD * 2);
constexpr size_t B_RR = MB_VTB + alb((size_t)RD * MALL * 2);
constexpr size_t B_KR = B_RR + alb((size_t)MALL * RD * 4);
constexpr size_t B_VR = B_KR + alb((size_t)MALL * RD * 4);
constexpr size_t B_AA = B_VR + alb((size_t)MALL * RD * 4);
constexpr size_t B_WW = B_AA + alb((size_t)MALL * RD * 4);
constexpr size_t B_KD = B_WW + alb((size_t)2 * MALL * RD * 4);
constexpr size_t B_BD = B_KD + alb((size_t)2 * MALL * RD * 4);
constexpr size_t B_GG = B_BD + alb((size_t)2 * MALL * RD * 4);
constexpr size_t MB_YP = B_GG + alb((size_t)MALL * RD * 4);
constexpr size_t MB_QP = MB_YP + alb((size_t)4 * NL * RD * 4);
constexpr size_t MB_SS = MB_QP + alb((size_t)2 * 64 * 16 * 4096 * 4);
constexpr size_t MB_MIXB = MB_SS + alb((size_t)64 * 16 * 4096 * 4);
constexpr size_t MB_ACT = MB_MIXB + alb((size_t)NL * D * 2);
constexpr size_t B_L0END = MB_ACT + alb((size_t)NL * DFF * 2);
constexpr size_t MB_U = B_ACTS;
constexpr size_t MB_VG = MB_U + alb((size_t)NL * D * 2);
constexpr size_t MB_VT = MB_VG + alb((size_t)NL * D * 4);
constexpr size_t MB_GATED = MB_VT + alb((size_t)NL * D * 2);
constexpr size_t MB_XG = MB_GATED + alb((size_t)NL * D * 2);
constexpr size_t MB_ACT2 = MB_XG + alb((size_t)NSLOT * D);
constexpr size_t MB_OUT2 = MB_ACT2 + alb((size_t)NSLOT * DFF);
constexpr size_t MB_ROUTE = MB_OUT2 + alb((size_t)NSLOT * D * 4);
constexpr size_t B_L1END = MB_ROUTE + 262144;
constexpr size_t MB_END = B_L0END > B_L1END ? B_L0END : B_L1END;
constexpr size_t O_MOD0 = B_MOD0 / 4, O_MOD1 = B_MOD1 / 4, O_MODP = B_MODP / 4, O_H = B_H / 4, O_Z = B_Z / 4, O_RR = B_RR / 4, O_KR = B_KR / 4, O_VR = B_VR / 4, O_AA = B_AA / 4,
                 O_WW = B_WW / 4, O_KD = B_KD / 4, O_BD = B_BD / 4, O_GG = B_GG / 4;

struct MP { const float* in[44]; float* out; unsigned char* ws; int ph_lo, ph_hi; };

enum { PH_CVT = 0, PH_XN1, PH_GEMM_Z, PH_PREP, PH_GEMM4, PH_ATTN, PH_CARRY, PH_FIX, PH_GEMM_O0, PH_XN2, PH_FFN_UP, PH_FFN_DOWN, PH_XN3, PH_GEMM_IN1, PH_LNT, PH_SPATIAL, PH_GEMM_O1, PH_XN4, PH_PLAN, PH_MOE_UP, PH_MOE_DOWN, PH_FINAL, PH_N };

__global__ void __launch_bounds__(512, 2) mega(MP p) {
    extern __shared__ __attribute__((aligned(16))) unsigned char lds_raw[];
    LAS unsigned char* lds = (LAS unsigned char*)lds_raw;
    const int tid = threadIdx.x, G = gridDim.x, bid = blockIdx.x;
    for (int u = tid; u < (LDS_BYTES - LDS_CTL) / 4; u += 512) ((LAS unsigned*)(lds + LDS_CTL))[u] = 0u;
    __syncthreads();
    XcdBarrier bar = xcd_barrier_post((unsigned*)(p.ws + MB_CTL), (volatile LAS unsigned*)(lds + LDS_CTL + 64));
    float* wsf = (float*)p.ws;
    const int lo = p.ph_lo, hi = p.ph_hi;
#define IN(k) (lo <= (k) && (k) < hi)
#define SEAM(k) do { if (IN(k) && IN((k) + 1)) xcd_barrier(bar); } while (0)
    bf16_t* W13 = (bf16_t*)(p.ws + MB_W13); bf16_t* W2 = (bf16_t*)(p.ws + MB_W2); bf16_t* XNB = (bf16_t*)(p.ws + MB_XNB); bf16_t* ACT = (bf16_t*)(p.ws + MB_ACT);

    bf16_t* WIN0 = (bf16_t*)(p.ws + MB_WIN0); bf16_t* WO0 = (bf16_t*)(p.ws + MB_WO0); bf16_t* MIXB = (bf16_t*)(p.ws + MB_MIXB);
    bf16_t* CQNB = (bf16_t*)(p.ws + MB_CQNB); bf16_t* CKVNB = (bf16_t*)(p.ws + MB_CKVNB); bf16_t* LA = (bf16_t*)(p.ws + MB_LA);
    bf16_t* WLORA = (bf16_t*)(p.ws + MB_WLORA); bf16_t* WUQ = (bf16_t*)(p.ws + MB_WUQ); bf16_t* WKN = (bf16_t*)(p.ws + MB_WKN); bf16_t* WV = (bf16_t*)(p.ws + MB_WV);
    bf16_t* QB = (bf16_t*)(p.ws + MB_QB); bf16_t* KNB = (bf16_t*)(p.ws + MB_KNB); bf16_t* VTB = (bf16_t*)(p.ws + MB_VTB); float* ROPEC = (float*)(p.ws + MB_ROPE); float* ROPES = ROPEC + 1024;
    bf16_t* W13E = (bf16_t*)(p.ws + MB_W13E); bf16_t* W2E = (bf16_t*)(p.ws + MB_W2E); bf16_t* WIN1 = (bf16_t*)(p.ws + MB_WIN1); bf16_t* WO1 = (bf16_t*)(p.ws + MB_WO1); bf16_t* WSB = (bf16_t*)(p.ws + MB_WSB);
    bf16_t* Ub = (bf16_t*)(p.ws + MB_U); float* VG = (float*)(p.ws + MB_VG); bf16_t* VT = (bf16_t*)(p.ws + MB_VT); bf16_t* GATED = (bf16_t*)(p.ws + MB_GATED); bf16_t* XNB2 = (bf16_t*)(p.ws + MB_XNB);
    bf16_t* XG = (bf16_t*)(p.ws + MB_XG); float* OUT2 = (float*)(p.ws + MB_OUT2); bf16_t* ACT2 = (bf16_t*)(p.ws + MB_ACT2);
    int* R_TOPE = (int*)(p.ws + MB_ROUTE); int* R_SLOT = R_TOPE + 16384; float* R_TOPG = (float*)(R_TOPE + 32768); int* R_BCNT = R_TOPE + 49152; int* R_CNTOFF = R_TOPE + 49152 + 4096;
    if (IN(PH_CVT)) {
        ph_small_cvt(p.in[16], p.in[18], p.in[19], WLORA, ROPEC, ROPES, G, bid);
        { MapPlain m{p.in[10], QW, QW}; cvt_T(lds, m, WUQ, QW, 512, G, bid); }
        { MapKV m{p.in[12], 0}; cvt_T(lds, m, WKN, 1024, 512, G, (bid + G - 96) % G); }
        { MapKV m{p.in[12], 1}; cvt_T(lds, m, WV, 1024, 512, G, (bid + G - 160) % G); }
        ph_ada(lds, p.in[4], p.in[29], p.in[5], p.in[30], p.in[1], p.in[3], wsf + O_MOD0, wsf + O_MOD1, G, bid);
        { MapPlain m{p.in[8], ZW, ZW}; cvt_T(lds, m, WIN0, ZLD, D, G, bid); }
        { MapPlain m{p.in[25], D, D}; cvt_T(lds, m, WO0, D, D, G, bid); }
        { MapIl m{p.in[26], (long)(p.in[27] - p.in[26]), DFF}; cvt_T(lds, m, W13, 2 * DFF, D, G, bid); }
        { MapPlain m{p.in[28], D, D}; cvt_T(lds, m, W2, D, DFF, G, bid); }
        { MapPlain m{p.in[33], 4096, 4096}; cvt_T(lds, m, WIN1, 4096, D, G, bid); }
        { MapPlain m{p.in[38], D, D}; cvt_T(lds, m, WO1, D, D, G, bid); }
        cvt_copy(p.in[36], WSB, (size_t)16 * 128 * 128, G, bid);
        __syncthreads();
    }
    SEAM(PH_CVT);
    if (IN(PH_XN1)) ph_norm_mod<false>(lds, p.in[0], p.in[2], p.in[6], wsf + O_MOD0, 0, 1, XNB, MALL, nullptr, nullptr, nullptr, nullptr, G, bid);
    SEAM(PH_XN1);
    if (IN(PH_GEMM_Z)) {
        pg8::DenseOrder S; S.init(XNB, D, WIN0, D, MALL, ZLD, G, bid);
        EpiF32 E{wsf + O_Z, ZLD};
        pg8::gemm_phase<EpiF32, pg8::DenseOrder, true, true>(lds, D, D, D, S, E);
    }
    SEAM(PH_GEMM_Z);
    if (IN(PH_PREP)) {
        ph_prep(wsf + O_Z, p.in[9], p.in[11], p.in[13], p.in[14], p.in[20], CQNB, CKVNB, KNB, LA, wsf + O_RR, wsf + O_KR, wsf + O_VR, wsf + O_AA, ROPEC, ROPES, G, bid);
    }
    SEAM(PH_PREP);
    if (IN(PH_GEMM4)) {
#pragma unroll 1
        for (int q = 0; q < 3; ++q) {
            const int kof = q * 128, kk = q < 2 ? 128 : 256, nn = q < 2 ? 2048 : 1024;
            pg8::DenseOrder S; S.init(LA + kof, 512, WLORA + (size_t)(q * 2048) * 512 + kof, 512, MALL, nn, G, (bid + G - 16 * q) % G);
            EpiLora E{p.in[15], p.in[17], p.in[21], wsf + O_KR, wsf + O_AA, wsf + O_WW, wsf + O_KD, wsf + O_BD, wsf + O_GG, q * 8};
            pg8::gemm_phase<EpiLora, pg8::DenseOrder, true, true>(lds, kk, 512, 512, S, E); }
        { pg8::DenseOrder S; S.init(CQNB, 512, WUQ, 512, NL, QW, G, (bid + 168) % G);
          EpiQ E{QB, ROPEC, ROPES};
          pg8::gemm_phase<EpiQ, pg8::DenseOrder, true, true>(lds, 512, 512, 512, S, E);
 }
        { pg8::DenseOrder S; S.init(CKVNB, 512, WKN, 512, MALL, 1024, G, (bid + 104) % G);
          EpiBf16 E{KNB, KLD};
          pg8::gemm_phase<EpiBf16, pg8::DenseOrder, true, true>(lds, 512, 512, 512, S, E); }
        { pg8::DenseOrder S; S.init(WV, 512, CKVNB, 512, 1024, MALL, G, (bid + 224) % G);
          EpiVT E{VTB};
          pg8::gemm_phase<EpiVT, pg8::DenseOrder, true, true>(lds, 512, 512, 512, S, E); }
    }
    SEAM(PH_GEMM4);
    float* YP = (float*)(p.ws + MB_YP); float* QP = (float*)(p.ws + MB_QP); float* SS = (float*)(p.ws + MB_SS);
    if (IN(PH_ATTN)) {
        ph_attn(lds, QB, KNB, VTB, MIXB, G, bid);
        { const MoeCv mc{p.in[40], (long)(p.in[41] - p.in[40]), p.in[42], (unsigned char*)W13E, (unsigned char*)W2E};
          ph_scan1(lds, wsf, (unsigned)O_AA, (unsigned)O_WW, (unsigned)O_BD, (unsigned)O_KD, (unsigned)O_RR, (unsigned)O_VR, YP, QP, mc, G, bid); }
        __syncthreads();
    }
    SEAM(PH_ATTN);
    if (IN(PH_CARRY)) ph_scan_carry(QP, SS, G, bid);
    SEAM(PH_CARRY);
    if (IN(PH_FIX)) ph_scan_fix(YP, SS, wsf + O_RR, wsf + O_KD, wsf + O_VR, wsf + O_GG, p.in[22], p.in[23], p.in[24], MIXB, G, bid);
    SEAM(PH_FIX);
    if (IN(PH_GEMM_O0)) {
        pg8::DenseOrder S; S.init(MIXB, D, WO0, D, NL, D, G, bid);
        EpiRes E{wsf + O_H, p.in[0], wsf + O_MOD0 + 2 * D};
        pg8::gemm_phase<EpiRes, pg8::DenseOrder, true, true>(lds, D, D, D, S, E);
    }
    SEAM(PH_GEMM_O0);
    if (IN(PH_XN2)) ph_norm_mod<false>(lds, wsf + O_H, nullptr, p.in[7], wsf + O_MOD0, 3, 4, XNB, NL, nullptr, nullptr, nullptr, nullptr, G, bid);
    SEAM(PH_XN2);
    if (IN(PH_FFN_UP)) {
        pg8::DenseOrder S; S.init(XNB, D, W13, D, NL, 2 * DFF, G, bid);
        EpiSwiglu E{ACT, DFF};
        pg8::gemm_phase<EpiSwiglu, pg8::DenseOrder, false, true>(lds, D, D, D, S, E);
    }
    SEAM(PH_FFN_UP);
    if (IN(PH_FFN_DOWN)) {
        pg8::DenseOrder S; S.init(ACT, DFF, W2, DFF, NL, D, G, bid);
        EpiRes E{wsf + O_H, wsf + O_H, wsf + O_MOD0 + 5 * D};
        pg8::gemm_phase<EpiRes, pg8::DenseOrder, true, true>(lds, DFF, DFF, DFF, S, E);
    }
    SEAM(PH_FFN_DOWN);
    if (IN(PH_XN3)) ph_norm_mod<false>(lds, wsf + O_H, nullptr, p.in[31], wsf + O_MOD1, 0, 1, XNB2, NL, nullptr, nullptr, nullptr, nullptr, G, bid);
    SEAM(PH_XN3);
    if (IN(PH_GEMM_IN1)) {
        pg8::DenseOrder S; S.init(XNB2, D, WIN1, D, NL, 4096, G, bid);
        EpiGelu E{Ub, VG};
        pg8::gemm_phase<EpiGelu, pg8::DenseOrder, true, true>(lds, D, D, D, S, E);
    }
    SEAM(PH_GEMM_IN1);
    if (IN(PH_LNT)) ph_ln_transpose(lds, VG, p.in[34], p.in[35], VT, G, bid);
    SEAM(PH_LNT);
    if (IN(PH_SPATIAL)) ph_spatial(WSB, VT, Ub, p.in[37], GATED, G, bid);
    SEAM(PH_SPATIAL);
    if (IN(PH_GEMM_O1)) {
        pg8::DenseOrder S; S.init(GATED, D, WO1, D, NL, D, G, bid);
        EpiRes E{wsf + O_H, wsf + O_H, wsf + O_MOD1 + 2 * D};
        pg8::gemm_phase<EpiRes, pg8::DenseOrder, true, true>(lds, D, D, D, S, E);
    }
    SEAM(PH_GEMM_O1);
    if (IN(PH_XN4)) ph_norm_mod<true>(lds, wsf + O_H, nullptr, p.in[32], wsf + O_MOD1, 3, 4, XNB2, NL, p.in[39], R_TOPE, R_TOPG, R_BCNT, G, bid);
    SEAM(PH_XN4);
    if (IN(PH_PLAN)) ph_moe_plan(lds, R_BCNT, R_TOPE, R_SLOT, R_CNTOFF, XNB2, XG, G, bid);
    SEAM(PH_PLAN);
    if (IN(PH_MOE_UP)) {
        pg8::MoeOrder S; S.init(R_CNTOFF, R_CNTOFF + 8, XG, D / 2, W13E, D / 2, (size_t)2 * DFF * D, 2 * DFF, G, bid);
        EpiSwigluF8 E{(unsigned char*)ACT2, DFF, 1.0f / 64.f};
        pg8::gemm_phase<EpiSwigluF8, pg8::MoeOrder, false, true, true>(lds, D / 2, D / 2, D / 2, S, E);
    }
    SEAM(PH_MOE_UP);
    if (IN(PH_MOE_DOWN)) {
        pg8::MoeOrder S; S.init(R_CNTOFF, R_CNTOFF + 8, ACT2, DFF / 2, W2E, DFF / 2, (size_t)D * DFF, D, G, bid);
        EpiBf16S E{(bf16_t*)OUT2, D, 1.0f / 128.f};
        pg8::gemm_phase<EpiBf16S, pg8::MoeOrder, true, true, true>(lds, DFF / 2, DFF / 2, DFF / 2, S, E);
    }
    SEAM(PH_MOE_DOWN);
    if (IN(PH_FINAL)) ph_final(wsf + O_H, (const bf16_t*)OUT2, R_SLOT, R_TOPG, wsf + O_MOD1 + 5 * D, p.in[43], p.out, G, bid);
#undef IN
#undef SEAM
}

static void launch_mega(hipStream_t stream, MP mp, int lo, int hi) {
    static int grid = 0;
    if (grid == 0) {
        int dev = 0, cus = 0;
        hipGetDevice(&dev); hipDeviceGetAttribute(&cus, hipDeviceAttributeMultiprocessorCount, dev);
        hipFuncSetAttribute((const void*)mega, hipFuncAttributeMaxDynamicSharedMemorySize, LDS_BYTES);
        int per_cu = 0; hipOccupancyMaxActiveBlocksPerMultiprocessor(&per_cu, (const void*)mega, 512, LDS_BYTES);
        if (per_cu < 1) fprintf(stderr, "mega: occupancy query says %d\n", per_cu);
        (void)hipGetLastError();
        grid = cus > 0 ? cus : 256;
    }
    hipMemsetAsync(mp.ws + MB_CTL, 0, CTL_BYTES, stream);
    mp.ph_lo = lo; mp.ph_hi = hi;
    hipLaunchKernelGGL(mega, dim3(grid), dim3(512), LDS_BYTES, stream, mp);
}
extern "C" void kernel_launch(void* const* d_in, const int* in_sizes, int n_in, void* d_out, int out_size, void* d_ws, size_t ws_size, hipStream_t stream) {
    if (n_in != 44 || ws_size < MB_END) { fprintf(stderr, "kernel_launch: bad n_in %d or ws %zu < %zu\n", n_in, ws_size, (size_t)MB_END); return; }
    MP mp{};
    for (int i = 0; i < 44; ++i) mp.in[i] = (const float*)d_in[i];
    mp.out = (float*)d_out; mp.ws = (unsigned char*)d_ws;
    launch_mega(stream, mp, 0, PH_N);
}
```

```cpp
#include <hip/hip_runtime.h>
#include <cstdio>
#include <cstdint>

constexpr int D = 2048, NB = 2, SEQ = 4096, CTX = 256;
constexpr int NL = NB * SEQ;
constexpr int NCX = NB * CTX;
constexpr int MALL = NL + NCX;
constexpr int NMOD = 6 * D;
constexpr int QL = 512, KVL = 512, ROPE = 64, NOPE = 128, VH = 128, HM = 8;
constexpr int MLA_IN = QL + KVL + ROPE;
constexpr int RD = 1024, RH = 16, RN = 64;
constexpr int RWKV_IN = 3 * RD + 128 + 128 + 160;
__device__ __forceinline__ size_t hmi(int row, int col) { return ((size_t)(col >> 6) * (8192 + 2 * 256) + row) * 64 + (col & 63); }
constexpr int ZW = MLA_IN + RWKV_IN;
constexpr int ZLD = 4608;
constexpr int KLD = 1088;
constexpr int QW = HM * (NOPE + ROPE);
constexpr int KVW = HM * (NOPE + VH);
constexpr int SK = CTX + SEQ;
constexpr int DFF = 7168, NE = 8;
constexpr int NSLOT = 18432;

constexpr int LDS_BYTES = 163840, LDS_CTL = 162816;

__device__ __forceinline__ float wave_sum(float v) {
#pragma unroll
    for (int o = 32; o > 0; o >>= 1) v += __shfl_xor(v, o);
    return v;
}
__device__ __forceinline__ float wave_sum_dpp(float v) {
    v += __builtin_bit_cast(float, __builtin_amdgcn_update_dpp(0, __builtin_bit_cast(int, v), 0xB1, 0xf, 0xf, true));
    v += __builtin_bit_cast(float, __builtin_amdgcn_update_dpp(0, __builtin_bit_cast(int, v), 0x4E, 0xf, 0xf, true));
    v += __builtin_bit_cast(float, __builtin_amdgcn_update_dpp(0, __builtin_bit_cast(int, v), 0x141, 0xf, 0xf, true));
    v += __builtin_bit_cast(float, __builtin_amdgcn_update_dpp(0, __builtin_bit_cast(int, v), 0x140, 0xf, 0xf, true));
    const int vi = __builtin_bit_cast(int, v);
    const float s0 = __builtin_bit_cast(float, __builtin_amdgcn_readlane(vi, 0)), s1 = __builtin_bit_cast(float, __builtin_amdgcn_readlane(vi, 16));
    const float s2 = __builtin_bit_cast(float, __builtin_amdgcn_readlane(vi, 32)), s3 = __builtin_bit_cast(float, __builtin_amdgcn_readlane(vi, 48));
    return (s0 + s1) + (s2 + s3);
}
__device__ __forceinline__ float sigmoidf_(float x) { return 1.0f / (1.0f + expf(-x)); }
__device__ __forceinline__ float siluf_(float x) { return x / (1.0f + expf(-x)); }

#define LAS __attribute__((address_space(3)))
typedef unsigned short bf16_t;
typedef short bf16x8 __attribute__((ext_vector_type(8)));
typedef float f32x4 __attribute__((ext_vector_type(4)));
typedef float f32x2 __attribute__((ext_vector_type(2)));
typedef unsigned u32x4 __attribute__((ext_vector_type(4)));
typedef unsigned u32x2 __attribute__((ext_vector_type(2)));
typedef int i32x8 __attribute__((ext_vector_type(8)));

__device__ __forceinline__ unsigned cvt_pk_bf16(float lo, float hi) { unsigned r; asm volatile("v_cvt_pk_bf16_f32 %0, %1, %2" : "=v"(r) : "v"(lo), "v"(hi)); return r; }
__device__ __forceinline__ unsigned pk4_fp8(float a, float b, float c, float d) { int p = __builtin_amdgcn_cvt_pk_fp8_f32(a, b, 0, false); p = __builtin_amdgcn_cvt_pk_fp8_f32(c, d, p, true); return (unsigned)p; }
__device__ __forceinline__ float bf2f(bf16_t b) { return __uint_as_float(((unsigned)b) << 16); }
__device__ __forceinline__ float fexp(float x) { return __builtin_amdgcn_exp2f(x * 1.4426950408889634f); }
__device__ __forceinline__ float flog(float x) { return __builtin_amdgcn_logf(x) * 0.6931471805599453f; }
__device__ __forceinline__ float fsigmoid(float x) { return __builtin_amdgcn_rcpf(1.0f + fexp(-x)); }
__device__ __forceinline__ float ftanh(float x) { return 1.0f - 2.0f * __builtin_amdgcn_rcpf(1.0f + fexp(2.0f * x)); }
__device__ __forceinline__ float rope_inv(int f) { const int q = f >> 2, r = f & 3; const float a = q == 0 ? 1.0f : q == 1 ? 0.1f : q == 2 ? 0.01f : 0.001f;
    const float b = r == 0 ? 1.0f : r == 1 ? 0.5623413251903491f : r == 2 ? 0.31622776601683794f : 0.1778279410038923f; return a * b; }

#define XB_TMO      128
#define XB_XCNT(j)  (256  + 64 * (j))
#define XB_XSUB(j)  (1280 + 64 * (j))
#define XB_XGEN(j)  (2304 + 64 * (j))
#define XB_TOP      3328
#define XB_TOPGEN   3392
#define XCD_BAR_WORDS 3456
#define XB_SPIN_CAP (1u << 18)
__device__ __forceinline__ unsigned xb_ld(unsigned* p)              { return __hip_atomic_load(p, __ATOMIC_RELAXED, __HIP_MEMORY_SCOPE_AGENT); }
__device__ __forceinline__ unsigned xb_add(unsigned* p, unsigned v) { return __hip_atomic_fetch_add(p, v, __ATOMIC_RELAXED, __HIP_MEMORY_SCOPE_AGENT); }
__device__ __forceinline__ unsigned xb_xcc_id() { return (unsigned)__builtin_amdgcn_s_getreg((3 << 11) | 20) & 0xFu; }
#define XB_SPIN(cond, bar) do { unsigned _sp = 0; while (cond) { __builtin_amdgcn_s_sleep(1); \
    if ((++_sp & 255u) == 0u) { if (xb_ld(&(bar)[XB_TMO])) break; if (_sp > XB_SPIN_CAP) { atomicAdd(&(bar)[XB_TMO], 1u); break; } } } } while (0)
struct XcdBarrier { unsigned* bar; unsigned x; volatile LAS unsigned* st; };
__device__ __forceinline__ XcdBarrier xcd_barrier_post(unsigned* bar, volatile LAS unsigned* st) {
    XcdBarrier b; b.bar = bar; b.x = xb_xcc_id(); b.st = st;
    if (threadIdx.x == 0) (void)xb_add(&bar[XB_XCNT(b.x)], 1u);
    return b;
}
__device__ __forceinline__ void xcd_barrier_complete(unsigned* bar, unsigned x, unsigned& nloc, unsigned& nx) {
    const unsigned G = gridDim.x * gridDim.y * gridDim.z;
    unsigned sum, cnt, mine, sp = 0u;
    for (;;) {
        sum = 0u; cnt = 0u; mine = 0u;
#pragma unroll
        for (unsigned j = 0; j < 16; ++j) { const unsigned c = xb_ld(&bar[XB_XCNT(j)]); sum += c; cnt += (c > 0u) ? 1u : 0u; mine = (j == x) ? c : mine; }
        if (sum == G) break;
        __builtin_amdgcn_s_sleep(1);
        if ((++sp & 255u) == 0u) { if (xb_ld(&bar[XB_TMO])) break; if (sp > XB_SPIN_CAP) { atomicAdd(&bar[XB_TMO], 1u); break; } }
    }
    nloc = mine > 0u ? mine : 1u; nx = cnt > 0u ? cnt : 1u;
}
__device__ __forceinline__ void xcd_barrier(const XcdBarrier& b) {
    asm volatile("s_waitcnt vmcnt(0)" ::: "memory");
    __syncthreads();
    if (threadIdx.x == 0) {
        unsigned* bar = b.bar;
        __builtin_amdgcn_s_waitcnt(0);
        unsigned nloc = b.st[0], nx = b.st[1];
        if (nloc == 0u) { xcd_barrier_complete(bar, b.x, nloc, nx); b.st[0] = nloc; b.st[1] = nx; }
        const unsigned old = xb_add(&bar[XB_XSUB(b.x)], 1u);
        const unsigned gen = old / nloc;
        if (old + 1u == (gen + 1u) * nloc) {
            __builtin_amdgcn_fence(__ATOMIC_RELEASE, "agent");
            asm volatile("s_waitcnt vmcnt(0)" ::: "memory");
            const unsigned og = xb_add(&bar[XB_TOP], 1u);
            const unsigned tg = og / nx;
            if (og + 1u == (tg + 1u) * nx) xb_add(&bar[XB_TOPGEN], 1u);
            else XB_SPIN(xb_ld(&bar[XB_TOPGEN]) == tg, bar);
            __builtin_amdgcn_fence(__ATOMIC_ACQUIRE, "agent");
            xb_add(&bar[XB_XGEN(b.x)], 1u);
            asm volatile("s_waitcnt vmcnt(0)" ::: "memory");
        } else {
            XB_SPIN(xb_ld(&bar[XB_XGEN(b.x)]) == gen, bar);
            __builtin_amdgcn_fence(__ATOMIC_ACQUIRE, "agent");
            asm volatile("s_waitcnt vmcnt(0)" ::: "memory");
        }
    }
    __syncthreads();
}

namespace pg8 {
constexpr int BM = 256, BK = 64, HALF = 128, HTB = HALF * BK * 2, STAGE_BYTES = 8 * HTB, NXCD = 8, WGM = 8;
__host__ __device__ __forceinline__ int lds_byte(int r, int c) { const int st = (r >> 4) * 2 + (c >> 5), rr = r & 15, cc = c & 31, ob = rr * 64 + cc * 2; return st * 1024 + (ob ^ (((ob >> 9) & 1) << 5)); }
__host__ __device__ __forceinline__ void stage_rc(int b, int& R, int& C) { const int st = b / 1024, sb = b % 1024, swz = sb ^ (((sb >> 9) & 1) << 5); R = (st >> 1) * 16 + swz / 64; C = (st & 1) * 32 + (swz % 64) / 2; }
__host__ __device__ __forceinline__ int perm32(int rho) { const int n = rho >> 4, i = rho & 15; return 8 * (i >> 2) + 4 * n + (i & 3); }
struct Unit { int pm, pn, kind; const char* a; const char* b; };

struct DenseOrder {
    int nM, nN, nwg, G, c, lda, ldb; const char* A; const char* B;
    __device__ void init(const bf16_t* A_, int lda_, const bf16_t* B_, int ldb_, int M, int N, int G_, int c_) { A = (const char*)A_; B = (const char*)B_; lda = lda_; ldb = ldb_; nM = M / BM; nN = N / BM; nwg = nM * nN; G = G_; c = c_; }
    __device__ bool next(int i, Unit& u) const {
        const long L = (long)i * G + c; if (L >= nwg) return false;
        int wgid = (int)L; { const int q = nwg / NXCD, r = nwg % NXCD, xcd = wgid % NXCD, off = wgid / NXCD; wgid = (xcd < r ? xcd * (q + 1) : r * (q + 1) + (xcd - r) * q) + off; }
        const int nig = WGM * nN, gid = wgid / nig, fm = gid * WGM, gsz = (nM - fm) < WGM ? (nM - fm) : WGM;
        u.pm = fm + ((wgid % nig) % gsz); u.pn = (wgid % nig) / gsz; u.kind = 0;
        u.a = A + (size_t)u.pm * BM * lda * 2; u.b = B + (size_t)u.pn * BM * ldb * 2; return true;
    }
};

template <class Epi, class Sched, bool ALIGN_EPI = false, bool SP2 = false, bool FP8 = false>
__device__ __forceinline__ void gemm_phase(LAS unsigned char* lds, const int K, const int lda, const int ldb, const Sched& S, const Epi& E) {
    const int tid = threadIdx.x, wid = __builtin_amdgcn_readfirstlane(tid >> 6), lane = tid & 63, wr = wid >> 2, wc = wid & 3, fr = lane & 15, fq = lane >> 4;
    const int nt = K / BK;
    unsigned voffA[2], voffB[2];
#pragma unroll
    for (int i = 0; i < 2; ++i) { int R, C; stage_rc(tid * 16 + i * 8192, R, C); const int Rb = Epi::PERM ? ((R & ~31) + perm32(R & 31)) : R;
        voffA[i] = (unsigned)(R * lda + C) * 2u; voffB[i] = (unsigned)(Rb * ldb + C) * 2u; }
    const size_t kstep = (size_t)(BK * 2);
    const size_t hstepA = (size_t)HALF * lda * 2, hstepB = (size_t)HALF * ldb * 2;
    const unsigned ldsw = (unsigned)wid * 1024u;
    const int aoff = lds_byte(wr * 64 + fr, fq * 8), boff = lds_byte(wc * 32 + fr, fq * 8);
#define PG8_SA(b, h) (((b) * 2 + (h)) * HTB)
#define PG8_SB(b, h) ((4 + (b) * 2 + (h)) * HTB)
#define PG8_STAGE(bufoff, gbase, voff) do { _Pragma("unroll") for (int _i = 0; _i < 2; ++_i) \
        __builtin_amdgcn_global_load_lds((const unsigned*)((const char*)(gbase) + (voff)[_i]), (LAS unsigned*)(lds + (bufoff) + ldsw + _i * 8192), 16, 0, 0); } while (0)
#define PG8_LDA(dst, b, h) do { _Pragma("unroll") for (int m = 0; m < 4; ++m) _Pragma("unroll") for (int k = 0; k < 2; ++k) dst[m][k] = *(const LAS bf16x8*)(lds + PG8_SA(b, h) + aoff + m * 2048 + k * 1024); } while (0)
#define PG8_LDB(dst, b, h) do { _Pragma("unroll") for (int n = 0; n < 2; ++n) _Pragma("unroll") for (int k = 0; k < 2; ++k) dst[n][k] = *(const LAS bf16x8*)(lds + PG8_SB(b, h) + boff + n * 2048 + k * 1024); } while (0)
#define PG8_CAT(x) __builtin_bit_cast(i32x8, __builtin_shufflevector((x)[0], (x)[1], 0, 1, 2, 3, 4, 5, 6, 7, 8, 9, 10, 11, 12, 13, 14, 15))
#define PG8_MMA(ai, bj, At, Bt) do { __builtin_amdgcn_s_setprio(1); _Pragma("unroll") for (int m = 0; m < 4; ++m) _Pragma("unroll") for (int n = 0; n < 2; ++n) { \
        if constexpr (FP8) { asm volatile("v_mfma_f32_16x16x128_f8f6f4 %0, %1, %2, %0" : "+v"(acc[ai][bj][m][n]) : "v"(PG8_CAT(Bt[n])), "v"(PG8_CAT(At[m]))); } \
        else { _Pragma("unroll") for (int k = 0; k < 2; ++k) acc[ai][bj][m][n] = __builtin_amdgcn_mfma_f32_16x16x32_bf16(Bt[n][k], At[m][k], acc[ai][bj][m][n], 0, 0, 0); } } \
        __builtin_amdgcn_s_setprio(0); } while (0)
#define PG8_WAIT_V(n) asm volatile("s_waitcnt vmcnt(" #n ")" ::: "memory")
#define PG8_WAIT_L(n) asm volatile("s_waitcnt lgkmcnt(" #n ")" ::: "memory")
#define PG8_BAR __builtin_amdgcn_s_barrier()
#define PG8_SCHED __builtin_amdgcn_sched_barrier(0)
    Unit cur, nxt; int ui = 0;
    if (!S.next(0, cur)) return;
    f32x4 acc[2][2][4][2];
#pragma unroll
    for (int a = 0; a < 2; ++a)
#pragma unroll
        for (int b = 0; b < 2; ++b)
#pragma unroll
            for (int m = 0; m < 4; ++m)
#pragma unroll
                for (int n = 0; n < 2; ++n) acc[a][b][m][n] = (f32x4){0.f, 0.f, 0.f, 0.f};
    bf16x8 At[4][2], B0[2][2], B1[2][2];
    const char* cA = cur.a; const char* cB = cur.b;
    if constexpr (SP2) {
        PG8_STAGE(PG8_SB(0, 0), cB, voffB); PG8_STAGE(PG8_SB(0, 1), cB + hstepB, voffB); PG8_STAGE(PG8_SA(0, 0), cA, voffA); PG8_STAGE(PG8_SA(0, 1), cA + hstepA, voffA);
        if (wr == 1) PG8_BAR;
        PG8_WAIT_V(2); PG8_BAR;
        PG8_STAGE(PG8_SB(1, 0), cB + kstep, voffB); PG8_STAGE(PG8_SA(1, 0), cA + kstep, voffA); PG8_STAGE(PG8_SB(1, 1), cB + hstepB + kstep, voffB);
        PG8_WAIT_V(6); PG8_BAR;
    } else {
        PG8_STAGE(PG8_SB(0, 0), cB, voffB); PG8_STAGE(PG8_SA(0, 0), cA, voffA); PG8_STAGE(PG8_SB(0, 1), cB + hstepB, voffB); PG8_STAGE(PG8_SA(0, 1), cA + hstepA, voffA);
        if (wr == 1) PG8_BAR;
        PG8_WAIT_V(4); PG8_BAR;
        PG8_STAGE(PG8_SB(1, 0), cB + kstep, voffB); PG8_STAGE(PG8_SA(1, 0), cA + kstep, voffA); PG8_STAGE(PG8_SB(1, 1), cB + hstepB + kstep, voffB);
        PG8_WAIT_V(6); PG8_BAR;
    }
    for (;;) {
        const bool has_next = S.next(ui + 1, nxt);
        const char* nA = has_next ? nxt.a : cA; const char* nB = has_next ? nxt.b : cB;
        for (int t = 0; t < nt; t += 2) {
            const bool last = (t == nt - 2);
            const char* a1 = cA + (size_t)(t + 1) * kstep;
            const char* a2 = last ? nA : cA + (size_t)(t + 2) * kstep; const char* b2 = last ? nB : cB + (size_t)(t + 2) * kstep;
            const char* a3 = a2 + kstep; const char* b3 = b2 + kstep;
            if constexpr (SP2) {
            PG8_LDB(B0, 0, 0); PG8_LDB(B1, 0, 1); PG8_SCHED; PG8_LDA(At, 0, 0); PG8_STAGE(PG8_SA(1, 1), a1 + hstepA, voffA);
            PG8_WAIT_V(8); PG8_WAIT_L(0); PG8_BAR; PG8_MMA(0, 0, At, B0); PG8_MMA(0, 1, At, B1); PG8_BAR; PG8_SCHED;
            PG8_LDA(At, 0, 1); PG8_STAGE(PG8_SB(0, 0), b2, voffB); PG8_STAGE(PG8_SB(0, 1), b2 + hstepB, voffB); PG8_STAGE(PG8_SA(0, 0), a2, voffA);
            PG8_WAIT_V(8); PG8_WAIT_L(0); PG8_BAR; PG8_MMA(1, 0, At, B0); PG8_MMA(1, 1, At, B1); PG8_BAR; PG8_SCHED;
            PG8_LDB(B0, 1, 0); PG8_LDB(B1, 1, 1); PG8_SCHED; PG8_LDA(At, 1, 0); PG8_STAGE(PG8_SA(0, 1), a2 + hstepA, voffA);
            PG8_WAIT_V(8); PG8_WAIT_L(0); PG8_BAR; PG8_MMA(0, 0, At, B0); PG8_MMA(0, 1, At, B1); PG8_BAR; PG8_SCHED;
            PG8_LDA(At, 1, 1); PG8_STAGE(PG8_SB(1, 0), b3, voffB); PG8_STAGE(PG8_SB(1, 1), b3 + hstepB, voffB); PG8_STAGE(PG8_SA(1, 0), a3, voffA);
            PG8_WAIT_V(8); PG8_WAIT_L(0); PG8_BAR; PG8_MMA(1, 0, At, B0); PG8_MMA(1, 1, At, B1); PG8_BAR; PG8_SCHED;
            } else {
            PG8_LDB(B0, 0, 0); PG8_SCHED; PG8_LDA(At, 0, 0); PG8_STAGE(PG8_SA(1, 1), a1 + hstepA, voffA);
            PG8_WAIT_L(8); PG8_BAR; PG8_WAIT_L(0); PG8_MMA(0, 0, At, B0); PG8_BAR; PG8_SCHED;
            PG8_LDB(B1, 0, 1); PG8_STAGE(PG8_SB(0, 0), b2, voffB);
            PG8_BAR; PG8_WAIT_L(0); PG8_MMA(0, 1, At, B1); PG8_BAR;
            PG8_LDA(At, 0, 1); PG8_STAGE(PG8_SA(0, 0), a2, voffA);
            PG8_BAR; PG8_WAIT_L(0); PG8_MMA(1, 0, At, B0); PG8_BAR; PG8_SCHED;
            PG8_STAGE(PG8_SB(0, 1), b2 + hstepB, voffB);
            PG8_WAIT_V(6); PG8_BAR; PG8_MMA(1, 1, At, B1); PG8_BAR;
            PG8_LDB(B0, 1, 0); PG8_SCHED; PG8_LDA(At, 1, 0); PG8_STAGE(PG8_SA(0, 1), a2 + hstepA, voffA);
            PG8_WAIT_L(8); PG8_BAR; PG8_WAIT_L(0); PG8_MMA(0, 0, At, B0); PG8_BAR; PG8_SCHED;
            PG8_LDB(B1, 1, 1); PG8_STAGE(PG8_SB(1, 0), b3, voffB);
            PG8_BAR; PG8_WAIT_L(0); PG8_MMA(0, 1, At, B1); PG8_BAR;
            PG8_LDA(At, 1, 1); PG8_STAGE(PG8_SA(1, 0), a3, voffA);
            PG8_BAR; PG8_WAIT_L(0); PG8_MMA(1, 0, At, B0); PG8_BAR; PG8_SCHED;
            PG8_STAGE(PG8_SB(1, 1), b3 + hstepB, voffB);
            PG8_WAIT_V(6); PG8_BAR; PG8_MMA(1, 1, At, B1); PG8_BAR;
            }
        }
        if constexpr (ALIGN_EPI) { if (wr == 0) PG8_BAR; }
        if constexpr (FP8) asm volatile("s_nop 15\n\ts_nop 15\n\ts_nop 7" ::: "memory");
        E(acc, cur, wr, wc, fr, fq);
        if (!has_next) break;
#pragma unroll
        for (int a = 0; a < 2; ++a)
#pragma unroll
            for (int b = 0; b < 2; ++b)
#pragma unroll
                for (int m = 0; m < 4; ++m)
#pragma unroll
                    for (int n = 0; n < 2; ++n) acc[a][b][m][n] = (f32x4){0.f, 0.f, 0.f, 0.f};
        cur = nxt; cA = nA; cB = nB; ++ui;
        if constexpr (ALIGN_EPI) { if (wr == 1) PG8_BAR; }
    }
    PG8_WAIT_V(0);
    if constexpr (!ALIGN_EPI) { if (wr == 0) PG8_BAR; }
    PG8_BAR;
#undef PG8_SA
#undef PG8_SB
#undef PG8_STAGE
#undef PG8_LDA
#undef PG8_LDB
#undef PG8_MMA
#undef PG8_CAT
#undef PG8_WAIT_V
#undef PG8_WAIT_L
#undef PG8_BAR
#undef PG8_SCHED
}
}
using pg8::Unit;

typedef const f32x4 (&AccRef)[2][2][4][2];
struct EpiF32 { static constexpr bool PERM = false; float* C; int ldc;
    __device__ __forceinline__ void operator()(AccRef acc, const Unit& u, int wr, int wc, int fr, int fq) const {
        const int row0 = u.pm * 256 + wr * 64 + fr, col0 = u.pn * 256 + wc * 32 + 4 * fq;
#pragma unroll
        for (int ai = 0; ai < 2; ++ai)
#pragma unroll
            for (int m = 0; m < 4; ++m) { float* rowp = C + (size_t)(row0 + ai * 128 + m * 16) * ldc + col0;
#pragma unroll
                for (int bj = 0; bj < 2; ++bj)
#pragma unroll
                    for (int n = 0; n < 2; ++n) *(f32x4*)(rowp + bj * 128 + n * 16) = acc[ai][bj][m][n]; }
    } };
struct EpiRes { static constexpr bool PERM = false; float* C; const float* R; const float* gate;
    __device__ __forceinline__ void operator()(AccRef acc, const Unit& u, int wr, int wc, int fr, int fq) const {
        const int row0 = u.pm * 256 + wr * 64 + fr, col0 = u.pn * 256 + wc * 32 + 4 * fq;
        const float* gp = gate + (size_t)((u.pm * 256) / SEQ) * NMOD + col0;
        f32x4 gv[2][2];
#pragma unroll
        for (int bj = 0; bj < 2; ++bj)
#pragma unroll
            for (int n = 0; n < 2; ++n) gv[bj][n] = *(const f32x4*)(gp + bj * 128 + n * 16);
#pragma unroll
        for (int ai = 0; ai < 2; ++ai)
#pragma unroll
          for (int mp = 0; mp < 2; ++mp) {
            f32x4 r[2][2][2];
#pragma unroll
            for (int mm = 0; mm < 2; ++mm) { const size_t off = (size_t)(row0 + ai * 128 + (mp * 2 + mm) * 16) * D + col0;
#pragma unroll
                for (int bj = 0; bj < 2; ++bj)
#pragma unroll
                    for (int n = 0; n < 2; ++n) r[mm][bj][n] = *(const f32x4*)(R + off + bj * 128 + n * 16); }
#pragma unroll
            for (int mm = 0; mm < 2; ++mm) { const size_t off = (size_t)(row0 + ai * 128 + (mp * 2 + mm) * 16) * D + col0;
#pragma unroll
                for (int bj = 0; bj < 2; ++bj)
#pragma unroll
                    for (int n = 0; n < 2; ++n) *(f32x4*)(C + off + bj * 128 + n * 16) = r[mm][bj][n] + gv[bj][n] * acc[ai][bj][mp * 2 + mm][n]; }
          }
    } };
struct EpiSwiglu { static constexpr bool PERM = true; bf16_t* O; int ldo;
    __device__ __forceinline__ void operator()(AccRef acc, const Unit& u, int wr, int wc, int fr, int fq) const {
        const int row0 = u.pm * 256 + wr * 64 + fr, col0 = u.pn * 128 + wc * 32 + 8 * fq;
#pragma unroll
        for (int ai = 0; ai < 2; ++ai)
#pragma unroll
            for (int m = 0; m < 4; ++m) { bf16_t* rowp = O + (size_t)(row0 + ai * 128 + m * 16) * ldo + col0;
                float o[8];
#pragma unroll
                for (int n = 0; n < 2; ++n)
#pragma unroll
                    for (int j = 0; j < 4; ++j) { const float a = acc[ai][0][m][n][j], b = acc[ai][1][m][n][j]; o[n * 4 + j] = a * __builtin_amdgcn_rcpf(1.0f + __expf(-a)) * b; }
                u32x4 w; w.x = cvt_pk_bf16(o[0], o[1]); w.y = cvt_pk_bf16(o[2], o[3]); w.z = cvt_pk_bf16(o[4], o[5]); w.w = cvt_pk_bf16(o[6], o[7]);
                *(u32x4*)rowp = w; }
    } };

struct EpiSwigluF8 { static constexpr bool PERM = true; unsigned char* O; int ldo; float sc;
    __device__ __forceinline__ void operator()(AccRef acc, const Unit& u, int wr, int wc, int fr, int fq) const {
        const int row0 = u.pm * 256 + wr * 64 + fr, col0 = u.pn * 128 + wc * 32 + 8 * fq;
#pragma unroll
        for (int ai = 0; ai < 2; ++ai)
#pragma unroll
            for (int m = 0; m < 4; ++m) { unsigned char* rowp = O + (size_t)(row0 + ai * 128 + m * 16) * ldo + col0;
                float o[8];
#pragma unroll
                for (int n = 0; n < 2; ++n)
#pragma unroll
                    for (int j = 0; j < 4; ++j) { const float a = acc[ai][0][m][n][j] * sc, b = acc[ai][1][m][n][j] * sc; o[n * 4 + j] = a * __builtin_amdgcn_rcpf(1.0f + __expf(-a)) * b; }
                u32x2 w; w.x = pk4_fp8(o[0], o[1], o[2], o[3]); w.y = pk4_fp8(o[4], o[5], o[6], o[7]);
                *(u32x2*)rowp = w; }
    } };
struct EpiBf16S { static constexpr bool PERM = true; bf16_t* O; int ldo; float sc;
    __device__ __forceinline__ void operator()(AccRef acc, const Unit& u, int wr, int wc, int fr, int fq) const {
        const int row0 = u.pm * 256 + wr * 64 + fr, col0 = u.pn * 256 + wc * 32 + 8 * fq;
#pragma unroll
        for (int ai = 0; ai < 2; ++ai)
#pragma unroll
            for (int m = 0; m < 4; ++m) { bf16_t* rowp = O + (size_t)(row0 + ai * 128 + m * 16) * ldo + col0;
#pragma unroll
                for (int bj = 0; bj < 2; ++bj) { const f32x4 v0 = acc[ai][bj][m][0] * sc, v1 = acc[ai][bj][m][1] * sc;
                    u32x4 w; w.x = cvt_pk_bf16(v0[0], v0[1]); w.y = cvt_pk_bf16(v0[2], v0[3]); w.z = cvt_pk_bf16(v1[0], v1[1]); w.w = cvt_pk_bf16(v1[2], v1[3]);
                    *(u32x4*)(rowp + bj * 128) = w; } }
    } };

struct MapPlain { const float* src; int ld, ncols;
    __device__ __forceinline__ const float* operator()(int n0) const { return n0 < ncols ? src + n0 : nullptr; } __device__ __forceinline__ int stride() const { return ld; } __device__ __forceinline__ bool valid(int n) const { return n < ncols; } };
struct MapIl { const float* s1; long d31; int ld;
    __device__ __forceinline__ const float* operator()(int n0) const { const int t = n0 >> 8, j = n0 & 255; return s1 + (j < 128 ? 0l : d31) + t * 128 + (j & 127); } __device__ __forceinline__ int stride() const { return ld; } __device__ __forceinline__ bool valid(int) const { return true; } };
template <bool FP8, class MAP>
__device__ __forceinline__ void cvt_ring(LAS unsigned char* lds, const MAP& map, void* dstv, int Nd, int K, float scale, int G, int c) {
    constexpr int NS = 4, SLOT = 32768;
    const int tid = threadIdx.x, wave = __builtin_amdgcn_readfirstlane(tid >> 6), lane = tid & 63;
    const int ntk = K / 128, nnt = Nd / 64, ntiles = nnt * ntk;
    if (c >= ntiles) return;
    const int nmine = (ntiles - c + G - 1) / G;
    const int ld = map.stride();
    __syncthreads();
    auto issue = [&](int it) {
        const int itc = it < nmine ? it : nmine - 1, tile = c + itc * G;
        const int n0 = (tile % nnt) * 64, k0 = (tile / nnt) * 128;
        const float* sp = map(n0);
        const int col = (lane & 15) * 4, colc = (sp && map.valid(n0 + col)) ? col : 0;
        const float* base = (sp ? sp : map(0)) + colc;
        LAS unsigned char* sl = lds + (it % NS) * SLOT + wave * 4096;
#pragma unroll
        for (int i = 0; i < 4; ++i)
            __builtin_amdgcn_global_load_lds((const unsigned*)(base + (size_t)(k0 + wave * 16 + i * 4 + (lane >> 4)) * ld), (LAS unsigned*)(sl + i * 1024), 16, 0, 0);
    };
#pragma unroll
    for (int i = 0; i < NS - 1; ++i) issue(i);
    for (int it = 0; it < nmine; ++it) {
        asm volatile("s_waitcnt vmcnt(8)" ::: "memory");
        __syncthreads();
        issue(it + NS - 1);
        const int tile = c + it * G, n0 = (tile % nnt) * 64, k0 = (tile / nnt) * 128;
        const LAS float* T = (const LAS float*)(lds + (it % NS) * SLOT);
        const bool ok = map(n0) != nullptr && map.valid(n0 + lane);
        if constexpr (FP8) {
            float v[16];
#pragma unroll
            for (int j = 0; j < 16; ++j) v[j] = ok ? T[(wave * 16 + j) * 64 + lane] * scale : 0.f;
            u32x4 w; w.x = pk4_fp8(v[0], v[1], v[2], v[3]); w.y = pk4_fp8(v[4], v[5], v[6], v[7]); w.z = pk4_fp8(v[8], v[9], v[10], v[11]); w.w = pk4_fp8(v[12], v[13], v[14], v[15]);
            *(u32x4*)((unsigned char*)dstv + (size_t)(n0 + lane) * K + k0 + wave * 16) = w;
        } else {
#pragma unroll
            for (int h = 0; h < 2; ++h) { const int kg = wave + 8 * h; float v[8];
#pragma unroll
                for (int j = 0; j < 8; ++j) v[j] = ok ? T[(kg * 8 + j) * 64 + lane] : 0.f;
                u32x4 w; w.x = cvt_pk_bf16(v[0], v[1]); w.y = cvt_pk_bf16(v[2], v[3]); w.z = cvt_pk_bf16(v[4], v[5]); w.w = cvt_pk_bf16(v[6], v[7]);
                *(u32x4*)((bf16_t*)dstv + (size_t)(n0 + lane) * K + k0 + kg * 8) = w; }
        }
    }
    asm volatile("s_waitcnt vmcnt(0)" ::: "memory");
    __syncthreads();
}
template <class MAP> __device__ __forceinline__ void cvt_T(LAS unsigned char* lds, const MAP& map, bf16_t* dst, int Nd, int K, int G, int c) { cvt_ring<false>(lds, map, dst, Nd, K, 1.f, G, c); }
template <class MAP> __device__ __forceinline__ void cvt_T8(LAS unsigned char* lds, const MAP& map, unsigned char* dst, int Nd, int K, float scale, int G, int c) { cvt_ring<true>(lds, map, dst, Nd, K, scale, G, c); }
__device__ __forceinline__ void cvt_copy(const float* src, bf16_t* dst, size_t n, int G, int c) {
    for (size_t i = ((size_t)c * 512 + threadIdx.x) * 8; i < n; i += (size_t)G * 512 * 8) {
        const float4 a = *(const float4*)(src + i), b = *(const float4*)(src + i + 4);
        u32x4 w; w.x = cvt_pk_bf16(a.x, a.y); w.y = cvt_pk_bf16(a.z, a.w); w.z = cvt_pk_bf16(b.x, b.y); w.w = cvt_pk_bf16(b.z, b.w);
        *(u32x4*)(dst + i) = w;
    }
}


__device__ __forceinline__ f32x2 gelu_pk(f32x2 v) {
    const f32x2 av = __builtin_elementwise_abs(v), d = av * 0.2316418882f + 1.0f;
    f32x2 t; t.x = __builtin_amdgcn_rcpf(d.x); t.y = __builtin_amdgcn_rcpf(d.y);
    f32x2 q = t * 0.5307027145f + (-0.7265760135f); q = q * t + 0.7107068705f; q = q * t + (-0.142248368f); q = q * t + 0.127414796f; q = q * t;
    const f32x2 s = (v * v) * (-0.72134752044f);
    f32x2 e; e.x = __builtin_amdgcn_exp2f(s.x); e.y = __builtin_amdgcn_exp2f(s.y);
    const f32x2 m = v * (q * e), r = v - m;
    f32x2 o; o.x = v.x < 0.f ? m.x : r.x; o.y = v.y < 0.f ? m.y : r.y; return o;
}
struct EpiGelu { static constexpr bool PERM = false; bf16_t* U; float* VG;
    __device__ __forceinline__ void operator()(AccRef acc, const Unit& u, int wr, int wc, int fr, int fq) const {
        const int row0 = u.pm * 256 + wr * 64 + fr, col0 = (u.pn & 7) * 256 + wc * 32 + 4 * fq;
        const bool isu = u.pn < 8;
#pragma unroll
        for (int ai = 0; ai < 2; ++ai)
#pragma unroll
            for (int m = 0; m < 4; ++m) { const size_t off = (size_t)(row0 + ai * 128 + m * 16) * D + col0;
#pragma unroll
                for (int bj = 0; bj < 2; ++bj)
#pragma unroll
                    for (int n = 0; n < 2; ++n) { const f32x4 v = acc[ai][bj][m][n];
                        const f32x2 a = gelu_pk((f32x2){v[0], v[1]}), b = gelu_pk((f32x2){v[2], v[3]});
                        if (isu) { u32x2 w; w.x = cvt_pk_bf16(a.x, a.y); w.y = cvt_pk_bf16(b.x, b.y); *(u32x2*)(U + off + bj * 128 + n * 16) = w; }
                        else *(f32x4*)(VG + off + bj * 128 + n * 16) = (f32x4){a.x, a.y, b.x, b.y}; } }
    } };

namespace pg8 {
struct MoeOrder {
    int cnt_t[8], off_t[8], nN, G, c, lda, ldb; const char* A; const char* B; size_t bstride;
    __device__ void init(const int* cnt, const int* off, const bf16_t* A_, int lda_, const bf16_t* B_, int ldb_, size_t bstride_bytes, int N, int G_, int c_) {
#pragma unroll
        for (int e = 0; e < 8; ++e) { cnt_t[e] = __builtin_amdgcn_readfirstlane((cnt[e] + 255) >> 8); off_t[e] = __builtin_amdgcn_readfirstlane(off[e] >> 8); }
        A = (const char*)A_; B = (const char*)B_; lda = lda_; ldb = ldb_; bstride = bstride_bytes; nN = N / 256; G = G_; c = c_;
    }
    __device__ bool next(int i, Unit& u) const {
        const int L = i * G + c, x = L & 7; int q = L >> 3; int e = 0; bool found = false; int te = 0, oe = 0;
        const int n8 = nN >> 3;
#pragma unroll
        for (int k = 0; k < 8; ++k) { const int ue = cnt_t[k] * n8; if (!found) { if (q < ue) { found = true; e = k; te = cnt_t[k]; oe = off_t[k]; } else q -= ue; } }
        if (!found) return false;
        const int pml = q % te; u.pn = (q / te) * 8 + x; u.pm = oe + pml; u.kind = e;
        u.a = A + (size_t)u.pm * 256 * lda * 2; u.b = B + (size_t)e * bstride + (size_t)u.pn * 256 * ldb * 2; return true;
    }
};
}

template <bool ROUTE>
__device__ __forceinline__ void ph_norm_mod(LAS unsigned char* lds, const float* srcL, const float* srcC, const float* gain, const float* mod, int chunk_sh, int chunk_sc, bf16_t* dst, int nrows,
                                            const float* router, int* tope, float* topg, int* bcnt, int G, int bid) {
    const int tid = threadIdx.x, wave = tid >> 6, lane = tid & 63;
    const int rpb = (nrows + G - 1) / G, r0 = bid * rpb, r1 = min(nrows, r0 + rpb);
    LAS int* lc = (LAS int*)lds;
    if (ROUTE) { if (tid < 8) lc[tid] = 0; __syncthreads(); }
    int cur_mrow = -1; float gm[32], shv[32];
    float4 xn[8];
    { const int rw = r0 + wave < r1 ? r0 + wave : r0; const float* s0_ = rw < NL ? srcL + (size_t)rw * D : srcC + (size_t)(rw - NL) * D;
#pragma unroll
      for (int i = 0; i < 8; ++i) xn[i] = *(const float4*)(s0_ + i * 256 + lane * 4); }
    for (int row = r0 + wave; row < r1; row += 8) {
        const int mrow = row < NL ? row / SEQ : 2;
        if (mrow != cur_mrow) { cur_mrow = mrow;
            const float* sh_ = mod + (size_t)mrow * NMOD + chunk_sh * D; const float* sc_ = mod + (size_t)mrow * NMOD + chunk_sc * D;
#pragma unroll
            for (int i = 0; i < 8; ++i) { const int c = i * 256 + lane * 4; const float4 g4 = *(const float4*)(gain + c), sc4 = *(const float4*)(sc_ + c), sh4 = *(const float4*)(sh_ + c);
                gm[i * 4] = g4.x * (1.f + sc4.x); gm[i * 4 + 1] = g4.y * (1.f + sc4.y); gm[i * 4 + 2] = g4.z * (1.f + sc4.z); gm[i * 4 + 3] = g4.w * (1.f + sc4.w);
                shv[i * 4] = sh4.x; shv[i * 4 + 1] = sh4.y; shv[i * 4 + 2] = sh4.z; shv[i * 4 + 3] = sh4.w; } }
        float v[32]; float ss = 0.f;
#pragma unroll
        for (int i = 0; i < 8; ++i) { const float4 x = xn[i]; v[i * 4] = x.x; v[i * 4 + 1] = x.y; v[i * 4 + 2] = x.z; v[i * 4 + 3] = x.w; ss += x.x * x.x + x.y * x.y + x.z * x.z + x.w * x.w; }
        { const int rn = row + 8 < r1 ? row + 8 : row; const float* sn_ = rn < NL ? srcL + (size_t)rn * D : srcC + (size_t)(rn - NL) * D;
#pragma unroll
          for (int i = 0; i < 8; ++i) xn[i] = *(const float4*)(sn_ + i * 256 + lane * 4); }
        ss = wave_sum_dpp(ss);
        const float rs = rsqrtf(ss * (1.0f / D) + 1e-6f);
        float a[8];
        if (ROUTE) {
#pragma unroll
            for (int e = 0; e < 8; ++e) a[e] = 0.f;
        }
#pragma unroll
        for (int i = 0; i < 8; ++i) {
            const int c = i * 256 + lane * 4;
            float o[4];
            o[0] = v[i * 4] * rs * gm[i * 4] + shv[i * 4]; o[1] = v[i * 4 + 1] * rs * gm[i * 4 + 1] + shv[i * 4 + 1];
            o[2] = v[i * 4 + 2] * rs * gm[i * 4 + 2] + shv[i * 4 + 2]; o[3] = v[i * 4 + 3] * rs * gm[i * 4 + 3] + shv[i * 4 + 3];
            if (ROUTE) *(unsigned*)((unsigned char*)dst + (size_t)row * D + c) = pk4_fp8(o[0], o[1], o[2], o[3]);
            else { u32x2 w; w.x = cvt_pk_bf16(o[0], o[1]); w.y = cvt_pk_bf16(o[2], o[3]); *(u32x2*)(dst + (size_t)row * D + c) = w; }
            if (ROUTE) {
#pragma unroll
                for (int j = 0; j < 4; ++j) { const float4 ra = *(const float4*)(router + (size_t)(c + j) * 8), rb = *(const float4*)(router + (size_t)(c + j) * 8 + 4);
                    a[0] += o[j] * ra.x; a[1] += o[j] * ra.y; a[2] += o[j] * ra.z; a[3] += o[j] * ra.w; a[4] += o[j] * rb.x; a[5] += o[j] * rb.y; a[6] += o[j] * rb.z; a[7] += o[j] * rb.w; }
            }
        }
        if (ROUTE) {
#pragma unroll
            for (int e = 0; e < 8; ++e) a[e] = wave_sum(a[e]);
            if (lane == 0) {
                int e0 = 0; float v0 = a[0];
#pragma unroll
                for (int e = 1; e < 8; ++e) if (a[e] > v0) { v0 = a[e]; e0 = e; }
                int e1 = 0; float v1 = -3e38f;
#pragma unroll
                for (int e = 0; e < 8; ++e) if (e != e0 && a[e] > v1) { v1 = a[e]; e1 = e; }
                const float ex = fexp(v1 - v0);
                tope[row * 2] = e0; tope[row * 2 + 1] = e1;
                topg[row * 2] = 1.f / (1.f + ex); topg[row * 2 + 1] = ex / (1.f + ex);
                atomicAdd((int*)&lc[e0], 1); atomicAdd((int*)&lc[e1], 1);
            }
        }
    }
    if (ROUTE) { __syncthreads(); if (tid < 8) bcnt[bid * 8 + tid] = lc[tid]; __syncthreads(); }
}

__device__ __forceinline__ void ph_moe_plan(LAS unsigned char* lds, const int* bcnt, const int* tope, int* slot, int* cntoff, const bf16_t* XNB, bf16_t* XG, int G, int bid) {
    const int tid = threadIdx.x;
    LAS int* base = (LAS int*)lds;
    LAS int* sl = base + 8;
    const int rpb = (NL + G - 1) / G, r0 = bid * rpb, r1 = min(NL, r0 + rpb);
    __syncthreads();
    for (int a = tid; a < (r1 - r0) * 2; a += 512) base[48 + 160 + a] = tope[r0 * 2 + a];
    if (tid < 8) { base[16 + tid] = 0; base[32 + tid] = 0; }
    __syncthreads();
    for (int bq = tid; bq < G; bq += 512) { const int4 c0 = *(const int4*)(bcnt + bq * 8), c1 = *(const int4*)(bcnt + bq * 8 + 4);
        const int cv[8] = {c0.x, c0.y, c0.z, c0.w, c1.x, c1.y, c1.z, c1.w};
#pragma unroll
        for (int e = 0; e < 8; ++e) { atomicAdd((int*)&base[16 + e], cv[e]); if (bq < bid) atomicAdd((int*)&base[32 + e], cv[e]); } }
    __syncthreads();
    if (tid == 0) {
        int off = 0;
        for (int e = 0; e < 8; ++e) { const int tot = base[16 + e]; base[e] = off + base[32 + e]; if (bid == 0) { cntoff[e] = tot; cntoff[8 + e] = off; } off += (tot + 255) & ~255; }
        int cur[8];
#pragma unroll
        for (int e = 0; e < 8; ++e) cur[e] = base[e];
        for (int a = r0 * 2; a < r1 * 2; ++a) { const int e = base[48 + 160 + a - r0 * 2]; int s = 0;
#pragma unroll
            for (int q = 0; q < 8; ++q) if (e == q) { s = cur[q]; cur[q]++; }
            slot[a] = s; base[48 + a - r0 * 2] = s; }
    }
    __syncthreads();
    const int na = (r1 - r0) * 2;
    for (int i0 = tid; i0 < na * 128; i0 += 512 * 4) {
        u32x4 v[4]; int so[4];
#pragma unroll
        for (int k = 0; k < 4; ++k) { const int i = i0 + k * 512; const bool ok = i < na * 128; const int a = ok ? i >> 7 : 0, c16 = i & 127; const int sl_ = base[48 + a], row = r0 + (a >> 1);
            so[k] = ok ? sl_ * (D / 16) + c16 : -1; v[k] = *(const u32x4*)((const unsigned char*)XNB + (size_t)row * D + c16 * 16); }
#pragma unroll
        for (int k = 0; k < 4; ++k) if (so[k] >= 0) *(u32x4*)((unsigned char*)XG + (size_t)so[k] * 16) = v[k];
    }
    __syncthreads();
}

__device__ __forceinline__ void ph_ln_transpose(LAS unsigned char* lds, const float* VG, const float* lnw, const float* lnb, bf16_t* VT, int G, int bid) {
    const int tid = threadIdx.x, wave = tid >> 6, lane = tid & 63;
    LAS bf16_t* T = (LAS bf16_t*)lds;
    for (int unit = bid; unit < NL / 32; unit += G) {
        const int row0 = unit * 32;
        __syncthreads();
        for (int rr = wave; rr < 32; rr += 8) {
            const float* src = VG + (size_t)(row0 + rr) * D;
            float v[32]; float s = 0.f;
#pragma unroll
            for (int i = 0; i < 8; ++i) { const float4 x = *(const float4*)(src + i * 256 + lane * 4); v[i * 4] = x.x; v[i * 4 + 1] = x.y; v[i * 4 + 2] = x.z; v[i * 4 + 3] = x.w; s += (x.x + x.y) + (x.z + x.w); }
            const float mu = wave_sum(s) * (1.f / 2048.f);
            float q = 0.f;
#pragma unroll
            for (int i = 0; i < 32; ++i) { const float dd = v[i] - mu; q += dd * dd; }
            const float rs = rsqrtf(wave_sum(q) * (1.f / 2048.f) + 1e-5f);
#pragma unroll
            for (int i = 0; i < 8; ++i) { const int c = i * 256 + lane * 4;
                const float4 w4 = *(const float4*)(lnw + c), b4 = *(const float4*)(lnb + c);
                u32x2 w; w.x = cvt_pk_bf16((v[i * 4] - mu) * rs * w4.x + b4.x, (v[i * 4 + 1] - mu) * rs * w4.y + b4.y);
                w.y = cvt_pk_bf16((v[i * 4 + 2] - mu) * rs * w4.z + b4.z, (v[i * 4 + 3] - mu) * rs * w4.w + b4.w);
                *(LAS u32x2*)(T + rr * 2048 + c) = w; }
        }
        __syncthreads();
        const int b = row0 / SEQ, n = (row0 % SEQ) / 128, q0 = row0 % 128;
        for (int it = tid; it < 1024 * 4; it += 512) {
            const int qg = it & 3, cp = it >> 2, c = cp * 2;
            unsigned e[8];
#pragma unroll
            for (int j = 0; j < 8; ++j) e[j] = *(const LAS unsigned*)(T + (qg * 8 + j) * 2048 + c);
            u32x4 w0, w1;
            w0.x = (e[0] & 0xffffu) | (e[1] << 16); w0.y = (e[2] & 0xffffu) | (e[3] << 16); w0.z = (e[4] & 0xffffu) | (e[5] << 16); w0.w = (e[6] & 0xffffu) | (e[7] << 16);
            w1.x = (e[0] >> 16) | (e[1] & 0xffff0000u); w1.y = (e[2] >> 16) | (e[3] & 0xffff0000u); w1.z = (e[4] >> 16) | (e[5] & 0xffff0000u); w1.w = (e[6] >> 16) | (e[7] & 0xffff0000u);
            const int g = c >> 7, cl = c & 127;
            bf16_t* dst = VT + ((((size_t)(b * 32 + n) * 16 + g) * 128 + cl) * 128 + q0 + qg * 8);
            *(u32x4*)dst = w0; *(u32x4*)(dst + 128) = w1;
        }
    }
    __syncthreads();
}

__device__ __forceinline__ void ph_spatial(const bf16_t* WS, const bf16_t* VT, const bf16_t* U, const float* bs, bf16_t* GATED, int G, int bid) {
    typedef float f32x16 __attribute__((ext_vector_type(16)));
    const int tid = threadIdx.x, wave = tid >> 6, lane = tid & 63, l32 = lane & 31, half = lane >> 5;
    const int p0 = (wave & 3) * 32, c0 = (wave >> 2) * 64;
    for (int unit = bid; unit < NB * 32 * 16; unit += G) {
        const int g = unit & 15, bn = unit >> 4;
        const bf16_t* Wp = WS + (size_t)g * 128 * 128 + (size_t)(p0 + l32) * 128 + half * 8;
        const bf16_t* Vp = VT + ((size_t)bn * 16 + g) * 128 * 128 + (size_t)(c0 + l32) * 128 + half * 8;
        f32x16 acc0, acc1;
#pragma unroll
        for (int i = 0; i < 16; ++i) { acc0[i] = 0.f; acc1[i] = 0.f; }
#pragma unroll
        for (int ks = 0; ks < 8; ++ks) {
            const bf16x8 w = *(const bf16x8*)(Wp + ks * 16), v0 = *(const bf16x8*)(Vp + ks * 16), v1 = *(const bf16x8*)(Vp + 32 * 128 + ks * 16);
            acc0 = __builtin_amdgcn_mfma_f32_32x32x16_bf16(v0, w, acc0, 0, 0, 0);
            acc1 = __builtin_amdgcn_mfma_f32_32x32x16_bf16(v1, w, acc1, 0, 0, 0);
        }
        const int p = p0 + l32;
        const float bias = bs[g * 128 + p];
        const size_t ob = (size_t)(bn * 128 + p) * D + g * 128 + c0 + 4 * half;
#pragma unroll
        for (int i4 = 0; i4 < 4; ++i4) {
#pragma unroll
            for (int hb = 0; hb < 2; ++hb) {
                const size_t o = ob + hb * 32 + 8 * i4;
                const u32x2 uu = *(const u32x2*)(U + o);
                const float u0 = __uint_as_float(uu.x << 16), u1 = __uint_as_float(uu.x & 0xffff0000u), u2 = __uint_as_float(uu.y << 16), u3 = __uint_as_float(uu.y & 0xffff0000u);
                const f32x16& a = hb == 0 ? acc0 : acc1;
                u32x2 w; w.x = cvt_pk_bf16(u0 * (a[i4 * 4] + bias), u1 * (a[i4 * 4 + 1] + bias)); w.y = cvt_pk_bf16(u2 * (a[i4 * 4 + 2] + bias), u3 * (a[i4 * 4 + 3] + bias));
                *(u32x2*)(GATED + o) = w;
            }
        }
    }
}

__device__ __forceinline__ void ph_final(const float* H, const bf16_t* OUT2, const int* slot, const float* topg, const float* g2, const float* fnorm, float* out, int G, int bid) {
    const int tid = threadIdx.x, wave = tid >> 6, lane = tid & 63;
    float fn[32], gv[32]; int cur_b = -1;
#pragma unroll
    for (int i = 0; i < 8; ++i) { const float4 f = *(const float4*)(fnorm + i * 256 + lane * 4); fn[i * 4] = f.x; fn[i * 4 + 1] = f.y; fn[i * 4 + 2] = f.z; fn[i * 4 + 3] = f.w; }
    for (int row = bid * 8 + wave; row < NL; row += G * 8) {
        const int s0 = slot[row * 2], s1 = slot[row * 2 + 1]; const float g0 = topg[row * 2], g1 = topg[row * 2 + 1];
        const float* h = H + (size_t)row * D; const bf16_t* o0 = OUT2 + (size_t)s0 * D; const bf16_t* o1 = OUT2 + (size_t)s1 * D;
        const int bb = row / SEQ;
        if (bb != cur_b) { cur_b = bb; const float* gg = g2 + (size_t)bb * NMOD;
#pragma unroll
            for (int i = 0; i < 8; ++i) { const float4 g = *(const float4*)(gg + i * 256 + lane * 4); gv[i * 4] = g.x; gv[i * 4 + 1] = g.y; gv[i * 4 + 2] = g.z; gv[i * 4 + 3] = g.w; } }
        float v[32]; float ss = 0.f;
#pragma unroll
        for (int i = 0; i < 8; ++i) { const int c = i * 256 + lane * 4;
            const float4 hv = *(const float4*)(h + c); const u32x2 a = *(const u32x2*)(o0 + c), b = *(const u32x2*)(o1 + c);
            const float a0 = __uint_as_float(a.x << 16), a1 = __uint_as_float(a.x & 0xffff0000u), a2 = __uint_as_float(a.y << 16), a3 = __uint_as_float(a.y & 0xffff0000u);
            const float b0 = __uint_as_float(b.x << 16), b1 = __uint_as_float(b.x & 0xffff0000u), b2 = __uint_as_float(b.y << 16), b3 = __uint_as_float(b.y & 0xffff0000u);
            v[i * 4] = hv.x + gv[i * 4] * (g0 * a0 + g1 * b0); v[i * 4 + 1] = hv.y + gv[i * 4 + 1] * (g0 * a1 + g1 * b1);
            v[i * 4 + 2] = hv.z + gv[i * 4 + 2] * (g0 * a2 + g1 * b2); v[i * 4 + 3] = hv.w + gv[i * 4 + 3] * (g0 * a3 + g1 * b3);
            ss += v[i * 4] * v[i * 4] + v[i * 4 + 1] * v[i * 4 + 1] + v[i * 4 + 2] * v[i * 4 + 2] + v[i * 4 + 3] * v[i * 4 + 3]; }
        const float rs = rsqrtf(wave_sum(ss) * (1.f / D) + 1e-6f);
#pragma unroll
        for (int i = 0; i < 8; ++i) { const int c = i * 256 + lane * 4;
            *(float4*)(out + (size_t)row * D + c) = (float4){v[i * 4] * rs * fn[i * 4], v[i * 4 + 1] * rs * fn[i * 4 + 1], v[i * 4 + 2] * rs * fn[i * 4 + 2], v[i * 4 + 3] * rs * fn[i * 4 + 3]}; }
    }
}

__device__ __forceinline__ void ph_ada(LAS unsigned char* lds, const float* W0, const float* W1, const float* b0, const float* b1, const float* c, const float* cc, float* mod0, float* mod1, int G, int bid) {
    const int tid = threadIdx.x, kq = tid / 24, c4 = tid % 24;
    LAS float* red = (LAS float*)lds;
    for (int u = bid; u < 256; u += G) {
        const int l = u >> 7, col0 = (u & 127) * 96;
        const float* W = (l == 0 ? W0 : W1) + col0 + c4 * 4;
        float a[12];
#pragma unroll
        for (int j = 0; j < 12; ++j) a[j] = 0.f;
        if (kq < 21) {
#pragma unroll 7
            for (int k = kq; k < D; k += 21) {
                const float4 w = *(const float4*)(W + (size_t)k * NMOD);
                const float x0 = c[k], x1 = c[D + k], x2 = cc[k];
                const float s0 = x0 * fsigmoid(x0), s1 = x1 * fsigmoid(x1), s2 = x2 * fsigmoid(x2);
                a[0] += s0 * w.x; a[1] += s0 * w.y; a[2] += s0 * w.z; a[3] += s0 * w.w;
                a[4] += s1 * w.x; a[5] += s1 * w.y; a[6] += s1 * w.z; a[7] += s1 * w.w;
                a[8] += s2 * w.x; a[9] += s2 * w.y; a[10] += s2 * w.z; a[11] += s2 * w.w;
            }
        }
        __syncthreads();
        if (kq < 21) {
#pragma unroll
            for (int j = 0; j < 12; ++j) red[(kq * 24 + c4) * 12 + j] = a[j];
        }
        __syncthreads();
        if (tid < 288) {
            const int cq = tid / 12, rj = tid % 12, row = rj >> 2, j = rj & 3, n = col0 + cq * 4 + j;
            float sum = (l == 0 ? b0 : b1)[n];
            for (int q = 0; q < 21; ++q) sum += red[(q * 24 + cq) * 12 + rj];
            if (!(l == 1 && row == 2)) (l == 0 ? mod0 : mod1)[(size_t)row * NMOD + n] = sum;
        }
    }
    __syncthreads();
}


__device__ __forceinline__ void ph_small_cvt(const float* w_up, const float* a_up, const float* g_up, bf16_t* WLORA, float* ropec, float* ropes, int G, int bid) {
    const int gt = bid * 512 + threadIdx.x, gs = G * 512;
    if (gt < 16) {
        const double x = (double)rope_inv(gt), x2 = x * x;
        double sn = x * (1.0 + x2 * (-1.0 / 6 + x2 * (1.0 / 120 + x2 * (-1.0 / 5040 + x2 * (1.0 / 362880 + x2 * (-1.0 / 39916800 + x2 * (1.0 / 6227020800.0)))))));
        double cs = 1.0 + x2 * (-0.5 + x2 * (1.0 / 24 + x2 * (-1.0 / 720 + x2 * (1.0 / 40320 + x2 * (-1.0 / 3628800 + x2 * (1.0 / 479001600.0 + x2 * (-1.0 / 87178291200.0)))))));
        double c = 1.0, s_ = 0.0;
        for (int pos = 0; pos < 64; ++pos) { ropec[pos * 16 + gt] = (float)c; ropes[pos * 16 + gt] = (float)s_; const double nc = c * cs - s_ * sn, ns = s_ * cs + c * sn; c = nc; s_ = ns; }
    }
    for (int i = gt; i < 5120 * 64; i += gs) {
        const int n = i >> 6, k0 = (i & 63) * 8, g = n >> 10, ch = n & 1023;
        float v[8];
#pragma unroll
        for (int q = 0; q < 8; ++q) { const int k = k0 + q; float x = 0.f;
            if (g < 4) { const int koff = g * 64; if (k >= koff && k < koff + 64) x = (g < 2 ? w_up : a_up)[(size_t)((g & 1) * 64 + (k - koff)) * RD + ch]; }
            else { if (k >= 256 && k < 416) x = g_up[(size_t)(k - 256) * RD + ch]; }
            v[q] = x; }
        u32x4 w; w.x = cvt_pk_bf16(v[0], v[1]); w.y = cvt_pk_bf16(v[2], v[3]); w.z = cvt_pk_bf16(v[4], v[5]); w.w = cvt_pk_bf16(v[6], v[7]);
        *(u32x4*)(WLORA + (size_t)n * 512 + k0) = w;
    }
}
struct MapKV { const float* src; int sel;
    __device__ __forceinline__ const float* operator()(int n0) const { const int h = n0 >> 7, d = n0 & 127; return src + h * 256 + sel * 128 + d; } __device__ __forceinline__ int stride() const { return KVW; } __device__ __forceinline__ bool valid(int) const { return true; } };

__device__ __forceinline__ void ph_prep(const float* Z, const float* qn, const float* kvn, const float* mup, const float* mun, const float* k_k,
                                        bf16_t* CQNB, bf16_t* CKVNB, bf16_t* KRB, bf16_t* LA, float* RR, float* KRf, float* VR, float* AA, const float* ropec, const float* ropes, int G, int bid) {
    const int wave = threadIdx.x >> 6, lane = threadIdx.x & 63;
    for (int row = bid * 8 + wave; row < MALL; row += G * 8) {
        const float* z = Z + (size_t)row * ZLD;
        int t, len; if (row < NL) { t = row % SEQ; len = SEQ; } else { t = (row - NL) % CTX; len = CTX; }
#pragma unroll
        for (int part = 0; part < 2; ++part) {
            const float4 a = *(const float4*)(z + part * 512 + lane * 8), b = *(const float4*)(z + part * 512 + lane * 8 + 4);
            float ss = a.x * a.x + a.y * a.y + a.z * a.z + a.w * a.w + b.x * b.x + b.y * b.y + b.z * b.z + b.w * b.w;
            ss = wave_sum(ss);
            const float rs = rsqrtf(ss * (1.f / 512.f) + 1e-6f);
            const float* gn = (part == 0 ? qn : kvn) + lane * 8;
            const float4 g0 = *(const float4*)gn, g1 = *(const float4*)(gn + 4);
            u32x4 w; w.x = cvt_pk_bf16(a.x * rs * g0.x, a.y * rs * g0.y); w.y = cvt_pk_bf16(a.z * rs * g0.z, a.w * rs * g0.w);
            w.z = cvt_pk_bf16(b.x * rs * g1.x, b.y * rs * g1.y); w.w = cvt_pk_bf16(b.z * rs * g1.z, b.w * rs * g1.w);
            *(u32x4*)((part == 0 ? CQNB : CKVNB) + (size_t)row * 512 + lane * 8) = w;
        }
        {
            const float val = z[1024 + lane]; const float oth = __shfl_xor(val, 16);
            float o = val;
            if (row < NL) {
                const int a = lane >> 5, hf = (lane >> 4) & 1, f = lane & 15;
                const int pos = a == 0 ? (t >> 6) : (t & 63);
                const float cs = ropec[pos * 16 + f], sn = ropes[pos * 16 + f];
                o = hf == 0 ? val * cs - oth * sn : val * cs + oth * sn;
            }
            KRB[(size_t)row * KLD + 1024 + lane] = (bf16_t)(cvt_pk_bf16(o, 0.f) & 0xffffu);
        }
        const float* zc = z + MLA_IN; const float* zp = zc - ZLD; const float* zn = zc + ZLD;
        const bool hp = t > 0, hn = t < len - 1;
#define SHIFT4(jj) ({ const int j_ = (jj); const f32x4 zz = *(const f32x4*)(zc + j_), mp = *(const f32x4*)(mup + j_), mn = *(const f32x4*)(mun + j_); \
            f32x4 pv = {0.f, 0.f, 0.f, 0.f}, nv = pv; if (hp) pv = *(const f32x4*)(zp + j_); if (hn) nv = *(const f32x4*)(zn + j_); zz + mp * (pv - zz) + mn * (nv - zz); })
        { f32x4 a0 = SHIFT4(lane * 4), a1 = SHIFT4((lane + 64) * 4), a2 = SHIFT4((lane + 128) * 4), a3 = SHIFT4((lane + 192) * 4);
          float* dst = RR + hmi(row, lane * 4); *(f32x4*)dst = a0; *(f32x4*)(dst + (size_t)4 * MALL * 64) = a1; *(f32x4*)(dst + (size_t)8 * MALL * 64) = a2; *(f32x4*)(dst + (size_t)12 * MALL * 64) = a3; }
        { f32x4 k[4]; k[0] = SHIFT4(1024 + lane * 4); k[1] = SHIFT4(1024 + (lane + 64) * 4); k[2] = SHIFT4(1024 + (lane + 128) * 4); k[3] = SHIFT4(1024 + (lane + 192) * 4);
#pragma unroll
          for (int i = 0; i < 4; ++i) { const int c = (lane + 64 * i) * 4;
            *(f32x4*)(KRf + hmi(row, c)) = k[i];
            const f32x4 kk = k[i] * *(const f32x4*)(k_k + c);
            float q = kk[0] * kk[0] + kk[1] * kk[1] + kk[2] * kk[2] + kk[3] * kk[3];
            q += __shfl_xor(q, 1); q += __shfl_xor(q, 2); q += __shfl_xor(q, 4); q += __shfl_xor(q, 8);
            const float inv = -1.0f / fmaxf(sqrtf(q), 1e-12f);
            *(f32x4*)(AA + hmi(row, c)) = kk * inv; } }
        { f32x4 a0 = SHIFT4(2048 + lane * 4), a1 = SHIFT4(2048 + (lane + 64) * 4), a2 = SHIFT4(2048 + (lane + 128) * 4), a3 = SHIFT4(2048 + (lane + 192) * 4);
          float* dst = VR + hmi(row, lane * 4); *(f32x4*)dst = a0; *(f32x4*)(dst + (size_t)4 * MALL * 64) = a1; *(f32x4*)(dst + (size_t)8 * MALL * 64) = a2; *(f32x4*)(dst + (size_t)12 * MALL * 64) = a3; }
        {
            const int c0 = lane * 8; f32x4 x0 = {0.f, 0.f, 0.f, 0.f}, x1 = x0;
            if (c0 < 416) { x0 = SHIFT4(3072 + c0); x1 = SHIFT4(3072 + c0 + 4); }
            float o[8];
#pragma unroll
            for (int q = 0; q < 4; ++q) { o[q] = c0 < 128 ? ftanh(x0[q]) : c0 < 256 ? x0[q] : c0 < 416 ? fsigmoid(x0[q]) : 0.f; o[4 + q] = c0 < 128 ? ftanh(x1[q]) : c0 < 256 ? x1[q] : c0 < 416 ? fsigmoid(x1[q]) : 0.f; }
            u32x4 w; w.x = cvt_pk_bf16(o[0], o[1]); w.y = cvt_pk_bf16(o[2], o[3]); w.z = cvt_pk_bf16(o[4], o[5]); w.w = cvt_pk_bf16(o[6], o[7]);
            *(u32x4*)(LA + (size_t)row * 512 + c0) = w;
        }
#undef SHIFT4
    }
}

struct EpiLora { static constexpr bool PERM = false; const float* w0; const float* a0; const float* k_a; const float* KRf; const float* AA; float* WW; float* KD; float* BD; float* GG; int pn0;
    __device__ __forceinline__ void operator()(AccRef acc, const Unit& u, int wr, int wc, int fr, int fq) const {
        const int png = u.pn + pn0, g = __builtin_amdgcn_readfirstlane(png >> 2), row0 = u.pm * 256 + wr * 64 + fr, ch0 = (png & 3) * 256 + wc * 32 + 4 * fq;
        if (g < 2) {
            f32x4 bb[2][2];
#pragma unroll
            for (int bj = 0; bj < 2; ++bj)
#pragma unroll
                for (int n = 0; n < 2; ++n) bb[bj][n] = *(const f32x4*)(w0 + g * RD + ch0 + bj * 128 + n * 16);
            float* dstp = WW + (size_t)g * MALL * RD;
#pragma unroll
            for (int ai = 0; ai < 2; ++ai)
#pragma unroll
                for (int m = 0; m < 4; ++m) { const int row = row0 + ai * 128 + m * 16;
#pragma unroll
                    for (int bj = 0; bj < 2; ++bj)
#pragma unroll
                        for (int n = 0; n < 2; ++n) { const size_t e = hmi(row, ch0 + bj * 128 + n * 16); const f32x4 v = acc[ai][bj][m][n], b = bb[bj][n]; f32x4 o;
#pragma unroll
                            for (int j = 0; j < 4; ++j) { const float y = -(b[j] + v[j]); const float sp = fmaxf(y, 0.f) + flog(1.0f + fexp(-fabsf(y))); o[j] = fexp(-fexp(-sp - 0.5f)); }
                            *(f32x4*)(dstp + e) = o; } }
        } else if (g < 4) {
            const int d = g - 2;
            f32x4 bb[2][2], ka[2][2];
#pragma unroll
            for (int bj = 0; bj < 2; ++bj)
#pragma unroll
                for (int n = 0; n < 2; ++n) { bb[bj][n] = *(const f32x4*)(a0 + d * RD + ch0 + bj * 128 + n * 16); ka[bj][n] = *(const f32x4*)(k_a + ch0 + bj * 128 + n * 16); }
            float* kdp = KD + (size_t)d * MALL * RD; float* bdp = BD + (size_t)d * MALL * RD;
#pragma unroll
            for (int ai = 0; ai < 2; ++ai)
#pragma unroll
                for (int m = 0; m < 4; ++m) {
                    f32x4 kv[2][2], aa[2][2];
#pragma unroll
                    for (int bj = 0; bj < 2; ++bj)
#pragma unroll
                        for (int n = 0; n < 2; ++n) { const size_t e = hmi(row0 + ai * 128 + m * 16, ch0 + bj * 128 + n * 16); kv[bj][n] = *(const f32x4*)(KRf + e); aa[bj][n] = *(const f32x4*)(AA + e); }
#pragma unroll
                    for (int bj = 0; bj < 2; ++bj)
#pragma unroll
                        for (int n = 0; n < 2; ++n) { const size_t e = hmi(row0 + ai * 128 + m * 16, ch0 + bj * 128 + n * 16); const f32x4 v = acc[ai][bj][m][n]; f32x4 okd, obd;
#pragma unroll
                            for (int j = 0; j < 4; ++j) { const float ic = fsigmoid(bb[bj][n][j] + v[j]); okd[j] = kv[bj][n][j] * (1.f + (ic - 1.f) * ka[bj][n][j]); obd[j] = -ic * aa[bj][n][j]; }
                            *(f32x4*)(kdp + e) = okd; *(f32x4*)(bdp + e) = obd; }
                }
        } else {
#pragma unroll
            for (int ai = 0; ai < 2; ++ai)
#pragma unroll
                for (int m = 0; m < 4; ++m)
#pragma unroll
                    for (int bj = 0; bj < 2; ++bj)
#pragma unroll
                        for (int n = 0; n < 2; ++n) *(f32x4*)(GG + hmi(row0 + ai * 128 + m * 16, ch0 + bj * 128 + n * 16)) = acc[ai][bj][m][n];
        }
    } };
struct EpiQ { static constexpr bool PERM = false; bf16_t* QB; const float* ropec; const float* ropes;
    __device__ __forceinline__ void operator()(AccRef acc, const Unit& u, int wr, int wc, int fr, int fq) const {
        const float qs = 0.07216878364870322f * 1.4426950408889634f;
        const int row0 = u.pm * 256 + wr * 64 + fr;
#pragma unroll
        for (int bj = 0; bj < 2; ++bj) {
            const int cg = u.pn * 256 + bj * 128 + wc * 32, part = (cg >> 5) % 6;
#pragma unroll
            for (int ai = 0; ai < 2; ++ai)
#pragma unroll
                for (int m = 0; m < 4; ++m) { const int row = row0 + ai * 128 + m * 16, t = row & (SEQ - 1);
                    f32x4 x1 = acc[ai][bj][m][0], x2 = acc[ai][bj][m][1];
                    if (part >= 4) { const int pos = part == 4 ? (t >> 6) : (t & 63);
                        const f32x4 c = *(const f32x4*)(ropec + pos * 16 + 4 * fq), sn = *(const f32x4*)(ropes + pos * 16 + 4 * fq);
                        const f32x4 o1 = x1 * c - x2 * sn, o2 = x2 * c + x1 * sn; x1 = o1; x2 = o2; }
                    x1 = x1 * qs; x2 = x2 * qs;
                    bf16_t* dst = QB + (size_t)row * QW + cg + 4 * fq;
                    u32x2 w1, w2; w1.x = cvt_pk_bf16(x1[0], x1[1]); w1.y = cvt_pk_bf16(x1[2], x1[3]); w2.x = cvt_pk_bf16(x2[0], x2[1]); w2.y = cvt_pk_bf16(x2[2], x2[3]);
                    *(u32x2*)dst = w1; *(u32x2*)(dst + 16) = w2; }
        }
    } };
struct EpiBf16 { static constexpr bool PERM = true; bf16_t* O; int ldo;
    __device__ __forceinline__ void operator()(AccRef acc, const Unit& u, int wr, int wc, int fr, int fq) const {
        const int row0 = u.pm * 256 + wr * 64 + fr, col0 = u.pn * 256 + wc * 32 + 8 * fq;
#pragma unroll
        for (int ai = 0; ai < 2; ++ai)
#pragma unroll
            for (int m = 0; m < 4; ++m) { bf16_t* rowp = O + (size_t)(row0 + ai * 128 + m * 16) * ldo + col0;
#pragma unroll
                for (int bj = 0; bj < 2; ++bj) { const f32x4 v0 = acc[ai][bj][m][0], v1 = acc[ai][bj][m][1];
                    u32x4 w; w.x = cvt_pk_bf16(v0[0], v0[1]); w.y = cvt_pk_bf16(v0[2], v0[3]); w.z = cvt_pk_bf16(v1[0], v1[1]); w.w = cvt_pk_bf16(v1[2], v1[3]);
                    *(u32x4*)(rowp + bj * 128) = w; } }
    } };
struct EpiVT { static constexpr bool PERM = false; bf16_t* VT;
    __device__ __forceinline__ void operator()(AccRef acc, const Unit& u, int wr, int wc, int fr, int fq) const {
        const int row0 = u.pm * 256 + wr * 64 + fr, pq = ((fq & 1) << 1) | (fq >> 1), col0 = u.pn * 256 + wc * 32 + 4 * pq;
#pragma unroll
        for (int ai = 0; ai < 2; ++ai)
#pragma unroll
            for (int m = 0; m < 4; ++m) { bf16_t* rowp = VT + (size_t)(row0 + ai * 128 + m * 16) * MALL + col0;
#pragma unroll
                for (int bj = 0; bj < 2; ++bj)
#pragma unroll
                    for (int n = 0; n < 2; ++n) { const f32x4 v = acc[ai][bj][m][n]; u32x2 w; w.x = cvt_pk_bf16(v[0], v[1]); w.y = cvt_pk_bf16(v[2], v[3]); *(u32x2*)(rowp + bj * 128 + n * 16) = w; } }
    } };

__device__ __forceinline__ void ph_attn(LAS unsigned char* lds, const bf16_t* QB, const bf16_t* KNB, const bf16_t* VTB, bf16_t* MIXB, int G, int bid) {
    typedef float f32x16 __attribute__((ext_vector_type(16)));
    constexpr int KP = 400, VP = 144, KBYTES = 64 * KP, BUF = KBYTES + 128 * VP, NT = SK / 64;
    const int tid = threadIdx.x, wave = tid >> 6, lane = tid & 63, l32 = lane & 31, half = lane >> 5;
    for (int unit = bid; unit < NB * HM * (SEQ / 256); unit += G) {
        const int bh = unit & 15, qb = unit >> 4, b = bh >> 3, h = bh & 7;
        const int qrow = b * SEQ + qb * 256 + wave * 32 + l32;
        bf16x8 qf[12];
#pragma unroll
        for (int ks = 0; ks < 12; ++ks) qf[ks] = *(const bf16x8*)(QB + (size_t)qrow * QW + h * 192 + ks * 16 + half * 8);
        f32x16 o[4];
#pragma unroll
        for (int d = 0; d < 4; ++d)
#pragma unroll
            for (int i = 0; i < 16; ++i) o[d][i] = 0.f;
        float mrun = -1e30f, lrun = 0.f;
        int ko[3], kd[3], vo[2], vd[2];
#pragma unroll
        for (int i = 0; i < 3; ++i) { const int id = tid + 512 * i, key = id / 24, cc = id % 24;
            ko[i] = key * KLD + (cc < 16 ? h * 128 + cc * 8 : 1024 + (cc - 16) * 8); kd[i] = key * KP + cc * 16; }
#pragma unroll
        for (int i = 0; i < 2; ++i) { const int id = tid + 512 * i, dv = id >> 3, cc = id & 7;
            vo[i] = (h * 128 + dv) * MALL + cc * 8; vd[i] = KBYTES + dv * VP + cc * 16; }
        u32x4 kr_[3], vr_[2];
        __syncthreads();
        {   const int trow = NL + b * CTX;
#pragma unroll
            for (int i = 0; i < 3; ++i) kr_[i] = *(const u32x4*)(KNB + (size_t)(ko[i] + trow * KLD));
#pragma unroll
            for (int i = 0; i < 2; ++i) vr_[i] = *(const u32x4*)(VTB + (size_t)(vo[i] + trow));
#pragma unroll
            for (int i = 0; i < 3; ++i) *(LAS u32x4*)(lds + kd[i]) = kr_[i];
#pragma unroll
            for (int i = 0; i < 2; ++i) *(LAS u32x4*)(lds + vd[i]) = vr_[i];
        }
        __syncthreads();
        for (int j = 0; j < NT; ++j) {
            LAS unsigned char* cb = lds + (j & 1) * BUF;
            if (j + 1 < NT) {
                const int jn = j + 1, trow = jn < 4 ? NL + b * CTX + 64 * jn : b * SEQ + 64 * (jn - 4);
#pragma unroll
                for (int i = 0; i < 3; ++i) kr_[i] = *(const u32x4*)(KNB + (size_t)(ko[i] + trow * KLD));
#pragma unroll
                for (int i = 0; i < 2; ++i) vr_[i] = *(const u32x4*)(VTB + (size_t)(vo[i] + trow));
            }
            f32x16 s0, s1;
#pragma unroll
            for (int i = 0; i < 16; ++i) { s0[i] = 0.f; s1[i] = 0.f; }
#pragma unroll
            for (int ks = 0; ks < 12; ++ks) {
                const bf16x8 a0 = *(const LAS bf16x8*)(cb + l32 * KP + ks * 32 + half * 16), a1 = *(const LAS bf16x8*)(cb + (32 + l32) * KP + ks * 32 + half * 16);
                s0 = __builtin_amdgcn_mfma_f32_32x32x16_bf16(a0, qf[ks], s0, 0, 0, 0);
                s1 = __builtin_amdgcn_mfma_f32_32x32x16_bf16(a1, qf[ks], s1, 0, 0, 0);
            }
            float mx = s0[0];
#pragma unroll
            for (int i = 1; i < 16; ++i) mx = fmaxf(mx, s0[i]);
#pragma unroll
            for (int i = 0; i < 16; ++i) mx = fmaxf(mx, s1[i]);
            mx = fmaxf(mx, __shfl_xor(mx, 32));
            const float mn = fmaxf(mrun, mx);
            const float alpha = __builtin_amdgcn_exp2f(mrun - mn);
            mrun = mn;
            float ps = 0.f;
#pragma unroll
            for (int i = 0; i < 16; ++i) { s0[i] = __builtin_amdgcn_exp2f(s0[i] - mn); s1[i] = __builtin_amdgcn_exp2f(s1[i] - mn); ps += s0[i] + s1[i]; }
            lrun = lrun * alpha + ps;
#pragma unroll
            for (int d = 0; d < 4; ++d)
#pragma unroll
                for (int i = 0; i < 16; ++i) o[d][i] *= alpha;
            bf16x8 pf[4];
#pragma unroll
            for (int s = 0; s < 4; ++s) {
                u32x4 w;
                if (s < 2) { const int i0 = (s & 1) * 8; w.x = cvt_pk_bf16(s0[i0], s0[i0 + 1]); w.y = cvt_pk_bf16(s0[i0 + 2], s0[i0 + 3]); w.z = cvt_pk_bf16(s0[i0 + 4], s0[i0 + 5]); w.w = cvt_pk_bf16(s0[i0 + 6], s0[i0 + 7]); }
                else { const int i0 = (s & 1) * 8; w.x = cvt_pk_bf16(s1[i0], s1[i0 + 1]); w.y = cvt_pk_bf16(s1[i0 + 2], s1[i0 + 3]); w.z = cvt_pk_bf16(s1[i0 + 4], s1[i0 + 5]); w.w = cvt_pk_bf16(s1[i0 + 6], s1[i0 + 7]); }
                pf[s] = __builtin_bit_cast(bf16x8, w);
            }
#pragma unroll
            for (int s = 0; s < 4; ++s)
#pragma unroll
                for (int d = 0; d < 4; ++d) {
                    const bf16x8 vf = *(const LAS bf16x8*)(cb + KBYTES + (32 * d + l32) * VP + s * 32 + half * 16);
                    o[d] = __builtin_amdgcn_mfma_f32_32x32x16_bf16(vf, pf[s], o[d], 0, 0, 0);
                }
            if (j + 1 < NT) {
                LAS unsigned char* nb = lds + ((j + 1) & 1) * BUF;
#pragma unroll
                for (int i = 0; i < 3; ++i) *(LAS u32x4*)(nb + kd[i]) = kr_[i];
#pragma unroll
                for (int i = 0; i < 2; ++i) *(LAS u32x4*)(nb + vd[i]) = vr_[i];
            }
            __syncthreads();
        }
        lrun += __shfl_xor(lrun, 32);
        const float il = 1.0f / lrun;
        bf16_t* dst = MIXB + (size_t)qrow * D + h * 128 + 4 * half;
#pragma unroll
        for (int d = 0; d < 4; ++d)
#pragma unroll
            for (int i4 = 0; i4 < 4; ++i4) { u32x2 w; w.x = cvt_pk_bf16(o[d][i4 * 4] * il, o[d][i4 * 4 + 1] * il); w.y = cvt_pk_bf16(o[d][i4 * 4 + 2] * il, o[d][i4 * 4 + 3] * il);
                *(u32x2*)(dst + 32 * d + 8 * i4) = w; }
    }
    __syncthreads();
}


constexpr int SC_CL = 272, SC_NC = 16;
__device__ __forceinline__ int scan_row(int b, int d, int g) {
    if (g < CTX) return NL + b * CTX + (d == 0 ? g : CTX - 1 - g);
    const int tp = g - CTX; return b * SEQ + (d == 0 ? tp : SEQ - 1 - tp);
}
#define DPP_FMAC(d, a, b, n) asm volatile("v_fmac_f32_dpp %0, %1, %2 row_newbcast:" #n " row_mask:0xf bank_mask:0xf" : "+v"(d) : "v"(a), "v"(b))
#define DPP_MULD(d, a, n)    asm volatile("v_mul_f32_dpp %0, %1, %0 row_newbcast:" #n " row_mask:0xf bank_mask:0xf" : "+v"(d) : "v"(a))
#define SC_FOR16(X) X(0) X(1) X(2) X(3) X(4) X(5) X(6) X(7) X(8) X(9) X(10) X(11) X(12) X(13) X(14) X(15)
struct MoeCv { const float* w1; long d31; const float* w2; unsigned char* W13E; unsigned char* W2E; };
constexpr int CV_PER_WAVE = 336, CV_ITEMS_W13 = 3584, CV_ITEMS_E = 5376, CV_WLDS = 4096;
static_assert((size_t)NE * CV_ITEMS_E * 8 == (size_t)CV_PER_WAVE * 1024, "MoE conversion tiles must split evenly over 1024 waves");
static_assert(4 * 5 * 6144 + 4 * CV_WLDS <= LDS_CTL, "scan rings + conversion images must fit below the LDS control words");
struct CvItem { const float* sp; unsigned char* dst; int ld, K; float sc; };
__device__ __forceinline__ CvItem cv_item(const MoeCv& mc, int it, int cw) {
    const int I = it * 1024 + cw, e = I / CV_ITEMS_E, r = I - e * CV_ITEMS_E;
    CvItem o;
    if (r < CV_ITEMS_W13) { const int kr = r / 224, nt = r - kr * 224, n0 = nt * 64, jj = n0 & 255;
        o.sp = mc.w1 + (jj < 128 ? 0l : mc.d31) + (size_t)e * D * DFF + (size_t)kr * 128 * DFF + (n0 >> 8) * 128 + (jj & 127); o.ld = DFF;
        o.dst = mc.W13E + (size_t)e * 2 * DFF * D + (size_t)n0 * D + kr * 128; o.K = D; o.sc = 64.f; }
    else { const int r2 = r - CV_ITEMS_W13, kr = r2 >> 5, n0 = (r2 & 31) * 64;
        o.sp = mc.w2 + (size_t)e * DFF * D + (size_t)kr * 128 * D + n0; o.ld = D;
        o.dst = mc.W2E + (size_t)e * D * DFF + (size_t)n0 * DFF + kr * 128; o.K = DFF; o.sc = 128.f; }
    return o;
}
__device__ __forceinline__ void moe_cvt_wave(LAS unsigned char* ct, const MoeCv& mc, int cw, int lane) {
    constexpr int NIT = CV_PER_WAVE / 8;
    const int l15 = lane & 15, l4 = lane >> 4;
    f32x4 buf[8][4];
    CvItem cur = cv_item(mc, 0, cw);
    { const float* lp = cur.sp + (size_t)(l4 * cur.ld + l15 * 4);
#pragma unroll
      for (int s = 0; s < 8; ++s)
#pragma unroll
        for (int q = 0; q < 4; ++q) buf[s][q] = *(const f32x4*)(lp + (size_t)(s * 16 + q * 4) * cur.ld); }
#pragma unroll 1
    for (int it = 0; it < NIT; ++it) {
        const CvItem nxt = cv_item(mc, it + 1 < NIT ? it + 1 : NIT - 1, cw);
        const float* lp = nxt.sp + (size_t)(l4 * nxt.ld + l15 * 4);
        unsigned char* dp = cur.dst + (size_t)lane * cur.K;
        const float sc = cur.sc;
        u32x4 wout[8];
#pragma unroll
        for (int s = 0; s < 8; ++s) {
#pragma unroll
            for (int q = 0; q < 4; ++q) *(LAS f32x4*)(ct + q * 1024 + lane * 16) = buf[s][q];
#pragma unroll
            for (int q = 0; q < 4; ++q) buf[s][q] = *(const f32x4*)(lp + (size_t)(s * 16 + q * 4) * nxt.ld);
            float v[16];
#pragma unroll
            for (int j = 0; j < 16; ++j) v[j] = ((const LAS float*)ct)[j * 64 + lane];
            u32x4 w; w.x = pk4_fp8(v[0] * sc, v[1] * sc, v[2] * sc, v[3] * sc); w.y = pk4_fp8(v[4] * sc, v[5] * sc, v[6] * sc, v[7] * sc);
            w.z = pk4_fp8(v[8] * sc, v[9] * sc, v[10] * sc, v[11] * sc); w.w = pk4_fp8(v[12] * sc, v[13] * sc, v[14] * sc, v[15] * sc);
            wout[s] = w;
        }
#pragma unroll
        for (int s = 0; s < 8; ++s) *(u32x4*)(dp + s * 16) = wout[s];
        cur = nxt;
    }
#pragma unroll
    for (int s = 0; s < 8; ++s) asm volatile("" :: "v"(buf[s][0]), "v"(buf[s][1]), "v"(buf[s][2]), "v"(buf[s][3]));
}
constexpr int SC_NSLOT = 5, SC_SLOTB = 6144, SC_WLDS = SC_NSLOT * SC_SLOTB;
#define SC_VSET(P) f32x4 P##av, P##wv, P##bv, P##kv, P##rv; float P##vv
#define SC_READV(P, sl) do { P##av = *(const LAS f32x4*)((sl) + l15 * 16); P##wv = *(const LAS f32x4*)((sl) + 1024 + l15 * 16); P##bv = *(const LAS f32x4*)((sl) + 2048 + l15 * 16); \
            P##kv = *(const LAS f32x4*)((sl) + 3072 + l15 * 16); P##rv = *(const LAS f32x4*)((sl) + 4096 + l15 * 16); P##vv = *(const LAS float*)((sl) + 5120 + lane * 4); } while (0)
#define SC_STEP(P, i) do { \
            float a0 = P##av[0], a1 = P##av[1], a2 = P##av[2], a3 = P##av[3], w0 = P##wv[0], w1 = P##wv[1], w2 = P##wv[2], w3 = P##wv[3], b0 = P##bv[0], b1 = P##bv[1], b2 = P##bv[2], b3 = P##bv[3]; \
            float k0 = P##kv[0], k1 = P##kv[1], k2 = P##kv[2], k3 = P##kv[3], r0 = P##rv[0], r1 = P##rv[1], r2 = P##rv[2], r3 = P##rv[3], vq = P##vv; \
            asm volatile("s_nop 1" : "+v"(a0), "+v"(a1), "+v"(a2), "+v"(a3)); \
            float c0 = 0.f, c1 = 0.f, c2 = 0.f, c3 = 0.f, e0 = 0.f, e1 = 0.f, e2 = 0.f, e3 = 0.f; \
            SC_FOR16(SC_SA) \
            float saq = (c0 + c1) + (c2 + c3), sap = (e0 + e1) + (e2 + e3); \
            asm volatile("s_nop 1" : "+v"(w0), "+v"(w1), "+v"(w2), "+v"(w3), "+v"(b0), "+v"(b1), "+v"(b2), "+v"(b3), "+v"(saq), "+v"(sap)); \
            SC_FOR16(SC_UP) \
            asm volatile("s_nop 1" : "+v"(k0), "+v"(k1), "+v"(k2), "+v"(k3), "+v"(vq)); \
            SC_FOR16(SC_VK) \
            if (gbase + (i) >= CTX) { \
                float y0 = 0.f, y1 = 0.f, y2 = 0.f, y3 = 0.f, z0 = 0.f, z1 = 0.f, z2 = 0.f, z3 = 0.f; \
                asm volatile("s_nop 1" : "+v"(r0), "+v"(r1), "+v"(r2), "+v"(r3)); \
                SC_FOR16(SC_Y) \
                const size_t yo_ = (size_t)scan_row(b, d, gbase + (i)) * 64; \
                ypq[yo_ + lane] = (y0 + y1) + (y2 + y3); ypp[yo_ + lane] = (z0 + z1) + (z2 + z3); \
            } } while (0)
#define SC_SA(n) DPP_FMAC(c0, a0, SQ[4 * n], n); DPP_FMAC(c1, a1, SQ[4 * n + 1], n); DPP_FMAC(c2, a2, SQ[4 * n + 2], n); DPP_FMAC(c3, a3, SQ[4 * n + 3], n); \
                 DPP_FMAC(e0, a0, SP[4 * n], n); DPP_FMAC(e1, a1, SP[4 * n + 1], n); DPP_FMAC(e2, a2, SP[4 * n + 2], n); DPP_FMAC(e3, a3, SP[4 * n + 3], n);
#define SC_UP(n) DPP_MULD(SQ[4 * n], w0, n); DPP_MULD(SQ[4 * n + 1], w1, n); DPP_MULD(SQ[4 * n + 2], w2, n); DPP_MULD(SQ[4 * n + 3], w3, n); \
                 DPP_MULD(SP[4 * n], w0, n); DPP_MULD(SP[4 * n + 1], w1, n); DPP_MULD(SP[4 * n + 2], w2, n); DPP_MULD(SP[4 * n + 3], w3, n); \
                 DPP_FMAC(SQ[4 * n], b0, saq, n); DPP_FMAC(SQ[4 * n + 1], b1, saq, n); DPP_FMAC(SQ[4 * n + 2], b2, saq, n); DPP_FMAC(SQ[4 * n + 3], b3, saq, n); \
                 DPP_FMAC(SP[4 * n], b0, sap, n); DPP_FMAC(SP[4 * n + 1], b1, sap, n); DPP_FMAC(SP[4 * n + 2], b2, sap, n); DPP_FMAC(SP[4 * n + 3], b3, sap, n);
#define SC_VK(n) DPP_FMAC(SQ[4 * n], k0, vq, n); DPP_FMAC(SQ[4 * n + 1], k1, vq, n); DPP_FMAC(SQ[4 * n + 2], k2, vq, n); DPP_FMAC(SQ[4 * n + 3], k3, vq, n);
#define SC_Y(n) DPP_FMAC(y0, r0, SQ[4 * n], n); DPP_FMAC(y1, r1, SQ[4 * n + 1], n); DPP_FMAC(y2, r2, SQ[4 * n + 2], n); DPP_FMAC(y3, r3, SQ[4 * n + 3], n); \
                DPP_FMAC(z0, r0, SP[4 * n], n); DPP_FMAC(z1, r1, SP[4 * n + 1], n); DPP_FMAC(z2, r2, SP[4 * n + 2], n); DPP_FMAC(z3, r3, SP[4 * n + 3], n);
__device__ __forceinline__ void ph_scan1(LAS unsigned char* lds, const float* wsf, unsigned oAA, unsigned oWW, unsigned oBD, unsigned oKD, unsigned oRR, unsigned oVR, float* YP, float* QP, const MoeCv mc, int G, int bid) {
    const int wave = __builtin_amdgcn_readfirstlane(threadIdx.x >> 6), lane = threadIdx.x & 63, l15 = lane & 15, vi = lane >> 4;
    if (wave >= 4) { for (int pb = bid; pb < 256; pb += G) moe_cvt_wave(lds + 4 * SC_WLDS + (wave - 4) * CV_WLDS, mc, pb * 4 + (wave - 4), lane); return; }
    LAS unsigned char* ring = lds + wave * SC_WLDS;
    for (int pb = bid; pb < 256; pb += G) {
        const int pair = pb * 4 + wave, chain = pair >> 4, chunk = pair & 15;
        const int b = chain >> 5, h = (chain >> 1) & 15, d = chain & 1;
        const unsigned dofs = (unsigned)d * MALL * RD;
        const unsigned oh = (unsigned)h * (MALL * 64), lane4 = lane * 4;
        const unsigned ob0 = oAA + oh, ob1 = oWW + dofs + oh, ob2 = oBD + dofs + oh, ob3 = oKD + dofs + oh, ob4 = oRR + oh, ob5 = oVR + oh;
        float SQ[64], SP[64];
#pragma unroll
        for (int k = 0; k < 64; ++k) { SQ[k] = 0.f; SP[k] = lane == k ? 1.f : 0.f; }
        float* ypq = YP + (size_t)d * NL * RD + (size_t)h * NL * 64;
        float* ypp = YP + (size_t)(2 + d) * NL * RD + (size_t)h * NL * 64;
        const int gbase = chunk * SC_CL;
        constexpr int NGRP = SC_CL / 4;
#define SC_ISSUE(grp, slot) do { const int gq_ = (grp) < NGRP ? (grp) : NGRP - 1; const unsigned ro_ = (unsigned)scan_row(b, d, gbase + 4 * gq_ + (d ? 3 : 0)) * 64; LAS unsigned char* sl_ = ring + (slot) * SC_SLOTB; \
            __builtin_amdgcn_global_load_lds((const unsigned*)(wsf + (ob0 + ro_) + lane4), (LAS unsigned*)sl_, 16, 0, 0); __builtin_amdgcn_global_load_lds((const unsigned*)(wsf + (ob1 + ro_) + lane4), (LAS unsigned*)(sl_ + 1024), 16, 0, 0); \
            __builtin_amdgcn_global_load_lds((const unsigned*)(wsf + (ob2 + ro_) + lane4), (LAS unsigned*)(sl_ + 2048), 16, 0, 0); __builtin_amdgcn_global_load_lds((const unsigned*)(wsf + (ob3 + ro_) + lane4), (LAS unsigned*)(sl_ + 3072), 16, 0, 0); \
            __builtin_amdgcn_global_load_lds((const unsigned*)(wsf + (ob4 + ro_) + lane4), (LAS unsigned*)(sl_ + 4096), 16, 0, 0); __builtin_amdgcn_global_load_lds((const unsigned*)(wsf + (ob5 + ro_) + lane4), (LAS unsigned*)(sl_ + 5120), 16, 0, 0); } while (0)
        SC_ISSUE(0, 0); SC_ISSUE(1, 1); SC_ISSUE(2, 2); SC_ISSUE(3, 3); SC_ISSUE(4, 4);
        SC_VSET(A); SC_VSET(B);
        asm volatile("s_waitcnt vmcnt(24)" ::: "memory");
        const int r0o = d ? 768 : 0, rstep = d ? -256 : 256;
        SC_READV(A, ring + r0o);
        asm volatile("s_waitcnt lgkmcnt(0)" ::: "memory");
        int slot = 0;
#pragma unroll 1
        for (int grp = 0; grp < NGRP; ++grp) {
            const int i = 4 * grp;
            const LAS unsigned char* sl = ring + slot * SC_SLOTB + r0o;
            const int nslot = slot == SC_NSLOT - 1 ? 0 : slot + 1;
            SC_READV(B, sl + rstep);
            SC_STEP(A, i);
            asm volatile("s_waitcnt lgkmcnt(0)" ::: "memory");
            SC_READV(A, sl + 2 * rstep);
            SC_STEP(B, i + 1);
            asm volatile("s_waitcnt lgkmcnt(0)" ::: "memory");
            SC_READV(B, sl + 3 * rstep);
            SC_STEP(A, i + 2);
            asm volatile("s_waitcnt lgkmcnt(0)" ::: "memory");
            SC_ISSUE(grp + SC_NSLOT, slot);
            asm volatile("s_waitcnt vmcnt(24)" ::: "memory");
            SC_READV(A, ring + nslot * SC_SLOTB + r0o);
            SC_STEP(B, i + 3);
            asm volatile("s_waitcnt lgkmcnt(0)" ::: "memory");
            slot = nslot;
        }
        asm volatile("s_waitcnt vmcnt(0)" ::: "memory");
#undef SC_ISSUE
        float* qpq = QP + ((((size_t)chain) * SC_NC + chunk) * 64 + lane) * 64;
        float* qpp = QP + ((((size_t)64 + chain) * SC_NC + chunk) * 64 + lane) * 64;
#pragma unroll
        for (int j = 0; j < 16; ++j) { *(f32x4*)(qpq + 4 * j) = (f32x4){SQ[4 * j], SQ[4 * j + 1], SQ[4 * j + 2], SQ[4 * j + 3]}; *(f32x4*)(qpp + 4 * j) = (f32x4){SP[4 * j], SP[4 * j + 1], SP[4 * j + 2], SP[4 * j + 3]}; }
    }
}
#undef SC_SA
#undef SC_UP
#undef SC_VK
#undef SC_Y
__device__ __forceinline__ void ph_scan_carry(const float* QP, float* SS, int G, int bid) {
    const int wave = __builtin_amdgcn_readfirstlane(threadIdx.x >> 6), lane = threadIdx.x & 63;
    for (int task = bid * 8 + wave; task < 64 * 32; task += G * 8) {
        const int chain = task >> 5, v0 = (task & 31) * 2;
        float s0 = 0.f, s1 = 0.f, P[64];
        const float* Pc = QP + (((size_t)64 + chain) * SC_NC) * 4096 + lane;
        const float* Qc = QP + (((size_t)chain) * SC_NC) * 4096 + v0 * 64 + lane;
        float* Sp = SS + (((size_t)chain * SC_NC) * 64 + v0) * 64 + lane;
#pragma unroll
        for (int k = 0; k < 64; ++k) P[k] = Pc[k * 64];
        float q0 = Qc[0], q1 = Qc[64];
#pragma unroll 1
        for (int c = 0; c < SC_NC - 1; ++c) {
            Sp[0] = s0; Sp[64] = s1; Sp += 4096;
            const int cn = c + 1 < SC_NC - 1 ? 1 : 0;
            Pc += cn * 4096; Qc += cn * 4096;
            float n0 = q0, n1 = q1; const int i0 = __builtin_bit_cast(int, s0), i1 = __builtin_bit_cast(int, s1);
            q0 = Qc[0]; q1 = Qc[64];
#pragma unroll
            for (int k = 0; k < 64; ++k) { const float pk = P[k];
                n0 += __builtin_bit_cast(float, __builtin_amdgcn_readlane(i0, k)) * pk; n1 += __builtin_bit_cast(float, __builtin_amdgcn_readlane(i1, k)) * pk;
                P[k] = Pc[k * 64]; }
            s0 = n0; s1 = n1;
        }
        Sp[0] = s0; Sp[64] = s1;
    }
}
struct FixLd { f32x4 p0, p1; float yl, r, ks, vr, gg; };
__device__ __forceinline__ FixLd fix_load(const float* YP, const float* RR, const float* KD, const float* VR, const float* GG, int row, int h, int lane) {
    FixLd x; const int l15 = lane & 15; const size_t e = ((size_t)h * NL + row) * 64, em = ((size_t)h * MALL + row) * 64;
    x.p0 = *(const f32x4*)(YP + (size_t)2 * NL * RD + e + l15 * 4); x.p1 = *(const f32x4*)(YP + (size_t)3 * NL * RD + e + l15 * 4);
    x.yl = YP[e + lane] + YP[(size_t)NL * RD + e + lane];
    x.r = RR[em + lane]; x.ks = KD[em + lane] + KD[(size_t)MALL * RD + em + lane]; x.vr = VR[em + lane]; x.gg = GG[em + lane];
    return x;
}
__device__ __forceinline__ void ph_scan_fix(const float* YP, const float* SS, const float* RR, const float* KD, const float* VR, const float* GG, const float* r_k, const float* lnw, const float* lnb, bf16_t* MIXB, int G, int bid) {
    const int wave = __builtin_amdgcn_readfirstlane(threadIdx.x >> 6), lane = threadIdx.x & 63;
    for (int task = bid * 8 + wave; task < 2048; task += G * 8) {
        const int b = task >> 10, h = (task >> 6) & 15, t0 = (task & 63) * 64, c = h * 64 + lane;
        const int chain0 = (b * 16 + h) * 2;
        float S0[64], S1[64]; int cc0 = -1, cc1 = -1;
        const float rk = r_k[c], lw = lnw[c], lb = lnb[c];
        FixLd ring[4];
#pragma unroll
        for (int k = 0; k < 4; ++k) ring[k] = fix_load(YP, RR, KD, VR, GG, b * SEQ + t0 + k, h, lane);
#pragma unroll 1
        for (int tt0 = 0; tt0 < 64; tt0 += 4)
#pragma unroll
          for (int k = 0; k < 4; ++k) {
            const int tt = tt0 + k, t = t0 + tt, row = b * SEQ + t;
            const FixLd cu = ring[k];
            { const int tn = tt < 60 ? t + 4 : t; ring[k] = fix_load(YP, RR, KD, VR, GG, b * SEQ + tn, h, lane); }
            const int c0 = (CTX + t) / SC_CL, c1 = (CTX + SEQ - 1 - t) / SC_CL;
            if (c0 != cc0) { cc0 = c0; const float* sp = SS + (((size_t)chain0 * SC_NC + c0) * 64 + lane) * 64;
#pragma unroll
                for (int j = 0; j < 16; ++j) { const f32x4 x = *(const f32x4*)(sp + 4 * j); S0[4 * j] = x[0]; S0[4 * j + 1] = x[1]; S0[4 * j + 2] = x[2]; S0[4 * j + 3] = x[3]; } }
            if (c1 != cc1) { cc1 = c1; const float* sp = SS + (((size_t)(chain0 + 1) * SC_NC + c1) * 64 + lane) * 64;
#pragma unroll
                for (int j = 0; j < 16; ++j) { const f32x4 x = *(const f32x4*)(sp + 4 * j); S1[4 * j] = x[0]; S1[4 * j + 1] = x[1]; S1[4 * j + 2] = x[2]; S1[4 * j + 3] = x[3]; } }
            float a0 = cu.p0[0], a1 = cu.p0[1], a2 = cu.p0[2], a3 = cu.p0[3], b0 = cu.p1[0], b1 = cu.p1[1], b2 = cu.p1[2], b3 = cu.p1[3];
            asm volatile("s_nop 1" : "+v"(a0), "+v"(a1), "+v"(a2), "+v"(a3), "+v"(b0), "+v"(b1), "+v"(b2), "+v"(b3));
            float y0 = 0.f, y1 = 0.f, y2 = 0.f, y3 = 0.f, z0 = 0.f, z1 = 0.f, z2 = 0.f, z3 = 0.f;
#define FX_N(n) DPP_FMAC(y0, a0, S0[4 * n], n); DPP_FMAC(y1, a1, S0[4 * n + 1], n); DPP_FMAC(y2, a2, S0[4 * n + 2], n); DPP_FMAC(y3, a3, S0[4 * n + 3], n); \
                DPP_FMAC(z0, b0, S1[4 * n], n); DPP_FMAC(z1, b1, S1[4 * n + 1], n); DPP_FMAC(z2, b2, S1[4 * n + 2], n); DPP_FMAC(z3, b3, S1[4 * n + 3], n);
            SC_FOR16(FX_N)
#undef FX_N
            const float y = cu.yl + ((y0 + y1) + (y2 + y3)) + ((z0 + z1) + (z2 + z3));
            const float mu = wave_sum_dpp(y) * (1.f / 64.f);
            const float dv = y - mu;
            const float var = wave_sum_dpp(dv * dv) * (1.f / 64.f);
            const float yn = dv * rsqrtf(var + 64e-5f) * lw + lb;
            const float bonus = wave_sum_dpp(cu.r * cu.ks * rk) * cu.vr;
            const float o = (yn + bonus) * cu.gg;
            const float on = __shfl_down(o, 1);
            if ((lane & 1) == 0) *(unsigned*)(MIXB + (size_t)row * D + 1024 + c) = cvt_pk_bf16(o, on);
        }
    }
}

constexpr size_t alb(size_t x) { return (x + 4095) & ~(size_t)4095; }
constexpr size_t CTL_BYTES = 65536;
constexpr size_t MB_CTL = 0;
constexpr size_t B_MOD0 = MB_CTL + CTL_BYTES;
constexpr size_t B_MOD1 = B_MOD0 + alb((size_t)3 * NMOD * 4);
constexpr size_t B_MODP = B_MOD1 + alb((size_t)2 * NMOD * 4);
constexpr size_t MB_ROPE = B_MODP + alb((size_t)2 * 32 * 3 * NMOD * 4);
constexpr size_t B_H = MB_ROPE + 8192;
constexpr size_t MB_XNB = B_H + alb((size_t)NL * D * 4);
constexpr size_t MB_WIN0 = MB_XNB + alb((size_t)MALL * D * 2);
constexpr size_t MB_WO0 = MB_WIN0 + alb((size_t)ZLD * D * 2);
constexpr size_t MB_W13 = MB_WO0 + alb((size_t)D * D * 2);
constexpr size_t MB_W2 = MB_W13 + alb((size_t)2 * DFF * D * 2);
constexpr size_t MB_WUQ = MB_W2 + alb((size_t)D * DFF * 2);
constexpr size_t MB_WKN = MB_WUQ + alb((size_t)QW * 512 * 2);
constexpr size_t MB_WV = MB_WKN + alb((size_t)1024 * 512 * 2);
constexpr size_t MB_WLORA = MB_WV + alb((size_t)1024 * 512 * 2);
constexpr size_t MB_WIN1 = MB_WLORA + alb((size_t)5120 * 512 * 2);
constexpr size_t MB_WO1 = MB_WIN1 + alb((size_t)4096 * D * 2);
constexpr size_t MB_WSB = MB_WO1 + alb((size_t)D * D * 2);
constexpr size_t MB_W13E = MB_WSB + alb((size_t)16 * 128 * 128 * 2);
constexpr size_t MB_W2E = MB_W13E + alb((size_t)NE * 2 * DFF * D);
constexpr size_t B_ACTS = MB_W2E + alb((size_t)NE * D * DFF);
constexpr size_t B_Z = B_ACTS;
constexpr size_t MB_CQNB = B_Z + alb((size_t)MALL * ZLD * 4);
constexpr size_t MB_CKVNB = MB_CQNB + alb((size_t)MALL * 512 * 2);
constexpr size_t MB_LA = MB_CKVNB + alb((size_t)MALL * 512 * 2);
constexpr size_t MB_QB = MB_LA + alb((size_t)MALL * 512 * 2);
constexpr size_t MB_KNB = MB_QB + alb((size_t)NL * QW * 2);
constexpr size_t MB_VTB = MB_KNB + alb((size_t)MALL * KLD * 2);
constexpr size_t B_RR = MB_VTB + alb((size_t)RD * MALL * 2);
constexpr size_t B_KR = B_RR + alb((size_t)MALL * RD * 4);
constexpr size_t B_VR = B_KR + alb((size_t)MALL * RD * 4);
constexpr size_t B_AA = B_VR + alb((size_t)MALL * RD * 4);
constexpr size_t B_WW = B_AA + alb((size_t)MALL * RD * 4);
constexpr size_t B_KD = B_WW + alb((size_t)2 * MALL * RD * 4);
constexpr size_t B_BD = B_KD + alb((size_t)2 * MALL * RD * 4);
constexpr size_t B_GG = B_BD + alb((size_t)2 * MALL * RD * 4);
constexpr size_t MB_YP = B_GG + alb((size_t)MALL * RD * 4);
constexpr size_t MB_QP = MB_YP + alb((size_t)4 * NL * RD * 4);
constexpr size_t MB_SS = MB_QP + alb((size_t)2 * 64 * 16 * 4096 * 4);
constexpr size_t MB_MIXB = MB_SS + alb((size_t)64 * 16 * 4096 * 4);
constexpr size_t MB_ACT = MB_MIXB + alb((size_t)NL * D * 2);
constexpr size_t B_L0END = MB_ACT + alb((size_t)NL * DFF * 2);
constexpr size_t MB_U = B_ACTS;
constexpr size_t MB_VG = MB_U + alb((size_t)NL * D * 2);
constexpr size_t MB_VT = MB_VG + alb((size_t)NL * D * 4);
constexpr size_t MB_GATED = MB_VT + alb((size_t)NL * D * 2);
constexpr size_t MB_XG = MB_GATED + alb((size_t)NL * D * 2);
constexpr size_t MB_ACT2 = MB_XG + alb((size_t)NSLOT * D);
constexpr size_t MB_OUT2 = MB_ACT2 + alb((size_t)NSLOT * DFF);
constexpr size_t MB_ROUTE = MB_OUT2 + alb((size_t)NSLOT * D * 4);
constexpr size_t B_L1END = MB_ROUTE + 262144;
constexpr size_t MB_END = B_L0END > B_L1END ? B_L0END : B_L1END;
constexpr size_t O_MOD0 = B_MOD0 / 4, O_MOD1 = B_MOD1 / 4, O_MODP = B_MODP / 4, O_H = B_H / 4, O_Z = B_Z / 4, O_RR = B_RR / 4, O_KR = B_KR / 4, O_VR = B_VR / 4, O_AA = B_AA / 4,
                 O_WW = B_WW / 4, O_KD = B_KD / 4, O_BD = B_BD / 4, O_GG = B_GG / 4;

struct MP { const float* in[44]; float* out; unsigned char* ws; int ph_lo, ph_hi; };

enum { PH_CVT = 0, PH_XN1, PH_GEMM_Z, PH_PREP, PH_GEMM4, PH_ATTN, PH_CARRY, PH_FIX, PH_GEMM_O0, PH_XN2, PH_FFN_UP, PH_FFN_DOWN, PH_XN3, PH_GEMM_IN1, PH_LNT, PH_SPATIAL, PH_GEMM_O1, PH_XN4, PH_PLAN, PH_MOE_UP, PH_MOE_DOWN, PH_FINAL, PH_N };

__global__ void __launch_bounds__(512, 2) mega(MP p) {
    extern __shared__ __attribute__((aligned(16))) unsigned char lds_raw[];
    LAS unsigned char* lds = (LAS unsigned char*)lds_raw;
    const int tid = threadIdx.x, G = gridDim.x, bid = blockIdx.x;
    for (int u = tid; u < (LDS_BYTES - LDS_CTL) / 4; u += 512) ((LAS unsigned*)(lds + LDS_CTL))[u] = 0u;
    __syncthreads();
    XcdBarrier bar = xcd_barrier_post((unsigned*)(p.ws + MB_CTL), (volatile LAS unsigned*)(lds + LDS_CTL + 64));
    float* wsf = (float*)p.ws;
    const int lo = p.ph_lo, hi = p.ph_hi;
#define IN(k) (lo <= (k) && (k) < hi)
#define SEAM(k) do { if (IN(k) && IN((k) + 1)) xcd_barrier(bar); } while (0)
    bf16_t* W13 = (bf16_t*)(p.ws + MB_W13); bf16_t* W2 = (bf16_t*)(p.ws + MB_W2); bf16_t* XNB = (bf16_t*)(p.ws + MB_XNB); bf16_t* ACT = (bf16_t*)(p.ws + MB_ACT);

    bf16_t* WIN0 = (bf16_t*)(p.ws + MB_WIN0); bf16_t* WO0 = (bf16_t*)(p.ws + MB_WO0); bf16_t* MIXB = (bf16_t*)(p.ws + MB_MIXB);
    bf16_t* CQNB = (bf16_t*)(p.ws + MB_CQNB); bf16_t* CKVNB = (bf16_t*)(p.ws + MB_CKVNB); bf16_t* LA = (bf16_t*)(p.ws + MB_LA);
    bf16_t* WLORA = (bf16_t*)(p.ws + MB_WLORA); bf16_t* WUQ = (bf16_t*)(p.ws + MB_WUQ); bf16_t* WKN = (bf16_t*)(p.ws + MB_WKN); bf16_t* WV = (bf16_t*)(p.ws + MB_WV);
    bf16_t* QB = (bf16_t*)(p.ws + MB_QB); bf16_t* KNB = (bf16_t*)(p.ws + MB_KNB); bf16_t* VTB = (bf16_t*)(p.ws + MB_VTB); float* ROPEC = (float*)(p.ws + MB_ROPE); float* ROPES = ROPEC + 1024;
    bf16_t* W13E = (bf16_t*)(p.ws + MB_W13E); bf16_t* W2E = (bf16_t*)(p.ws + MB_W2E); bf16_t* WIN1 = (bf16_t*)(p.ws + MB_WIN1); bf16_t* WO1 = (bf16_t*)(p.ws + MB_WO1); bf16_t* WSB = (bf16_t*)(p.ws + MB_WSB);
    bf16_t* Ub = (bf16_t*)(p.ws + MB_U); float* VG = (float*)(p.ws + MB_VG); bf16_t* VT = (bf16_t*)(p.ws + MB_VT); bf16_t* GATED = (bf16_t*)(p.ws + MB_GATED); bf16_t* XNB2 = (bf16_t*)(p.ws + MB_XNB);
    bf16_t* XG = (bf16_t*)(p.ws + MB_XG); float* OUT2 = (float*)(p.ws + MB_OUT2); bf16_t* ACT2 = (bf16_t*)(p.ws + MB_ACT2);
    int* R_TOPE = (int*)(p.ws + MB_ROUTE); int* R_SLOT = R_TOPE + 16384; float* R_TOPG = (float*)(R_TOPE + 32768); int* R_BCNT = R_TOPE + 49152; int* R_CNTOFF = R_TOPE + 49152 + 4096;
    if (IN(PH_CVT)) {
        ph_small_cvt(p.in[16], p.in[18], p.in[19], WLORA, ROPEC, ROPES, G, bid);
        { MapPlain m{p.in[10], QW, QW}; cvt_T(lds, m, WUQ, QW, 512, G, bid); }
        { MapKV m{p.in[12], 0}; cvt_T(lds, m, WKN, 1024, 512, G, (bid + G - 96) % G); }
        { MapKV m{p.in[12], 1}; cvt_T(lds, m, WV, 1024, 512, G, (bid + G - 160) % G); }
        ph_ada(lds, p.in[4], p.in[29], p.in[5], p.in[30], p.in[1], p.in[3], wsf + O_MOD0, wsf + O_MOD1, G, bid);
        { MapPlain m{p.in[8], ZW, ZW}; cvt_T(lds, m, WIN0, ZLD, D, G, bid); }
        { MapPlain m{p.in[25], D, D}; cvt_T(lds, m, WO0, D, D, G, bid); }
        { MapIl m{p.in[26], (long)(p.in[27] - p.in[26]), DFF}; cvt_T(lds, m, W13, 2 * DFF, D, G, bid); }
        { MapPlain m{p.in[28], D, D}; cvt_T(lds, m, W2, D, DFF, G, bid); }
        { MapPlain m{p.in[33], 4096, 4096}; cvt_T(lds, m, WIN1, 4096, D, G, bid); }
        { MapPlain m{p.in[38], D, D}; cvt_T(lds, m, WO1, D, D, G, bid); }
        cvt_copy(p.in[36], WSB, (size_t)16 * 128 * 128, G, bid);
        __syncthreads();
    }
    SEAM(PH_CVT);
    if (IN(PH_XN1)) ph_norm_mod<false>(lds, p.in[0], p.in[2], p.in[6], wsf + O_MOD0, 0, 1, XNB, MALL, nullptr, nullptr, nullptr, nullptr, G, bid);
    SEAM(PH_XN1);
    if (IN(PH_GEMM_Z)) {
        pg8::DenseOrder S; S.init(XNB, D, WIN0, D, MALL, ZLD, G, bid);
        EpiF32 E{wsf + O_Z, ZLD};
        pg8::gemm_phase<EpiF32, pg8::DenseOrder, true, true>(lds, D, D, D, S, E);
    }
    SEAM(PH_GEMM_Z);
    if (IN(PH_PREP)) {
        ph_prep(wsf + O_Z, p.in[9], p.in[11], p.in[13], p.in[14], p.in[20], CQNB, CKVNB, KNB, LA, wsf + O_RR, wsf + O_KR, wsf + O_VR, wsf + O_AA, ROPEC, ROPES, G, bid);
    }
    SEAM(PH_PREP);
    if (IN(PH_GEMM4)) {
#pragma unroll 1
        for (int q = 0; q < 3; ++q) {
            const int kof = q * 128, kk = q < 2 ? 128 : 256, nn = q < 2 ? 2048 : 1024;
            pg8::DenseOrder S; S.init(LA + kof, 512, WLORA + (size_t)(q * 2048) * 512 + kof, 512, MALL, nn, G, (bid + G - 16 * q) % G);
            EpiLora E{p.in[15], p.in[17], p.in[21], wsf + O_KR, wsf + O_AA, wsf + O_WW, wsf + O_KD, wsf + O_BD, wsf + O_GG, q * 8};
            pg8::gemm_phase<EpiLora, pg8::DenseOrder, true, true>(lds, kk, 512, 512, S, E); }
        { pg8::DenseOrder S; S.init(CQNB, 512, WUQ, 512, NL, QW, G, (bid + 168) % G);
          EpiQ E{QB, ROPEC, ROPES};
          pg8::gemm_phase<EpiQ, pg8::DenseOrder, true, true>(lds, 512, 512, 512, S, E);
 }
        { pg8::DenseOrder S; S.init(CKVNB, 512, WKN, 512, MALL, 1024, G, (bid + 104) % G);
          EpiBf16 E{KNB, KLD};
          pg8::gemm_phase<EpiBf16, pg8::DenseOrder, true, true>(lds, 512, 512, 512, S, E); }
        { pg8::DenseOrder S; S.init(WV, 512, CKVNB, 512, 1024, MALL, G, (bid + 224) % G);
          EpiVT E{VTB};
          pg8::gemm_phase<EpiVT, pg8::DenseOrder, true, true>(lds, 512, 512, 512, S, E); }
    }
    SEAM(PH_GEMM4);
    float* YP = (float*)(p.ws + MB_YP); float* QP = (float*)(p.ws + MB_QP); float* SS = (float*)(p.ws + MB_SS);
    if (IN(PH_ATTN)) {
        ph_attn(lds, QB, KNB, VTB, MIXB, G, bid);
        { const MoeCv mc{p.in[40], (long)(p.in[41] - p.in[40]), p.in[42], (unsigned char*)W13E, (unsigned char*)W2E};
          ph_scan1(lds, wsf, (unsigned)O_AA, (unsigned)O_WW, (unsigned)O_BD, (unsigned)O_KD, (unsigned)O_RR, (unsigned)O_VR, YP, QP, mc, G, bid); }
        __syncthreads();
    }
    SEAM(PH_ATTN);
    if (IN(PH_CARRY)) ph_scan_carry(QP, SS, G, bid);
    SEAM(PH_CARRY);
    if (IN(PH_FIX)) ph_scan_fix(YP, SS, wsf + O_RR, wsf + O_KD, wsf + O_VR, wsf + O_GG, p.in[22], p.in[23], p.in[24], MIXB, G, bid);
    SEAM(PH_FIX);
    if (IN(PH_GEMM_O0)) {
        pg8::DenseOrder S; S.init(MIXB, D, WO0, D, NL, D, G, bid);
        EpiRes E{wsf + O_H, p.in[0], wsf + O_MOD0 + 2 * D};
        pg8::gemm_phase<EpiRes, pg8::DenseOrder, true, true>(lds, D, D, D, S, E);
    }
    SEAM(PH_GEMM_O0);
    if (IN(PH_XN2)) ph_norm_mod<false>(lds, wsf + O_H, nullptr, p.in[7], wsf + O_MOD0, 3, 4, XNB, NL, nullptr, nullptr, nullptr, nullptr, G, bid);
    SEAM(PH_XN2);
    if (IN(PH_FFN_UP)) {
        pg8::DenseOrder S; S.init(XNB, D, W13, D, NL, 2 * DFF, G, bid);
        EpiSwiglu E{ACT, DFF};
        pg8::gemm_phase<EpiSwiglu, pg8::DenseOrder, false, true>(lds, D, D, D, S, E);
    }
    SEAM(PH_FFN_UP);
    if (IN(PH_FFN_DOWN)) {
        pg8::DenseOrder S; S.init(ACT, DFF, W2, DFF, NL, D, G, bid);
        EpiRes E{wsf + O_H, wsf + O_H, wsf + O_MOD0 + 5 * D};
        pg8::gemm_phase<EpiRes, pg8::DenseOrder, true, true>(lds, DFF, DFF, DFF, S, E);
    }
    SEAM(PH_FFN_DOWN);
    if (IN(PH_XN3)) ph_norm_mod<false>(lds, wsf + O_H, nullptr, p.in[31], wsf + O_MOD1, 0, 1, XNB2, NL, nullptr, nullptr, nullptr, nullptr, G, bid);
    SEAM(PH_XN3);
    if (IN(PH_GEMM_IN1)) {
        pg8::DenseOrder S; S.init(XNB2, D, WIN1, D, NL, 4096, G, bid);
        EpiGelu E{Ub, VG};
        pg8::gemm_phase<EpiGelu, pg8::DenseOrder, true, true>(lds, D, D, D, S, E);
    }
    SEAM(PH_GEMM_IN1);
    if (IN(PH_LNT)) ph_ln_transpose(lds, VG, p.in[34], p.in[35], VT, G, bid);
    SEAM(PH_LNT);
    if (IN(PH_SPATIAL)) ph_spatial(WSB, VT, Ub, p.in[37], GATED, G, bid);
    SEAM(PH_SPATIAL);
    if (IN(PH_GEMM_O1)) {
        pg8::DenseOrder S; S.init(GATED, D, WO1, D, NL, D, G, bid);
        EpiRes E{wsf + O_H, wsf + O_H, wsf + O_MOD1 + 2 * D};
        pg8::gemm_phase<EpiRes, pg8::DenseOrder, true, true>(lds, D, D, D, S, E);
    }
    SEAM(PH_GEMM_O1);
    if (IN(PH_XN4)) ph_norm_mod<true>(lds, wsf + O_H, nullptr, p.in[32], wsf + O_MOD1, 3, 4, XNB2, NL, p.in[39], R_TOPE, R_TOPG, R_BCNT, G, bid);
    SEAM(PH_XN4);
    if (IN(PH_PLAN)) ph_moe_plan(lds, R_BCNT, R_TOPE, R_SLOT, R_CNTOFF, XNB2, XG, G, bid);
    SEAM(PH_PLAN);
    if (IN(PH_MOE_UP)) {
        pg8::MoeOrder S; S.init(R_CNTOFF, R_CNTOFF + 8, XG, D / 2, W13E, D / 2, (size_t)2 * DFF * D, 2 * DFF, G, bid);
        EpiSwigluF8 E{(unsigned char*)ACT2, DFF, 1.0f / 64.f};
        pg8::gemm_phase<EpiSwigluF8, pg8::MoeOrder, false, true, true>(lds, D / 2, D / 2, D / 2, S, E);
    }
    SEAM(PH_MOE_UP);
    if (IN(PH_MOE_DOWN)) {
        pg8::MoeOrder S; S.init(R_CNTOFF, R_CNTOFF + 8, ACT2, DFF / 2, W2E, DFF / 2, (size_t)D * DFF, D, G, bid);
        EpiBf16S E{(bf16_t*)OUT2, D, 1.0f / 128.f};
        pg8::gemm_phase<EpiBf16S, pg8::MoeOrder, true, true, true>(lds, DFF / 2, DFF / 2, DFF / 2, S, E);
    }
    SEAM(PH_MOE_DOWN);
    if (IN(PH_FINAL)) ph_final(wsf + O_H, (const bf16_t*)OUT2, R_SLOT, R_TOPG, wsf + O_MOD1 + 5 * D, p.in[43], p.out, G, bid);
#undef IN
#undef SEAM
}

static void launch_mega(hipStream_t stream, MP mp, int lo, int hi) {
    static int grid = 0;
    if (grid == 0) {
        int dev = 0, cus = 0;
        hipGetDevice(&dev); hipDeviceGetAttribute(&cus, hipDeviceAttributeMultiprocessorCount, dev);
        hipFuncSetAttribute((const void*)mega, hipFuncAttributeMaxDynamicSharedMemorySize, LDS_BYTES);
        int per_cu = 0; hipOccupancyMaxActiveBlocksPerMultiprocessor(&per_cu, (const void*)mega, 512, LDS_BYTES);
        if (per_cu < 1) fprintf(stderr, "mega: occupancy query says %d\n", per_cu);
        (void)hipGetLastError();
        grid = cus > 0 ? cus : 256;
    }
    hipMemsetAsync(mp.ws + MB_CTL, 0, CTL_BYTES, stream);
    mp.ph_lo = lo; mp.ph_hi = hi;
    hipLaunchKernelGGL(mega, dim3(grid), dim3(512), LDS_BYTES, stream, mp);
}
extern "C" void kernel_launch(void* const* d_in, const int* in_sizes, int n_in, void* d_out, int out_size, void* d_ws, size_t ws_size, hipStream_t stream) {
    if (n_in != 44 || ws_size < MB_END) { fprintf(stderr, "kernel_launch: bad n_in %d or ws %zu < %zu\n", n_in, ws_size, (size_t)MB_END); return; }
    MP mp{};
    for (int i = 0; i < 44; ++i) mp.in[i] = (const float*)d_in[i];
    mp.out = (float*)d_out; mp.ws = (unsigned char*)d_ws;
    launch_mega(stream, mp, 0, PH_N);
}
```

```cpp
#include <hip/hip_runtime.h>
#include <cstdio>
#include <cstdint>

constexpr int D = 2048, NB = 2, SEQ = 4096, CTX = 256;
constexpr int NL = NB * SEQ;
constexpr int NCX = NB * CTX;
constexpr int MALL = NL + NCX;
constexpr int NMOD = 6 * D;
constexpr int QL = 512, KVL = 512, ROPE = 64, NOPE = 128, VH = 128, HM = 8;
constexpr int MLA_IN = QL + KVL + ROPE;
constexpr int RD = 1024, RH = 16, RN = 64;
constexpr int RWKV_IN = 3 * RD + 128 + 128 + 160;
__device__ __forceinline__ size_t hmi(int row, int col) { return ((size_t)(col >> 6) * (8192 + 2 * 256) + row) * 64 + (col & 63); }
constexpr int ZW = MLA_IN + RWKV_IN;
constexpr int ZLD = 4608;
constexpr int KLD = 1088;
constexpr int QW = HM * (NOPE + ROPE);
constexpr int KVW = HM * (NOPE + VH);
constexpr int SK = CTX + SEQ;
constexpr int DFF = 7168, NE = 8;
constexpr int NSLOT = 18432;

constexpr int LDS_BYTES = 163840, LDS_CTL = 162816;

__device__ __forceinline__ float wave_sum(float v) {
#pragma unroll
    for (int o = 32; o > 0; o >>= 1) v += __shfl_xor(v, o);
    return v;
}
__device__ __forceinline__ float wave_sum_dpp(float v) {
    v += __builtin_bit_cast(float, __builtin_amdgcn_update_dpp(0, __builtin_bit_cast(int, v), 0xB1, 0xf, 0xf, true));
    v += __builtin_bit_cast(float, __builtin_amdgcn_update_dpp(0, __builtin_bit_cast(int, v), 0x4E, 0xf, 0xf, true));
    v += __builtin_bit_cast(float, __builtin_amdgcn_update_dpp(0, __builtin_bit_cast(int, v), 0x141, 0xf, 0xf, true));
    v += __builtin_bit_cast(float, __builtin_amdgcn_update_dpp(0, __builtin_bit_cast(int, v), 0x140, 0xf, 0xf, true));
    const int vi = __builtin_bit_cast(int, v);
    const float s0 = __builtin_bit_cast(float, __builtin_amdgcn_readlane(vi, 0)), s1 = __builtin_bit_cast(float, __builtin_amdgcn_readlane(vi, 16));
    const float s2 = __builtin_bit_cast(float, __builtin_amdgcn_readlane(vi, 32)), s3 = __builtin_bit_cast(float, __builtin_amdgcn_readlane(vi, 48));
    return (s0 + s1) + (s2 + s3);
}
__device__ __forceinline__ int wave_isum_dpp(int v) {
    v += __builtin_amdgcn_update_dpp(0, v, 0xB1, 0xf, 0xf, true);
    v += __builtin_amdgcn_update_dpp(0, v, 0x4E, 0xf, 0xf, true);
    v += __builtin_amdgcn_update_dpp(0, v, 0x141, 0xf, 0xf, true);
    v += __builtin_amdgcn_update_dpp(0, v, 0x140, 0xf, 0xf, true);
    return (__builtin_amdgcn_readlane(v, 0) + __builtin_amdgcn_readlane(v, 16)) + (__builtin_amdgcn_readlane(v, 32) + __builtin_amdgcn_readlane(v, 48));
}
__device__ __forceinline__ float sigmoidf_(float x) { return 1.0f / (1.0f + expf(-x)); }
__device__ __forceinline__ float siluf_(float x) { return x / (1.0f + expf(-x)); }

#define LAS __attribute__((address_space(3)))
typedef unsigned short bf16_t;
typedef short bf16x8 __attribute__((ext_vector_type(8)));
typedef float f32x4 __attribute__((ext_vector_type(4)));
typedef float f32x2 __attribute__((ext_vector_type(2)));
typedef unsigned u32x4 __attribute__((ext_vector_type(4)));
typedef unsigned u32x2 __attribute__((ext_vector_type(2)));
typedef int i32x8 __attribute__((ext_vector_type(8)));

__device__ __forceinline__ unsigned cvt_pk_bf16(float lo, float hi) { unsigned r; asm volatile("v_cvt_pk_bf16_f32 %0, %1, %2" : "=v"(r) : "v"(lo), "v"(hi)); return r; }
__device__ __forceinline__ unsigned pk4_fp8(float a, float b, float c, float d) { int p = __builtin_amdgcn_cvt_pk_fp8_f32(a, b, 0, false); p = __builtin_amdgcn_cvt_pk_fp8_f32(c, d, p, true); return (unsigned)p; }
__device__ __forceinline__ float bf2f(bf16_t b) { return __uint_as_float(((unsigned)b) << 16); }
__device__ __forceinline__ float fexp(float x) { return __builtin_amdgcn_exp2f(x * 1.4426950408889634f); }
__device__ __forceinline__ float flog(float x) { return __builtin_amdgcn_logf(x) * 0.6931471805599453f; }
__device__ __forceinline__ float fsigmoid(float x) { return __builtin_amdgcn_rcpf(1.0f + fexp(-x)); }
__device__ __forceinline__ float ftanh(float x) { return 1.0f - 2.0f * __builtin_amdgcn_rcpf(1.0f + fexp(2.0f * x)); }
__device__ __forceinline__ float rope_inv(int f) { const int q = f >> 2, r = f & 3; const float a = q == 0 ? 1.0f : q == 1 ? 0.1f : q == 2 ? 0.01f : 0.001f;
    const float b = r == 0 ? 1.0f : r == 1 ? 0.5623413251903491f : r == 2 ? 0.31622776601683794f : 0.1778279410038923f; return a * b; }

#define XB_TMO      128
#define XB_XCNT(j)  (256  + 64 * (j))
#define XB_XSUB(j)  (1280 + 64 * (j))
#define XB_XGEN(j)  (2304 + 64 * (j))
#define XB_TOP      3328
#define XB_TOPGEN   3392
#define XCD_BAR_WORDS 3456
#define XB_SPIN_CAP (1u << 18)
__device__ __forceinline__ unsigned xb_ld(unsigned* p)              { return __hip_atomic_load(p, __ATOMIC_RELAXED, __HIP_MEMORY_SCOPE_AGENT); }
__device__ __forceinline__ unsigned xb_add(unsigned* p, unsigned v) { return __hip_atomic_fetch_add(p, v, __ATOMIC_RELAXED, __HIP_MEMORY_SCOPE_AGENT); }
__device__ __forceinline__ unsigned xb_xcc_id() { return (unsigned)__builtin_amdgcn_s_getreg((3 << 11) | 20) & 0xFu; }
#define XB_SPIN(cond, bar) do { unsigned _sp = 0; while (cond) { __builtin_amdgcn_s_sleep(1); \
    if ((++_sp & 255u) == 0u) { if (xb_ld(&(bar)[XB_TMO])) break; if (_sp > XB_SPIN_CAP) { atomicAdd(&(bar)[XB_TMO], 1u); break; } } } } while (0)
struct XcdBarrier { unsigned* bar; unsigned x; volatile LAS unsigned* st; };
__device__ __forceinline__ XcdBarrier xcd_barrier_post(unsigned* bar, volatile LAS unsigned* st) {
    XcdBarrier b; b.bar = bar; b.x = xb_xcc_id(); b.st = st;
    if (threadIdx.x == 0) (void)xb_add(&bar[XB_XCNT(b.x)], 1u);
    return b;
}
__device__ __forceinline__ void xcd_barrier_complete(unsigned* bar, unsigned x, unsigned& nloc, unsigned& nx) {
    const unsigned G = gridDim.x * gridDim.y * gridDim.z;
    unsigned sum, cnt, mine, sp = 0u;
    for (;;) {
        sum = 0u; cnt = 0u; mine = 0u;
#pragma unroll
        for (unsigned j = 0; j < 16; ++j) { const unsigned c = xb_ld(&bar[XB_XCNT(j)]); sum += c; cnt += (c > 0u) ? 1u : 0u; mine = (j == x) ? c : mine; }
        if (sum == G) break;
        __builtin_amdgcn_s_sleep(1);
        if ((++sp & 255u) == 0u) { if (xb_ld(&bar[XB_TMO])) break; if (sp > XB_SPIN_CAP) { atomicAdd(&bar[XB_TMO], 1u); break; } }
    }
    nloc = mine > 0u ? mine : 1u; nx = cnt > 0u ? cnt : 1u;
}
__device__ __forceinline__ void xcd_barrier(const XcdBarrier& b) {
    asm volatile("s_waitcnt vmcnt(0)" ::: "memory");
    __syncthreads();
    if (threadIdx.x == 0) {
        unsigned* bar = b.bar;
        __builtin_amdgcn_s_waitcnt(0);
        unsigned nloc = b.st[0], nx = b.st[1];
        if (nloc == 0u) { xcd_barrier_complete(bar, b.x, nloc, nx); b.st[0] = nloc; b.st[1] = nx; }
        const unsigned old = xb_add(&bar[XB_XSUB(b.x)], 1u);
        const unsigned gen = old / nloc;
        if (old + 1u == (gen + 1u) * nloc) {
            __builtin_amdgcn_fence(__ATOMIC_RELEASE, "agent");
            asm volatile("s_waitcnt vmcnt(0)" ::: "memory");
            const unsigned og = xb_add(&bar[XB_TOP], 1u);
            const unsigned tg = og / nx;
            if (og + 1u == (tg + 1u) * nx) xb_add(&bar[XB_TOPGEN], 1u);
            else XB_SPIN(xb_ld(&bar[XB_TOPGEN]) == tg, bar);
            __builtin_amdgcn_fence(__ATOMIC_ACQUIRE, "agent");
            xb_add(&bar[XB_XGEN(b.x)], 1u);
            asm volatile("s_waitcnt vmcnt(0)" ::: "memory");
        } else {
            XB_SPIN(xb_ld(&bar[XB_XGEN(b.x)]) == gen, bar);
            __builtin_amdgcn_fence(__ATOMIC_ACQUIRE, "agent");
            asm volatile("s_waitcnt vmcnt(0)" ::: "memory");
        }
    }
    __syncthreads();
}

namespace pg8 {
constexpr int BM = 256, BK = 64, HALF = 128, HTB = HALF * BK * 2, STAGE_BYTES = 8 * HTB, NXCD = 8, WGM = 8;
__host__ __device__ __forceinline__ int lds_byte(int r, int c) { const int st = (r >> 4) * 2 + (c >> 5), rr = r & 15, cc = c & 31, ob = rr * 64 + cc * 2; return st * 1024 + (ob ^ (((ob >> 9) & 1) << 5)); }
__host__ __device__ __forceinline__ void stage_rc(int b, int& R, int& C) { const int st = b / 1024, sb = b % 1024, swz = sb ^ (((sb >> 9) & 1) << 5); R = (st >> 1) * 16 + swz / 64; C = (st & 1) * 32 + (swz % 64) / 2; }
__host__ __device__ __forceinline__ int perm32(int rho) { const int n = rho >> 4, i = rho & 15; return 8 * (i >> 2) + 4 * n + (i & 3); }
struct Unit { int pm, pn, kind; const char* a; const char* b; };

struct DenseOrder {
    int nM, nN, nwg, G, c, lda, ldb; const char* A; const char* B;
    __device__ void init(const bf16_t* A_, int lda_, const bf16_t* B_, int ldb_, int M, int N, int G_, int c_) { A = (const char*)A_; B = (const char*)B_; lda = lda_; ldb = ldb_; nM = M / BM; nN = N / BM; nwg = nM * nN; G = G_; c = c_; }
    __device__ bool next(int i, Unit& u) const {
        const long L = (long)i * G + c; if (L >= nwg) return false;
        int wgid = (int)L; { const int q = nwg / NXCD, r = nwg % NXCD, xcd = wgid % NXCD, off = wgid / NXCD; wgid = (xcd < r ? xcd * (q + 1) : r * (q + 1) + (xcd - r) * q) + off; }
        const int nig = WGM * nN, gid = wgid / nig, fm = gid * WGM, gsz = (nM - fm) < WGM ? (nM - fm) : WGM;
        u.pm = fm + ((wgid % nig) % gsz); u.pn = (wgid % nig) / gsz; u.kind = 0;
        u.a = A + (size_t)u.pm * BM * lda * 2; u.b = B + (size_t)u.pn * BM * ldb * 2; return true;
    }
};

template <class Epi, class Sched, bool ALIGN_EPI = false, bool SP2 = false, bool FP8 = false>
__device__ __forceinline__ void gemm_phase(LAS unsigned char* lds, const int K, const int lda, const int ldb, const Sched& S, const Epi& E) {
    const int tid = threadIdx.x, wid = __builtin_amdgcn_readfirstlane(tid >> 6), lane = tid & 63, wr = wid >> 2, wc = wid & 3, fr = lane & 15, fq = lane >> 4;
    const int nt = K / BK;
    unsigned voffA[2], voffB[2];
#pragma unroll
    for (int i = 0; i < 2; ++i) { int R, C; stage_rc(tid * 16 + i * 8192, R, C); const int Rb = Epi::PERM ? ((R & ~31) + perm32(R & 31)) : R;
        voffA[i] = (unsigned)(R * lda + C) * 2u; voffB[i] = (unsigned)(Rb * ldb + C) * 2u; }
    const size_t kstep = (size_t)(BK * 2);
    const size_t hstepA = (size_t)HALF * lda * 2, hstepB = (size_t)HALF * ldb * 2;
    const unsigned ldsw = (unsigned)wid * 1024u;
    const int aoff = lds_byte(wr * 64 + fr, fq * 8), boff = lds_byte(wc * 32 + fr, fq * 8);
#define PG8_SA(b, h) (((b) * 2 + (h)) * HTB)
#define PG8_SB(b, h) ((4 + (b) * 2 + (h)) * HTB)
#define PG8_STAGE(bufoff, gbase, voff) do { _Pragma("unroll") for (int _i = 0; _i < 2; ++_i) \
        __builtin_amdgcn_global_load_lds((const unsigned*)((const char*)(gbase) + (voff)[_i]), (LAS unsigned*)(lds + (bufoff) + ldsw + _i * 8192), 16, 0, 0); } while (0)
#define PG8_LDA(dst, b, h) do { _Pragma("unroll") for (int m = 0; m < 4; ++m) _Pragma("unroll") for (int k = 0; k < 2; ++k) dst[m][k] = *(const LAS bf16x8*)(lds + PG8_SA(b, h) + aoff + m * 2048 + k * 1024); } while (0)
#define PG8_LDB(dst, b, h) do { _Pragma("unroll") for (int n = 0; n < 2; ++n) _Pragma("unroll") for (int k = 0; k < 2; ++k) dst[n][k] = *(const LAS bf16x8*)(lds + PG8_SB(b, h) + boff + n * 2048 + k * 1024); } while (0)
#define PG8_CAT(x) __builtin_bit_cast(i32x8, __builtin_shufflevector((x)[0], (x)[1], 0, 1, 2, 3, 4, 5, 6, 7, 8, 9, 10, 11, 12, 13, 14, 15))
#define PG8_MMA(ai, bj, At, Bt) do { __builtin_amdgcn_s_setprio(1); _Pragma("unroll") for (int m = 0; m < 4; ++m) _Pragma("unroll") for (int n = 0; n < 2; ++n) { \
        if constexpr (FP8) { asm volatile("v_mfma_f32_16x16x128_f8f6f4 %0, %1, %2, %0" : "+v"(acc[ai][bj][m][n]) : "v"(PG8_CAT(Bt[n])), "v"(PG8_CAT(At[m]))); } \
        else { _Pragma("unroll") for (int k = 0; k < 2; ++k) acc[ai][bj][m][n] = __builtin_amdgcn_mfma_f32_16x16x32_bf16(Bt[n][k], At[m][k], acc[ai][bj][m][n], 0, 0, 0); } } \
        __builtin_amdgcn_s_setprio(0); } while (0)
#define PG8_WAIT_V(n) asm volatile("s_waitcnt vmcnt(" #n ")" ::: "memory")
#define PG8_WAIT_L(n) asm volatile("s_waitcnt lgkmcnt(" #n ")" ::: "memory")
#define PG8_BAR __builtin_amdgcn_s_barrier()
#define PG8_SCHED __builtin_amdgcn_sched_barrier(0)
    Unit cur, nxt; int ui = 0;
    if (!S.next(0, cur)) return;
    f32x4 acc[2][2][4][2];
#pragma unroll
    for (int a = 0; a < 2; ++a)
#pragma unroll
        for (int b = 0; b < 2; ++b)
#pragma unroll
            for (int m = 0; m < 4; ++m)
#pragma unroll
                for (int n = 0; n < 2; ++n) acc[a][b][m][n] = (f32x4){0.f, 0.f, 0.f, 0.f};
    bf16x8 At[4][2], B0[2][2], B1[2][2];
    const char* cA = cur.a; const char* cB = cur.b;
    if constexpr (SP2) {
        PG8_STAGE(PG8_SB(0, 0), cB, voffB); PG8_STAGE(PG8_SB(0, 1), cB + hstepB, voffB); PG8_STAGE(PG8_SA(0, 0), cA, voffA); PG8_STAGE(PG8_SA(0, 1), cA + hstepA, voffA);
        if (wr == 1) PG8_BAR;
        PG8_WAIT_V(2); PG8_BAR;
        PG8_STAGE(PG8_SB(1, 0), cB + kstep, voffB); PG8_STAGE(PG8_SA(1, 0), cA + kstep, voffA); PG8_STAGE(PG8_SB(1, 1), cB + hstepB + kstep, voffB);
        PG8_WAIT_V(6); PG8_BAR;
    } else {
        PG8_STAGE(PG8_SB(0, 0), cB, voffB); PG8_STAGE(PG8_SA(0, 0), cA, voffA); PG8_STAGE(PG8_SB(0, 1), cB + hstepB, voffB); PG8_STAGE(PG8_SA(0, 1), cA + hstepA, voffA);
        if (wr == 1) PG8_BAR;
        PG8_WAIT_V(4); PG8_BAR;
        PG8_STAGE(PG8_SB(1, 0), cB + kstep, voffB); PG8_STAGE(PG8_SA(1, 0), cA + kstep, voffA); PG8_STAGE(PG8_SB(1, 1), cB + hstepB + kstep, voffB);
        PG8_WAIT_V(6); PG8_BAR;
    }
    for (;;) {
        const bool has_next = S.next(ui + 1, nxt);
        const char* nA = has_next ? nxt.a : cA; const char* nB = has_next ? nxt.b : cB;
        for (int t = 0; t < nt; t += 2) {
            const bool last = (t == nt - 2);
            const char* a1 = cA + (size_t)(t + 1) * kstep;
            const char* a2 = last ? nA : cA + (size_t)(t + 2) * kstep; const char* b2 = last ? nB : cB + (size_t)(t + 2) * kstep;
            const char* a3 = a2 + kstep; const char* b3 = b2 + kstep;
            if constexpr (SP2) {
            PG8_LDB(B0, 0, 0); PG8_LDB(B1, 0, 1); PG8_SCHED; PG8_LDA(At, 0, 0); PG8_STAGE(PG8_SA(1, 1), a1 + hstepA, voffA);
            PG8_WAIT_V(8); PG8_WAIT_L(0); PG8_BAR; PG8_MMA(0, 0, At, B0); PG8_MMA(0, 1, At, B1); PG8_BAR; PG8_SCHED;
            PG8_LDA(At, 0, 1); PG8_STAGE(PG8_SB(0, 0), b2, voffB); PG8_STAGE(PG8_SB(0, 1), b2 + hstepB, voffB); PG8_STAGE(PG8_SA(0, 0), a2, voffA);
            PG8_WAIT_V(8); PG8_WAIT_L(0); PG8_BAR; PG8_MMA(1, 0, At, B0); PG8_MMA(1, 1, At, B1); PG8_BAR; PG8_SCHED;
            PG8_LDB(B0, 1, 0); PG8_LDB(B1, 1, 1); PG8_SCHED; PG8_LDA(At, 1, 0); PG8_STAGE(PG8_SA(0, 1), a2 + hstepA, voffA);
            PG8_WAIT_V(8); PG8_WAIT_L(0); PG8_BAR; PG8_MMA(0, 0, At, B0); PG8_MMA(0, 1, At, B1); PG8_BAR; PG8_SCHED;
            PG8_LDA(At, 1, 1); PG8_STAGE(PG8_SB(1, 0), b3, voffB); PG8_STAGE(PG8_SB(1, 1), b3 + hstepB, voffB); PG8_STAGE(PG8_SA(1, 0), a3, voffA);
            PG8_WAIT_V(8); PG8_WAIT_L(0); PG8_BAR; PG8_MMA(1, 0, At, B0); PG8_MMA(1, 1, At, B1); PG8_BAR; PG8_SCHED;
            } else {
            PG8_LDB(B0, 0, 0); PG8_SCHED; PG8_LDA(At, 0, 0); PG8_STAGE(PG8_SA(1, 1), a1 + hstepA, voffA);
            PG8_WAIT_L(8); PG8_BAR; PG8_WAIT_L(0); PG8_MMA(0, 0, At, B0); PG8_BAR; PG8_SCHED;
            PG8_LDB(B1, 0, 1); PG8_STAGE(PG8_SB(0, 0), b2, voffB);
            PG8_BAR; PG8_WAIT_L(0); PG8_MMA(0, 1, At, B1); PG8_BAR;
            PG8_LDA(At, 0, 1); PG8_STAGE(PG8_SA(0, 0), a2, voffA);
            PG8_BAR; PG8_WAIT_L(0); PG8_MMA(1, 0, At, B0); PG8_BAR; PG8_SCHED;
            PG8_STAGE(PG8_SB(0, 1), b2 + hstepB, voffB);
            PG8_WAIT_V(6); PG8_BAR; PG8_MMA(1, 1, At, B1); PG8_BAR;
            PG8_LDB(B0, 1, 0); PG8_SCHED; PG8_LDA(At, 1, 0); PG8_STAGE(PG8_SA(0, 1), a2 + hstepA, voffA);
            PG8_WAIT_L(8); PG8_BAR; PG8_WAIT_L(0); PG8_MMA(0, 0, At, B0); PG8_BAR; PG8_SCHED;
            PG8_LDB(B1, 1, 1); PG8_STAGE(PG8_SB(1, 0), b3, voffB);
            PG8_BAR; PG8_WAIT_L(0); PG8_MMA(0, 1, At, B1); PG8_BAR;
            PG8_LDA(At, 1, 1); PG8_STAGE(PG8_SA(1, 0), a3, voffA);
            PG8_BAR; PG8_WAIT_L(0); PG8_MMA(1, 0, At, B0); PG8_BAR; PG8_SCHED;
            PG8_STAGE(PG8_SB(1, 1), b3 + hstepB, voffB);
            PG8_WAIT_V(6); PG8_BAR; PG8_MMA(1, 1, At, B1); PG8_BAR;
            }
        }
        if constexpr (ALIGN_EPI) { if (wr == 0) PG8_BAR; }
        if constexpr (FP8) asm volatile("s_nop 15\n\ts_nop 15\n\ts_nop 7" ::: "memory");
        E(acc, cur, wr, wc, fr, fq);
        if (!has_next) break;
#pragma unroll
        for (int a = 0; a < 2; ++a)
#pragma unroll
            for (int b = 0; b < 2; ++b)
#pragma unroll
                for (int m = 0; m < 4; ++m)
#pragma unroll
                    for (int n = 0; n < 2; ++n) acc[a][b][m][n] = (f32x4){0.f, 0.f, 0.f, 0.f};
        cur = nxt; cA = nA; cB = nB; ++ui;
        if constexpr (ALIGN_EPI) { if (wr == 1) PG8_BAR; }
    }
    PG8_WAIT_V(0);
    if constexpr (!ALIGN_EPI) { if (wr == 0) PG8_BAR; }
    PG8_BAR;
#undef PG8_SA
#undef PG8_SB
#undef PG8_STAGE
#undef PG8_LDA
#undef PG8_LDB
#undef PG8_MMA
#undef PG8_CAT
#undef PG8_WAIT_V
#undef PG8_WAIT_L
#undef PG8_BAR
#undef PG8_SCHED
}
}
using pg8::Unit;

typedef const f32x4 (&AccRef)[2][2][4][2];
struct EpiF32 { static constexpr bool PERM = false; float* C; int ldc;
    __device__ __forceinline__ void operator()(AccRef acc, const Unit& u, int wr, int wc, int fr, int fq) const {
        const int row0 = u.pm * 256 + wr * 64 + fr, col0 = u.pn * 256 + wc * 32 + 4 * fq;
#pragma unroll
        for (int ai = 0; ai < 2; ++ai)
#pragma unroll
            for (int m = 0; m < 4; ++m) { float* rowp = C + (size_t)(row0 + ai * 128 + m * 16) * ldc + col0;
#pragma unroll
                for (int bj = 0; bj < 2; ++bj)
#pragma unroll
                    for (int n = 0; n < 2; ++n) *(f32x4*)(rowp + bj * 128 + n * 16) = acc[ai][bj][m][n]; }
    } };
struct EpiRes { static constexpr bool PERM = false; float* C; const float* R; const float* gate;
    __device__ __forceinline__ void operator()(AccRef acc, const Unit& u, int wr, int wc, int fr, int fq) const {
        const int row0 = u.pm * 256 + wr * 64 + fr, col0 = u.pn * 256 + wc * 32 + 4 * fq;
        const float* gp = gate + (size_t)((u.pm * 256) / SEQ) * NMOD + col0;
        f32x4 gv[2][2];
#pragma unroll
        for (int bj = 0; bj < 2; ++bj)
#pragma unroll
            for (int n = 0; n < 2; ++n) gv[bj][n] = *(const f32x4*)(gp + bj * 128 + n * 16);
#pragma unroll
        for (int ai = 0; ai < 2; ++ai)
#pragma unroll
          for (int mp = 0; mp < 2; ++mp) {
            f32x4 r[2][2][2];
#pragma unroll
            for (int mm = 0; mm < 2; ++mm) { const size_t off = (size_t)(row0 + ai * 128 + (mp * 2 + mm) * 16) * D + col0;
#pragma unroll
                for (int bj = 0; bj < 2; ++bj)
#pragma unroll
                    for (int n = 0; n < 2; ++n) r[mm][bj][n] = *(const f32x4*)(R + off + bj * 128 + n * 16); }
#pragma unroll
            for (int mm = 0; mm < 2; ++mm) { const size_t off = (size_t)(row0 + ai * 128 + (mp * 2 + mm) * 16) * D + col0;
#pragma unroll
                for (int bj = 0; bj < 2; ++bj)
#pragma unroll
                    for (int n = 0; n < 2; ++n) *(f32x4*)(C + off + bj * 128 + n * 16) = r[mm][bj][n] + gv[bj][n] * acc[ai][bj][mp * 2 + mm][n]; }
          }
    } };
struct EpiSwiglu { static constexpr bool PERM = true; bf16_t* O; int ldo;
    __device__ __forceinline__ void operator()(AccRef acc, const Unit& u, int wr, int wc, int fr, int fq) const {
        const int row0 = u.pm * 256 + wr * 64 + fr, col0 = u.pn * 128 + wc * 32 + 8 * fq;
#pragma unroll
        for (int ai = 0; ai < 2; ++ai)
#pragma unroll
            for (int m = 0; m < 4; ++m) { bf16_t* rowp = O + (size_t)(row0 + ai * 128 + m * 16) * ldo + col0;
                float o[8];
#pragma unroll
                for (int n = 0; n < 2; ++n)
#pragma unroll
                    for (int j = 0; j < 4; ++j) { const float a = acc[ai][0][m][n][j], b = acc[ai][1][m][n][j]; o[n * 4 + j] = a * __builtin_amdgcn_rcpf(1.0f + __expf(-a)) * b; }
                u32x4 w; w.x = cvt_pk_bf16(o[0], o[1]); w.y = cvt_pk_bf16(o[2], o[3]); w.z = cvt_pk_bf16(o[4], o[5]); w.w = cvt_pk_bf16(o[6], o[7]);
                *(u32x4*)rowp = w; }
    } };

struct EpiSwigluF8 { static constexpr bool PERM = true; unsigned char* O; int ldo; float sc;
    __device__ __forceinline__ void operator()(AccRef acc, const Unit& u, int wr, int wc, int fr, int fq) const {
        const int row0 = u.pm * 256 + wr * 64 + fr, col0 = u.pn * 128 + wc * 32 + 8 * fq;
#pragma unroll
        for (int ai = 0; ai < 2; ++ai)
#pragma unroll
            for (int m = 0; m < 4; ++m) { unsigned char* rowp = O + (size_t)(row0 + ai * 128 + m * 16) * ldo + col0;
                float o[8];
#pragma unroll
                for (int n = 0; n < 2; ++n)
#pragma unroll
                    for (int j = 0; j < 4; ++j) { const float a = acc[ai][0][m][n][j] * sc, b = acc[ai][1][m][n][j] * sc; o[n * 4 + j] = a * __builtin_amdgcn_rcpf(1.0f + __expf(-a)) * b; }
                u32x2 w; w.x = pk4_fp8(o[0], o[1], o[2], o[3]); w.y = pk4_fp8(o[4], o[5], o[6], o[7]);
                *(u32x2*)rowp = w; }
    } };
struct EpiBf16S { static constexpr bool PERM = true; bf16_t* O; int ldo; float sc;
    __device__ __forceinline__ void operator()(AccRef acc, const Unit& u, int wr, int wc, int fr, int fq) const {
        const int row0 = u.pm * 256 + wr * 64 + fr, col0 = u.pn * 256 + wc * 32 + 8 * fq;
#pragma unroll
        for (int ai = 0; ai < 2; ++ai)
#pragma unroll
            for (int m = 0; m < 4; ++m) { bf16_t* rowp = O + (size_t)(row0 + ai * 128 + m * 16) * ldo + col0;
#pragma unroll
                for (int bj = 0; bj < 2; ++bj) { const f32x4 v0 = acc[ai][bj][m][0] * sc, v1 = acc[ai][bj][m][1] * sc;
                    u32x4 w; w.x = cvt_pk_bf16(v0[0], v0[1]); w.y = cvt_pk_bf16(v0[2], v0[3]); w.z = cvt_pk_bf16(v1[0], v1[1]); w.w = cvt_pk_bf16(v1[2], v1[3]);
                    *(u32x4*)(rowp + bj * 128) = w; } }
    } };

struct MapPlain { const float* src; int ld, ncols;
    __device__ __forceinline__ const float* operator()(int n0) const { return n0 < ncols ? src + n0 : nullptr; } __device__ __forceinline__ int stride() const { return ld; } __device__ __forceinline__ bool valid(int n) const { return n < ncols; } };
struct MapIl { const float* s1; long d31; int ld;
    __device__ __forceinline__ const float* operator()(int n0) const { const int t = n0 >> 8, j = n0 & 255; return s1 + (j < 128 ? 0l : d31) + t * 128 + (j & 127); } __device__ __forceinline__ int stride() const { return ld; } __device__ __forceinline__ bool valid(int) const { return true; } };
template <bool FP8, class MAP>
__device__ __forceinline__ void cvt_ring(LAS unsigned char* lds, const MAP& map, void* dstv, int Nd, int K, float scale, int G, int c) {
    constexpr int NS = 4, SLOT = 32768;
    const int tid = threadIdx.x, wave = __builtin_amdgcn_readfirstlane(tid >> 6), lane = tid & 63;
    const int ntk = K / 128, nnt = Nd / 64, ntiles = nnt * ntk;
    if (c >= ntiles) return;
    const int nmine = (ntiles - c + G - 1) / G;
    const int ld = map.stride();
    __syncthreads();
    auto issue = [&](int it) {
        const int itc = it < nmine ? it : nmine - 1, tile = c + itc * G;
        const int n0 = (tile % nnt) * 64, k0 = (tile / nnt) * 128;
        const float* sp = map(n0);
        const int col = (lane & 15) * 4, colc = (sp && map.valid(n0 + col)) ? col : 0;
        const float* base = (sp ? sp : map(0)) + colc;
        LAS unsigned char* sl = lds + (it % NS) * SLOT + wave * 4096;
#pragma unroll
        for (int i = 0; i < 4; ++i)
            __builtin_amdgcn_global_load_lds((const unsigned*)(base + (size_t)(k0 + wave * 16 + i * 4 + (lane >> 4)) * ld), (LAS unsigned*)(sl + i * 1024), 16, 0, 0);
    };
#pragma unroll
    for (int i = 0; i < NS - 1; ++i) issue(i);
    for (int it = 0; it < nmine; ++it) {
        asm volatile("s_waitcnt vmcnt(8)" ::: "memory");
        __syncthreads();
        issue(it + NS - 1);
        const int tile = c + it * G, n0 = (tile % nnt) * 64, k0 = (tile / nnt) * 128;
        const LAS float* T = (const LAS float*)(lds + (it % NS) * SLOT);
        const bool ok = map(n0) != nullptr && map.valid(n0 + lane);
        if constexpr (FP8) {
            float v[16];
#pragma unroll
            for (int j = 0; j < 16; ++j) v[j] = ok ? T[(wave * 16 + j) * 64 + lane] * scale : 0.f;
            u32x4 w; w.x = pk4_fp8(v[0], v[1], v[2], v[3]); w.y = pk4_fp8(v[4], v[5], v[6], v[7]); w.z = pk4_fp8(v[8], v[9], v[10], v[11]); w.w = pk4_fp8(v[12], v[13], v[14], v[15]);
            *(u32x4*)((unsigned char*)dstv + (size_t)(n0 + lane) * K + k0 + wave * 16) = w;
        } else {
#pragma unroll
            for (int h = 0; h < 2; ++h) { const int kg = wave + 8 * h; float v[8];
#pragma unroll
                for (int j = 0; j < 8; ++j) v[j] = ok ? T[(kg * 8 + j) * 64 + lane] : 0.f;
                u32x4 w; w.x = cvt_pk_bf16(v[0], v[1]); w.y = cvt_pk_bf16(v[2], v[3]); w.z = cvt_pk_bf16(v[4], v[5]); w.w = cvt_pk_bf16(v[6], v[7]);
                *(u32x4*)((bf16_t*)dstv + (size_t)(n0 + lane) * K + k0 + kg * 8) = w; }
        }
    }
    asm volatile("s_waitcnt vmcnt(0)" ::: "memory");
    __syncthreads();
}
template <class MAP> __device__ __forceinline__ void cvt_T(LAS unsigned char* lds, const MAP& map, bf16_t* dst, int Nd, int K, int G, int c) { cvt_ring<false>(lds, map, dst, Nd, K, 1.f, G, c); }
template <class MAP> __device__ __forceinline__ void cvt_T8(LAS unsigned char* lds, const MAP& map, unsigned char* dst, int Nd, int K, float scale, int G, int c) { cvt_ring<true>(lds, map, dst, Nd, K, scale, G, c); }
__device__ __forceinline__ void cvt_copy(const float* src, bf16_t* dst, size_t n, int G, int c) {
    for (size_t i = ((size_t)c * 512 + threadIdx.x) * 8; i < n; i += (size_t)G * 512 * 8) {
        const float4 a = *(const float4*)(src + i), b = *(const float4*)(src + i + 4);
        u32x4 w; w.x = cvt_pk_bf16(a.x, a.y); w.y = cvt_pk_bf16(a.z, a.w); w.z = cvt_pk_bf16(b.x, b.y); w.w = cvt_pk_bf16(b.z, b.w);
        *(u32x4*)(dst + i) = w;
    }
}


__device__ __forceinline__ f32x2 gelu_pk(f32x2 v) {
    const f32x2 av = __builtin_elementwise_abs(v), d = av * 0.2316418882f + 1.0f;
    f32x2 t; t.x = __builtin_amdgcn_rcpf(d.x); t.y = __builtin_amdgcn_rcpf(d.y);
    f32x2 q = t * 0.5307027145f + (-0.7265760135f); q = q * t + 0.7107068705f; q = q * t + (-0.142248368f); q = q * t + 0.127414796f; q = q * t;
    const f32x2 s = (v * v) * (-0.72134752044f);
    f32x2 e; e.x = __builtin_amdgcn_exp2f(s.x); e.y = __builtin_amdgcn_exp2f(s.y);
    const f32x2 m = v * (q * e), r = v - m;
    f32x2 o; o.x = v.x < 0.f ? m.x : r.x; o.y = v.y < 0.f ? m.y : r.y; return o;
}
struct EpiGelu { static constexpr bool PERM = false; bf16_t* U; float* VG;
    __device__ __forceinline__ void operator()(AccRef acc, const Unit& u, int wr, int wc, int fr, int fq) const {
        const int row0 = u.pm * 256 + wr * 64 + fr, col0 = (u.pn & 7) * 256 + wc * 32 + 4 * fq;
        const bool isu = u.pn < 8;
#pragma unroll
        for (int ai = 0; ai < 2; ++ai)
#pragma unroll
            for (int m = 0; m < 4; ++m) { const size_t off = (size_t)(row0 + ai * 128 + m * 16) * D + col0;
#pragma unroll
                for (int bj = 0; bj < 2; ++bj)
#pragma unroll
                    for (int n = 0; n < 2; ++n) { const f32x4 v = acc[ai][bj][m][n];
                        const f32x2 a = gelu_pk((f32x2){v[0], v[1]}), b = gelu_pk((f32x2){v[2], v[3]});
                        if (isu) { u32x2 w; w.x = cvt_pk_bf16(a.x, a.y); w.y = cvt_pk_bf16(b.x, b.y); *(u32x2*)(U + off + bj * 128 + n * 16) = w; }
                        else *(f32x4*)(VG + off + bj * 128 + n * 16) = (f32x4){a.x, a.y, b.x, b.y}; } }
    } };

namespace pg8 {
struct MoeOrder {
    int cnt_t[8], off_t[8], nN, G, c, lda, ldb; const char* A; const char* B; size_t bstride;
    __device__ void init(const int* cnt, const int* off, const bf16_t* A_, int lda_, const bf16_t* B_, int ldb_, size_t bstride_bytes, int N, int G_, int c_) {
#pragma unroll
        for (int e = 0; e < 8; ++e) { cnt_t[e] = __builtin_amdgcn_readfirstlane((cnt[e] + 255) >> 8); off_t[e] = __builtin_amdgcn_readfirstlane(off[e] >> 8); }
        A = (const char*)A_; B = (const char*)B_; lda = lda_; ldb = ldb_; bstride = bstride_bytes; nN = N / 256; G = G_; c = c_;
    }
    __device__ bool next(int i, Unit& u) const {
        const int L = i * G + c, x = L & 7; int q = L >> 3; int e = 0; bool found = false; int te = 0, oe = 0;
        const int n8 = nN >> 3;
#pragma unroll
        for (int k = 0; k < 8; ++k) { const int ue = cnt_t[k] * n8; if (!found) { if (q < ue) { found = true; e = k; te = cnt_t[k]; oe = off_t[k]; } else q -= ue; } }
        if (!found) return false;
        const int pml = q % te; u.pn = (q / te) * 8 + x; u.pm = oe + pml; u.kind = e;
        u.a = A + (size_t)u.pm * 256 * lda * 2; u.b = B + (size_t)e * bstride + (size_t)u.pn * 256 * ldb * 2; return true;
    }
};
}

template <bool ROUTE>
__device__ __forceinline__ void ph_norm_mod(LAS unsigned char* lds, const float* srcL, const float* srcC, const float* gain, const float* mod, int chunk_sh, int chunk_sc, bf16_t* dst, int nrows,
                                            const float* router, int* tope, float* topg, int* bcnt, int G, int bid) {
    const int tid = threadIdx.x, wave = tid >> 6, lane = tid & 63;
    const int rpb = (nrows + G - 1) / G, r0 = bid * rpb, r1 = min(nrows, r0 + rpb);
    LAS int* lc = (LAS int*)lds;
    if (ROUTE) { if (tid < 8) lc[tid] = 0; __syncthreads(); }
    int cur_mrow = -1; float gm[32], shv[32];
    float4 xn[8];
    { const int rw = r0 + wave < r1 ? r0 + wave : r0; const float* s0_ = rw < NL ? srcL + (size_t)rw * D : srcC + (size_t)(rw - NL) * D;
#pragma unroll
      for (int i = 0; i < 8; ++i) xn[i] = *(const float4*)(s0_ + i * 256 + lane * 4); }
    for (int row = r0 + wave; row < r1; row += 8) {
        const int mrow = row < NL ? row / SEQ : 2;
        if (mrow != cur_mrow) { cur_mrow = mrow;
            const float* sh_ = mod + (size_t)mrow * NMOD + chunk_sh * D; const float* sc_ = mod + (size_t)mrow * NMOD + chunk_sc * D;
#pragma unroll
            for (int i = 0; i < 8; ++i) { const int c = i * 256 + lane * 4; const float4 g4 = *(const float4*)(gain + c), sc4 = *(const float4*)(sc_ + c), sh4 = *(const float4*)(sh_ + c);
                gm[i * 4] = g4.x * (1.f + sc4.x); gm[i * 4 + 1] = g4.y * (1.f + sc4.y); gm[i * 4 + 2] = g4.z * (1.f + sc4.z); gm[i * 4 + 3] = g4.w * (1.f + sc4.w);
                shv[i * 4] = sh4.x; shv[i * 4 + 1] = sh4.y; shv[i * 4 + 2] = sh4.z; shv[i * 4 + 3] = sh4.w; } }
        float v[32]; float ss = 0.f;
#pragma unroll
        for (int i = 0; i < 8; ++i) { const float4 x = xn[i]; v[i * 4] = x.x; v[i * 4 + 1] = x.y; v[i * 4 + 2] = x.z; v[i * 4 + 3] = x.w; ss += x.x * x.x + x.y * x.y + x.z * x.z + x.w * x.w; }
        { const int rn = row + 8 < r1 ? row + 8 : row; const float* sn_ = rn < NL ? srcL + (size_t)rn * D : srcC + (size_t)(rn - NL) * D;
#pragma unroll
          for (int i = 0; i < 8; ++i) xn[i] = *(const float4*)(sn_ + i * 256 + lane * 4); }
        ss = wave_sum_dpp(ss);
        const float rs = rsqrtf(ss * (1.0f / D) + 1e-6f);
        float a[8];
        if (ROUTE) {
#pragma unroll
            for (int e = 0; e < 8; ++e) a[e] = 0.f;
        }
#pragma unroll
        for (int i = 0; i < 8; ++i) {
            const int c = i * 256 + lane * 4;
            float o[4];
            o[0] = v[i * 4] * rs * gm[i * 4] + shv[i * 4]; o[1] = v[i * 4 + 1] * rs * gm[i * 4 + 1] + shv[i * 4 + 1];
            o[2] = v[i * 4 + 2] * rs * gm[i * 4 + 2] + shv[i * 4 + 2]; o[3] = v[i * 4 + 3] * rs * gm[i * 4 + 3] + shv[i * 4 + 3];
            if (ROUTE) *(unsigned*)((unsigned char*)dst + (size_t)row * D + c) = pk4_fp8(o[0], o[1], o[2], o[3]);
            else { u32x2 w; w.x = cvt_pk_bf16(o[0], o[1]); w.y = cvt_pk_bf16(o[2], o[3]); *(u32x2*)(dst + (size_t)row * D + c) = w; }
            if (ROUTE) {
#pragma unroll
                for (int j = 0; j < 4; ++j) { const float4 ra = *(const float4*)(router + (size_t)(c + j) * 8), rb = *(const float4*)(router + (size_t)(c + j) * 8 + 4);
                    a[0] += o[j] * ra.x; a[1] += o[j] * ra.y; a[2] += o[j] * ra.z; a[3] += o[j] * ra.w; a[4] += o[j] * rb.x; a[5] += o[j] * rb.y; a[6] += o[j] * rb.z; a[7] += o[j] * rb.w; }
            }
        }
        if (ROUTE) {
#pragma unroll
            for (int e = 0; e < 8; ++e) a[e] = wave_sum(a[e]);
            if (lane == 0) {
                int e0 = 0; float v0 = a[0];
#pragma unroll
                for (int e = 1; e < 8; ++e) if (a[e] > v0) { v0 = a[e]; e0 = e; }
                int e1 = 0; float v1 = -3e38f;
#pragma unroll
                for (int e = 0; e < 8; ++e) if (e != e0 && a[e] > v1) { v1 = a[e]; e1 = e; }
                const float ex = fexp(v1 - v0);
                tope[row * 2] = e0; tope[row * 2 + 1] = e1;
                topg[row * 2] = 1.f / (1.f + ex); topg[row * 2 + 1] = ex / (1.f + ex);
                atomicAdd((int*)&lc[e0], 1); atomicAdd((int*)&lc[e1], 1);
            }
        }
    }
    if (ROUTE) { __syncthreads(); if (tid < 8) bcnt[bid * 8 + tid] = lc[tid]; __syncthreads(); }
}

__device__ __forceinline__ void ph_moe_plan(LAS unsigned char* lds, const int* bcnt, const int* tope, int* slot, int* cntoff, const bf16_t* XNB, bf16_t* XG, int G, int bid) {
    const int tid = threadIdx.x;
    LAS int* base = (LAS int*)lds;
    LAS int* sl = base + 8;
    const int rpb = (NL + G - 1) / G, r0 = bid * rpb, r1 = min(NL, r0 + rpb);
    __syncthreads();
    for (int a = tid; a < (r1 - r0) * 2; a += 512) base[48 + 160 + a] = tope[r0 * 2 + a];
    if (tid < 8) { base[16 + tid] = 0; base[32 + tid] = 0; }
    __syncthreads();
    for (int bq0 = 0; bq0 < G; bq0 += 512) { const int bq = bq0 + tid; int cv[8] = {0, 0, 0, 0, 0, 0, 0, 0};
        if (bq < G) { const int4 c0 = *(const int4*)(bcnt + bq * 8), c1 = *(const int4*)(bcnt + bq * 8 + 4); cv[0] = c0.x; cv[1] = c0.y; cv[2] = c0.z; cv[3] = c0.w; cv[4] = c1.x; cv[5] = c1.y; cv[6] = c1.z; cv[7] = c1.w; }
#pragma unroll
        for (int e = 0; e < 8; ++e) { const int tot = wave_isum_dpp(cv[e]), pre = wave_isum_dpp(bq < bid ? cv[e] : 0);
            if ((tid & 63) == 0 && tot != 0) { atomicAdd((int*)&base[16 + e], tot); if (pre != 0) atomicAdd((int*)&base[32 + e], pre); } } }
    __syncthreads();
    if (tid == 0) {
        int off = 0;
        for (int e = 0; e < 8; ++e) { const int tot = base[16 + e]; base[e] = off + base[32 + e]; if (bid == 0) { cntoff[e] = tot; cntoff[8 + e] = off; } off += (tot + 255) & ~255; }
        int cur[8];
#pragma unroll
        for (int e = 0; e < 8; ++e) cur[e] = base[e];
        for (int a = r0 * 2; a < r1 * 2; ++a) { const int e = base[48 + 160 + a - r0 * 2]; int s = 0;
#pragma unroll
            for (int q = 0; q < 8; ++q) if (e == q) { s = cur[q]; cur[q]++; }
            slot[a] = s; base[48 + a - r0 * 2] = s; }
    }
    __syncthreads();
    const int na = (r1 - r0) * 2;
    for (int i0 = tid; i0 < na * 128; i0 += 512 * 4) {
        u32x4 v[4]; int so[4];
#pragma unroll
        for (int k = 0; k < 4; ++k) { const int i = i0 + k * 512; const bool ok = i < na * 128; const int a = ok ? i >> 7 : 0, c16 = i & 127; const int sl_ = base[48 + a], row = r0 + (a >> 1);
            so[k] = ok ? sl_ * (D / 16) + c16 : -1; v[k] = *(const u32x4*)((const unsigned char*)XNB + (size_t)row * D + c16 * 16); }
#pragma unroll
        for (int k = 0; k < 4; ++k) if (so[k] >= 0) *(u32x4*)((unsigned char*)XG + (size_t)so[k] * 16) = v[k];
    }
    __syncthreads();
}

__device__ __forceinline__ void ph_ln_transpose(LAS unsigned char* lds, const float* VG, const float* lnw, const float* lnb, bf16_t* VT, int G, int bid) {
    const int tid = threadIdx.x, wave = tid >> 6, lane = tid & 63;
    LAS bf16_t* T = (LAS bf16_t*)lds;
    for (int unit = bid; unit < NL / 32; unit += G) {
        const int row0 = unit * 32;
        __syncthreads();
        for (int rr = wave; rr < 32; rr += 8) {
            const float* src = VG + (size_t)(row0 + rr) * D;
            float v[32]; float s = 0.f;
#pragma unroll
            for (int i = 0; i < 8; ++i) { const float4 x = *(const float4*)(src + i * 256 + lane * 4); v[i * 4] = x.x; v[i * 4 + 1] = x.y; v[i * 4 + 2] = x.z; v[i * 4 + 3] = x.w; s += (x.x + x.y) + (x.z + x.w); }
            const float mu = wave_sum(s) * (1.f / 2048.f);
            float q = 0.f;
#pragma unroll
            for (int i = 0; i < 32; ++i) { const float dd = v[i] - mu; q += dd * dd; }
            const float rs = rsqrtf(wave_sum(q) * (1.f / 2048.f) + 1e-5f);
#pragma unroll
            for (int i = 0; i < 8; ++i) { const int c = i * 256 + lane * 4;
                const float4 w4 = *(const float4*)(lnw + c), b4 = *(const float4*)(lnb + c);
                u32x2 w; w.x = cvt_pk_bf16((v[i * 4] - mu) * rs * w4.x + b4.x, (v[i * 4 + 1] - mu) * rs * w4.y + b4.y);
                w.y = cvt_pk_bf16((v[i * 4 + 2] - mu) * rs * w4.z + b4.z, (v[i * 4 + 3] - mu) * rs * w4.w + b4.w);
                *(LAS u32x2*)(T + rr * 2048 + c) = w; }
        }
        __syncthreads();
        const int b = row0 / SEQ, n = (row0 % SEQ) / 128, q0 = row0 % 128;
        for (int it = tid; it < 1024 * 4; it += 512) {
            const int qg = it & 3, cp = it >> 2, c = cp * 2;
            unsigned e[8];
#pragma unroll
            for (int j = 0; j < 8; ++j) e[j] = *(const LAS unsigned*)(T + (qg * 8 + j) * 2048 + c);
            u32x4 w0, w1;
            w0.x = (e[0] & 0xffffu) | (e[1] << 16); w0.y = (e[2] & 0xffffu) | (e[3] << 16); w0.z = (e[4] & 0xffffu) | (e[5] << 16); w0.w = (e[6] & 0xffffu) | (e[7] << 16);
            w1.x = (e[0] >> 16) | (e[1] & 0xffff0000u); w1.y = (e[2] >> 16) | (e[3] & 0xffff0000u); w1.z = (e[4] >> 16) | (e[5] & 0xffff0000u); w1.w = (e[6] >> 16) | (e[7] & 0xffff0000u);
            const int g = c >> 7, cl = c & 127;
            bf16_t* dst = VT + ((((size_t)(b * 32 + n) * 16 + g) * 128 + cl) * 128 + q0 + qg * 8);
            *(u32x4*)dst = w0; *(u32x4*)(dst + 128) = w1;
        }
    }
    __syncthreads();
}

__device__ __forceinline__ void ph_spatial(const bf16_t* WS, const bf16_t* VT, const bf16_t* U, const float* bs, bf16_t* GATED, int G, int bid) {
    typedef float f32x16 __attribute__((ext_vector_type(16)));
    const int tid = threadIdx.x, wave = tid >> 6, lane = tid & 63, l32 = lane & 31, half = lane >> 5;
    const int p0 = (wave & 3) * 32, c0 = (wave >> 2) * 64;
    for (int unit = bid; unit < NB * 32 * 16; unit += G) {
        const int g = unit & 15, bn = unit >> 4;
        const bf16_t* Wp = WS + (size_t)g * 128 * 128 + (size_t)(p0 + l32) * 128 + half * 8;
        const bf16_t* Vp = VT + ((size_t)bn * 16 + g) * 128 * 128 + (size_t)(c0 + l32) * 128 + half * 8;
        f32x16 acc0, acc1;
#pragma unroll
        for (int i = 0; i < 16; ++i) { acc0[i] = 0.f; acc1[i] = 0.f; }
#pragma unroll
        for (int ks = 0; ks < 8; ++ks) {
            const bf16x8 w = *(const bf16x8*)(Wp + ks * 16), v0 = *(const bf16x8*)(Vp + ks * 16), v1 = *(const bf16x8*)(Vp + 32 * 128 + ks * 16);
            acc0 = __builtin_amdgcn_mfma_f32_32x32x16_bf16(v0, w, acc0, 0, 0, 0);
            acc1 = __builtin_amdgcn_mfma_f32_32x32x16_bf16(v1, w, acc1, 0, 0, 0);
        }
        const int p = p0 + l32;
        const float bias = bs[g * 128 + p];
        const size_t ob = (size_t)(bn * 128 + p) * D + g * 128 + c0 + 4 * half;
#pragma unroll
        for (int i4 = 0; i4 < 4; ++i4) {
#pragma unroll
            for (int hb = 0; hb < 2; ++hb) {
                const size_t o = ob + hb * 32 + 8 * i4;
                const u32x2 uu = *(const u32x2*)(U + o);
                const float u0 = __uint_as_float(uu.x << 16), u1 = __uint_as_float(uu.x & 0xffff0000u), u2 = __uint_as_float(uu.y << 16), u3 = __uint_as_float(uu.y & 0xffff0000u);
                const f32x16& a = hb == 0 ? acc0 : acc1;
                u32x2 w; w.x = cvt_pk_bf16(u0 * (a[i4 * 4] + bias), u1 * (a[i4 * 4 + 1] + bias)); w.y = cvt_pk_bf16(u2 * (a[i4 * 4 + 2] + bias), u3 * (a[i4 * 4 + 3] + bias));
                *(u32x2*)(GATED + o) = w;
            }
        }
    }
}

__device__ __forceinline__ void ph_final(const float* H, const bf16_t* OUT2, const int* slot, const float* topg, const float* g2, const float* fnorm, float* out, int G, int bid) {
    const int tid = threadIdx.x, wave = tid >> 6, lane = tid & 63;
    float fn[32], gv[32]; int cur_b = -1;
#pragma unroll
    for (int i = 0; i < 8; ++i) { const float4 f = *(const float4*)(fnorm + i * 256 + lane * 4); fn[i * 4] = f.x; fn[i * 4 + 1] = f.y; fn[i * 4 + 2] = f.z; fn[i * 4 + 3] = f.w; }
    for (int row = bid * 8 + wave; row < NL; row += G * 8) {
        const int s0 = slot[row * 2], s1 = slot[row * 2 + 1]; const float g0 = topg[row * 2], g1 = topg[row * 2 + 1];
        const float* h = H + (size_t)row * D; const bf16_t* o0 = OUT2 + (size_t)s0 * D; const bf16_t* o1 = OUT2 + (size_t)s1 * D;
        const int bb = row / SEQ;
        if (bb != cur_b) { cur_b = bb; const float* gg = g2 + (size_t)bb * NMOD;
#pragma unroll
            for (int i = 0; i < 8; ++i) { const float4 g = *(const float4*)(gg + i * 256 + lane * 4); gv[i * 4] = g.x; gv[i * 4 + 1] = g.y; gv[i * 4 + 2] = g.z; gv[i * 4 + 3] = g.w; } }
        float v[32]; float ss = 0.f;
#pragma unroll
        for (int i = 0; i < 8; ++i) { const int c = i * 256 + lane * 4;
            const float4 hv = *(const float4*)(h + c); const u32x2 a = *(const u32x2*)(o0 + c), b = *(const u32x2*)(o1 + c);
            const float a0 = __uint_as_float(a.x << 16), a1 = __uint_as_float(a.x & 0xffff0000u), a2 = __uint_as_float(a.y << 16), a3 = __uint_as_float(a.y & 0xffff0000u);
            const float b0 = __uint_as_float(b.x << 16), b1 = __uint_as_float(b.x & 0xffff0000u), b2 = __uint_as_float(b.y << 16), b3 = __uint_as_float(b.y & 0xffff0000u);
            v[i * 4] = hv.x + gv[i * 4] * (g0 * a0 + g1 * b0); v[i * 4 + 1] = hv.y + gv[i * 4 + 1] * (g0 * a1 + g1 * b1);
            v[i * 4 + 2] = hv.z + gv[i * 4 + 2] * (g0 * a2 + g1 * b2); v[i * 4 + 3] = hv.w + gv[i * 4 + 3] * (g0 * a3 + g1 * b3);
            ss += v[i * 4] * v[i * 4] + v[i * 4 + 1] * v[i * 4 + 1] + v[i * 4 + 2] * v[i * 4 + 2] + v[i * 4 + 3] * v[i * 4 + 3]; }
        const float rs = rsqrtf(wave_sum(ss) * (1.f / D) + 1e-6f);
#pragma unroll
        for (int i = 0; i < 8; ++i) { const int c = i * 256 + lane * 4;
            *(float4*)(out + (size_t)row * D + c) = (float4){v[i * 4] * rs * fn[i * 4], v[i * 4 + 1] * rs * fn[i * 4 + 1], v[i * 4 + 2] * rs * fn[i * 4 + 2], v[i * 4 + 3] * rs * fn[i * 4 + 3]}; }
    }
}

__device__ __forceinline__ void ph_ada(LAS unsigned char* lds, const float* W0, const float* W1, const float* b0, const float* b1, const float* c, const float* cc, float* mod0, float* mod1, int G, int bid) {
    const int tid = threadIdx.x, kq = tid / 24, c4 = tid % 24;
    LAS float* red = (LAS float*)lds;
    for (int u = bid; u < 256; u += G) {
        const int l = u >> 7, col0 = (u & 127) * 96;
        const float* W = (l == 0 ? W0 : W1) + col0 + c4 * 4;
        float a[12];
#pragma unroll
        for (int j = 0; j < 12; ++j) a[j] = 0.f;
        if (kq < 21) {
#pragma unroll 7
            for (int k = kq; k < D; k += 21) {
                const float4 w = *(const float4*)(W + (size_t)k * NMOD);
                const float x0 = c[k], x1 = c[D + k], x2 = cc[k];
                const float s0 = x0 * fsigmoid(x0), s1 = x1 * fsigmoid(x1), s2 = x2 * fsigmoid(x2);
                a[0] += s0 * w.x; a[1] += s0 * w.y; a[2] += s0 * w.z; a[3] += s0 * w.w;
                a[4] += s1 * w.x; a[5] += s1 * w.y; a[6] += s1 * w.z; a[7] += s1 * w.w;
                a[8] += s2 * w.x; a[9] += s2 * w.y; a[10] += s2 * w.z; a[11] += s2 * w.w;
            }
        }
        __syncthreads();
        if (kq < 21) {
#pragma unroll
            for (int j = 0; j < 12; ++j) red[(kq * 24 + c4) * 12 + j] = a[j];
        }
        __syncthreads();
        if (tid < 288) {
            const int cq = tid / 12, rj = tid % 12, row = rj >> 2, j = rj & 3, n = col0 + cq * 4 + j;
            float sum = (l == 0 ? b0 : b1)[n];
            for (int q = 0; q < 21; ++q) sum += red[(q * 24 + cq) * 12 + rj];
            if (!(l == 1 && row == 2)) (l == 0 ? mod0 : mod1)[(size_t)row * NMOD + n] = sum;
        }
    }
    __syncthreads();
}


__device__ __forceinline__ void ph_small_cvt(const float* w_up, const float* a_up, const float* g_up, bf16_t* WLORA, float* ropec, float* ropes, int G, int bid) {
    const int gt = bid * 512 + threadIdx.x, gs = G * 512;
    if (gt < 16) {
        const double x = (double)rope_inv(gt), x2 = x * x;
        double sn = x * (1.0 + x2 * (-1.0 / 6 + x2 * (1.0 / 120 + x2 * (-1.0 / 5040 + x2 * (1.0 / 362880 + x2 * (-1.0 / 39916800 + x2 * (1.0 / 6227020800.0)))))));
        double cs = 1.0 + x2 * (-0.5 + x2 * (1.0 / 24 + x2 * (-1.0 / 720 + x2 * (1.0 / 40320 + x2 * (-1.0 / 3628800 + x2 * (1.0 / 479001600.0 + x2 * (-1.0 / 87178291200.0)))))));
        double c = 1.0, s_ = 0.0;
        for (int pos = 0; pos < 64; ++pos) { ropec[pos * 16 + gt] = (float)c; ropes[pos * 16 + gt] = (float)s_; const double nc = c * cs - s_ * sn, ns = s_ * cs + c * sn; c = nc; s_ = ns; }
    }
    for (int i = gt; i < 5120 * 64; i += gs) {
        const int n = i >> 6, k0 = (i & 63) * 8, g = n >> 10, ch = n & 1023;
        float v[8];
#pragma unroll
        for (int q = 0; q < 8; ++q) { const int k = k0 + q; float x = 0.f;
            if (g < 4) { const int koff = g * 64; if (k >= koff && k < koff + 64) x = (g < 2 ? w_up : a_up)[(size_t)((g & 1) * 64 + (k - koff)) * RD + ch]; }
            else { if (k >= 256 && k < 416) x = g_up[(size_t)(k - 256) * RD + ch]; }
            v[q] = x; }
        u32x4 w; w.x = cvt_pk_bf16(v[0], v[1]); w.y = cvt_pk_bf16(v[2], v[3]); w.z = cvt_pk_bf16(v[4], v[5]); w.w = cvt_pk_bf16(v[6], v[7]);
        *(u32x4*)(WLORA + (size_t)n * 512 + k0) = w;
    }
}
struct MapKV { const float* src; int sel;
    __device__ __forceinline__ const float* operator()(int n0) const { const int h = n0 >> 7, d = n0 & 127; return src + h * 256 + sel * 128 + d; } __device__ __forceinline__ int stride() const { return KVW; } __device__ __forceinline__ bool valid(int) const { return true; } };

__device__ __forceinline__ void ph_prep(const float* Z, const float* qn, const float* kvn, const float* mup, const float* mun, const float* k_k,
                                        bf16_t* CQNB, bf16_t* CKVNB, bf16_t* KRB, bf16_t* LA, float* RR, float* KRf, float* VR, float* AA, const float* ropec, const float* ropes, int G, int bid) {
    const int wave = threadIdx.x >> 6, lane = threadIdx.x & 63;
    for (int row = bid * 8 + wave; row < MALL; row += G * 8) {
        const float* z = Z + (size_t)row * ZLD;
        int t, len; if (row < NL) { t = row % SEQ; len = SEQ; } else { t = (row - NL) % CTX; len = CTX; }
#pragma unroll
        for (int part = 0; part < 2; ++part) {
            const float4 a = *(const float4*)(z + part * 512 + lane * 8), b = *(const float4*)(z + part * 512 + lane * 8 + 4);
            float ss = a.x * a.x + a.y * a.y + a.z * a.z + a.w * a.w + b.x * b.x + b.y * b.y + b.z * b.z + b.w * b.w;
            ss = wave_sum(ss);
            const float rs = rsqrtf(ss * (1.f / 512.f) + 1e-6f);
            const float* gn = (part == 0 ? qn : kvn) + lane * 8;
            const float4 g0 = *(const float4*)gn, g1 = *(const float4*)(gn + 4);
            u32x4 w; w.x = cvt_pk_bf16(a.x * rs * g0.x, a.y * rs * g0.y); w.y = cvt_pk_bf16(a.z * rs * g0.z, a.w * rs * g0.w);
            w.z = cvt_pk_bf16(b.x * rs * g1.x, b.y * rs * g1.y); w.w = cvt_pk_bf16(b.z * rs * g1.z, b.w * rs * g1.w);
            *(u32x4*)((part == 0 ? CQNB : CKVNB) + (size_t)row * 512 + lane * 8) = w;
        }
        {
            const float val = z[1024 + lane]; const float oth = __shfl_xor(val, 16);
            float o = val;
            if (row < NL) {
                const int a = lane >> 5, hf = (lane >> 4) & 1, f = lane & 15;
                const int pos = a == 0 ? (t >> 6) : (t & 63);
                const float cs = ropec[pos * 16 + f], sn = ropes[pos * 16 + f];
                o = hf == 0 ? val * cs - oth * sn : val * cs + oth * sn;
            }
            KRB[(size_t)row * KLD + 1024 + lane] = (bf16_t)(cvt_pk_bf16(o, 0.f) & 0xffffu);
        }
        const float* zc = z + MLA_IN; const float* zp = zc - ZLD; const float* zn = zc + ZLD;
        const bool hp = t > 0, hn = t < len - 1;
#define SHIFT4(jj) ({ const int j_ = (jj); const f32x4 zz = *(const f32x4*)(zc + j_), mp = *(const f32x4*)(mup + j_), mn = *(const f32x4*)(mun + j_); \
            f32x4 pv = {0.f, 0.f, 0.f, 0.f}, nv = pv; if (hp) pv = *(const f32x4*)(zp + j_); if (hn) nv = *(const f32x4*)(zn + j_); zz + mp * (pv - zz) + mn * (nv - zz); })
        { f32x4 a0 = SHIFT4(lane * 4), a1 = SHIFT4((lane + 64) * 4), a2 = SHIFT4((lane + 128) * 4), a3 = SHIFT4((lane + 192) * 4);
          float* dst = RR + hmi(row, lane * 4); *(f32x4*)dst = a0; *(f32x4*)(dst + (size_t)4 * MALL * 64) = a1; *(f32x4*)(dst + (size_t)8 * MALL * 64) = a2; *(f32x4*)(dst + (size_t)12 * MALL * 64) = a3; }
        { f32x4 k[4]; k[0] = SHIFT4(1024 + lane * 4); k[1] = SHIFT4(1024 + (lane + 64) * 4); k[2] = SHIFT4(1024 + (lane + 128) * 4); k[3] = SHIFT4(1024 + (lane + 192) * 4);
#pragma unroll
          for (int i = 0; i < 4; ++i) { const int c = (lane + 64 * i) * 4;
            *(f32x4*)(KRf + hmi(row, c)) = k[i];
            const f32x4 kk = k[i] * *(const f32x4*)(k_k + c);
            float q = kk[0] * kk[0] + kk[1] * kk[1] + kk[2] * kk[2] + kk[3] * kk[3];
            q += __shfl_xor(q, 1); q += __shfl_xor(q, 2); q += __shfl_xor(q, 4); q += __shfl_xor(q, 8);
            const float inv = -1.0f / fmaxf(sqrtf(q), 1e-12f);
            *(f32x4*)(AA + hmi(row, c)) = kk * inv; } }
        { f32x4 a0 = SHIFT4(2048 + lane * 4), a1 = SHIFT4(2048 + (lane + 64) * 4), a2 = SHIFT4(2048 + (lane + 128) * 4), a3 = SHIFT4(2048 + (lane + 192) * 4);
          float* dst = VR + hmi(row, lane * 4); *(f32x4*)dst = a0; *(f32x4*)(dst + (size_t)4 * MALL * 64) = a1; *(f32x4*)(dst + (size_t)8 * MALL * 64) = a2; *(f32x4*)(dst + (size_t)12 * MALL * 64) = a3; }
        {
            const int c0 = lane * 8; f32x4 x0 = {0.f, 0.f, 0.f, 0.f}, x1 = x0;
            if (c0 < 416) { x0 = SHIFT4(3072 + c0); x1 = SHIFT4(3072 + c0 + 4); }
            float o[8];
#pragma unroll
            for (int q = 0; q < 4; ++q) { o[q] = c0 < 128 ? ftanh(x0[q]) : c0 < 256 ? x0[q] : c0 < 416 ? fsigmoid(x0[q]) : 0.f; o[4 + q] = c0 < 128 ? ftanh(x1[q]) : c0 < 256 ? x1[q] : c0 < 416 ? fsigmoid(x1[q]) : 0.f; }
            u32x4 w; w.x = cvt_pk_bf16(o[0], o[1]); w.y = cvt_pk_bf16(o[2], o[3]); w.z = cvt_pk_bf16(o[4], o[5]); w.w = cvt_pk_bf16(o[6], o[7]);
            *(u32x4*)(LA + (size_t)row * 512 + c0) = w;
        }
#undef SHIFT4
    }
}

struct EpiLora { static constexpr bool PERM = false; const float* w0; const float* a0; const float* k_a; const float* KRf; const float* AA; float* WW; float* KD; float* BD; float* GG; int pn0;
    __device__ __forceinline__ void operator()(AccRef acc, const Unit& u, int wr, int wc, int fr, int fq) const {
        const int png = u.pn + pn0, g = __builtin_amdgcn_readfirstlane(png >> 2), row0 = u.pm * 256 + wr * 64 + fr, ch0 = (png & 3) * 256 + wc * 32 + 4 * fq;
        if (g < 2) {
            f32x4 bb[2][2];
#pragma unroll
            for (int bj = 0; bj < 2; ++bj)
#pragma unroll
                for (int n = 0; n < 2; ++n) bb[bj][n] = *(const f32x4*)(w0 + g * RD + ch0 + bj * 128 + n * 16);
            float* dstp = WW + (size_t)g * MALL * RD;
#pragma unroll
            for (int ai = 0; ai < 2; ++ai)
#pragma unroll
                for (int m = 0; m < 4; ++m) { const int row = row0 + ai * 128 + m * 16;
#pragma unroll
                    for (int bj = 0; bj < 2; ++bj)
#pragma unroll
                        for (int n = 0; n < 2; ++n) { const size_t e = hmi(row, ch0 + bj * 128 + n * 16); const f32x4 v = acc[ai][bj][m][n], b = bb[bj][n]; f32x4 o;
#pragma unroll
                            for (int j = 0; j < 4; ++j) { const float y = -(b[j] + v[j]); const float sp = fmaxf(y, 0.f) + flog(1.0f + fexp(-fabsf(y))); o[j] = fexp(-fexp(-sp - 0.5f)); }
                            *(f32x4*)(dstp + e) = o; } }
        } else if (g < 4) {
            const int d = g - 2;
            f32x4 bb[2][2], ka[2][2];
#pragma unroll
            for (int bj = 0; bj < 2; ++bj)
#pragma unroll
                for (int n = 0; n < 2; ++n) { bb[bj][n] = *(const f32x4*)(a0 + d * RD + ch0 + bj * 128 + n * 16); ka[bj][n] = *(const f32x4*)(k_a + ch0 + bj * 128 + n * 16); }
            float* kdp = KD + (size_t)d * MALL * RD; float* bdp = BD + (size_t)d * MALL * RD;
#pragma unroll
            for (int ai = 0; ai < 2; ++ai)
#pragma unroll
                for (int m = 0; m < 4; ++m) {
                    f32x4 kv[2][2], aa[2][2];
#pragma unroll
                    for (int bj = 0; bj < 2; ++bj)
#pragma unroll
                        for (int n = 0; n < 2; ++n) { const size_t e = hmi(row0 + ai * 128 + m * 16, ch0 + bj * 128 + n * 16); kv[bj][n] = *(const f32x4*)(KRf + e); aa[bj][n] = *(const f32x4*)(AA + e); }
#pragma unroll
                    for (int bj = 0; bj < 2; ++bj)
#pragma unroll
                        for (int n = 0; n < 2; ++n) { const size_t e = hmi(row0 + ai * 128 + m * 16, ch0 + bj * 128 + n * 16); const f32x4 v = acc[ai][bj][m][n]; f32x4 okd, obd;
#pragma unroll
                            for (int j = 0; j < 4; ++j) { const float ic = fsigmoid(bb[bj][n][j] + v[j]); okd[j] = kv[bj][n][j] * (1.f + (ic - 1.f) * ka[bj][n][j]); obd[j] = -ic * aa[bj][n][j]; }
                            *(f32x4*)(kdp + e) = okd; *(f32x4*)(bdp + e) = obd; }
                }
        } else {
#pragma unroll
            for (int ai = 0; ai < 2; ++ai)
#pragma unroll
                for (int m = 0; m < 4; ++m)
#pragma unroll
                    for (int bj = 0; bj < 2; ++bj)
#pragma unroll
                        for (int n = 0; n < 2; ++n) *(f32x4*)(GG + hmi(row0 + ai * 128 + m * 16, ch0 + bj * 128 + n * 16)) = acc[ai][bj][m][n];
        }
    } };
struct EpiQ { static constexpr bool PERM = false; bf16_t* QB; const float* ropec; const float* ropes;
    __device__ __forceinline__ void operator()(AccRef acc, const Unit& u, int wr, int wc, int fr, int fq) const {
        const float qs = 0.07216878364870322f * 1.4426950408889634f;
        const int row0 = u.pm * 256 + wr * 64 + fr;
#pragma unroll
        for (int bj = 0; bj < 2; ++bj) {
            const int cg = u.pn * 256 + bj * 128 + wc * 32, part = (cg >> 5) % 6;
#pragma unroll
            for (int ai = 0; ai < 2; ++ai)
#pragma unroll
                for (int m = 0; m < 4; ++m) { const int row = row0 + ai * 128 + m * 16, t = row & (SEQ - 1);
                    f32x4 x1 = acc[ai][bj][m][0], x2 = acc[ai][bj][m][1];
                    if (part >= 4) { const int pos = part == 4 ? (t >> 6) : (t & 63);
                        const f32x4 c = *(const f32x4*)(ropec + pos * 16 + 4 * fq), sn = *(const f32x4*)(ropes + pos * 16 + 4 * fq);
                        const f32x4 o1 = x1 * c - x2 * sn, o2 = x2 * c + x1 * sn; x1 = o1; x2 = o2; }
                    x1 = x1 * qs; x2 = x2 * qs;
                    bf16_t* dst = QB + (size_t)row * QW + cg + 4 * fq;
                    u32x2 w1, w2; w1.x = cvt_pk_bf16(x1[0], x1[1]); w1.y = cvt_pk_bf16(x1[2], x1[3]); w2.x = cvt_pk_bf16(x2[0], x2[1]); w2.y = cvt_pk_bf16(x2[2], x2[3]);
                    *(u32x2*)dst = w1; *(u32x2*)(dst + 16) = w2; }
        }
    } };
struct EpiBf16 { static constexpr bool PERM = true; bf16_t* O; int ldo;
    __device__ __forceinline__ void operator()(AccRef acc, const Unit& u, int wr, int wc, int fr, int fq) const {
        const int row0 = u.pm * 256 + wr * 64 + fr, col0 = u.pn * 256 + wc * 32 + 8 * fq;
#pragma unroll
        for (int ai = 0; ai < 2; ++ai)
#pragma unroll
            for (int m = 0; m < 4; ++m) { bf16_t* rowp = O + (size_t)(row0 + ai * 128 + m * 16) * ldo + col0;
#pragma unroll
                for (int bj = 0; bj < 2; ++bj) { const f32x4 v0 = acc[ai][bj][m][0], v1 = acc[ai][bj][m][1];
                    u32x4 w; w.x = cvt_pk_bf16(v0[0], v0[1]); w.y = cvt_pk_bf16(v0[2], v0[3]); w.z = cvt_pk_bf16(v1[0], v1[1]); w.w = cvt_pk_bf16(v1[2], v1[3]);
                    *(u32x4*)(rowp + bj * 128) = w; } }
    } };
struct EpiVT { static constexpr bool PERM = false; bf16_t* VT;
    __device__ __forceinline__ void operator()(AccRef acc, const Unit& u, int wr, int wc, int fr, int fq) const {
        const int row0 = u.pm * 256 + wr * 64 + fr, pq = ((fq & 1) << 1) | (fq >> 1), col0 = u.pn * 256 + wc * 32 + 4 * pq;
#pragma unroll
        for (int ai = 0; ai < 2; ++ai)
#pragma unroll
            for (int m = 0; m < 4; ++m) { bf16_t* rowp = VT + (size_t)(row0 + ai * 128 + m * 16) * MALL + col0;
#pragma unroll
                for (int bj = 0; bj < 2; ++bj)
#pragma unroll
                    for (int n = 0; n < 2; ++n) { const f32x4 v = acc[ai][bj][m][n]; u32x2 w; w.x = cvt_pk_bf16(v[0], v[1]); w.y = cvt_pk_bf16(v[2], v[3]); *(u32x2*)(rowp + bj * 128 + n * 16) = w; } }
    } };

__device__ __forceinline__ void ph_attn(LAS unsigned char* lds, const bf16_t* QB, const bf16_t* KNB, const bf16_t* VTB, bf16_t* MIXB, int G, int bid) {
    typedef float f32x16 __attribute__((ext_vector_type(16)));
    constexpr int KP = 400, VP = 144, KBYTES = 64 * KP, BUF = KBYTES + 128 * VP, NT = SK / 64;
    const int tid = threadIdx.x, wave = tid >> 6, lane = tid & 63, l32 = lane & 31, half = lane >> 5;
    for (int unit = bid; unit < NB * HM * (SEQ / 256); unit += G) {
        const int bh = unit & 15, qb = unit >> 4, b = bh >> 3, h = bh & 7;
        const int qrow = b * SEQ + qb * 256 + wave * 32 + l32;
        bf16x8 qf[12];
#pragma unroll
        for (int ks = 0; ks < 12; ++ks) qf[ks] = *(const bf16x8*)(QB + (size_t)qrow * QW + h * 192 + ks * 16 + half * 8);
        f32x16 o[4];
#pragma unroll
        for (int d = 0; d < 4; ++d)
#pragma unroll
            for (int i = 0; i < 16; ++i) o[d][i] = 0.f;
        float mrun = -1e30f, lrun = 0.f;
        int ko[3], kd[3], vo[2], vd[2];
#pragma unroll
        for (int i = 0; i < 3; ++i) { const int id = tid + 512 * i, key = id / 24, cc = id % 24;
            ko[i] = key * KLD + (cc < 16 ? h * 128 + cc * 8 : 1024 + (cc - 16) * 8); kd[i] = key * KP + cc * 16; }
#pragma unroll
        for (int i = 0; i < 2; ++i) { const int id = tid + 512 * i, dv = id >> 3, cc = id & 7;
            vo[i] = (h * 128 + dv) * MALL + cc * 8; vd[i] = KBYTES + dv * VP + cc * 16; }
        u32x4 kr_[3], vr_[2];
        __syncthreads();
        {   const int trow = NL + b * CTX;
#pragma unroll
            for (int i = 0; i < 3; ++i) kr_[i] = *(const u32x4*)(KNB + (size_t)(ko[i] + trow * KLD));
#pragma unroll
            for (int i = 0; i < 2; ++i) vr_[i] = *(const u32x4*)(VTB + (size_t)(vo[i] + trow));
#pragma unroll
            for (int i = 0; i < 3; ++i) *(LAS u32x4*)(lds + kd[i]) = kr_[i];
#pragma unroll
            for (int i = 0; i < 2; ++i) *(LAS u32x4*)(lds + vd[i]) = vr_[i];
        }
        __syncthreads();
        for (int j = 0; j < NT; ++j) {
            LAS unsigned char* cb = lds + (j & 1) * BUF;
            if (j + 1 < NT) {
                const int jn = j + 1, trow = jn < 4 ? NL + b * CTX + 64 * jn : b * SEQ + 64 * (jn - 4);
#pragma unroll
                for (int i = 0; i < 3; ++i) kr_[i] = *(const u32x4*)(KNB + (size_t)(ko[i] + trow * KLD));
#pragma unroll
                for (int i = 0; i < 2; ++i) vr_[i] = *(const u32x4*)(VTB + (size_t)(vo[i] + trow));
            }
            f32x16 s0, s1;
#pragma unroll
            for (int i = 0; i < 16; ++i) { s0[i] = 0.f; s1[i] = 0.f; }
#pragma unroll
            for (int ks = 0; ks < 12; ++ks) {
                const bf16x8 a0 = *(const LAS bf16x8*)(cb + l32 * KP + ks * 32 + half * 16), a1 = *(const LAS bf16x8*)(cb + (32 + l32) * KP + ks * 32 + half * 16);
                s0 = __builtin_amdgcn_mfma_f32_32x32x16_bf16(a0, qf[ks], s0, 0, 0, 0);
                s1 = __builtin_amdgcn_mfma_f32_32x32x16_bf16(a1, qf[ks], s1, 0, 0, 0);
            }
            float mx = s0[0];
#pragma unroll
            for (int i = 1; i < 16; ++i) mx = fmaxf(mx, s0[i]);
#pragma unroll
            for (int i = 0; i < 16; ++i) mx = fmaxf(mx, s1[i]);
            mx = fmaxf(mx, __shfl_xor(mx, 32));
            const float mn = fmaxf(mrun, mx);
            const float alpha = __builtin_amdgcn_exp2f(mrun - mn);
            mrun = mn;
            float ps = 0.f;
#pragma unroll
            for (int i = 0; i < 16; ++i) { s0[i] = __builtin_amdgcn_exp2f(s0[i] - mn); s1[i] = __builtin_amdgcn_exp2f(s1[i] - mn); ps += s0[i] + s1[i]; }
            lrun = lrun * alpha + ps;
#pragma unroll
            for (int d = 0; d < 4; ++d)
#pragma unroll
                for (int i = 0; i < 16; ++i) o[d][i] *= alpha;
            bf16x8 pf[4];
#pragma unroll
            for (int s = 0; s < 4; ++s) {
                u32x4 w;
                if (s < 2) { const int i0 = (s & 1) * 8; w.x = cvt_pk_bf16(s0[i0], s0[i0 + 1]); w.y = cvt_pk_bf16(s0[i0 + 2], s0[i0 + 3]); w.z = cvt_pk_bf16(s0[i0 + 4], s0[i0 + 5]); w.w = cvt_pk_bf16(s0[i0 + 6], s0[i0 + 7]); }
                else { const int i0 = (s & 1) * 8; w.x = cvt_pk_bf16(s1[i0], s1[i0 + 1]); w.y = cvt_pk_bf16(s1[i0 + 2], s1[i0 + 3]); w.z = cvt_pk_bf16(s1[i0 + 4], s1[i0 + 5]); w.w = cvt_pk_bf16(s1[i0 + 6], s1[i0 + 7]); }
                pf[s] = __builtin_bit_cast(bf16x8, w);
            }
#pragma unroll
            for (int s = 0; s < 4; ++s)
#pragma unroll
                for (int d = 0; d < 4; ++d) {
                    const bf16x8 vf = *(const LAS bf16x8*)(cb + KBYTES + (32 * d + l32) * VP + s * 32 + half * 16);
                    o[d] = __builtin_amdgcn_mfma_f32_32x32x16_bf16(vf, pf[s], o[d], 0, 0, 0);
                }
            if (j + 1 < NT) {
                LAS unsigned char* nb = lds + ((j + 1) & 1) * BUF;
#pragma unroll
                for (int i = 0; i < 3; ++i) *(LAS u32x4*)(nb + kd[i]) = kr_[i];
#pragma unroll
                for (int i = 0; i < 2; ++i) *(LAS u32x4*)(nb + vd[i]) = vr_[i];
            }
            __syncthreads();
        }
        lrun += __shfl_xor(lrun, 32);
        const float il = 1.0f / lrun;
        bf16_t* dst = MIXB + (size_t)qrow * D + h * 128 + 4 * half;
#pragma unroll
        for (int d = 0; d < 4; ++d)
#pragma unroll
            for (int i4 = 0; i4 < 4; ++i4) { u32x2 w; w.x = cvt_pk_bf16(o[d][i4 * 4] * il, o[d][i4 * 4 + 1] * il); w.y = cvt_pk_bf16(o[d][i4 * 4 + 2] * il, o[d][i4 * 4 + 3] * il);
                *(u32x2*)(dst + 32 * d + 8 * i4) = w; }
    }
    __syncthreads();
}


constexpr int SC_CL = 272, SC_NC = 16;
__device__ __forceinline__ int scan_row(int b, int d, int g) {
    if (g < CTX) return NL + b * CTX + (d == 0 ? g : CTX - 1 - g);
    const int tp = g - CTX; return b * SEQ + (d == 0 ? tp : SEQ - 1 - tp);
}
#define DPP_FMAC(d, a, b, n) asm volatile("v_fmac_f32_dpp %0, %1, %2 row_newbcast:" #n " row_mask:0xf bank_mask:0xf" : "+v"(d) : "v"(a), "v"(b))
#define DPP_MULD(d, a, n)    asm volatile("v_mul_f32_dpp %0, %1, %0 row_newbcast:" #n " row_mask:0xf bank_mask:0xf" : "+v"(d) : "v"(a))
#define SC_FOR16(X) X(0) X(1) X(2) X(3) X(4) X(5) X(6) X(7) X(8) X(9) X(10) X(11) X(12) X(13) X(14) X(15)
struct MoeCv { const float* w1; long d31; const float* w2; unsigned char* W13E; unsigned char* W2E; };
constexpr int CV_PER_WAVE = 336, CV_ITEMS_W13 = 3584, CV_ITEMS_E = 5376, CV_WLDS = 4096;
static_assert((size_t)NE * CV_ITEMS_E * 8 == (size_t)CV_PER_WAVE * 1024, "MoE conversion tiles must split evenly over 1024 waves");
static_assert(4 * 5 * 6144 + 4 * CV_WLDS <= LDS_CTL, "scan rings + conversion images must fit below the LDS control words");
struct CvItem { const float* sp; unsigned char* dst; int ld, K; float sc; };
__device__ __forceinline__ CvItem cv_item(const MoeCv& mc, int it, int cw) {
    const int I = it * 1024 + cw, e = I / CV_ITEMS_E, r = I - e * CV_ITEMS_E;
    CvItem o;
    if (r < CV_ITEMS_W13) { const int kr = r / 224, nt = r - kr * 224, n0 = nt * 64, jj = n0 & 255;
        o.sp = mc.w1 + (jj < 128 ? 0l : mc.d31) + (size_t)e * D * DFF + (size_t)kr * 128 * DFF + (n0 >> 8) * 128 + (jj & 127); o.ld = DFF;
        o.dst = mc.W13E + (size_t)e * 2 * DFF * D + (size_t)n0 * D + kr * 128; o.K = D; o.sc = 64.f; }
    else { const int r2 = r - CV_ITEMS_W13, kr = r2 >> 5, n0 = (r2 & 31) * 64;
        o.sp = mc.w2 + (size_t)e * DFF * D + (size_t)kr * 128 * D + n0; o.ld = D;
        o.dst = mc.W2E + (size_t)e * D * DFF + (size_t)n0 * DFF + kr * 128; o.K = DFF; o.sc = 128.f; }
    return o;
}
__device__ __forceinline__ void moe_cvt_wave(LAS unsigned char* ct, const MoeCv& mc, int cw, int lane) {
    constexpr int NIT = CV_PER_WAVE / 8;
    const int l15 = lane & 15, l4 = lane >> 4;
    f32x4 buf[8][4];
    CvItem cur = cv_item(mc, 0, cw);
    { const float* lp = cur.sp + (size_t)(l4 * cur.ld + l15 * 4);
#pragma unroll
      for (int s = 0; s < 8; ++s)
#pragma unroll
        for (int q = 0; q < 4; ++q) buf[s][q] = *(const f32x4*)(lp + (size_t)(s * 16 + q * 4) * cur.ld); }
#pragma unroll 1
    for (int it = 0; it < NIT; ++it) {
        const CvItem nxt = cv_item(mc, it + 1 < NIT ? it + 1 : NIT - 1, cw);
        const float* lp = nxt.sp + (size_t)(l4 * nxt.ld + l15 * 4);
        unsigned char* dp = cur.dst + (size_t)lane * cur.K;
        const float sc = cur.sc;
        u32x4 wout[8];
#pragma unroll
        for (int s = 0; s < 8; ++s) {
#pragma unroll
            for (int q = 0; q < 4; ++q) *(LAS f32x4*)(ct + q * 1024 + lane * 16) = buf[s][q];
#pragma unroll
            for (int q = 0; q < 4; ++q) buf[s][q] = *(const f32x4*)(lp + (size_t)(s * 16 + q * 4) * nxt.ld);
            float v[16];
#pragma unroll
            for (int j = 0; j < 16; ++j) v[j] = ((const LAS float*)ct)[j * 64 + lane];
            u32x4 w; w.x = pk4_fp8(v[0] * sc, v[1] * sc, v[2] * sc, v[3] * sc); w.y = pk4_fp8(v[4] * sc, v[5] * sc, v[6] * sc, v[7] * sc);
            w.z = pk4_fp8(v[8] * sc, v[9] * sc, v[10] * sc, v[11] * sc); w.w = pk4_fp8(v[12] * sc, v[13] * sc, v[14] * sc, v[15] * sc);
            wout[s] = w;
        }
#pragma unroll
        for (int s = 0; s < 8; ++s) *(u32x4*)(dp + s * 16) = wout[s];
        cur = nxt;
    }
#pragma unroll
    for (int s = 0; s < 8; ++s) asm volatile("" :: "v"(buf[s][0]), "v"(buf[s][1]), "v"(buf[s][2]), "v"(buf[s][3]));
}
constexpr int SC_NSLOT = 5, SC_SLOTB = 6144, SC_WLDS = SC_NSLOT * SC_SLOTB;
#define SC_VSET(P) f32x4 P##av, P##wv, P##bv, P##kv, P##rv; float P##vv
#define SC_READV(P, sl) do { P##av = *(const LAS f32x4*)((sl) + l15 * 16); P##wv = *(const LAS f32x4*)((sl) + 1024 + l15 * 16); P##bv = *(const LAS f32x4*)((sl) + 2048 + l15 * 16); \
            P##kv = *(const LAS f32x4*)((sl) + 3072 + l15 * 16); P##rv = *(const LAS f32x4*)((sl) + 4096 + l15 * 16); P##vv = *(const LAS float*)((sl) + 5120 + lane * 4); } while (0)
#define SC_STEP(P, i) do { \
            float a0 = P##av[0], a1 = P##av[1], a2 = P##av[2], a3 = P##av[3], w0 = P##wv[0], w1 = P##wv[1], w2 = P##wv[2], w3 = P##wv[3], b0 = P##bv[0], b1 = P##bv[1], b2 = P##bv[2], b3 = P##bv[3]; \
            float k0 = P##kv[0], k1 = P##kv[1], k2 = P##kv[2], k3 = P##kv[3], r0 = P##rv[0], r1 = P##rv[1], r2 = P##rv[2], r3 = P##rv[3], vq = P##vv; \
            asm volatile("s_nop 1" : "+v"(a0), "+v"(a1), "+v"(a2), "+v"(a3)); \
            float c0 = 0.f, c1 = 0.f, c2 = 0.f, c3 = 0.f, e0 = 0.f, e1 = 0.f, e2 = 0.f, e3 = 0.f; \
            SC_FOR16(SC_SA) \
            float saq = (c0 + c1) + (c2 + c3), sap = (e0 + e1) + (e2 + e3); \
            asm volatile("s_nop 1" : "+v"(w0), "+v"(w1), "+v"(w2), "+v"(w3), "+v"(b0), "+v"(b1), "+v"(b2), "+v"(b3), "+v"(saq), "+v"(sap)); \
            SC_FOR16(SC_UP) \
            asm volatile("s_nop 1" : "+v"(k0), "+v"(k1), "+v"(k2), "+v"(k3), "+v"(vq)); \
            SC_FOR16(SC_VK) \
            if (gbase + (i) >= CTX) { \
                float y0 = 0.f, y1 = 0.f, y2 = 0.f, y3 = 0.f, z0 = 0.f, z1 = 0.f, z2 = 0.f, z3 = 0.f; \
                asm volatile("s_nop 1" : "+v"(r0), "+v"(r1), "+v"(r2), "+v"(r3)); \
                SC_FOR16(SC_Y) \
                const size_t yo_ = (size_t)scan_row(b, d, gbase + (i)) * 64; \
                ypq[yo_ + lane] = (y0 + y1) + (y2 + y3); ypp[yo_ + lane] = (z0 + z1) + (z2 + z3); \
            } } while (0)
#define SC_SA(n) DPP_FMAC(c0, a0, SQ[4 * n], n); DPP_FMAC(c1, a1, SQ[4 * n + 1], n); DPP_FMAC(c2, a2, SQ[4 * n + 2], n); DPP_FMAC(c3, a3, SQ[4 * n + 3], n); \
                 DPP_FMAC(e0, a0, SP[4 * n], n); DPP_FMAC(e1, a1, SP[4 * n + 1], n); DPP_FMAC(e2, a2, SP[4 * n + 2], n); DPP_FMAC(e3, a3, SP[4 * n + 3], n);
#define SC_UP(n) DPP_MULD(SQ[4 * n], w0, n); DPP_MULD(SQ[4 * n + 1], w1, n); DPP_MULD(SQ[4 * n + 2], w2, n); DPP_MULD(SQ[4 * n + 3], w3, n); \
                 DPP_MULD(SP[4 * n], w0, n); DPP_MULD(SP[4 * n + 1], w1, n); DPP_MULD(SP[4 * n + 2], w2, n); DPP_MULD(SP[4 * n + 3], w3, n); \
                 DPP_FMAC(SQ[4 * n], b0, saq, n); DPP_FMAC(SQ[4 * n + 1], b1, saq, n); DPP_FMAC(SQ[4 * n + 2], b2, saq, n); DPP_FMAC(SQ[4 * n + 3], b3, saq, n); \
                 DPP_FMAC(SP[4 * n], b0, sap, n); DPP_FMAC(SP[4 * n + 1], b1, sap, n); DPP_FMAC(SP[4 * n + 2], b2, sap, n); DPP_FMAC(SP[4 * n + 3], b3, sap, n);
#define SC_VK(n) DPP_FMAC(SQ[4 * n], k0, vq, n); DPP_FMAC(SQ[4 * n + 1], k1, vq, n); DPP_FMAC(SQ[4 * n + 2], k2, vq, n); DPP_FMAC(SQ[4 * n + 3], k3, vq, n);
#define SC_Y(n) DPP_FMAC(y0, r0, SQ[4 * n], n); DPP_FMAC(y1, r1, SQ[4 * n + 1], n); DPP_FMAC(y2, r2, SQ[4 * n + 2], n); DPP_FMAC(y3, r3, SQ[4 * n + 3], n); \
                DPP_FMAC(z0, r0, SP[4 * n], n); DPP_FMAC(z1, r1, SP[4 * n + 1], n); DPP_FMAC(z2, r2, SP[4 * n + 2], n); DPP_FMAC(z3, r3, SP[4 * n + 3], n);
__device__ __forceinline__ void ph_scan1(LAS unsigned char* lds, const float* wsf, unsigned oAA, unsigned oWW, unsigned oBD, unsigned oKD, unsigned oRR, unsigned oVR, float* YP, float* QP, const MoeCv mc, int G, int bid) {
    const int wave = __builtin_amdgcn_readfirstlane(threadIdx.x >> 6), lane = threadIdx.x & 63, l15 = lane & 15, vi = lane >> 4;
    if (wave >= 4) { for (int pb = bid; pb < 256; pb += G) moe_cvt_wave(lds + 4 * SC_WLDS + (wave - 4) * CV_WLDS, mc, pb * 4 + (wave - 4), lane); return; }
    LAS unsigned char* ring = lds + wave * SC_WLDS;
    for (int pb = bid; pb < 256; pb += G) {
        const int pair = pb * 4 + wave, chain = pair >> 4, chunk = pair & 15;
        const int b = chain >> 5, h = (chain >> 1) & 15, d = chain & 1;
        const unsigned dofs = (unsigned)d * MALL * RD;
        const unsigned oh = (unsigned)h * (MALL * 64), lane4 = lane * 4;
        const unsigned ob0 = oAA + oh, ob1 = oWW + dofs + oh, ob2 = oBD + dofs + oh, ob3 = oKD + dofs + oh, ob4 = oRR + oh, ob5 = oVR + oh;
        float SQ[64], SP[64];
#pragma unroll
        for (int k = 0; k < 64; ++k) { SQ[k] = 0.f; SP[k] = lane == k ? 1.f : 0.f; }
        float* ypq = YP + (size_t)d * NL * RD + (size_t)h * NL * 64;
        float* ypp = YP + (size_t)(2 + d) * NL * RD + (size_t)h * NL * 64;
        const int gbase = chunk * SC_CL;
        constexpr int NGRP = SC_CL / 4;
#define SC_ISSUE(grp, slot) do { const int gq_ = (grp) < NGRP ? (grp) : NGRP - 1; const unsigned ro_ = (unsigned)scan_row(b, d, gbase + 4 * gq_ + (d ? 3 : 0)) * 64; LAS unsigned char* sl_ = ring + (slot) * SC_SLOTB; \
            __builtin_amdgcn_global_load_lds((const unsigned*)(wsf + (ob0 + ro_) + lane4), (LAS unsigned*)sl_, 16, 0, 0); __builtin_amdgcn_global_load_lds((const unsigned*)(wsf + (ob1 + ro_) + lane4), (LAS unsigned*)(sl_ + 1024), 16, 0, 0); \
            __builtin_amdgcn_global_load_lds((const unsigned*)(wsf + (ob2 + ro_) + lane4), (LAS unsigned*)(sl_ + 2048), 16, 0, 0); __builtin_amdgcn_global_load_lds((const unsigned*)(wsf + (ob3 + ro_) + lane4), (LAS unsigned*)(sl_ + 3072), 16, 0, 0); \
            __builtin_amdgcn_global_load_lds((const unsigned*)(wsf + (ob4 + ro_) + lane4), (LAS unsigned*)(sl_ + 4096), 16, 0, 0); __builtin_amdgcn_global_load_lds((const unsigned*)(wsf + (ob5 + ro_) + lane4), (LAS unsigned*)(sl_ + 5120), 16, 0, 0); } while (0)
        SC_ISSUE(0, 0); SC_ISSUE(1, 1); SC_ISSUE(2, 2); SC_ISSUE(3, 3); SC_ISSUE(4, 4);
        SC_VSET(A); SC_VSET(B);
        asm volatile("s_waitcnt vmcnt(24)" ::: "memory");
        const int r0o = d ? 768 : 0, rstep = d ? -256 : 256;
        SC_READV(A, ring + r0o);
        asm volatile("s_waitcnt lgkmcnt(0)" ::: "memory");
        int slot = 0;
#pragma unroll 1
        for (int grp = 0; grp < NGRP; ++grp) {
            const int i = 4 * grp;
            const LAS unsigned char* sl = ring + slot * SC_SLOTB + r0o;
            const int nslot = slot == SC_NSLOT - 1 ? 0 : slot + 1;
            SC_READV(B, sl + rstep);
            SC_STEP(A, i);
            asm volatile("s_waitcnt lgkmcnt(0)" ::: "memory");
            SC_READV(A, sl + 2 * rstep);
            SC_STEP(B, i + 1);
            asm volatile("s_waitcnt lgkmcnt(0)" ::: "memory");
            SC_READV(B, sl + 3 * rstep);
            SC_STEP(A, i + 2);
            asm volatile("s_waitcnt lgkmcnt(0)" ::: "memory");
            SC_ISSUE(grp + SC_NSLOT, slot);
            asm volatile("s_waitcnt vmcnt(24)" ::: "memory");
            SC_READV(A, ring + nslot * SC_SLOTB + r0o);
            SC_STEP(B, i + 3);
            asm volatile("s_waitcnt lgkmcnt(0)" ::: "memory");
            slot = nslot;
        }
        asm volatile("s_waitcnt vmcnt(0)" ::: "memory");
#undef SC_ISSUE
        float* qpq = QP + ((((size_t)chain) * SC_NC + chunk) * 64 + lane) * 64;
        float* qpp = QP + ((((size_t)64 + chain) * SC_NC + chunk) * 64 + lane) * 64;
#pragma unroll
        for (int j = 0; j < 16; ++j) { *(f32x4*)(qpq + 4 * j) = (f32x4){SQ[4 * j], SQ[4 * j + 1], SQ[4 * j + 2], SQ[4 * j + 3]}; *(f32x4*)(qpp + 4 * j) = (f32x4){SP[4 * j], SP[4 * j + 1], SP[4 * j + 2], SP[4 * j + 3]}; }
    }
}
#undef SC_SA
#undef SC_UP
#undef SC_VK
#undef SC_Y
__device__ __forceinline__ void ph_scan_carry(const float* QP, float* SS, int G, int bid) {
    const int wave = __builtin_amdgcn_readfirstlane(threadIdx.x >> 6), lane = threadIdx.x & 63;
    for (int task = bid * 8 + wave; task < 64 * 32; task += G * 8) {
        const int chain = task >> 5, v0 = (task & 31) * 2;
        float s0 = 0.f, s1 = 0.f, P[64];
        const float* Pc = QP + (((size_t)64 + chain) * SC_NC) * 4096 + lane;
        const float* Qc = QP + (((size_t)chain) * SC_NC) * 4096 + v0 * 64 + lane;
        float* Sp = SS + (((size_t)chain * SC_NC) * 64 + v0) * 64 + lane;
#pragma unroll
        for (int k = 0; k < 64; ++k) P[k] = Pc[k * 64];
        float q0 = Qc[0], q1 = Qc[64];
#pragma unroll 1
        for (int c = 0; c < SC_NC - 1; ++c) {
            Sp[0] = s0; Sp[64] = s1; Sp += 4096;
            const int cn = c + 1 < SC_NC - 1 ? 1 : 0;
            Pc += cn * 4096; Qc += cn * 4096;
            float n0 = q0, n1 = q1; const int i0 = __builtin_bit_cast(int, s0), i1 = __builtin_bit_cast(int, s1);
            q0 = Qc[0]; q1 = Qc[64];
#pragma unroll
            for (int k = 0; k < 64; ++k) { const float pk = P[k];
                n0 += __builtin_bit_cast(float, __builtin_amdgcn_readlane(i0, k)) * pk; n1 += __builtin_bit_cast(float, __builtin_amdgcn_readlane(i1, k)) * pk;
                P[k] = Pc[k * 64]; }
            s0 = n0; s1 = n1;
        }
        Sp[0] = s0; Sp[64] = s1;
    }
}
struct FixLd { f32x4 p0, p1; float yl, r, ks, vr, gg; };
__device__ __forceinline__ FixLd fix_load(const float* YP, const float* RR, const float* KD, const float* VR, const float* GG, int row, int h, int lane) {
    FixLd x; const int l15 = lane & 15; const size_t e = ((size_t)h * NL + row) * 64, em = ((size_t)h * MALL + row) * 64;
    x.p0 = *(const f32x4*)(YP + (size_t)2 * NL * RD + e + l15 * 4); x.p1 = *(const f32x4*)(YP + (size_t)3 * NL * RD + e + l15 * 4);
    x.yl = YP[e + lane] + YP[(size_t)NL * RD + e + lane];
    x.r = RR[em + lane]; x.ks = KD[em + lane] + KD[(size_t)MALL * RD + em + lane]; x.vr = VR[em + lane]; x.gg = GG[em + lane];
    return x;
}
__device__ __forceinline__ void ph_scan_fix(const float* YP, const float* SS, const float* RR, const float* KD, const float* VR, const float* GG, const float* r_k, const float* lnw, const float* lnb, bf16_t* MIXB, int G, int bid) {
    const int wave = __builtin_amdgcn_readfirstlane(threadIdx.x >> 6), lane = threadIdx.x & 63;
    for (int task = bid * 8 + wave; task < 2048; task += G * 8) {
        const int b = task >> 10, h = (task >> 6) & 15, t0 = (task & 63) * 64, c = h * 64 + lane;
        const int chain0 = (b * 16 + h) * 2;
        float S0[64], S1[64]; int cc0 = -1, cc1 = -1;
        const float rk = r_k[c], lw = lnw[c], lb = lnb[c];
        FixLd ring[4];
#pragma unroll
        for (int k = 0; k < 4; ++k) ring[k] = fix_load(YP, RR, KD, VR, GG, b * SEQ + t0 + k, h, lane);
#pragma unroll 1
        for (int tt0 = 0; tt0 < 64; tt0 += 4)
#pragma unroll
          for (int k = 0; k < 4; ++k) {
            const int tt = tt0 + k, t = t0 + tt, row = b * SEQ + t;
            const FixLd cu = ring[k];
            { const int tn = tt < 60 ? t + 4 : t; ring[k] = fix_load(YP, RR, KD, VR, GG, b * SEQ + tn, h, lane); }
            const int c0 = (CTX + t) / SC_CL, c1 = (CTX + SEQ - 1 - t) / SC_CL;
            if (c0 != cc0) { cc0 = c0; const float* sp = SS + (((size_t)chain0 * SC_NC + c0) * 64 + lane) * 64;
#pragma unroll
                for (int j = 0; j < 16; ++j) { const f32x4 x = *(const f32x4*)(sp + 4 * j); S0[4 * j] = x[0]; S0[4 * j + 1] = x[1]; S0[4 * j + 2] = x[2]; S0[4 * j + 3] = x[3]; } }
            if (c1 != cc1) { cc1 = c1; const float* sp = SS + (((size_t)(chain0 + 1) * SC_NC + c1) * 64 + lane) * 64;
#pragma unroll
                for (int j = 0; j < 16; ++j) { const f32x4 x = *(const f32x4*)(sp + 4 * j); S1[4 * j] = x[0]; S1[4 * j + 1] = x[1]; S1[4 * j + 2] = x[2]; S1[4 * j + 3] = x[3]; } }
            float a0 = cu.p0[0], a1 = cu.p0[1], a2 = cu.p0[2], a3 = cu.p0[3], b0 = cu.p1[0], b1 = cu.p1[1], b2 = cu.p1[2], b3 = cu.p1[3];
            asm volatile("s_nop 1" : "+v"(a0), "+v"(a1), "+v"(a2), "+v"(a3), "+v"(b0), "+v"(b1), "+v"(b2), "+v"(b3));
            float y0 = 0.f, y1 = 0.f, y2 = 0.f, y3 = 0.f, z0 = 0.f, z1 = 0.f, z2 = 0.f, z3 = 0.f;
#define FX_N(n) DPP_FMAC(y0, a0, S0[4 * n], n); DPP_FMAC(y1, a1, S0[4 * n + 1], n); DPP_FMAC(y2, a2, S0[4 * n + 2], n); DPP_FMAC(y3, a3, S0[4 * n + 3], n); \
                DPP_FMAC(z0, b0, S1[4 * n], n); DPP_FMAC(z1, b1, S1[4 * n + 1], n); DPP_FMAC(z2, b2, S1[4 * n + 2], n); DPP_FMAC(z3, b3, S1[4 * n + 3], n);
            SC_FOR16(FX_N)
#undef FX_N
            const float y = cu.yl + ((y0 + y1) + (y2 + y3)) + ((z0 + z1) + (z2 + z3));
            const float mu = wave_sum_dpp(y) * (1.f / 64.f);
            const float dv = y - mu;
            const float var = wave_sum_dpp(dv * dv) * (1.f / 64.f);
            const float yn = dv * rsqrtf(var + 64e-5f) * lw + lb;
            const float bonus = wave_sum_dpp(cu.r * cu.ks * rk) * cu.vr;
            const float o = (yn + bonus) * cu.gg;
            const float on = __shfl_down(o, 1);
            if ((lane & 1) == 0) *(unsigned*)(MIXB + (size_t)row * D + 1024 + c) = cvt_pk_bf16(o, on);
        }
    }
}

constexpr size_t alb(size_t x) { return (x + 4095) & ~(size_t)4095; }
constexpr size_t CTL_BYTES = 65536;
constexpr size_t MB_CTL = 0;
constexpr size_t B_MOD0 = MB_CTL + CTL_BYTES;
constexpr size_t B_MOD1 = B_MOD0 + alb((size_t)3 * NMOD * 4);
constexpr size_t B_MODP = B_MOD1 + alb((size_t)2 * NMOD * 4);
constexpr size_t MB_ROPE = B_MODP + alb((size_t)2 * 32 * 3 * NMOD * 4);
constexpr size_t B_H = MB_ROPE + 8192;
constexpr size_t MB_XNB = B_H + alb((size_t)NL * D * 4);
constexpr size_t MB_WIN0 = MB_XNB + alb((size_t)MALL * D * 2);
constexpr size_t MB_WO0 = MB_WIN0 + alb((size_t)ZLD * D * 2);
constexpr size_t MB_W13 = MB_WO0 + alb((size_t)D * D * 2);
constexpr size_t MB_W2 = MB_W13 + alb((size_t)2 * DFF * D * 2);
constexpr size_t MB_WUQ = MB_W2 + alb((size_t)D * DFF * 2);
constexpr size_t MB_WKN = MB_WUQ + alb((size_t)QW * 512 * 2);
constexpr size_t MB_WV = MB_WKN + alb((size_t)1024 * 512 * 2);
constexpr size_t MB_WLORA = MB_WV + alb((size_t)1024 * 512 * 2);
constexpr size_t MB_WIN1 = MB_WLORA + alb((size_t)5120 * 512 * 2);
constexpr size_t MB_WO1 = MB_WIN1 + alb((size_t)4096 * D * 2);
constexpr size_t MB_WSB = MB_WO1 + alb((size_t)D * D * 2);
constexpr size_t MB_W13E = MB_WSB + alb((size_t)16 * 128 * 128 * 2);
constexpr size_t MB_W2E = MB_W13E + alb((size_t)NE * 2 * DFF * D);
constexpr size_t B_ACTS = MB_W2E + alb((size_t)NE * D * DFF);
constexpr size_t B_Z = B_ACTS;
constexpr size_t MB_CQNB = B_Z + alb((size_t)MALL * ZLD * 4);
constexpr size_t MB_CKVNB = MB_CQNB + alb((size_t)MALL * 512 * 2);
constexpr size_t MB_LA = MB_CKVNB + alb((size_t)MALL * 512 * 2);
constexpr size_t MB_QB = MB_LA + alb((size_t)MALL * 512 * 2);
constexpr size_t MB_KNB = MB_QB + alb((size_t)NL * QW * 2);
constexpr size_t MB_VTB = MB_KNB + alb((size_t)MALL * KLD * 2);
constexpr size_t B_RR = MB_VTB + alb((size_t)RD * MALL * 2);
constexpr size_t B_KR = B_RR + alb((size_t)MALL * RD * 4);
constexpr size_t B_VR = B_KR + alb((size_t)MALL * RD * 4);
constexpr size_t B_AA = B_VR + alb((size_t)MALL * RD * 4);
constexpr size_t B_WW = B_AA + alb((size_t)MALL * RD * 4);
constexpr size_t B_KD = B_WW + alb((size_t)2 * MALL * RD * 4);
constexpr size_t B_BD = B_KD + alb((size_t)2 * MALL * RD * 4);
constexpr size_t B_GG = B_BD + alb((size_t)2 * MALL * RD * 4);
constexpr size_t MB_YP = B_GG + alb((size_t)MALL * RD * 4);
constexpr size_t MB_QP = MB_YP + alb((size_t)4 * NL * RD * 4);
constexpr size_t MB_SS = MB_QP + alb((size_t)2 * 64 * 16 * 4096 * 4);
constexpr size_t MB_MIXB = MB_SS + alb((size_t)64 * 16 * 4096 * 4);
constexpr size_t MB_ACT = MB_MIXB + alb((size_t)NL * D * 2);
constexpr size_t B_L0END = MB_ACT + alb((size_t)NL * DFF * 2);
constexpr size_t MB_U = B_ACTS;
constexpr size_t MB_VG = MB_U + alb((size_t)NL * D * 2);
constexpr size_t MB_VT = MB_VG + alb((size_t)NL * D * 4);
constexpr size_t MB_GATED = MB_VT + alb((size_t)NL * D * 2);
constexpr size_t MB_XG = MB_GATED + alb((size_t)NL * D * 2);
constexpr size_t MB_ACT2 = MB_XG + alb((size_t)NSLOT * D);
constexpr size_t MB_OUT2 = MB_ACT2 + alb((size_t)NSLOT * DFF);
constexpr size_t MB_ROUTE = MB_OUT2 + alb((size_t)NSLOT * D * 4);
constexpr size_t B_L1END = MB_ROUTE + 262144;
constexpr size_t MB_END = B_L0END > B_L1END ? B_L0END : B_L1END;
constexpr size_t O_MOD0 = B_MOD0 / 4, O_MOD1 = B_MOD1 / 4, O_MODP = B_MODP / 4, O_H = B_H / 4, O_Z = B_Z / 4, O_RR = B_RR / 4, O_KR = B_KR / 4, O_VR = B_VR / 4, O_AA = B_AA / 4,
                 O_WW = B_WW / 4, O_KD = B_KD / 4, O_BD = B_BD / 4, O_GG = B_GG / 4;

struct MP { const float* in[44]; float* out; unsigned char* ws; int ph_lo, ph_hi; };

enum { PH_CVT = 0, PH_XN1, PH_GEMM_Z, PH_PREP, PH_GEMM4, PH_ATTN, PH_CARRY, PH_FIX, PH_GEMM_O0, PH_XN2, PH_FFN_UP, PH_FFN_DOWN, PH_XN3, PH_GEMM_IN1, PH_LNT, PH_SPATIAL, PH_GEMM_O1, PH_XN4, PH_PLAN, PH_MOE_UP, PH_MOE_DOWN, PH_FINAL, PH_N };

__global__ void __launch_bounds__(512, 2) mega(MP p) {
    extern __shared__ __attribute__((aligned(16))) unsigned char lds_raw[];
    LAS unsigned char* lds = (LAS unsigned char*)lds_raw;
    const int tid = threadIdx.x, G = gridDim.x, bid = blockIdx.x;
    for (int u = tid; u < (LDS_BYTES - LDS_CTL) / 4; u += 512) ((LAS unsigned*)(lds + LDS_CTL))[u] = 0u;
    __syncthreads();
    XcdBarrier bar = xcd_barrier_post((unsigned*)(p.ws + MB_CTL), (volatile LAS unsigned*)(lds + LDS_CTL + 64));
    float* wsf = (float*)p.ws;
    const int lo = p.ph_lo, hi = p.ph_hi;
#define IN(k) (lo <= (k) && (k) < hi)
#define SEAM(k) do { if (IN(k) && IN((k) + 1)) xcd_barrier(bar); } while (0)
    bf16_t* W13 = (bf16_t*)(p.ws + MB_W13); bf16_t* W2 = (bf16_t*)(p.ws + MB_W2); bf16_t* XNB = (bf16_t*)(p.ws + MB_XNB); bf16_t* ACT = (bf16_t*)(p.ws + MB_ACT);

    bf16_t* WIN0 = (bf16_t*)(p.ws + MB_WIN0); bf16_t* WO0 = (bf16_t*)(p.ws + MB_WO0); bf16_t* MIXB = (bf16_t*)(p.ws + MB_MIXB);
    bf16_t* CQNB = (bf16_t*)(p.ws + MB_CQNB); bf16_t* CKVNB = (bf16_t*)(p.ws + MB_CKVNB); bf16_t* LA = (bf16_t*)(p.ws + MB_LA);
    bf16_t* WLORA = (bf16_t*)(p.ws + MB_WLORA); bf16_t* WUQ = (bf16_t*)(p.ws + MB_WUQ); bf16_t* WKN = (bf16_t*)(p.ws + MB_WKN); bf16_t* WV = (bf16_t*)(p.ws + MB_WV);
    bf16_t* QB = (bf16_t*)(p.ws + MB_QB); bf16_t* KNB = (bf16_t*)(p.ws + MB_KNB); bf16_t* VTB = (bf16_t*)(p.ws + MB_VTB); float* ROPEC = (float*)(p.ws + MB_ROPE); float* ROPES = ROPEC + 1024;
    bf16_t* W13E = (bf16_t*)(p.ws + MB_W13E); bf16_t* W2E = (bf16_t*)(p.ws + MB_W2E); bf16_t* WIN1 = (bf16_t*)(p.ws + MB_WIN1); bf16_t* WO1 = (bf16_t*)(p.ws + MB_WO1); bf16_t* WSB = (bf16_t*)(p.ws + MB_WSB);
    bf16_t* Ub = (bf16_t*)(p.ws + MB_U); float* VG = (float*)(p.ws + MB_VG); bf16_t* VT = (bf16_t*)(p.ws + MB_VT); bf16_t* GATED = (bf16_t*)(p.ws + MB_GATED); bf16_t* XNB2 = (bf16_t*)(p.ws + MB_XNB);
    bf16_t* XG = (bf16_t*)(p.ws + MB_XG); float* OUT2 = (float*)(p.ws + MB_OUT2); bf16_t* ACT2 = (bf16_t*)(p.ws + MB_ACT2);
    int* R_TOPE = (int*)(p.ws + MB_ROUTE); int* R_SLOT = R_TOPE + 16384; float* R_TOPG = (float*)(R_TOPE + 32768); int* R_BCNT = R_TOPE + 49152; int* R_CNTOFF = R_TOPE + 49152 + 4096;
    if (IN(PH_CVT)) {
        ph_small_cvt(p.in[16], p.in[18], p.in[19], WLORA, ROPEC, ROPES, G, bid);
        { MapPlain m{p.in[10], QW, QW}; cvt_T(lds, m, WUQ, QW, 512, G, bid); }
        { MapKV m{p.in[12], 0}; cvt_T(lds, m, WKN, 1024, 512, G, (bid + G - 96) % G); }
        { MapKV m{p.in[12], 1}; cvt_T(lds, m, WV, 1024, 512, G, (bid + G - 160) % G); }
        ph_ada(lds, p.in[4], p.in[29], p.in[5], p.in[30], p.in[1], p.in[3], wsf + O_MOD0, wsf + O_MOD1, G, bid);
        { MapPlain m{p.in[8], ZW, ZW}; cvt_T(lds, m, WIN0, ZLD, D, G, bid); }
        { MapPlain m{p.in[25], D, D}; cvt_T(lds, m, WO0, D, D, G, bid); }
        { MapIl m{p.in[26], (long)(p.in[27] - p.in[26]), DFF}; cvt_T(lds, m, W13, 2 * DFF, D, G, bid); }
        { MapPlain m{p.in[28], D, D}; cvt_T(lds, m, W2, D, DFF, G, bid); }
        { MapPlain m{p.in[33], 4096, 4096}; cvt_T(lds, m, WIN1, 4096, D, G, bid); }
        { MapPlain m{p.in[38], D, D}; cvt_T(lds, m, WO1, D, D, G, bid); }
        cvt_copy(p.in[36], WSB, (size_t)16 * 128 * 128, G, bid);
        __syncthreads();
    }
    SEAM(PH_CVT);
    if (IN(PH_XN1)) ph_norm_mod<false>(lds, p.in[0], p.in[2], p.in[6], wsf + O_MOD0, 0, 1, XNB, MALL, nullptr, nullptr, nullptr, nullptr, G, bid);
    SEAM(PH_XN1);
    if (IN(PH_GEMM_Z)) {
        pg8::DenseOrder S; S.init(XNB, D, WIN0, D, MALL, ZLD, G, bid);
        EpiF32 E{wsf + O_Z, ZLD};
        pg8::gemm_phase<EpiF32, pg8::DenseOrder, true, true>(lds, D, D, D, S, E);
    }
    SEAM(PH_GEMM_Z);
    if (IN(PH_PREP)) {
        ph_prep(wsf + O_Z, p.in[9], p.in[11], p.in[13], p.in[14], p.in[20], CQNB, CKVNB, KNB, LA, wsf + O_RR, wsf + O_KR, wsf + O_VR, wsf + O_AA, ROPEC, ROPES, G, bid);
    }
    SEAM(PH_PREP);
    if (IN(PH_GEMM4)) {
#pragma unroll 1
        for (int q = 0; q < 3; ++q) {
            const int kof = q * 128, kk = q < 2 ? 128 : 256, nn = q < 2 ? 2048 : 1024;
            pg8::DenseOrder S; S.init(LA + kof, 512, WLORA + (size_t)(q * 2048) * 512 + kof, 512, MALL, nn, G, (bid + G - 16 * q) % G);
            EpiLora E{p.in[15], p.in[17], p.in[21], wsf + O_KR, wsf + O_AA, wsf + O_WW, wsf + O_KD, wsf + O_BD, wsf + O_GG, q * 8};
            pg8::gemm_phase<EpiLora, pg8::DenseOrder, true, true>(lds, kk, 512, 512, S, E); }
        { pg8::DenseOrder S; S.init(CQNB, 512, WUQ, 512, NL, QW, G, (bid + 168) % G);
          EpiQ E{QB, ROPEC, ROPES};
          pg8::gemm_phase<EpiQ, pg8::DenseOrder, true, true>(lds, 512, 512, 512, S, E);
 }
        { pg8::DenseOrder S; S.init(CKVNB, 512, WKN, 512, MALL, 1024, G, (bid + 104) % G);
          EpiBf16 E{KNB, KLD};
          pg8::gemm_phase<EpiBf16, pg8::DenseOrder, true, true>(lds, 512, 512, 512, S, E); }
        { pg8::DenseOrder S; S.init(WV, 512, CKVNB, 512, 1024, MALL, G, (bid + 224) % G);
          EpiVT E{VTB};
          pg8::gemm_phase<EpiVT, pg8::DenseOrder, true, true>(lds, 512, 512, 512, S, E); }
    }
    SEAM(PH_GEMM4);
    float* YP = (float*)(p.ws + MB_YP); float* QP = (float*)(p.ws + MB_QP); float* SS = (float*)(p.ws + MB_SS);
    if (IN(PH_ATTN)) {
        ph_attn(lds, QB, KNB, VTB, MIXB, G, bid);
        { const MoeCv mc{p.in[40], (long)(p.in[41] - p.in[40]), p.in[42], (unsigned char*)W13E, (unsigned char*)W2E};
          ph_scan1(lds, wsf, (unsigned)O_AA, (unsigned)O_WW, (unsigned)O_BD, (unsigned)O_KD, (unsigned)O_RR, (unsigned)O_VR, YP, QP, mc, G, bid); }
        __syncthreads();
    }
    SEAM(PH_ATTN);
    if (IN(PH_CARRY)) ph_scan_carry(QP, SS, G, bid);
    SEAM(PH_CARRY);
    if (IN(PH_FIX)) ph_scan_fix(YP, SS, wsf + O_RR, wsf + O_KD, wsf + O_VR, wsf + O_GG, p.in[22], p.in[23], p.in[24], MIXB, G, bid);
    SEAM(PH_FIX);
    if (IN(PH_GEMM_O0)) {
        pg8::DenseOrder S; S.init(MIXB, D, WO0, D, NL, D, G, bid);
        EpiRes E{wsf + O_H, p.in[0], wsf + O_MOD0 + 2 * D};
        pg8::gemm_phase<EpiRes, pg8::DenseOrder, true, true>(lds, D, D, D, S, E);
    }
    SEAM(PH_GEMM_O0);
    if (IN(PH_XN2)) ph_norm_mod<false>(lds, wsf + O_H, nullptr, p.in[7], wsf + O_MOD0, 3, 4, XNB, NL, nullptr, nullptr, nullptr, nullptr, G, bid);
    SEAM(PH_XN2);
    if (IN(PH_FFN_UP)) {
        pg8::DenseOrder S; S.init(XNB, D, W13, D, NL, 2 * DFF, G, bid);
        EpiSwiglu E{ACT, DFF};
        pg8::gemm_phase<EpiSwiglu, pg8::DenseOrder, false, true>(lds, D, D, D, S, E);
    }
    SEAM(PH_FFN_UP);
    if (IN(PH_FFN_DOWN)) {
        pg8::DenseOrder S; S.init(ACT, DFF, W2, DFF, NL, D, G, bid);
        EpiRes E{wsf + O_H, wsf + O_H, wsf + O_MOD0 + 5 * D};
        pg8::gemm_phase<EpiRes, pg8::DenseOrder, true, true>(lds, DFF, DFF, DFF, S, E);
    }
    SEAM(PH_FFN_DOWN);
    if (IN(PH_XN3)) ph_norm_mod<false>(lds, wsf + O_H, nullptr, p.in[31], wsf + O_MOD1, 0, 1, XNB2, NL, nullptr, nullptr, nullptr, nullptr, G, bid);
    SEAM(PH_XN3);
    if (IN(PH_GEMM_IN1)) {
        pg8::DenseOrder S; S.init(XNB2, D, WIN1, D, NL, 4096, G, bid);
        EpiGelu E{Ub, VG};
        pg8::gemm_phase<EpiGelu, pg8::DenseOrder, true, true>(lds, D, D, D, S, E);
    }
    SEAM(PH_GEMM_IN1);
    if (IN(PH_LNT)) ph_ln_transpose(lds, VG, p.in[34], p.in[35], VT, G, bid);
    SEAM(PH_LNT);
    if (IN(PH_SPATIAL)) ph_spatial(WSB, VT, Ub, p.in[37], GATED, G, bid);
    SEAM(PH_SPATIAL);
    if (IN(PH_GEMM_O1)) {
        pg8::DenseOrder S; S.init(GATED, D, WO1, D, NL, D, G, bid);
        EpiRes E{wsf + O_H, wsf + O_H, wsf + O_MOD1 + 2 * D};
        pg8::gemm_phase<EpiRes, pg8::DenseOrder, true, true>(lds, D, D, D, S, E);
    }
    SEAM(PH_GEMM_O1);
    if (IN(PH_XN4)) ph_norm_mod<true>(lds, wsf + O_H, nullptr, p.in[32], wsf + O_MOD1, 3, 4, XNB2, NL, p.in[39], R_TOPE, R_TOPG, R_BCNT, G, bid);
    SEAM(PH_XN4);
    if (IN(PH_PLAN)) ph_moe_plan(lds, R_BCNT, R_TOPE, R_SLOT, R_CNTOFF, XNB2, XG, G, bid);
    SEAM(PH_PLAN);
    if (IN(PH_MOE_UP)) {
        pg8::MoeOrder S; S.init(R_CNTOFF, R_CNTOFF + 8, XG, D / 2, W13E, D / 2, (size_t)2 * DFF * D, 2 * DFF, G, bid);
        EpiSwigluF8 E{(unsigned char*)ACT2, DFF, 1.0f / 64.f};
        pg8::gemm_phase<EpiSwigluF8, pg8::MoeOrder, false, true, true>(lds, D / 2, D / 2, D / 2, S, E);
    }
    SEAM(PH_MOE_UP);
    if (IN(PH_MOE_DOWN)) {
        pg8::MoeOrder S; S.init(R_CNTOFF, R_CNTOFF + 8, ACT2, DFF / 2, W2E, DFF / 2, (size_t)D * DFF, D, G, bid);
        EpiBf16S E{(bf16_t*)OUT2, D, 1.0f / 128.f};
        pg8::gemm_phase<EpiBf16S, pg8::MoeOrder, true, true, true>(lds, DFF / 2, DFF / 2, DFF / 2, S, E);
    }
    SEAM(PH_MOE_DOWN);
    if (IN(PH_FINAL)) ph_final(wsf + O_H, (const bf16_t*)OUT2, R_SLOT, R_TOPG, wsf + O_MOD1 + 5 * D, p.in[43], p.out, G, bid);
#undef IN
#undef SEAM
}

static void launch_mega(hipStream_t stream, MP mp, int lo, int hi) {
    static int grid = 0;
    if (grid == 0) {
        int dev = 0, cus = 0;
        hipGetDevice(&dev); hipDeviceGetAttribute(&cus, hipDeviceAttributeMultiprocessorCount, dev);
        hipFuncSetAttribute((const void*)mega, hipFuncAttributeMaxDynamicSharedMemorySize, LDS_BYTES);
        int per_cu = 0; hipOccupancyMaxActiveBlocksPerMultiprocessor(&per_cu, (const void*)mega, 512, LDS_BYTES);
        if (per_cu < 1) fprintf(stderr, "mega: occupancy query says %d\n", per_cu);
        (void)hipGetLastError();
        grid = cus > 0 ? cus : 256;
    }
    hipMemsetAsync(mp.ws + MB_CTL, 0, CTL_BYTES, stream);
    mp.ph_lo = lo; mp.ph_hi = hi;
    hipLaunchKernelGGL(mega, dim3(grid), dim3(512), LDS_BYTES, stream, mp);
}
extern "C" void kernel_launch(void* const* d_in, const int* in_sizes, int n_in, void* d_out, int out_size, void* d_ws, size_t ws_size, hipStream_t stream) {
    if (n_in != 44 || ws_size < MB_END) { fprintf(stderr, "kernel_launch: bad n_in %d or ws %zu < %zu\n", n_in, ws_size, (size_t)MB_END); return; }
    MP mp{};
    for (int i = 0; i < 44; ++i) mp.in[i] = (const float*)d_in[i];
    mp.out = (float*)d_out; mp.ws = (unsigned char*)d_ws;
    launch_mega(stream, mp, 0, PH_N);
}
```

```cpp
#include <hip/hip_runtime.h>
#include <cstdio>
#include <cstdint>

constexpr int D = 2048, NB = 2, SEQ = 4096, CTX = 256;
constexpr int NL = NB * SEQ;
constexpr int NCX = NB * CTX;
constexpr int MALL = NL + NCX;
constexpr int NMOD = 6 * D;
constexpr int QL = 512, KVL = 512, ROPE = 64, NOPE = 128, VH = 128, HM = 8;
constexpr int MLA_IN = QL + KVL + ROPE;
constexpr int RD = 1024, RH = 16, RN = 64;
constexpr int RWKV_IN = 3 * RD + 128 + 128 + 160;
__device__ __forceinline__ size_t hmi(int row, int col) { return ((size_t)(col >> 6) * (8192 + 2 * 256) + row) * 64 + (col & 63); }
constexpr int ZW = MLA_IN + RWKV_IN;
constexpr int ZLD = 4608;
constexpr int KLD = 1088;
constexpr int QW = HM * (NOPE + ROPE);
constexpr int KVW = HM * (NOPE + VH);
constexpr int SK = CTX + SEQ;
constexpr int DFF = 7168, NE = 8;
constexpr int NSLOT = 18432;

constexpr int LDS_BYTES = 163840, LDS_CTL = 162816;

__device__ __forceinline__ float wave_sum(float v) {
#pragma unroll
    for (int o = 32; o > 0; o >>= 1) v += __shfl_xor(v, o);
    return v;
}
__device__ __forceinline__ float wave_sum_dpp(float v) {
    v += __builtin_bit_cast(float, __builtin_amdgcn_update_dpp(0, __builtin_bit_cast(int, v), 0xB1, 0xf, 0xf, true));
    v += __builtin_bit_cast(float, __builtin_amdgcn_update_dpp(0, __builtin_bit_cast(int, v), 0x4E, 0xf, 0xf, true));
    v += __builtin_bit_cast(float, __builtin_amdgcn_update_dpp(0, __builtin_bit_cast(int, v), 0x141, 0xf, 0xf, true));
    v += __builtin_bit_cast(float, __builtin_amdgcn_update_dpp(0, __builtin_bit_cast(int, v), 0x140, 0xf, 0xf, true));
    const int vi = __builtin_bit_cast(int, v);
    const float s0 = __builtin_bit_cast(float, __builtin_amdgcn_readlane(vi, 0)), s1 = __builtin_bit_cast(float, __builtin_amdgcn_readlane(vi, 16));
    const float s2 = __builtin_bit_cast(float, __builtin_amdgcn_readlane(vi, 32)), s3 = __builtin_bit_cast(float, __builtin_amdgcn_readlane(vi, 48));
    return (s0 + s1) + (s2 + s3);
}
__device__ __forceinline__ int wave_isum_dpp(int v) {
    v += __builtin_amdgcn_update_dpp(0, v, 0xB1, 0xf, 0xf, true);
    v += __builtin_amdgcn_update_dpp(0, v, 0x4E, 0xf, 0xf, true);
    v += __builtin_amdgcn_update_dpp(0, v, 0x141, 0xf, 0xf, true);
    v += __builtin_amdgcn_update_dpp(0, v, 0x140, 0xf, 0xf, true);
    return (__builtin_amdgcn_readlane(v, 0) + __builtin_amdgcn_readlane(v, 16)) + (__builtin_amdgcn_readlane(v, 32) + __builtin_amdgcn_readlane(v, 48));
}
__device__ __forceinline__ float sigmoidf_(float x) { return 1.0f / (1.0f + expf(-x)); }
__device__ __forceinline__ float siluf_(float x) { return x / (1.0f + expf(-x)); }

#define LAS __attribute__((address_space(3)))
typedef unsigned short bf16_t;
typedef short bf16x8 __attribute__((ext_vector_type(8)));
typedef float f32x4 __attribute__((ext_vector_type(4)));
typedef float f32x2 __attribute__((ext_vector_type(2)));
typedef unsigned u32x4 __attribute__((ext_vector_type(4)));
typedef unsigned u32x2 __attribute__((ext_vector_type(2)));
typedef int i32x8 __attribute__((ext_vector_type(8)));

__device__ __forceinline__ unsigned cvt_pk_bf16(float lo, float hi) { unsigned r; asm volatile("v_cvt_pk_bf16_f32 %0, %1, %2" : "=v"(r) : "v"(lo), "v"(hi)); return r; }
__device__ __forceinline__ unsigned pk4_fp8(float a, float b, float c, float d) { int p = __builtin_amdgcn_cvt_pk_fp8_f32(a, b, 0, false); p = __builtin_amdgcn_cvt_pk_fp8_f32(c, d, p, true); return (unsigned)p; }
__device__ __forceinline__ float bf2f(bf16_t b) { return __uint_as_float(((unsigned)b) << 16); }
__device__ __forceinline__ float fexp(float x) { return __builtin_amdgcn_exp2f(x * 1.4426950408889634f); }
__device__ __forceinline__ float flog(float x) { return __builtin_amdgcn_logf(x) * 0.6931471805599453f; }
__device__ __forceinline__ float fsigmoid(float x) { return __builtin_amdgcn_rcpf(1.0f + fexp(-x)); }
__device__ __forceinline__ float ftanh(float x) { return 1.0f - 2.0f * __builtin_amdgcn_rcpf(1.0f + fexp(2.0f * x)); }
__device__ __forceinline__ float rope_inv(int f) { const int q = f >> 2, r = f & 3; const float a = q == 0 ? 1.0f : q == 1 ? 0.1f : q == 2 ? 0.01f : 0.001f;
    const float b = r == 0 ? 1.0f : r == 1 ? 0.5623413251903491f : r == 2 ? 0.31622776601683794f : 0.1778279410038923f; return a * b; }

#define XB_TMO      128
#define XB_XCNT(j)  (256  + 64 * (j))
#define XB_XSUB(j)  (1280 + 64 * (j))
#define XB_XGEN(j)  (2304 + 64 * (j))
#define XB_TOP      3328
#define XB_TOPGEN   3392
#define XCD_BAR_WORDS 3456
#define XB_SPIN_CAP (1u << 18)
__device__ __forceinline__ unsigned xb_ld(unsigned* p)              { return __hip_atomic_load(p, __ATOMIC_RELAXED, __HIP_MEMORY_SCOPE_AGENT); }
__device__ __forceinline__ unsigned xb_add(unsigned* p, unsigned v) { return __hip_atomic_fetch_add(p, v, __ATOMIC_RELAXED, __HIP_MEMORY_SCOPE_AGENT); }
__device__ __forceinline__ unsigned xb_xcc_id() { return (unsigned)__builtin_amdgcn_s_getreg((3 << 11) | 20) & 0xFu; }
#define XB_SPIN(cond, bar) do { unsigned _sp = 0; while (cond) { __builtin_amdgcn_s_sleep(1); \
    if ((++_sp & 255u) == 0u) { if (xb_ld(&(bar)[XB_TMO])) break; if (_sp > XB_SPIN_CAP) { atomicAdd(&(bar)[XB_TMO], 1u); break; } } } } while (0)
struct XcdBarrier { unsigned* bar; unsigned x; volatile LAS unsigned* st; };
__device__ __forceinline__ XcdBarrier xcd_barrier_post(unsigned* bar, volatile LAS unsigned* st) {
    XcdBarrier b; b.bar = bar; b.x = xb_xcc_id(); b.st = st;
    if (threadIdx.x == 0) (void)xb_add(&bar[XB_XCNT(b.x)], 1u);
    return b;
}
__device__ __forceinline__ void xcd_barrier_complete(unsigned* bar, unsigned x, unsigned& nloc, unsigned& nx) {
    const unsigned G = gridDim.x * gridDim.y * gridDim.z;
    unsigned sum, cnt, mine, sp = 0u;
    for (;;) {
        sum = 0u; cnt = 0u; mine = 0u;
#pragma unroll
        for (unsigned j = 0; j < 16; ++j) { const unsigned c = xb_ld(&bar[XB_XCNT(j)]); sum += c; cnt += (c > 0u) ? 1u : 0u; mine = (j == x) ? c : mine; }
        if (sum == G) break;
        __builtin_amdgcn_s_sleep(1);
        if ((++sp & 255u) == 0u) { if (xb_ld(&bar[XB_TMO])) break; if (sp > XB_SPIN_CAP) { atomicAdd(&bar[XB_TMO], 1u); break; } }
    }
    nloc = mine > 0u ? mine : 1u; nx = cnt > 0u ? cnt : 1u;
}
__device__ __forceinline__ void xcd_barrier(const XcdBarrier& b) {
    asm volatile("s_waitcnt vmcnt(0)" ::: "memory");
    __syncthreads();
    if (threadIdx.x == 0) {
        unsigned* bar = b.bar;
        __builtin_amdgcn_s_waitcnt(0);
        unsigned nloc = b.st[0], nx = b.st[1];
        if (nloc == 0u) { xcd_barrier_complete(bar, b.x, nloc, nx); b.st[0] = nloc; b.st[1] = nx; }
        const unsigned old = xb_add(&bar[XB_XSUB(b.x)], 1u);
        const unsigned gen = old / nloc;
        if (old + 1u == (gen + 1u) * nloc) {
            __builtin_amdgcn_fence(__ATOMIC_RELEASE, "agent");
            asm volatile("s_waitcnt vmcnt(0)" ::: "memory");
            const unsigned og = xb_add(&bar[XB_TOP], 1u);
            const unsigned tg = og / nx;
            if (og + 1u == (tg + 1u) * nx) xb_add(&bar[XB_TOPGEN], 1u);
            else XB_SPIN(xb_ld(&bar[XB_TOPGEN]) == tg, bar);
            __builtin_amdgcn_fence(__ATOMIC_ACQUIRE, "agent");
            xb_add(&bar[XB_XGEN(b.x)], 1u);
            asm volatile("s_waitcnt vmcnt(0)" ::: "memory");
        } else {
            XB_SPIN(xb_ld(&bar[XB_XGEN(b.x)]) == gen, bar);
            __builtin_amdgcn_fence(__ATOMIC_ACQUIRE, "agent");
            asm volatile("s_waitcnt vmcnt(0)" ::: "memory");
        }
    }
    __syncthreads();
}

namespace pg8 {
constexpr int BM = 256, BK = 64, HALF = 128, HTB = HALF * BK * 2, STAGE_BYTES = 8 * HTB, NXCD = 8, WGM = 8;
__host__ __device__ __forceinline__ int lds_byte(int r, int c) { const int st = (r >> 4) * 2 + (c >> 5), rr = r & 15, cc = c & 31, ob = rr * 64 + cc * 2; return st * 1024 + (ob ^ (((ob >> 9) & 1) << 5)); }
__host__ __device__ __forceinline__ void stage_rc(int b, int& R, int& C) { const int st = b / 1024, sb = b % 1024, swz = sb ^ (((sb >> 9) & 1) << 5); R = (st >> 1) * 16 + swz / 64; C = (st & 1) * 32 + (swz % 64) / 2; }
__host__ __device__ __forceinline__ int perm32(int rho) { const int n = rho >> 4, i = rho & 15; return 8 * (i >> 2) + 4 * n + (i & 3); }
struct Unit { int pm, pn, kind; const char* a; const char* b; };

struct DenseOrder {
    int nM, nN, nwg, G, c, lda, ldb; const char* A; const char* B;
    __device__ void init(const bf16_t* A_, int lda_, const bf16_t* B_, int ldb_, int M, int N, int G_, int c_) { A = (const char*)A_; B = (const char*)B_; lda = lda_; ldb = ldb_; nM = M / BM; nN = N / BM; nwg = nM * nN; G = G_; c = c_; }
    __device__ bool next(int i, Unit& u) const {
        const long L = (long)i * G + c; if (L >= nwg) return false;
        int wgid = (int)L; { const int q = nwg / NXCD, r = nwg % NXCD, xcd = wgid % NXCD, off = wgid / NXCD; wgid = (xcd < r ? xcd * (q + 1) : r * (q + 1) + (xcd - r) * q) + off; }
        const int nig = WGM * nN, gid = wgid / nig, fm = gid * WGM, gsz = (nM - fm) < WGM ? (nM - fm) : WGM;
        u.pm = fm + ((wgid % nig) % gsz); u.pn = (wgid % nig) / gsz; u.kind = 0;
        u.a = A + (size_t)u.pm * BM * lda * 2; u.b = B + (size_t)u.pn * BM * ldb * 2; return true;
    }
};

template <class Epi, class Sched, bool ALIGN_EPI = false, bool SP2 = false, bool FP8 = false>
__device__ __forceinline__ void gemm_phase(LAS unsigned char* lds, const int K, const int lda, const int ldb, const Sched& S, const Epi& E) {
    const int tid = threadIdx.x, wid = __builtin_amdgcn_readfirstlane(tid >> 6), lane = tid & 63, wr = wid >> 2, wc = wid & 3, fr = lane & 15, fq = lane >> 4;
    const int nt = K / BK;
    unsigned voffA[2], voffB[2];
#pragma unroll
    for (int i = 0; i < 2; ++i) { int R, C; stage_rc(tid * 16 + i * 8192, R, C); const int Rb = Epi::PERM ? ((R & ~31) + perm32(R & 31)) : R;
        voffA[i] = (unsigned)(R * lda + C) * 2u; voffB[i] = (unsigned)(Rb * ldb + C) * 2u; }
    const size_t kstep = (size_t)(BK * 2);
    const size_t hstepA = (size_t)HALF * lda * 2, hstepB = (size_t)HALF * ldb * 2;
    const unsigned ldsw = (unsigned)wid * 1024u;
    const int aoff = lds_byte(wr * 64 + fr, fq * 8), boff = lds_byte(wc * 32 + fr, fq * 8);
#define PG8_SA(b, h) (((b) * 2 + (h)) * HTB)
#define PG8_SB(b, h) ((4 + (b) * 2 + (h)) * HTB)
#define PG8_STAGE(bufoff, gbase, voff) do { _Pragma("unroll") for (int _i = 0; _i < 2; ++_i) \
        __builtin_amdgcn_global_load_lds((const unsigned*)((const char*)(gbase) + (voff)[_i]), (LAS unsigned*)(lds + (bufoff) + ldsw + _i * 8192), 16, 0, 0); } while (0)
#define PG8_LDA(dst, b, h) do { _Pragma("unroll") for (int m = 0; m < 4; ++m) _Pragma("unroll") for (int k = 0; k < 2; ++k) dst[m][k] = *(const LAS bf16x8*)(lds + PG8_SA(b, h) + aoff + m * 2048 + k * 1024); } while (0)
#define PG8_LDB(dst, b, h) do { _Pragma("unroll") for (int n = 0; n < 2; ++n) _Pragma("unroll") for (int k = 0; k < 2; ++k) dst[n][k] = *(const LAS bf16x8*)(lds + PG8_SB(b, h) + boff + n * 2048 + k * 1024); } while (0)
#define PG8_CAT(x) __builtin_bit_cast(i32x8, __builtin_shufflevector((x)[0], (x)[1], 0, 1, 2, 3, 4, 5, 6, 7, 8, 9, 10, 11, 12, 13, 14, 15))
#define PG8_MMA(ai, bj, At, Bt) do { __builtin_amdgcn_s_setprio(1); _Pragma("unroll") for (int m = 0; m < 4; ++m) _Pragma("unroll") for (int n = 0; n < 2; ++n) { \
        if constexpr (FP8) { asm volatile("v_mfma_f32_16x16x128_f8f6f4 %0, %1, %2, %0" : "+v"(acc[ai][bj][m][n]) : "v"(PG8_CAT(Bt[n])), "v"(PG8_CAT(At[m]))); } \
        else { _Pragma("unroll") for (int k = 0; k < 2; ++k) acc[ai][bj][m][n] = __builtin_amdgcn_mfma_f32_16x16x32_bf16(Bt[n][k], At[m][k], acc[ai][bj][m][n], 0, 0, 0); } } \
        __builtin_amdgcn_s_setprio(0); } while (0)
#define PG8_WAIT_V(n) asm volatile("s_waitcnt vmcnt(" #n ")" ::: "memory")
#define PG8_WAIT_L(n) asm volatile("s_waitcnt lgkmcnt(" #n ")" ::: "memory")
#define PG8_BAR __builtin_amdgcn_s_barrier()
#define PG8_SCHED __builtin_amdgcn_sched_barrier(0)
    Unit cur, nxt; int ui = 0;
    if (!S.next(0, cur)) return;
    f32x4 acc[2][2][4][2];
#pragma unroll
    for (int a = 0; a < 2; ++a)
#pragma unroll
        for (int b = 0; b < 2; ++b)
#pragma unroll
            for (int m = 0; m < 4; ++m)
#pragma unroll
                for (int n = 0; n < 2; ++n) acc[a][b][m][n] = (f32x4){0.f, 0.f, 0.f, 0.f};
    bf16x8 At[4][2], B0[2][2], B1[2][2];
    const char* cA = cur.a; const char* cB = cur.b;
    if constexpr (SP2) {
        PG8_STAGE(PG8_SB(0, 0), cB, voffB); PG8_STAGE(PG8_SB(0, 1), cB + hstepB, voffB); PG8_STAGE(PG8_SA(0, 0), cA, voffA); PG8_STAGE(PG8_SA(0, 1), cA + hstepA, voffA);
        if (wr == 1) PG8_BAR;
        PG8_WAIT_V(2); PG8_BAR;
        PG8_STAGE(PG8_SB(1, 0), cB + kstep, voffB); PG8_STAGE(PG8_SA(1, 0), cA + kstep, voffA); PG8_STAGE(PG8_SB(1, 1), cB + hstepB + kstep, voffB);
        PG8_WAIT_V(6); PG8_BAR;
    } else {
        PG8_STAGE(PG8_SB(0, 0), cB, voffB); PG8_STAGE(PG8_SA(0, 0), cA, voffA); PG8_STAGE(PG8_SB(0, 1), cB + hstepB, voffB); PG8_STAGE(PG8_SA(0, 1), cA + hstepA, voffA);
        if (wr == 1) PG8_BAR;
        PG8_WAIT_V(4); PG8_BAR;
        PG8_STAGE(PG8_SB(1, 0), cB + kstep, voffB); PG8_STAGE(PG8_SA(1, 0), cA + kstep, voffA); PG8_STAGE(PG8_SB(1, 1), cB + hstepB + kstep, voffB);
        PG8_WAIT_V(6); PG8_BAR;
    }
    for (;;) {
        const bool has_next = S.next(ui + 1, nxt);
        const char* nA = has_next ? nxt.a : cA; const char* nB = has_next ? nxt.b : cB;
        for (int t = 0; t < nt; t += 2) {
            const bool last = (t == nt - 2);
            const char* a1 = cA + (size_t)(t + 1) * kstep;
            const char* a2 = last ? nA : cA + (size_t)(t + 2) * kstep; const char* b2 = last ? nB : cB + (size_t)(t + 2) * kstep;
            const char* a3 = a2 + kstep; const char* b3 = b2 + kstep;
            if constexpr (SP2) {
            PG8_LDB(B0, 0, 0); PG8_LDB(B1, 0, 1); PG8_SCHED; PG8_LDA(At, 0, 0); PG8_STAGE(PG8_SA(1, 1), a1 + hstepA, voffA);
            PG8_WAIT_V(8); PG8_WAIT_L(0); PG8_BAR; PG8_MMA(0, 0, At, B0); PG8_MMA(0, 1, At, B1); PG8_BAR; PG8_SCHED;
            PG8_LDA(At, 0, 1); PG8_STAGE(PG8_SB(0, 0), b2, voffB); PG8_STAGE(PG8_SB(0, 1), b2 + hstepB, voffB); PG8_STAGE(PG8_SA(0, 0), a2, voffA);
            PG8_WAIT_V(8); PG8_WAIT_L(0); PG8_BAR; PG8_MMA(1, 0, At, B0); PG8_MMA(1, 1, At, B1); PG8_BAR; PG8_SCHED;
            PG8_LDB(B0, 1, 0); PG8_LDB(B1, 1, 1); PG8_SCHED; PG8_LDA(At, 1, 0); PG8_STAGE(PG8_SA(0, 1), a2 + hstepA, voffA);
            PG8_WAIT_V(8); PG8_WAIT_L(0); PG8_BAR; PG8_MMA(0, 0, At, B0); PG8_MMA(0, 1, At, B1); PG8_BAR; PG8_SCHED;
            PG8_LDA(At, 1, 1); PG8_STAGE(PG8_SB(1, 0), b3, voffB); PG8_STAGE(PG8_SB(1, 1), b3 + hstepB, voffB); PG8_STAGE(PG8_SA(1, 0), a3, voffA);
            PG8_WAIT_V(8); PG8_WAIT_L(0); PG8_BAR; PG8_MMA(1, 0, At, B0); PG8_MMA(1, 1, At, B1); PG8_BAR; PG8_SCHED;
            } else {
            PG8_LDB(B0, 0, 0); PG8_SCHED; PG8_LDA(At, 0, 0); PG8_STAGE(PG8_SA(1, 1), a1 + hstepA, voffA);
            PG8_WAIT_L(8); PG8_BAR; PG8_WAIT_L(0); PG8_MMA(0, 0, At, B0); PG8_BAR; PG8_SCHED;
            PG8_LDB(B1, 0, 1); PG8_STAGE(PG8_SB(0, 0), b2, voffB);
            PG8_BAR; PG8_WAIT_L(0); PG8_MMA(0, 1, At, B1); PG8_BAR;
            PG8_LDA(At, 0, 1); PG8_STAGE(PG8_SA(0, 0), a2, voffA);
            PG8_BAR; PG8_WAIT_L(0); PG8_MMA(1, 0, At, B0); PG8_BAR; PG8_SCHED;
            PG8_STAGE(PG8_SB(0, 1), b2 + hstepB, voffB);
            PG8_WAIT_V(6); PG8_BAR; PG8_MMA(1, 1, At, B1); PG8_BAR;
            PG8_LDB(B0, 1, 0); PG8_SCHED; PG8_LDA(At, 1, 0); PG8_STAGE(PG8_SA(0, 1), a2 + hstepA, voffA);
            PG8_WAIT_L(8); PG8_BAR; PG8_WAIT_L(0); PG8_MMA(0, 0, At, B0); PG8_BAR; PG8_SCHED;
            PG8_LDB(B1, 1, 1); PG8_STAGE(PG8_SB(1, 0), b3, voffB);
            PG8_BAR; PG8_WAIT_L(0); PG8_MMA(0, 1, At, B1); PG8_BAR;
            PG8_LDA(At, 1, 1); PG8_STAGE(PG8_SA(1, 0), a3, voffA);
            PG8_BAR; PG8_WAIT_L(0); PG8_MMA(1, 0, At, B0); PG8_BAR; PG8_SCHED;
            PG8_STAGE(PG8_SB(1, 1), b3 + hstepB, voffB);
            PG8_WAIT_V(6); PG8_BAR; PG8_MMA(1, 1, At, B1); PG8_BAR;
            }
        }
        if constexpr (ALIGN_EPI) { if (wr == 0) PG8_BAR; }
        if constexpr (FP8) asm volatile("s_nop 15\n\ts_nop 15\n\ts_nop 7" ::: "memory");
        E(acc, cur, wr, wc, fr, fq);
        if (!has_next) break;
#pragma unroll
        for (int a = 0; a < 2; ++a)
#pragma unroll
            for (int b = 0; b < 2; ++b)
#pragma unroll
                for (int m = 0; m < 4; ++m)
#pragma unroll
                    for (int n = 0; n < 2; ++n) acc[a][b][m][n] = (f32x4){0.f, 0.f, 0.f, 0.f};
        cur = nxt; cA = nA; cB = nB; ++ui;
        if constexpr (ALIGN_EPI) { if (wr == 1) PG8_BAR; }
    }
    PG8_WAIT_V(0);
    if constexpr (!ALIGN_EPI) { if (wr == 0) PG8_BAR; }
    PG8_BAR;
#undef PG8_SA
#undef PG8_SB
#undef PG8_STAGE
#undef PG8_LDA
#undef PG8_LDB
#undef PG8_MMA
#undef PG8_CAT
#undef PG8_WAIT_V
#undef PG8_WAIT_L
#undef PG8_BAR
#undef PG8_SCHED
}
}
using pg8::Unit;

typedef const f32x4 (&AccRef)[2][2][4][2];
struct EpiF32 { static constexpr bool PERM = false; float* C; int ldc;
    __device__ __forceinline__ void operator()(AccRef acc, const Unit& u, int wr, int wc, int fr, int fq) const {
        const int row0 = u.pm * 256 + wr * 64 + fr, col0 = u.pn * 256 + wc * 32 + 4 * fq;
#pragma unroll
        for (int ai = 0; ai < 2; ++ai)
#pragma unroll
            for (int m = 0; m < 4; ++m) { float* rowp = C + (size_t)(row0 + ai * 128 + m * 16) * ldc + col0;
#pragma unroll
                for (int bj = 0; bj < 2; ++bj)
#pragma unroll
                    for (int n = 0; n < 2; ++n) *(f32x4*)(rowp + bj * 128 + n * 16) = acc[ai][bj][m][n]; }
    } };
struct EpiRes { static constexpr bool PERM = false; float* C; const float* R; const float* gate;
    __device__ __forceinline__ void operator()(AccRef acc, const Unit& u, int wr, int wc, int fr, int fq) const {
        const int row0 = u.pm * 256 + wr * 64 + fr, col0 = u.pn * 256 + wc * 32 + 4 * fq;
        const float* gp = gate + (size_t)((u.pm * 256) / SEQ) * NMOD + col0;
        f32x4 gv[2][2];
#pragma unroll
        for (int bj = 0; bj < 2; ++bj)
#pragma unroll
            for (int n = 0; n < 2; ++n) gv[bj][n] = *(const f32x4*)(gp + bj * 128 + n * 16);
#pragma unroll
        for (int ai = 0; ai < 2; ++ai)
#pragma unroll
          for (int mp = 0; mp < 2; ++mp) {
            f32x4 r[2][2][2];
#pragma unroll
            for (int mm = 0; mm < 2; ++mm) { const size_t off = (size_t)(row0 + ai * 128 + (mp * 2 + mm) * 16) * D + col0;
#pragma unroll
                for (int bj = 0; bj < 2; ++bj)
#pragma unroll
                    for (int n = 0; n < 2; ++n) r[mm][bj][n] = *(const f32x4*)(R + off + bj * 128 + n * 16); }
#pragma unroll
            for (int mm = 0; mm < 2; ++mm) { const size_t off = (size_t)(row0 + ai * 128 + (mp * 2 + mm) * 16) * D + col0;
#pragma unroll
                for (int bj = 0; bj < 2; ++bj)
#pragma unroll
                    for (int n = 0; n < 2; ++n) *(f32x4*)(C + off + bj * 128 + n * 16) = r[mm][bj][n] + gv[bj][n] * acc[ai][bj][mp * 2 + mm][n]; }
          }
    } };
__device__ __forceinline__ f32x2 swiglu_pk(f32x2 a, f32x2 b, float nsl, float s2) {
    const f32x2 t = a * nsl; f32x2 e; e.x = __builtin_amdgcn_exp2f(t.x); e.y = __builtin_amdgcn_exp2f(t.y);
    const f32x2 d = e + 1.0f; f32x2 r; r.x = __builtin_amdgcn_rcpf(d.x); r.y = __builtin_amdgcn_rcpf(d.y);
    return (a * b) * (r * s2);
}
struct EpiSwiglu { static constexpr bool PERM = true; bf16_t* O; int ldo;
    __device__ __forceinline__ void operator()(AccRef acc, const Unit& u, int wr, int wc, int fr, int fq) const {
        const int row0 = u.pm * 256 + wr * 64 + fr, col0 = u.pn * 128 + wc * 32 + 8 * fq;
#pragma unroll
        for (int ai = 0; ai < 2; ++ai)
#pragma unroll
            for (int m = 0; m < 4; ++m) { bf16_t* rowp = O + (size_t)(row0 + ai * 128 + m * 16) * ldo + col0;
                float o[8];
#pragma unroll
                for (int n = 0; n < 2; ++n)
#pragma unroll
                    for (int j = 0; j < 4; j += 2) { const f32x4 av = acc[ai][0][m][n], bv = acc[ai][1][m][n];
                        const f32x2 r = swiglu_pk((f32x2){av[j], av[j + 1]}, (f32x2){bv[j], bv[j + 1]}, -1.4426950408889634f, 1.0f); o[n * 4 + j] = r.x; o[n * 4 + j + 1] = r.y; }
                u32x4 w; w.x = cvt_pk_bf16(o[0], o[1]); w.y = cvt_pk_bf16(o[2], o[3]); w.z = cvt_pk_bf16(o[4], o[5]); w.w = cvt_pk_bf16(o[6], o[7]);
                *(u32x4*)rowp = w; }
    } };

struct EpiSwigluF8 { static constexpr bool PERM = true; unsigned char* O; int ldo; float sc;
    __device__ __forceinline__ void operator()(AccRef acc, const Unit& u, int wr, int wc, int fr, int fq) const {
        const int row0 = u.pm * 256 + wr * 64 + fr, col0 = u.pn * 128 + wc * 32 + 8 * fq;
#pragma unroll
        for (int ai = 0; ai < 2; ++ai)
#pragma unroll
            for (int m = 0; m < 4; ++m) { unsigned char* rowp = O + (size_t)(row0 + ai * 128 + m * 16) * ldo + col0;
                float o[8];
#pragma unroll
                for (int n = 0; n < 2; ++n)
#pragma unroll
                    for (int j = 0; j < 4; j += 2) { const f32x4 av = acc[ai][0][m][n], bv = acc[ai][1][m][n];
                        const f32x2 r = swiglu_pk((f32x2){av[j], av[j + 1]}, (f32x2){bv[j], bv[j + 1]}, -1.4426950408889634f * sc, sc * sc); o[n * 4 + j] = r.x; o[n * 4 + j + 1] = r.y; }
                u32x2 w; w.x = pk4_fp8(o[0], o[1], o[2], o[3]); w.y = pk4_fp8(o[4], o[5], o[6], o[7]);
                *(u32x2*)rowp = w; }
    } };
struct EpiBf16S { static constexpr bool PERM = true; bf16_t* O; int ldo; float sc;
    __device__ __forceinline__ void operator()(AccRef acc, const Unit& u, int wr, int wc, int fr, int fq) const {
        const int row0 = u.pm * 256 + wr * 64 + fr, col0 = u.pn * 256 + wc * 32 + 8 * fq;
#pragma unroll
        for (int ai = 0; ai < 2; ++ai)
#pragma unroll
            for (int m = 0; m < 4; ++m) { bf16_t* rowp = O + (size_t)(row0 + ai * 128 + m * 16) * ldo + col0;
#pragma unroll
                for (int bj = 0; bj < 2; ++bj) { const f32x4 v0 = acc[ai][bj][m][0] * sc, v1 = acc[ai][bj][m][1] * sc;
                    u32x4 w; w.x = cvt_pk_bf16(v0[0], v0[1]); w.y = cvt_pk_bf16(v0[2], v0[3]); w.z = cvt_pk_bf16(v1[0], v1[1]); w.w = cvt_pk_bf16(v1[2], v1[3]);
                    *(u32x4*)(rowp + bj * 128) = w; } }
    } };

struct MapPlain { const float* src; int ld, ncols;
    __device__ __forceinline__ const float* operator()(int n0) const { return n0 < ncols ? src + n0 : nullptr; } __device__ __forceinline__ int stride() const { return ld; } __device__ __forceinline__ bool valid(int n) const { return n < ncols; } };
struct MapIl { const float* s1; long d31; int ld;
    __device__ __forceinline__ const float* operator()(int n0) const { const int t = n0 >> 8, j = n0 & 255; return s1 + (j < 128 ? 0l : d31) + t * 128 + (j & 127); } __device__ __forceinline__ int stride() const { return ld; } __device__ __forceinline__ bool valid(int) const { return true; } };
template <bool FP8, class MAP>
__device__ __forceinline__ void cvt_ring(LAS unsigned char* lds, const MAP& map, void* dstv, int Nd, int K, float scale, int G, int c) {
    constexpr int NS = 4, SLOT = 32768;
    const int tid = threadIdx.x, wave = __builtin_amdgcn_readfirstlane(tid >> 6), lane = tid & 63;
    const int ntk = K / 128, nnt = Nd / 64, ntiles = nnt * ntk;
    if (c >= ntiles) return;
    const int nmine = (ntiles - c + G - 1) / G;
    const int ld = map.stride();
    __syncthreads();
    auto issue = [&](int it) {
        const int itc = it < nmine ? it : nmine - 1, tile = c + itc * G;
        const int n0 = (tile % nnt) * 64, k0 = (tile / nnt) * 128;
        const float* sp = map(n0);
        const int col = (lane & 15) * 4, colc = (sp && map.valid(n0 + col)) ? col : 0;
        const float* base = (sp ? sp : map(0)) + colc;
        LAS unsigned char* sl = lds + (it % NS) * SLOT + wave * 4096;
#pragma unroll
        for (int i = 0; i < 4; ++i)
            __builtin_amdgcn_global_load_lds((const unsigned*)(base + (size_t)(k0 + wave * 16 + i * 4 + (lane >> 4)) * ld), (LAS unsigned*)(sl + i * 1024), 16, 0, 0);
    };
#pragma unroll
    for (int i = 0; i < NS - 1; ++i) issue(i);
    for (int it = 0; it < nmine; ++it) {
        asm volatile("s_waitcnt vmcnt(8)" ::: "memory");
        __syncthreads();
        issue(it + NS - 1);
        const int tile = c + it * G, n0 = (tile % nnt) * 64, k0 = (tile / nnt) * 128;
        const LAS float* T = (const LAS float*)(lds + (it % NS) * SLOT);
        const bool ok = map(n0) != nullptr && map.valid(n0 + lane);
        if constexpr (FP8) {
            float v[16];
#pragma unroll
            for (int j = 0; j < 16; ++j) v[j] = ok ? T[(wave * 16 + j) * 64 + lane] * scale : 0.f;
            u32x4 w; w.x = pk4_fp8(v[0], v[1], v[2], v[3]); w.y = pk4_fp8(v[4], v[5], v[6], v[7]); w.z = pk4_fp8(v[8], v[9], v[10], v[11]); w.w = pk4_fp8(v[12], v[13], v[14], v[15]);
            *(u32x4*)((unsigned char*)dstv + (size_t)(n0 + lane) * K + k0 + wave * 16) = w;
        } else {
#pragma unroll
            for (int h = 0; h < 2; ++h) { const int kg = wave + 8 * h; float v[8];
#pragma unroll
                for (int j = 0; j < 8; ++j) v[j] = ok ? T[(kg * 8 + j) * 64 + lane] : 0.f;
                u32x4 w; w.x = cvt_pk_bf16(v[0], v[1]); w.y = cvt_pk_bf16(v[2], v[3]); w.z = cvt_pk_bf16(v[4], v[5]); w.w = cvt_pk_bf16(v[6], v[7]);
                *(u32x4*)((bf16_t*)dstv + (size_t)(n0 + lane) * K + k0 + kg * 8) = w; }
        }
    }
    asm volatile("s_waitcnt vmcnt(0)" ::: "memory");
    __syncthreads();
}
template <class MAP> __device__ __forceinline__ void cvt_T(LAS unsigned char* lds, const MAP& map, bf16_t* dst, int Nd, int K, int G, int c) { cvt_ring<false>(lds, map, dst, Nd, K, 1.f, G, c); }
template <class MAP> __device__ __forceinline__ void cvt_T8(LAS unsigned char* lds, const MAP& map, unsigned char* dst, int Nd, int K, float scale, int G, int c) { cvt_ring<true>(lds, map, dst, Nd, K, scale, G, c); }
__device__ __forceinline__ void cvt_copy(const float* src, bf16_t* dst, size_t n, int G, int c) {
    for (size_t i = ((size_t)c * 512 + threadIdx.x) * 8; i < n; i += (size_t)G * 512 * 8) {
        const float4 a = *(const float4*)(src + i), b = *(const float4*)(src + i + 4);
        u32x4 w; w.x = cvt_pk_bf16(a.x, a.y); w.y = cvt_pk_bf16(a.z, a.w); w.z = cvt_pk_bf16(b.x, b.y); w.w = cvt_pk_bf16(b.z, b.w);
        *(u32x4*)(dst + i) = w;
    }
}


__device__ __forceinline__ f32x2 gelu_pk(f32x2 v) {
    const f32x2 av = __builtin_elementwise_abs(v), d = av * 0.2316418882f + 1.0f;
    f32x2 t; t.x = __builtin_amdgcn_rcpf(d.x); t.y = __builtin_amdgcn_rcpf(d.y);
    f32x2 q = t * 0.5307027145f + (-0.7265760135f); q = q * t + 0.7107068705f; q = q * t + (-0.142248368f); q = q * t + 0.127414796f; q = q * t;
    const f32x2 s = (v * v) * (-0.72134752044f);
    f32x2 e; e.x = __builtin_amdgcn_exp2f(s.x); e.y = __builtin_amdgcn_exp2f(s.y);
    const f32x2 m = v * (q * e), r = v - m;
    f32x2 o; o.x = v.x < 0.f ? m.x : r.x; o.y = v.y < 0.f ? m.y : r.y; return o;
}
struct EpiGelu { static constexpr bool PERM = false; bf16_t* U; float* VG;
    __device__ __forceinline__ void operator()(AccRef acc, const Unit& u, int wr, int wc, int fr, int fq) const {
        const int row0 = u.pm * 256 + wr * 64 + fr, col0 = (u.pn & 7) * 256 + wc * 32 + 4 * fq;
        const bool isu = u.pn < 8;
#pragma unroll
        for (int ai = 0; ai < 2; ++ai)
#pragma unroll
            for (int m = 0; m < 4; ++m) { const size_t off = (size_t)(row0 + ai * 128 + m * 16) * D + col0;
#pragma unroll
                for (int bj = 0; bj < 2; ++bj)
#pragma unroll
                    for (int n = 0; n < 2; ++n) { const f32x4 v = acc[ai][bj][m][n];
                        const f32x2 a = gelu_pk((f32x2){v[0], v[1]}), b = gelu_pk((f32x2){v[2], v[3]});
                        if (isu) { u32x2 w; w.x = cvt_pk_bf16(a.x, a.y); w.y = cvt_pk_bf16(b.x, b.y); *(u32x2*)(U + off + bj * 128 + n * 16) = w; }
                        else *(f32x4*)(VG + off + bj * 128 + n * 16) = (f32x4){a.x, a.y, b.x, b.y}; } }
    } };

namespace pg8 {
struct MoeOrder {
    int cnt_t[8], off_t[8], nN, G, c, lda, ldb; const char* A; const char* B; size_t bstride;
    __device__ void init(const int* cnt, const int* off, const bf16_t* A_, int lda_, const bf16_t* B_, int ldb_, size_t bstride_bytes, int N, int G_, int c_) {
#pragma unroll
        for (int e = 0; e < 8; ++e) { cnt_t[e] = __builtin_amdgcn_readfirstlane((cnt[e] + 255) >> 8); off_t[e] = __builtin_amdgcn_readfirstlane(off[e] >> 8); }
        A = (const char*)A_; B = (const char*)B_; lda = lda_; ldb = ldb_; bstride = bstride_bytes; nN = N / 256; G = G_; c = c_;
    }
    __device__ bool next(int i, Unit& u) const {
        const int L = i * G + c, x = L & 7; int q = L >> 3; int e = 0; bool found = false; int te = 0, oe = 0;
        const int n8 = nN >> 3;
#pragma unroll
        for (int k = 0; k < 8; ++k) { const int ue = cnt_t[k] * n8; if (!found) { if (q < ue) { found = true; e = k; te = cnt_t[k]; oe = off_t[k]; } else q -= ue; } }
        if (!found) return false;
        const int pml = q % te; u.pn = (q / te) * 8 + x; u.pm = oe + pml; u.kind = e;
        u.a = A + (size_t)u.pm * 256 * lda * 2; u.b = B + (size_t)e * bstride + (size_t)u.pn * 256 * ldb * 2; return true;
    }
};
}

template <bool ROUTE>
__device__ __forceinline__ void ph_norm_mod(LAS unsigned char* lds, const float* srcL, const float* srcC, const float* gain, const float* mod, int chunk_sh, int chunk_sc, bf16_t* dst, int nrows,
                                            const float* router, int* tope, float* topg, int* bcnt, int G, int bid) {
    const int tid = threadIdx.x, wave = tid >> 6, lane = tid & 63;
    const int rpb = (nrows + G - 1) / G, r0 = bid * rpb, r1 = min(nrows, r0 + rpb);
    LAS int* lc = (LAS int*)lds;
    if (ROUTE) { if (tid < 8) lc[tid] = 0; __syncthreads(); }
    int cur_mrow = -1; float gm[32], shv[32];
    float4 xn[8];
    { const int rw = r0 + wave < r1 ? r0 + wave : r0; const float* s0_ = rw < NL ? srcL + (size_t)rw * D : srcC + (size_t)(rw - NL) * D;
#pragma unroll
      for (int i = 0; i < 8; ++i) xn[i] = *(const float4*)(s0_ + i * 256 + lane * 4); }
    for (int row = r0 + wave; row < r1; row += 8) {
        const int mrow = row < NL ? row / SEQ : 2;
        if (mrow != cur_mrow) { cur_mrow = mrow;
            const float* sh_ = mod + (size_t)mrow * NMOD + chunk_sh * D; const float* sc_ = mod + (size_t)mrow * NMOD + chunk_sc * D;
#pragma unroll
            for (int i = 0; i < 8; ++i) { const int c = i * 256 + lane * 4; const float4 g4 = *(const float4*)(gain + c), sc4 = *(const float4*)(sc_ + c), sh4 = *(const float4*)(sh_ + c);
                gm[i * 4] = g4.x * (1.f + sc4.x); gm[i * 4 + 1] = g4.y * (1.f + sc4.y); gm[i * 4 + 2] = g4.z * (1.f + sc4.z); gm[i * 4 + 3] = g4.w * (1.f + sc4.w);
                shv[i * 4] = sh4.x; shv[i * 4 + 1] = sh4.y; shv[i * 4 + 2] = sh4.z; shv[i * 4 + 3] = sh4.w; } }
        float v[32]; float ss = 0.f;
#pragma unroll
        for (int i = 0; i < 8; ++i) { const float4 x = xn[i]; v[i * 4] = x.x; v[i * 4 + 1] = x.y; v[i * 4 + 2] = x.z; v[i * 4 + 3] = x.w; ss += x.x * x.x + x.y * x.y + x.z * x.z + x.w * x.w; }
        { const int rn = row + 8 < r1 ? row + 8 : row; const float* sn_ = rn < NL ? srcL + (size_t)rn * D : srcC + (size_t)(rn - NL) * D;
#pragma unroll
          for (int i = 0; i < 8; ++i) xn[i] = *(const float4*)(sn_ + i * 256 + lane * 4); }
        ss = wave_sum_dpp(ss);
        const float rs = rsqrtf(ss * (1.0f / D) + 1e-6f);
        float a[8];
        if (ROUTE) {
#pragma unroll
            for (int e = 0; e < 8; ++e) a[e] = 0.f;
        }
#pragma unroll
        for (int i = 0; i < 8; ++i) {
            const int c = i * 256 + lane * 4;
            float o[4];
            o[0] = v[i * 4] * rs * gm[i * 4] + shv[i * 4]; o[1] = v[i * 4 + 1] * rs * gm[i * 4 + 1] + shv[i * 4 + 1];
            o[2] = v[i * 4 + 2] * rs * gm[i * 4 + 2] + shv[i * 4 + 2]; o[3] = v[i * 4 + 3] * rs * gm[i * 4 + 3] + shv[i * 4 + 3];
            if (ROUTE) *(unsigned*)((unsigned char*)dst + (size_t)row * D + c) = pk4_fp8(o[0], o[1], o[2], o[3]);
            else { u32x2 w; w.x = cvt_pk_bf16(o[0], o[1]); w.y = cvt_pk_bf16(o[2], o[3]); *(u32x2*)(dst + (size_t)row * D + c) = w; }
            if (ROUTE) {
#pragma unroll
                for (int j = 0; j < 4; ++j) { const float4 ra = *(const float4*)(router + (size_t)(c + j) * 8), rb = *(const float4*)(router + (size_t)(c + j) * 8 + 4);
                    a[0] += o[j] * ra.x; a[1] += o[j] * ra.y; a[2] += o[j] * ra.z; a[3] += o[j] * ra.w; a[4] += o[j] * rb.x; a[5] += o[j] * rb.y; a[6] += o[j] * rb.z; a[7] += o[j] * rb.w; }
            }
        }
        if (ROUTE) {
#pragma unroll
            for (int e = 0; e < 8; ++e) a[e] = wave_sum(a[e]);
            if (lane == 0) {
                int e0 = 0; float v0 = a[0];
#pragma unroll
                for (int e = 1; e < 8; ++e) if (a[e] > v0) { v0 = a[e]; e0 = e; }
                int e1 = 0; float v1 = -3e38f;
#pragma unroll
                for (int e = 0; e < 8; ++e) if (e != e0 && a[e] > v1) { v1 = a[e]; e1 = e; }
                const float ex = fexp(v1 - v0);
                tope[row * 2] = e0; tope[row * 2 + 1] = e1;
                topg[row * 2] = 1.f / (1.f + ex); topg[row * 2 + 1] = ex / (1.f + ex);
                atomicAdd((int*)&lc[e0], 1); atomicAdd((int*)&lc[e1], 1);
            }
        }
    }
    if (ROUTE) { __syncthreads(); if (tid < 8) bcnt[bid * 8 + tid] = lc[tid]; __syncthreads(); }
}

__device__ __forceinline__ void ph_moe_plan(LAS unsigned char* lds, const int* bcnt, const int* tope, int* slot, int* cntoff, const bf16_t* XNB, bf16_t* XG, int G, int bid) {
    const int tid = threadIdx.x;
    LAS int* base = (LAS int*)lds;
    LAS int* sl = base + 8;
    const int rpb = (NL + G - 1) / G, r0 = bid * rpb, r1 = min(NL, r0 + rpb);
    __syncthreads();
    for (int a = tid; a < (r1 - r0) * 2; a += 512) base[48 + 160 + a] = tope[r0 * 2 + a];
    if (tid < 8) { base[16 + tid] = 0; base[32 + tid] = 0; }
    __syncthreads();
    for (int bq0 = 0; bq0 < G; bq0 += 512) { const int bq = bq0 + tid; int cv[8] = {0, 0, 0, 0, 0, 0, 0, 0};
        if (bq < G) { const int4 c0 = *(const int4*)(bcnt + bq * 8), c1 = *(const int4*)(bcnt + bq * 8 + 4); cv[0] = c0.x; cv[1] = c0.y; cv[2] = c0.z; cv[3] = c0.w; cv[4] = c1.x; cv[5] = c1.y; cv[6] = c1.z; cv[7] = c1.w; }
#pragma unroll
        for (int e = 0; e < 8; ++e) { const int tot = wave_isum_dpp(cv[e]), pre = wave_isum_dpp(bq < bid ? cv[e] : 0);
            if ((tid & 63) == 0 && tot != 0) { atomicAdd((int*)&base[16 + e], tot); if (pre != 0) atomicAdd((int*)&base[32 + e], pre); } } }
    __syncthreads();
    if (tid == 0) {
        int off = 0;
        for (int e = 0; e < 8; ++e) { const int tot = base[16 + e]; base[e] = off + base[32 + e]; if (bid == 0) { cntoff[e] = tot; cntoff[8 + e] = off; } off += (tot + 255) & ~255; }
        int cur[8];
#pragma unroll
        for (int e = 0; e < 8; ++e) cur[e] = base[e];
        for (int a = r0 * 2; a < r1 * 2; ++a) { const int e = base[48 + 160 + a - r0 * 2]; int s = 0;
#pragma unroll
            for (int q = 0; q < 8; ++q) if (e == q) { s = cur[q]; cur[q]++; }
            slot[a] = s; base[48 + a - r0 * 2] = s; }
    }
    __syncthreads();
    const int na = (r1 - r0) * 2;
    for (int i0 = tid; i0 < na * 128; i0 += 512 * 4) {
        u32x4 v[4]; int so[4];
#pragma unroll
        for (int k = 0; k < 4; ++k) { const int i = i0 + k * 512; const bool ok = i < na * 128; const int a = ok ? i >> 7 : 0, c16 = i & 127; const int sl_ = base[48 + a], row = r0 + (a >> 1);
            so[k] = ok ? sl_ * (D / 16) + c16 : -1; v[k] = *(const u32x4*)((const unsigned char*)XNB + (size_t)row * D + c16 * 16); }
#pragma unroll
        for (int k = 0; k < 4; ++k) if (so[k] >= 0) *(u32x4*)((unsigned char*)XG + (size_t)so[k] * 16) = v[k];
    }
    __syncthreads();
}

__device__ __forceinline__ void ph_ln_transpose(LAS unsigned char* lds, const float* VG, const float* lnw, const float* lnb, bf16_t* VT, int G, int bid) {
    const int tid = threadIdx.x, wave = tid >> 6, lane = tid & 63;
    LAS bf16_t* T = (LAS bf16_t*)lds;
    for (int unit = bid; unit < NL / 32; unit += G) {
        const int row0 = unit * 32;
        __syncthreads();
        for (int rr = wave; rr < 32; rr += 8) {
            const float* src = VG + (size_t)(row0 + rr) * D;
            float v[32]; float s = 0.f;
#pragma unroll
            for (int i = 0; i < 8; ++i) { const float4 x = *(const float4*)(src + i * 256 + lane * 4); v[i * 4] = x.x; v[i * 4 + 1] = x.y; v[i * 4 + 2] = x.z; v[i * 4 + 3] = x.w; s += (x.x + x.y) + (x.z + x.w); }
            const float mu = wave_sum(s) * (1.f / 2048.f);
            float q = 0.f;
#pragma unroll
            for (int i = 0; i < 32; ++i) { const float dd = v[i] - mu; q += dd * dd; }
            const float rs = rsqrtf(wave_sum(q) * (1.f / 2048.f) + 1e-5f);
#pragma unroll
            for (int i = 0; i < 8; ++i) { const int c = i * 256 + lane * 4;
                const float4 w4 = *(const float4*)(lnw + c), b4 = *(const float4*)(lnb + c);
                u32x2 w; w.x = cvt_pk_bf16((v[i * 4] - mu) * rs * w4.x + b4.x, (v[i * 4 + 1] - mu) * rs * w4.y + b4.y);
                w.y = cvt_pk_bf16((v[i * 4 + 2] - mu) * rs * w4.z + b4.z, (v[i * 4 + 3] - mu) * rs * w4.w + b4.w);
                *(LAS u32x2*)(T + rr * 2048 + c) = w; }
        }
        __syncthreads();
        const int b = row0 / SEQ, n = (row0 % SEQ) / 128, q0 = row0 % 128;
        for (int it = tid; it < 1024 * 4; it += 512) {
            const int qg = it & 3, cp = it >> 2, c = cp * 2;
            unsigned e[8];
#pragma unroll
            for (int j = 0; j < 8; ++j) e[j] = *(const LAS unsigned*)(T + (qg * 8 + j) * 2048 + c);
            u32x4 w0, w1;
            w0.x = (e[0] & 0xffffu) | (e[1] << 16); w0.y = (e[2] & 0xffffu) | (e[3] << 16); w0.z = (e[4] & 0xffffu) | (e[5] << 16); w0.w = (e[6] & 0xffffu) | (e[7] << 16);
            w1.x = (e[0] >> 16) | (e[1] & 0xffff0000u); w1.y = (e[2] >> 16) | (e[3] & 0xffff0000u); w1.z = (e[4] >> 16) | (e[5] & 0xffff0000u); w1.w = (e[6] >> 16) | (e[7] & 0xffff0000u);
            const int g = c >> 7, cl = c & 127;
            bf16_t* dst = VT + ((((size_t)(b * 32 + n) * 16 + g) * 128 + cl) * 128 + q0 + qg * 8);
            *(u32x4*)dst = w0; *(u32x4*)(dst + 128) = w1;
        }
    }
    __syncthreads();
}

__device__ __forceinline__ void ph_spatial(const bf16_t* WS, const bf16_t* VT, const bf16_t* U, const float* bs, bf16_t* GATED, int G, int bid) {
    typedef float f32x16 __attribute__((ext_vector_type(16)));
    const int tid = threadIdx.x, wave = tid >> 6, lane = tid & 63, l32 = lane & 31, half = lane >> 5;
    const int p0 = (wave & 3) * 32, c0 = (wave >> 2) * 64;
    for (int unit = bid; unit < NB * 32 * 16; unit += G) {
        const int g = unit & 15, bn = unit >> 4;
        const bf16_t* Wp = WS + (size_t)g * 128 * 128 + (size_t)(p0 + l32) * 128 + half * 8;
        const bf16_t* Vp = VT + ((size_t)bn * 16 + g) * 128 * 128 + (size_t)(c0 + l32) * 128 + half * 8;
        f32x16 acc0, acc1;
#pragma unroll
        for (int i = 0; i < 16; ++i) { acc0[i] = 0.f; acc1[i] = 0.f; }
#pragma unroll
        for (int ks = 0; ks < 8; ++ks) {
            const bf16x8 w = *(const bf16x8*)(Wp + ks * 16), v0 = *(const bf16x8*)(Vp + ks * 16), v1 = *(const bf16x8*)(Vp + 32 * 128 + ks * 16);
            acc0 = __builtin_amdgcn_mfma_f32_32x32x16_bf16(v0, w, acc0, 0, 0, 0);
            acc1 = __builtin_amdgcn_mfma_f32_32x32x16_bf16(v1, w, acc1, 0, 0, 0);
        }
        const int p = p0 + l32;
        const float bias = bs[g * 128 + p];
        const size_t ob = (size_t)(bn * 128 + p) * D + g * 128 + c0 + 4 * half;
#pragma unroll
        for (int i4 = 0; i4 < 4; ++i4) {
#pragma unroll
            for (int hb = 0; hb < 2; ++hb) {
                const size_t o = ob + hb * 32 + 8 * i4;
                const u32x2 uu = *(const u32x2*)(U + o);
                const float u0 = __uint_as_float(uu.x << 16), u1 = __uint_as_float(uu.x & 0xffff0000u), u2 = __uint_as_float(uu.y << 16), u3 = __uint_as_float(uu.y & 0xffff0000u);
                const f32x16& a = hb == 0 ? acc0 : acc1;
                u32x2 w; w.x = cvt_pk_bf16(u0 * (a[i4 * 4] + bias), u1 * (a[i4 * 4 + 1] + bias)); w.y = cvt_pk_bf16(u2 * (a[i4 * 4 + 2] + bias), u3 * (a[i4 * 4 + 3] + bias));
                *(u32x2*)(GATED + o) = w;
            }
        }
    }
}

__device__ __forceinline__ void ph_final(const float* H, const bf16_t* OUT2, const int* slot, const float* topg, const float* g2, const float* fnorm, float* out, int G, int bid) {
    const int tid = threadIdx.x, wave = tid >> 6, lane = tid & 63;
    float fn[32], gv[32]; int cur_b = -1;
#pragma unroll
    for (int i = 0; i < 8; ++i) { const float4 f = *(const float4*)(fnorm + i * 256 + lane * 4); fn[i * 4] = f.x; fn[i * 4 + 1] = f.y; fn[i * 4 + 2] = f.z; fn[i * 4 + 3] = f.w; }
    for (int row = bid * 8 + wave; row < NL; row += G * 8) {
        const int s0 = slot[row * 2], s1 = slot[row * 2 + 1]; const float g0 = topg[row * 2], g1 = topg[row * 2 + 1];
        const float* h = H + (size_t)row * D; const bf16_t* o0 = OUT2 + (size_t)s0 * D; const bf16_t* o1 = OUT2 + (size_t)s1 * D;
        const int bb = row / SEQ;
        if (bb != cur_b) { cur_b = bb; const float* gg = g2 + (size_t)bb * NMOD;
#pragma unroll
            for (int i = 0; i < 8; ++i) { const float4 g = *(const float4*)(gg + i * 256 + lane * 4); gv[i * 4] = g.x; gv[i * 4 + 1] = g.y; gv[i * 4 + 2] = g.z; gv[i * 4 + 3] = g.w; } }
        float v[32]; float ss = 0.f;
#pragma unroll
        for (int i = 0; i < 8; ++i) { const int c = i * 256 + lane * 4;
            const float4 hv = *(const float4*)(h + c); const u32x2 a = *(const u32x2*)(o0 + c), b = *(const u32x2*)(o1 + c);
            const float a0 = __uint_as_float(a.x << 16), a1 = __uint_as_float(a.x & 0xffff0000u), a2 = __uint_as_float(a.y << 16), a3 = __uint_as_float(a.y & 0xffff0000u);
            const float b0 = __uint_as_float(b.x << 16), b1 = __uint_as_float(b.x & 0xffff0000u), b2 = __uint_as_float(b.y << 16), b3 = __uint_as_float(b.y & 0xffff0000u);
            v[i * 4] = hv.x + gv[i * 4] * (g0 * a0 + g1 * b0); v[i * 4 + 1] = hv.y + gv[i * 4 + 1] * (g0 * a1 + g1 * b1);
            v[i * 4 + 2] = hv.z + gv[i * 4 + 2] * (g0 * a2 + g1 * b2); v[i * 4 + 3] = hv.w + gv[i * 4 + 3] * (g0 * a3 + g1 * b3);
            ss += v[i * 4] * v[i * 4] + v[i * 4 + 1] * v[i * 4 + 1] + v[i * 4 + 2] * v[i * 4 + 2] + v[i * 4 + 3] * v[i * 4 + 3]; }
        const float rs = rsqrtf(wave_sum(ss) * (1.f / D) + 1e-6f);
#pragma unroll
        for (int i = 0; i < 8; ++i) { const int c = i * 256 + lane * 4;
            *(float4*)(out + (size_t)row * D + c) = (float4){v[i * 4] * rs * fn[i * 4], v[i * 4 + 1] * rs * fn[i * 4 + 1], v[i * 4 + 2] * rs * fn[i * 4 + 2], v[i * 4 + 3] * rs * fn[i * 4 + 3]}; }
    }
}

__device__ __forceinline__ void ph_ada(LAS unsigned char* lds, const float* W0, const float* W1, const float* b0, const float* b1, const float* c, const float* cc, float* mod0, float* mod1, int G, int bid) {
    const int tid = threadIdx.x, kq = tid / 24, c4 = tid % 24;
    LAS float* red = (LAS float*)lds;
    for (int u = bid; u < 256; u += G) {
        const int l = u >> 7, col0 = (u & 127) * 96;
        const float* W = (l == 0 ? W0 : W1) + col0 + c4 * 4;
        float a[12];
#pragma unroll
        for (int j = 0; j < 12; ++j) a[j] = 0.f;
        if (kq < 21) {
#pragma unroll 7
            for (int k = kq; k < D; k += 21) {
                const float4 w = *(const float4*)(W + (size_t)k * NMOD);
                const float x0 = c[k], x1 = c[D + k], x2 = cc[k];
                const float s0 = x0 * fsigmoid(x0), s1 = x1 * fsigmoid(x1), s2 = x2 * fsigmoid(x2);
                a[0] += s0 * w.x; a[1] += s0 * w.y; a[2] += s0 * w.z; a[3] += s0 * w.w;
                a[4] += s1 * w.x; a[5] += s1 * w.y; a[6] += s1 * w.z; a[7] += s1 * w.w;
                a[8] += s2 * w.x; a[9] += s2 * w.y; a[10] += s2 * w.z; a[11] += s2 * w.w;
            }
        }
        __syncthreads();
        if (kq < 21) {
#pragma unroll
            for (int j = 0; j < 12; ++j) red[(kq * 24 + c4) * 12 + j] = a[j];
        }
        __syncthreads();
        if (tid < 288) {
            const int cq = tid / 12, rj = tid % 12, row = rj >> 2, j = rj & 3, n = col0 + cq * 4 + j;
            float sum = (l == 0 ? b0 : b1)[n];
            for (int q = 0; q < 21; ++q) sum += red[(q * 24 + cq) * 12 + rj];
            if (!(l == 1 && row == 2)) (l == 0 ? mod0 : mod1)[(size_t)row * NMOD + n] = sum;
        }
    }
    __syncthreads();
}


__device__ __forceinline__ void ph_small_cvt(const float* w_up, const float* a_up, const float* g_up, bf16_t* WLORA, float* ropec, float* ropes, int G, int bid) {
    const int gt = bid * 512 + threadIdx.x, gs = G * 512;
    if (gt < 16) {
        const double x = (double)rope_inv(gt), x2 = x * x;
        double sn = x * (1.0 + x2 * (-1.0 / 6 + x2 * (1.0 / 120 + x2 * (-1.0 / 5040 + x2 * (1.0 / 362880 + x2 * (-1.0 / 39916800 + x2 * (1.0 / 6227020800.0)))))));
        double cs = 1.0 + x2 * (-0.5 + x2 * (1.0 / 24 + x2 * (-1.0 / 720 + x2 * (1.0 / 40320 + x2 * (-1.0 / 3628800 + x2 * (1.0 / 479001600.0 + x2 * (-1.0 / 87178291200.0)))))));
        double c = 1.0, s_ = 0.0;
        for (int pos = 0; pos < 64; ++pos) { ropec[pos * 16 + gt] = (float)c; ropes[pos * 16 + gt] = (float)s_; const double nc = c * cs - s_ * sn, ns = s_ * cs + c * sn; c = nc; s_ = ns; }
    }
    for (int i = gt; i < 5120 * 64; i += gs) {
        const int n = i >> 6, k0 = (i & 63) * 8, g = n >> 10, ch = n & 1023;
        float v[8];
#pragma unroll
        for (int q = 0; q < 8; ++q) { const int k = k0 + q; float x = 0.f;
            if (g < 4) { const int koff = g * 64; if (k >= koff && k < koff + 64) x = (g < 2 ? w_up : a_up)[(size_t)((g & 1) * 64 + (k - koff)) * RD + ch]; }
            else { if (k >= 256 && k < 416) x = g_up[(size_t)(k - 256) * RD + ch]; }
            v[q] = x; }
        u32x4 w; w.x = cvt_pk_bf16(v[0], v[1]); w.y = cvt_pk_bf16(v[2], v[3]); w.z = cvt_pk_bf16(v[4], v[5]); w.w = cvt_pk_bf16(v[6], v[7]);
        *(u32x4*)(WLORA + (size_t)n * 512 + k0) = w;
    }
}
struct MapKV { const float* src; int sel;
    __device__ __forceinline__ const float* operator()(int n0) const { const int h = n0 >> 7, d = n0 & 127; return src + h * 256 + sel * 128 + d; } __device__ __forceinline__ int stride() const { return KVW; } __device__ __forceinline__ bool valid(int) const { return true; } };

__device__ __forceinline__ void ph_prep(const float* Z, const float* qn, const float* kvn, const float* mup, const float* mun, const float* k_k,
                                        bf16_t* CQNB, bf16_t* CKVNB, bf16_t* KRB, bf16_t* LA, float* RR, float* KRf, float* VR, float* AA, const float* ropec, const float* ropes, int G, int bid) {
    const int wave = threadIdx.x >> 6, lane = threadIdx.x & 63;
    for (int row = bid * 8 + wave; row < MALL; row += G * 8) {
        const float* z = Z + (size_t)row * ZLD;
        int t, len; if (row < NL) { t = row % SEQ; len = SEQ; } else { t = (row - NL) % CTX; len = CTX; }
#pragma unroll
        for (int part = 0; part < 2; ++part) {
            const float4 a = *(const float4*)(z + part * 512 + lane * 8), b = *(const float4*)(z + part * 512 + lane * 8 + 4);
            float ss = a.x * a.x + a.y * a.y + a.z * a.z + a.w * a.w + b.x * b.x + b.y * b.y + b.z * b.z + b.w * b.w;
            ss = wave_sum(ss);
            const float rs = rsqrtf(ss * (1.f / 512.f) + 1e-6f);
            const float* gn = (part == 0 ? qn : kvn) + lane * 8;
            const float4 g0 = *(const float4*)gn, g1 = *(const float4*)(gn + 4);
            u32x4 w; w.x = cvt_pk_bf16(a.x * rs * g0.x, a.y * rs * g0.y); w.y = cvt_pk_bf16(a.z * rs * g0.z, a.w * rs * g0.w);
            w.z = cvt_pk_bf16(b.x * rs * g1.x, b.y * rs * g1.y); w.w = cvt_pk_bf16(b.z * rs * g1.z, b.w * rs * g1.w);
            *(u32x4*)((part == 0 ? CQNB : CKVNB) + (size_t)row * 512 + lane * 8) = w;
        }
        {
            const float val = z[1024 + lane]; const float oth = __shfl_xor(val, 16);
            float o = val;
            if (row < NL) {
                const int a = lane >> 5, hf = (lane >> 4) & 1, f = lane & 15;
                const int pos = a == 0 ? (t >> 6) : (t & 63);
                const float cs = ropec[pos * 16 + f], sn = ropes[pos * 16 + f];
                o = hf == 0 ? val * cs - oth * sn : val * cs + oth * sn;
            }
            KRB[(size_t)row * KLD + 1024 + lane] = (bf16_t)(cvt_pk_bf16(o, 0.f) & 0xffffu);
        }
        const float* zc = z + MLA_IN; const float* zp = zc - ZLD; const float* zn = zc + ZLD;
        const bool hp = t > 0, hn = t < len - 1;
#define SHIFT4(jj) ({ const int j_ = (jj); const f32x4 zz = *(const f32x4*)(zc + j_), mp = *(const f32x4*)(mup + j_), mn = *(const f32x4*)(mun + j_); \
            f32x4 pv = {0.f, 0.f, 0.f, 0.f}, nv = pv; if (hp) pv = *(const f32x4*)(zp + j_); if (hn) nv = *(const f32x4*)(zn + j_); zz + mp * (pv - zz) + mn * (nv - zz); })
        { f32x4 a0 = SHIFT4(lane * 4), a1 = SHIFT4((lane + 64) * 4), a2 = SHIFT4((lane + 128) * 4), a3 = SHIFT4((lane + 192) * 4);
          float* dst = RR + hmi(row, lane * 4); *(f32x4*)dst = a0; *(f32x4*)(dst + (size_t)4 * MALL * 64) = a1; *(f32x4*)(dst + (size_t)8 * MALL * 64) = a2; *(f32x4*)(dst + (size_t)12 * MALL * 64) = a3; }
        { f32x4 k[4]; k[0] = SHIFT4(1024 + lane * 4); k[1] = SHIFT4(1024 + (lane + 64) * 4); k[2] = SHIFT4(1024 + (lane + 128) * 4); k[3] = SHIFT4(1024 + (lane + 192) * 4);
#pragma unroll
          for (int i = 0; i < 4; ++i) { const int c = (lane + 64 * i) * 4;
            *(f32x4*)(KRf + hmi(row, c)) = k[i];
            const f32x4 kk = k[i] * *(const f32x4*)(k_k + c);
            float q = kk[0] * kk[0] + kk[1] * kk[1] + kk[2] * kk[2] + kk[3] * kk[3];
            q += __shfl_xor(q, 1); q += __shfl_xor(q, 2); q += __shfl_xor(q, 4); q += __shfl_xor(q, 8);
            const float inv = -1.0f / fmaxf(sqrtf(q), 1e-12f);
            *(f32x4*)(AA + hmi(row, c)) = kk * inv; } }
        { f32x4 a0 = SHIFT4(2048 + lane * 4), a1 = SHIFT4(2048 + (lane + 64) * 4), a2 = SHIFT4(2048 + (lane + 128) * 4), a3 = SHIFT4(2048 + (lane + 192) * 4);
          float* dst = VR + hmi(row, lane * 4); *(f32x4*)dst = a0; *(f32x4*)(dst + (size_t)4 * MALL * 64) = a1; *(f32x4*)(dst + (size_t)8 * MALL * 64) = a2; *(f32x4*)(dst + (size_t)12 * MALL * 64) = a3; }
        {
            const int c0 = lane * 8; f32x4 x0 = {0.f, 0.f, 0.f, 0.f}, x1 = x0;
            if (c0 < 416) { x0 = SHIFT4(3072 + c0); x1 = SHIFT4(3072 + c0 + 4); }
            float o[8];
#pragma unroll
            for (int q = 0; q < 4; ++q) { o[q] = c0 < 128 ? ftanh(x0[q]) : c0 < 256 ? x0[q] : c0 < 416 ? fsigmoid(x0[q]) : 0.f; o[4 + q] = c0 < 128 ? ftanh(x1[q]) : c0 < 256 ? x1[q] : c0 < 416 ? fsigmoid(x1[q]) : 0.f; }
            u32x4 w; w.x = cvt_pk_bf16(o[0], o[1]); w.y = cvt_pk_bf16(o[2], o[3]); w.z = cvt_pk_bf16(o[4], o[5]); w.w = cvt_pk_bf16(o[6], o[7]);
            *(u32x4*)(LA + (size_t)row * 512 + c0) = w;
        }
#undef SHIFT4
    }
}

struct EpiLora { static constexpr bool PERM = false; const float* w0; const float* a0; const float* k_a; const float* KRf; const float* AA; float* WW; float* KD; float* BD; float* GG; int pn0;
    __device__ __forceinline__ void operator()(AccRef acc, const Unit& u, int wr, int wc, int fr, int fq) const {
        const int png = u.pn + pn0, g = __builtin_amdgcn_readfirstlane(png >> 2), row0 = u.pm * 256 + wr * 64 + fr, ch0 = (png & 3) * 256 + wc * 32 + 4 * fq;
        if (g < 2) {
            f32x4 bb[2][2];
#pragma unroll
            for (int bj = 0; bj < 2; ++bj)
#pragma unroll
                for (int n = 0; n < 2; ++n) bb[bj][n] = *(const f32x4*)(w0 + g * RD + ch0 + bj * 128 + n * 16);
            float* dstp = WW + (size_t)g * MALL * RD;
#pragma unroll
            for (int ai = 0; ai < 2; ++ai)
#pragma unroll
                for (int m = 0; m < 4; ++m) { const int row = row0 + ai * 128 + m * 16;
#pragma unroll
                    for (int bj = 0; bj < 2; ++bj)
#pragma unroll
                        for (int n = 0; n < 2; ++n) { const size_t e = hmi(row, ch0 + bj * 128 + n * 16); const f32x4 v = acc[ai][bj][m][n], b = bb[bj][n]; f32x4 o;
#pragma unroll
                            for (int j = 0; j < 4; ++j) { const float y = -(b[j] + v[j]); const float sp = fmaxf(y, 0.f) + flog(1.0f + fexp(-fabsf(y))); o[j] = fexp(-fexp(-sp - 0.5f)); }
                            *(f32x4*)(dstp + e) = o; } }
        } else if (g < 4) {
            const int d = g - 2;
            f32x4 bb[2][2], ka[2][2];
#pragma unroll
            for (int bj = 0; bj < 2; ++bj)
#pragma unroll
                for (int n = 0; n < 2; ++n) { bb[bj][n] = *(const f32x4*)(a0 + d * RD + ch0 + bj * 128 + n * 16); ka[bj][n] = *(const f32x4*)(k_a + ch0 + bj * 128 + n * 16); }
            float* kdp = KD + (size_t)d * MALL * RD; float* bdp = BD + (size_t)d * MALL * RD;
#pragma unroll
            for (int ai = 0; ai < 2; ++ai)
#pragma unroll
                for (int m = 0; m < 4; ++m) {
                    f32x4 kv[2][2], aa[2][2];
#pragma unroll
                    for (int bj = 0; bj < 2; ++bj)
#pragma unroll
                        for (int n = 0; n < 2; ++n) { const size_t e = hmi(row0 + ai * 128 + m * 16, ch0 + bj * 128 + n * 16); kv[bj][n] = *(const f32x4*)(KRf + e); aa[bj][n] = *(const f32x4*)(AA + e); }
#pragma unroll
                    for (int bj = 0; bj < 2; ++bj)
#pragma unroll
                        for (int n = 0; n < 2; ++n) { const size_t e = hmi(row0 + ai * 128 + m * 16, ch0 + bj * 128 + n * 16); const f32x4 v = acc[ai][bj][m][n]; f32x4 okd, obd;
#pragma unroll
                            for (int j = 0; j < 4; ++j) { const float ic = fsigmoid(bb[bj][n][j] + v[j]); okd[j] = kv[bj][n][j] * (1.f + (ic - 1.f) * ka[bj][n][j]); obd[j] = -ic * aa[bj][n][j]; }
                            *(f32x4*)(kdp + e) = okd; *(f32x4*)(bdp + e) = obd; }
                }
        } else {
#pragma unroll
            for (int ai = 0; ai < 2; ++ai)
#pragma unroll
                for (int m = 0; m < 4; ++m)
#pragma unroll
                    for (int bj = 0; bj < 2; ++bj)
#pragma unroll
                        for (int n = 0; n < 2; ++n) *(f32x4*)(GG + hmi(row0 + ai * 128 + m * 16, ch0 + bj * 128 + n * 16)) = acc[ai][bj][m][n];
        }
    } };
struct EpiQ { static constexpr bool PERM = false; bf16_t* QB; const float* ropec; const float* ropes;
    __device__ __forceinline__ void operator()(AccRef acc, const Unit& u, int wr, int wc, int fr, int fq) const {
        const float qs = 0.07216878364870322f * 1.4426950408889634f;
        const int row0 = u.pm * 256 + wr * 64 + fr;
#pragma unroll
        for (int bj = 0; bj < 2; ++bj) {
            const int cg = u.pn * 256 + bj * 128 + wc * 32, part = (cg >> 5) % 6;
#pragma unroll
            for (int ai = 0; ai < 2; ++ai)
#pragma unroll
                for (int m = 0; m < 4; ++m) { const int row = row0 + ai * 128 + m * 16, t = row & (SEQ - 1);
                    f32x4 x1 = acc[ai][bj][m][0], x2 = acc[ai][bj][m][1];
                    if (part >= 4) { const int pos = part == 4 ? (t >> 6) : (t & 63);
                        const f32x4 c = *(const f32x4*)(ropec + pos * 16 + 4 * fq), sn = *(const f32x4*)(ropes + pos * 16 + 4 * fq);
                        const f32x4 o1 = x1 * c - x2 * sn, o2 = x2 * c + x1 * sn; x1 = o1; x2 = o2; }
                    x1 = x1 * qs; x2 = x2 * qs;
                    bf16_t* dst = QB + (size_t)row * QW + cg + 4 * fq;
                    u32x2 w1, w2; w1.x = cvt_pk_bf16(x1[0], x1[1]); w1.y = cvt_pk_bf16(x1[2], x1[3]); w2.x = cvt_pk_bf16(x2[0], x2[1]); w2.y = cvt_pk_bf16(x2[2], x2[3]);
                    *(u32x2*)dst = w1; *(u32x2*)(dst + 16) = w2; }
        }
    } };
struct EpiBf16 { static constexpr bool PERM = true; bf16_t* O; int ldo;
    __device__ __forceinline__ void operator()(AccRef acc, const Unit& u, int wr, int wc, int fr, int fq) const {
        const int row0 = u.pm * 256 + wr * 64 + fr, col0 = u.pn * 256 + wc * 32 + 8 * fq;
#pragma unroll
        for (int ai = 0; ai < 2; ++ai)
#pragma unroll
            for (int m = 0; m < 4; ++m) { bf16_t* rowp = O + (size_t)(row0 + ai * 128 + m * 16) * ldo + col0;
#pragma unroll
                for (int bj = 0; bj < 2; ++bj) { const f32x4 v0 = acc[ai][bj][m][0], v1 = acc[ai][bj][m][1];
                    u32x4 w; w.x = cvt_pk_bf16(v0[0], v0[1]); w.y = cvt_pk_bf16(v0[2], v0[3]); w.z = cvt_pk_bf16(v1[0], v1[1]); w.w = cvt_pk_bf16(v1[2], v1[3]);
                    *(u32x4*)(rowp + bj * 128) = w; } }
    } };
struct EpiVT { static constexpr bool PERM = false; bf16_t* VT;
    __device__ __forceinline__ void operator()(AccRef acc, const Unit& u, int wr, int wc, int fr, int fq) const {
        const int row0 = u.pm * 256 + wr * 64 + fr, pq = ((fq & 1) << 1) | (fq >> 1), col0 = u.pn * 256 + wc * 32 + 4 * pq;
#pragma unroll
        for (int ai = 0; ai < 2; ++ai)
#pragma unroll
            for (int m = 0; m < 4; ++m) { bf16_t* rowp = VT + (size_t)(row0 + ai * 128 + m * 16) * MALL + col0;
#pragma unroll
                for (int bj = 0; bj < 2; ++bj)
#pragma unroll
                    for (int n = 0; n < 2; ++n) { const f32x4 v = acc[ai][bj][m][n]; u32x2 w; w.x = cvt_pk_bf16(v[0], v[1]); w.y = cvt_pk_bf16(v[2], v[3]); *(u32x2*)(rowp + bj * 128 + n * 16) = w; } }
    } };

__device__ __forceinline__ void ph_attn(LAS unsigned char* lds, const bf16_t* QB, const bf16_t* KNB, const bf16_t* VTB, bf16_t* MIXB, int G, int bid) {
    typedef float f32x16 __attribute__((ext_vector_type(16)));
    constexpr int KP = 400, VP = 144, KBYTES = 64 * KP, BUF = KBYTES + 128 * VP, NT = SK / 64;
    const int tid = threadIdx.x, wave = tid >> 6, lane = tid & 63, l32 = lane & 31, half = lane >> 5;
    for (int unit = bid; unit < NB * HM * (SEQ / 256); unit += G) {
        const int bh = unit & 15, qb = unit >> 4, b = bh >> 3, h = bh & 7;
        const int qrow = b * SEQ + qb * 256 + wave * 32 + l32;
        bf16x8 qf[12];
#pragma unroll
        for (int ks = 0; ks < 12; ++ks) qf[ks] = *(const bf16x8*)(QB + (size_t)qrow * QW + h * 192 + ks * 16 + half * 8);
        f32x16 o[4];
#pragma unroll
        for (int d = 0; d < 4; ++d)
#pragma unroll
            for (int i = 0; i < 16; ++i) o[d][i] = 0.f;
        float mrun = -1e30f, lrun = 0.f;
        int ko[3], kd[3], vo[2], vd[2];
#pragma unroll
        for (int i = 0; i < 3; ++i) { const int id = tid + 512 * i, key = id / 24, cc = id % 24;
            ko[i] = key * KLD + (cc < 16 ? h * 128 + cc * 8 : 1024 + (cc - 16) * 8); kd[i] = key * KP + cc * 16; }
#pragma unroll
        for (int i = 0; i < 2; ++i) { const int id = tid + 512 * i, dv = id >> 3, cc = id & 7;
            vo[i] = (h * 128 + dv) * MALL + cc * 8; vd[i] = KBYTES + dv * VP + cc * 16; }
        u32x4 kr_[3], vr_[2];
        __syncthreads();
        {   const int trow = NL + b * CTX;
#pragma unroll
            for (int i = 0; i < 3; ++i) kr_[i] = *(const u32x4*)(KNB + (size_t)(ko[i] + trow * KLD));
#pragma unroll
            for (int i = 0; i < 2; ++i) vr_[i] = *(const u32x4*)(VTB + (size_t)(vo[i] + trow));
#pragma unroll
            for (int i = 0; i < 3; ++i) *(LAS u32x4*)(lds + kd[i]) = kr_[i];
#pragma unroll
            for (int i = 0; i < 2; ++i) *(LAS u32x4*)(lds + vd[i]) = vr_[i];
        }
        __syncthreads();
        for (int j = 0; j < NT; ++j) {
            LAS unsigned char* cb = lds + (j & 1) * BUF;
            if (j + 1 < NT) {
                const int jn = j + 1, trow = jn < 4 ? NL + b * CTX + 64 * jn : b * SEQ + 64 * (jn - 4);
#pragma unroll
                for (int i = 0; i < 3; ++i) kr_[i] = *(const u32x4*)(KNB + (size_t)(ko[i] + trow * KLD));
#pragma unroll
                for (int i = 0; i < 2; ++i) vr_[i] = *(const u32x4*)(VTB + (size_t)(vo[i] + trow));
            }
            f32x16 s0, s1;
#pragma unroll
            for (int i = 0; i < 16; ++i) { s0[i] = 0.f; s1[i] = 0.f; }
#pragma unroll
            for (int ks = 0; ks < 12; ++ks) {
                const bf16x8 a0 = *(const LAS bf16x8*)(cb + l32 * KP + ks * 32 + half * 16), a1 = *(const LAS bf16x8*)(cb + (32 + l32) * KP + ks * 32 + half * 16);
                s0 = __builtin_amdgcn_mfma_f32_32x32x16_bf16(a0, qf[ks], s0, 0, 0, 0);
                s1 = __builtin_amdgcn_mfma_f32_32x32x16_bf16(a1, qf[ks], s1, 0, 0, 0);
            }
            float mx = s0[0];
#pragma unroll
            for (int i = 1; i < 16; ++i) mx = fmaxf(mx, s0[i]);
#pragma unroll
            for (int i = 0; i < 16; ++i) mx = fmaxf(mx, s1[i]);
            mx = fmaxf(mx, __shfl_xor(mx, 32));
            const float mn = fmaxf(mrun, mx);
            const float alpha = __builtin_amdgcn_exp2f(mrun - mn);
            mrun = mn;
            float ps = 0.f;
#pragma unroll
            for (int i = 0; i < 16; ++i) { s0[i] = __builtin_amdgcn_exp2f(s0[i] - mn); s1[i] = __builtin_amdgcn_exp2f(s1[i] - mn); ps += s0[i] + s1[i]; }
            lrun = lrun * alpha + ps;
#pragma unroll
            for (int d = 0; d < 4; ++d)
#pragma unroll
                for (int i = 0; i < 16; ++i) o[d][i] *= alpha;
            bf16x8 pf[4];
#pragma unroll
            for (int s = 0; s < 4; ++s) {
                u32x4 w;
                if (s < 2) { const int i0 = (s & 1) * 8; w.x = cvt_pk_bf16(s0[i0], s0[i0 + 1]); w.y = cvt_pk_bf16(s0[i0 + 2], s0[i0 + 3]); w.z = cvt_pk_bf16(s0[i0 + 4], s0[i0 + 5]); w.w = cvt_pk_bf16(s0[i0 + 6], s0[i0 + 7]); }
                else { const int i0 = (s & 1) * 8; w.x = cvt_pk_bf16(s1[i0], s1[i0 + 1]); w.y = cvt_pk_bf16(s1[i0 + 2], s1[i0 + 3]); w.z = cvt_pk_bf16(s1[i0 + 4], s1[i0 + 5]); w.w = cvt_pk_bf16(s1[i0 + 6], s1[i0 + 7]); }
                pf[s] = __builtin_bit_cast(bf16x8, w);
            }
#pragma unroll
            for (int s = 0; s < 4; ++s)
#pragma unroll
                for (int d = 0; d < 4; ++d) {
                    const bf16x8 vf = *(const LAS bf16x8*)(cb + KBYTES + (32 * d + l32) * VP + s * 32 + half * 16);
                    o[d] = __builtin_amdgcn_mfma_f32_32x32x16_bf16(vf, pf[s], o[d], 0, 0, 0);
                }
            if (j + 1 < NT) {
                LAS unsigned char* nb = lds + ((j + 1) & 1) * BUF;
#pragma unroll
                for (int i = 0; i < 3; ++i) *(LAS u32x4*)(nb + kd[i]) = kr_[i];
#pragma unroll
                for (int i = 0; i < 2; ++i) *(LAS u32x4*)(nb + vd[i]) = vr_[i];
            }
            __syncthreads();
        }
        lrun += __shfl_xor(lrun, 32);
        const float il = 1.0f / lrun;
        bf16_t* dst = MIXB + (size_t)qrow * D + h * 128 + 4 * half;
#pragma unroll
        for (int d = 0; d < 4; ++d)
#pragma unroll
            for (int i4 = 0; i4 < 4; ++i4) { u32x2 w; w.x = cvt_pk_bf16(o[d][i4 * 4] * il, o[d][i4 * 4 + 1] * il); w.y = cvt_pk_bf16(o[d][i4 * 4 + 2] * il, o[d][i4 * 4 + 3] * il);
                *(u32x2*)(dst + 32 * d + 8 * i4) = w; }
    }
    __syncthreads();
}


constexpr int SC_CL = 272, SC_NC = 16;
__device__ __forceinline__ int scan_row(int b, int d, int g) {
    if (g < CTX) return NL + b * CTX + (d == 0 ? g : CTX - 1 - g);
    const int tp = g - CTX; return b * SEQ + (d == 0 ? tp : SEQ - 1 - tp);
}
#define DPP_FMAC(d, a, b, n) asm volatile("v_fmac_f32_dpp %0, %1, %2 row_newbcast:" #n " row_mask:0xf bank_mask:0xf" : "+v"(d) : "v"(a), "v"(b))
#define DPP_MULD(d, a, n)    asm volatile("v_mul_f32_dpp %0, %1, %0 row_newbcast:" #n " row_mask:0xf bank_mask:0xf" : "+v"(d) : "v"(a))
#define SC_FOR16(X) X(0) X(1) X(2) X(3) X(4) X(5) X(6) X(7) X(8) X(9) X(10) X(11) X(12) X(13) X(14) X(15)
struct MoeCv { const float* w1; long d31; const float* w2; unsigned char* W13E; unsigned char* W2E; };
constexpr int CV_PER_WAVE = 336, CV_ITEMS_W13 = 3584, CV_ITEMS_E = 5376, CV_WLDS = 4096;
static_assert((size_t)NE * CV_ITEMS_E * 8 == (size_t)CV_PER_WAVE * 1024, "MoE conversion tiles must split evenly over 1024 waves");
static_assert(4 * 5 * 6144 + 4 * CV_WLDS <= LDS_CTL, "scan rings + conversion images must fit below the LDS control words");
struct CvItem { const float* sp; unsigned char* dst; int ld, K; float sc; };
__device__ __forceinline__ CvItem cv_item(const MoeCv& mc, int it, int cw) {
    const int I = it * 1024 + cw, e = I / CV_ITEMS_E, r = I - e * CV_ITEMS_E;
    CvItem o;
    if (r < CV_ITEMS_W13) { const int kr = r / 224, nt = r - kr * 224, n0 = nt * 64, jj = n0 & 255;
        o.sp = mc.w1 + (jj < 128 ? 0l : mc.d31) + (size_t)e * D * DFF + (size_t)kr * 128 * DFF + (n0 >> 8) * 128 + (jj & 127); o.ld = DFF;
        o.dst = mc.W13E + (size_t)e * 2 * DFF * D + (size_t)n0 * D + kr * 128; o.K = D; o.sc = 64.f; }
    else { const int r2 = r - CV_ITEMS_W13, kr = r2 >> 5, n0 = (r2 & 31) * 64;
        o.sp = mc.w2 + (size_t)e * DFF * D + (size_t)kr * 128 * D + n0; o.ld = D;
        o.dst = mc.W2E + (size_t)e * D * DFF + (size_t)n0 * DFF + kr * 128; o.K = DFF; o.sc = 128.f; }
    return o;
}
__device__ __forceinline__ void moe_cvt_wave(LAS unsigned char* ct, const MoeCv& mc, int cw, int lane) {
    constexpr int NIT = CV_PER_WAVE / 8;
    const int l15 = lane & 15, l4 = lane >> 4;
    f32x4 buf[8][4];
    CvItem cur = cv_item(mc, 0, cw);
    { const float* lp = cur.sp + (size_t)(l4 * cur.ld + l15 * 4);
#pragma unroll
      for (int s = 0; s < 8; ++s)
#pragma unroll
        for (int q = 0; q < 4; ++q) buf[s][q] = *(const f32x4*)(lp + (size_t)(s * 16 + q * 4) * cur.ld); }
#pragma unroll 1
    for (int it = 0; it < NIT; ++it) {
        const CvItem nxt = cv_item(mc, it + 1 < NIT ? it + 1 : NIT - 1, cw);
        const float* lp = nxt.sp + (size_t)(l4 * nxt.ld + l15 * 4);
        unsigned char* dp = cur.dst + (size_t)lane * cur.K;
        const float sc = cur.sc;
        u32x4 wout[8];
#pragma unroll
        for (int s = 0; s < 8; ++s) {
#pragma unroll
            for (int q = 0; q < 4; ++q) *(LAS f32x4*)(ct + q * 1024 + lane * 16) = buf[s][q];
#pragma unroll
            for (int q = 0; q < 4; ++q) buf[s][q] = *(const f32x4*)(lp + (size_t)(s * 16 + q * 4) * nxt.ld);
            float v[16];
#pragma unroll
            for (int j = 0; j < 16; ++j) v[j] = ((const LAS float*)ct)[j * 64 + lane];
            u32x4 w; w.x = pk4_fp8(v[0] * sc, v[1] * sc, v[2] * sc, v[3] * sc); w.y = pk4_fp8(v[4] * sc, v[5] * sc, v[6] * sc, v[7] * sc);
            w.z = pk4_fp8(v[8] * sc, v[9] * sc, v[10] * sc, v[11] * sc); w.w = pk4_fp8(v[12] * sc, v[13] * sc, v[14] * sc, v[15] * sc);
            wout[s] = w;
        }
#pragma unroll
        for (int s = 0; s < 8; ++s) *(u32x4*)(dp + s * 16) = wout[s];
        cur = nxt;
    }
#pragma unroll
    for (int s = 0; s < 8; ++s) asm volatile("" :: "v"(buf[s][0]), "v"(buf[s][1]), "v"(buf[s][2]), "v"(buf[s][3]));
}
constexpr int SC_NSLOT = 5, SC_SLOTB = 6144, SC_WLDS = SC_NSLOT * SC_SLOTB;
#define SC_VSET(P) f32x4 P##av, P##wv, P##bv, P##kv, P##rv; float P##vv
#define SC_READV(P, sl) do { P##av = *(const LAS f32x4*)((sl) + l15 * 16); P##wv = *(const LAS f32x4*)((sl) + 1024 + l15 * 16); P##bv = *(const LAS f32x4*)((sl) + 2048 + l15 * 16); \
            P##kv = *(const LAS f32x4*)((sl) + 3072 + l15 * 16); P##rv = *(const LAS f32x4*)((sl) + 4096 + l15 * 16); P##vv = *(const LAS float*)((sl) + 5120 + lane * 4); } while (0)
#define SC_STEP(P, i) do { \
            float a0 = P##av[0], a1 = P##av[1], a2 = P##av[2], a3 = P##av[3], w0 = P##wv[0], w1 = P##wv[1], w2 = P##wv[2], w3 = P##wv[3], b0 = P##bv[0], b1 = P##bv[1], b2 = P##bv[2], b3 = P##bv[3]; \
            float k0 = P##kv[0], k1 = P##kv[1], k2 = P##kv[2], k3 = P##kv[3], r0 = P##rv[0], r1 = P##rv[1], r2 = P##rv[2], r3 = P##rv[3], vq = P##vv; \
            asm volatile("s_nop 1" : "+v"(a0), "+v"(a1), "+v"(a2), "+v"(a3)); \
            float c0 = 0.f, c1 = 0.f, c2 = 0.f, c3 = 0.f, e0 = 0.f, e1 = 0.f, e2 = 0.f, e3 = 0.f; \
            SC_FOR16(SC_SA) \
            float saq = (c0 + c1) + (c2 + c3), sap = (e0 + e1) + (e2 + e3); \
            asm volatile("s_nop 1" : "+v"(w0), "+v"(w1), "+v"(w2), "+v"(w3), "+v"(b0), "+v"(b1), "+v"(b2), "+v"(b3), "+v"(saq), "+v"(sap)); \
            SC_FOR16(SC_UP) \
            asm volatile("s_nop 1" : "+v"(k0), "+v"(k1), "+v"(k2), "+v"(k3), "+v"(vq)); \
            SC_FOR16(SC_VK) \
            if (gbase + (i) >= CTX) { \
                float y0 = 0.f, y1 = 0.f, y2 = 0.f, y3 = 0.f, z0 = 0.f, z1 = 0.f, z2 = 0.f, z3 = 0.f; \
                asm volatile("s_nop 1" : "+v"(r0), "+v"(r1), "+v"(r2), "+v"(r3)); \
                SC_FOR16(SC_Y) \
                const size_t yo_ = (size_t)scan_row(b, d, gbase + (i)) * 64; \
                ypq[yo_ + lane] = (y0 + y1) + (y2 + y3); ypp[yo_ + lane] = (z0 + z1) + (z2 + z3); \
            } } while (0)
#define SC_SA(n) DPP_FMAC(c0, a0, SQ[4 * n], n); DPP_FMAC(c1, a1, SQ[4 * n + 1], n); DPP_FMAC(c2, a2, SQ[4 * n + 2], n); DPP_FMAC(c3, a3, SQ[4 * n + 3], n); \
                 DPP_FMAC(e0, a0, SP[4 * n], n); DPP_FMAC(e1, a1, SP[4 * n + 1], n); DPP_FMAC(e2, a2, SP[4 * n + 2], n); DPP_FMAC(e3, a3, SP[4 * n + 3], n);
#define SC_UP(n) DPP_MULD(SQ[4 * n], w0, n); DPP_MULD(SQ[4 * n + 1], w1, n); DPP_MULD(SQ[4 * n + 2], w2, n); DPP_MULD(SQ[4 * n + 3], w3, n); \
                 DPP_MULD(SP[4 * n], w0, n); DPP_MULD(SP[4 * n + 1], w1, n); DPP_MULD(SP[4 * n + 2], w2, n); DPP_MULD(SP[4 * n + 3], w3, n); \
                 DPP_FMAC(SQ[4 * n], b0, saq, n); DPP_FMAC(SQ[4 * n + 1], b1, saq, n); DPP_FMAC(SQ[4 * n + 2], b2, saq, n); DPP_FMAC(SQ[4 * n + 3], b3, saq, n); \
                 DPP_FMAC(SP[4 * n], b0, sap, n); DPP_FMAC(SP[4 * n + 1], b1, sap, n); DPP_FMAC(SP[4 * n + 2], b2, sap, n); DPP_FMAC(SP[4 * n + 3], b3, sap, n);
#define SC_VK(n) DPP_FMAC(SQ[4 * n], k0, vq, n); DPP_FMAC(SQ[4 * n + 1], k1, vq, n); DPP_FMAC(SQ[4 * n + 2], k2, vq, n); DPP_FMAC(SQ[4 * n + 3], k3, vq, n);
#define SC_Y(n) DPP_FMAC(y0, r0, SQ[4 * n], n); DPP_FMAC(y1, r1, SQ[4 * n + 1], n); DPP_FMAC(y2, r2, SQ[4 * n + 2], n); DPP_FMAC(y3, r3, SQ[4 * n + 3], n); \
                DPP_FMAC(z0, r0, SP[4 * n], n); DPP_FMAC(z1, r1, SP[4 * n + 1], n); DPP_FMAC(z2, r2, SP[4 * n + 2], n); DPP_FMAC(z3, r3, SP[4 * n + 3], n);
__device__ __forceinline__ void ph_scan1(LAS unsigned char* lds, const float* wsf, unsigned oAA, unsigned oWW, unsigned oBD, unsigned oKD, unsigned oRR, unsigned oVR, float* YP, float* QP, const MoeCv mc, int G, int bid) {
    const int wave = __builtin_amdgcn_readfirstlane(threadIdx.x >> 6), lane = threadIdx.x & 63, l15 = lane & 15, vi = lane >> 4;
    if (wave >= 4) { for (int pb = bid; pb < 256; pb += G) moe_cvt_wave(lds + 4 * SC_WLDS + (wave - 4) * CV_WLDS, mc, pb * 4 + (wave - 4), lane); return; }
    LAS unsigned char* ring = lds + wave * SC_WLDS;
    for (int pb = bid; pb < 256; pb += G) {
        const int pair = pb * 4 + wave, chain = pair >> 4, chunk = pair & 15;
        const int b = chain >> 5, h = (chain >> 1) & 15, d = chain & 1;
        const unsigned dofs = (unsigned)d * MALL * RD;
        const unsigned oh = (unsigned)h * (MALL * 64), lane4 = lane * 4;
        const unsigned ob0 = oAA + oh, ob1 = oWW + dofs + oh, ob2 = oBD + dofs + oh, ob3 = oKD + dofs + oh, ob4 = oRR + oh, ob5 = oVR + oh;
        float SQ[64], SP[64];
#pragma unroll
        for (int k = 0; k < 64; ++k) { SQ[k] = 0.f; SP[k] = lane == k ? 1.f : 0.f; }
        float* ypq = YP + (size_t)d * NL * RD + (size_t)h * NL * 64;
        float* ypp = YP + (size_t)(2 + d) * NL * RD + (size_t)h * NL * 64;
        const int gbase = chunk * SC_CL;
        constexpr int NGRP = SC_CL / 4;
#define SC_ISSUE(grp, slot) do { const int gq_ = (grp) < NGRP ? (grp) : NGRP - 1; const unsigned ro_ = (unsigned)scan_row(b, d, gbase + 4 * gq_ + (d ? 3 : 0)) * 64; LAS unsigned char* sl_ = ring + (slot) * SC_SLOTB; \
            __builtin_amdgcn_global_load_lds((const unsigned*)(wsf + (ob0 + ro_) + lane4), (LAS unsigned*)sl_, 16, 0, 0); __builtin_amdgcn_global_load_lds((const unsigned*)(wsf + (ob1 + ro_) + lane4), (LAS unsigned*)(sl_ + 1024), 16, 0, 0); \
            __builtin_amdgcn_global_load_lds((const unsigned*)(wsf + (ob2 + ro_) + lane4), (LAS unsigned*)(sl_ + 2048), 16, 0, 0); __builtin_amdgcn_global_load_lds((const unsigned*)(wsf + (ob3 + ro_) + lane4), (LAS unsigned*)(sl_ + 3072), 16, 0, 0); \
            __builtin_amdgcn_global_load_lds((const unsigned*)(wsf + (ob4 + ro_) + lane4), (LAS unsigned*)(sl_ + 4096), 16, 0, 0); __builtin_amdgcn_global_load_lds((const unsigned*)(wsf + (ob5 + ro_) + lane4), (LAS unsigned*)(sl_ + 5120), 16, 0, 0); } while (0)
        SC_ISSUE(0, 0); SC_ISSUE(1, 1); SC_ISSUE(2, 2); SC_ISSUE(3, 3); SC_ISSUE(4, 4);
        SC_VSET(A); SC_VSET(B);
        asm volatile("s_waitcnt vmcnt(24)" ::: "memory");
        const int r0o = d ? 768 : 0, rstep = d ? -256 : 256;
        SC_READV(A, ring + r0o);
        asm volatile("s_waitcnt lgkmcnt(0)" ::: "memory");
        int slot = 0;
#pragma unroll 1
        for (int grp = 0; grp < NGRP; ++grp) {
            const int i = 4 * grp;
            const LAS unsigned char* sl = ring + slot * SC_SLOTB + r0o;
            const int nslot = slot == SC_NSLOT - 1 ? 0 : slot + 1;
            SC_READV(B, sl + rstep);
            SC_STEP(A, i);
            asm volatile("s_waitcnt lgkmcnt(0)" ::: "memory");
            SC_READV(A, sl + 2 * rstep);
            SC_STEP(B, i + 1);
            asm volatile("s_waitcnt lgkmcnt(0)" ::: "memory");
            SC_READV(B, sl + 3 * rstep);
            SC_STEP(A, i + 2);
            asm volatile("s_waitcnt lgkmcnt(0)" ::: "memory");
            SC_ISSUE(grp + SC_NSLOT, slot);
            asm volatile("s_waitcnt vmcnt(24)" ::: "memory");
            SC_READV(A, ring + nslot * SC_SLOTB + r0o);
            SC_STEP(B, i + 3);
            asm volatile("s_waitcnt lgkmcnt(0)" ::: "memory");
            slot = nslot;
        }
        asm volatile("s_waitcnt vmcnt(0)" ::: "memory");
#undef SC_ISSUE
        float* qpq = QP + ((((size_t)chain) * SC_NC + chunk) * 64 + lane) * 64;
        float* qpp = QP + ((((size_t)64 + chain) * SC_NC + chunk) * 64 + lane) * 64;
#pragma unroll
        for (int j = 0; j < 16; ++j) { *(f32x4*)(qpq + 4 * j) = (f32x4){SQ[4 * j], SQ[4 * j + 1], SQ[4 * j + 2], SQ[4 * j + 3]}; *(f32x4*)(qpp + 4 * j) = (f32x4){SP[4 * j], SP[4 * j + 1], SP[4 * j + 2], SP[4 * j + 3]}; }
    }
}
#undef SC_SA
#undef SC_UP
#undef SC_VK
#undef SC_Y
__device__ __forceinline__ void ph_scan_carry(const float* QP, float* SS, int G, int bid) {
    const int wave = __builtin_amdgcn_readfirstlane(threadIdx.x >> 6), lane = threadIdx.x & 63;
    for (int task = bid * 8 + wave; task < 64 * 32; task += G * 8) {
        const int chain = task >> 5, v0 = (task & 31) * 2;
        float s0 = 0.f, s1 = 0.f, P[64];
        const float* Pc = QP + (((size_t)64 + chain) * SC_NC) * 4096 + lane;
        const float* Qc = QP + (((size_t)chain) * SC_NC) * 4096 + v0 * 64 + lane;
        float* Sp = SS + (((size_t)chain * SC_NC) * 64 + v0) * 64 + lane;
#pragma unroll
        for (int k = 0; k < 64; ++k) P[k] = Pc[k * 64];
        float q0 = Qc[0], q1 = Qc[64];
#pragma unroll 1
        for (int c = 0; c < SC_NC - 1; ++c) {
            Sp[0] = s0; Sp[64] = s1; Sp += 4096;
            const int cn = c + 1 < SC_NC - 1 ? 1 : 0;
            Pc += cn * 4096; Qc += cn * 4096;
            float n0 = q0, n1 = q1; const int i0 = __builtin_bit_cast(int, s0), i1 = __builtin_bit_cast(int, s1);
            q0 = Qc[0]; q1 = Qc[64];
#pragma unroll
            for (int k = 0; k < 64; ++k) { const float pk = P[k];
                n0 += __builtin_bit_cast(float, __builtin_amdgcn_readlane(i0, k)) * pk; n1 += __builtin_bit_cast(float, __builtin_amdgcn_readlane(i1, k)) * pk;
                P[k] = Pc[k * 64]; }
            s0 = n0; s1 = n1;
        }
        Sp[0] = s0; Sp[64] = s1;
    }
}
struct FixLd { f32x4 p0, p1; float yl, r, ks, vr, gg; };
__device__ __forceinline__ FixLd fix_load(const float* YP, const float* RR, const float* KD, const float* VR, const float* GG, int row, int h, int lane) {
    FixLd x; const int l15 = lane & 15; const size_t e = ((size_t)h * NL + row) * 64, em = ((size_t)h * MALL + row) * 64;
    x.p0 = *(const f32x4*)(YP + (size_t)2 * NL * RD + e + l15 * 4); x.p1 = *(const f32x4*)(YP + (size_t)3 * NL * RD + e + l15 * 4);
    x.yl = YP[e + lane] + YP[(size_t)NL * RD + e + lane];
    x.r = RR[em + lane]; x.ks = KD[em + lane] + KD[(size_t)MALL * RD + em + lane]; x.vr = VR[em + lane]; x.gg = GG[em + lane];
    return x;
}
__device__ __forceinline__ void ph_scan_fix(const float* YP, const float* SS, const float* RR, const float* KD, const float* VR, const float* GG, const float* r_k, const float* lnw, const float* lnb, bf16_t* MIXB, int G, int bid) {
    const int wave = __builtin_amdgcn_readfirstlane(threadIdx.x >> 6), lane = threadIdx.x & 63;
    for (int task = bid * 8 + wave; task < 2048; task += G * 8) {
        const int b = task >> 10, h = (task >> 6) & 15, t0 = (task & 63) * 64, c = h * 64 + lane;
        const int chain0 = (b * 16 + h) * 2;
        float S0[64], S1[64]; int cc0 = -1, cc1 = -1;
        const float rk = r_k[c], lw = lnw[c], lb = lnb[c];
        FixLd ring[4];
#pragma unroll
        for (int k = 0; k < 4; ++k) ring[k] = fix_load(YP, RR, KD, VR, GG, b * SEQ + t0 + k, h, lane);
#pragma unroll 1
        for (int tt0 = 0; tt0 < 64; tt0 += 4)
#pragma unroll
          for (int k = 0; k < 4; ++k) {
            const int tt = tt0 + k, t = t0 + tt, row = b * SEQ + t;
            const FixLd cu = ring[k];
            { const int tn = tt < 60 ? t + 4 : t; ring[k] = fix_load(YP, RR, KD, VR, GG, b * SEQ + tn, h, lane); }
            const int c0 = (CTX + t) / SC_CL, c1 = (CTX + SEQ - 1 - t) / SC_CL;
            if (c0 != cc0) { cc0 = c0; const float* sp = SS + (((size_t)chain0 * SC_NC + c0) * 64 + lane) * 64;
#pragma unroll
                for (int j = 0; j < 16; ++j) { const f32x4 x = *(const f32x4*)(sp + 4 * j); S0[4 * j] = x[0]; S0[4 * j + 1] = x[1]; S0[4 * j + 2] = x[2]; S0[4 * j + 3] = x[3]; } }
            if (c1 != cc1) { cc1 = c1; const float* sp = SS + (((size_t)(chain0 + 1) * SC_NC + c1) * 64 + lane) * 64;
#pragma unroll
                for (int j = 0; j < 16; ++j) { const f32x4 x = *(const f32x4*)(sp + 4 * j); S1[4 * j] = x[0]; S1[4 * j + 1] = x[1]; S1[4 * j + 2] = x[2]; S1[4 * j + 3] = x[3]; } }
            float a0 = cu.p0[0], a1 = cu.p0[1], a2 = cu.p0[2], a3 = cu.p0[3], b0 = cu.p1[0], b1 = cu.p1[1], b2 = cu.p1[2], b3 = cu.p1[3];
            asm volatile("s_nop 1" : "+v"(a0), "+v"(a1), "+v"(a2), "+v"(a3), "+v"(b0), "+v"(b1), "+v"(b2), "+v"(b3));
            float y0 = 0.f, y1 = 0.f, y2 = 0.f, y3 = 0.f, z0 = 0.f, z1 = 0.f, z2 = 0.f, z3 = 0.f;
#define FX_N(n) DPP_FMAC(y0, a0, S0[4 * n], n); DPP_FMAC(y1, a1, S0[4 * n + 1], n); DPP_FMAC(y2, a2, S0[4 * n + 2], n); DPP_FMAC(y3, a3, S0[4 * n + 3], n); \
                DPP_FMAC(z0, b0, S1[4 * n], n); DPP_FMAC(z1, b1, S1[4 * n + 1], n); DPP_FMAC(z2, b2, S1[4 * n + 2], n); DPP_FMAC(z3, b3, S1[4 * n + 3], n);
            SC_FOR16(FX_N)
#undef FX_N
            const float y = cu.yl + ((y0 + y1) + (y2 + y3)) + ((z0 + z1) + (z2 + z3));
            const float mu = wave_sum_dpp(y) * (1.f / 64.f);
            const float dv = y - mu;
            const float var = wave_sum_dpp(dv * dv) * (1.f / 64.f);
            const float yn = dv * rsqrtf(var + 64e-5f) * lw + lb;
            const float bonus = wave_sum_dpp(cu.r * cu.ks * rk) * cu.vr;
            const float o = (yn + bonus) * cu.gg;
            const float on = __shfl_down(o, 1);
            if ((lane & 1) == 0) *(unsigned*)(MIXB + (size_t)row * D + 1024 + c) = cvt_pk_bf16(o, on);
        }
    }
}

constexpr size_t alb(size_t x) { return (x + 4095) & ~(size_t)4095; }
constexpr size_t CTL_BYTES = 65536;
constexpr size_t MB_CTL = 0;
constexpr size_t B_MOD0 = MB_CTL + CTL_BYTES;
constexpr size_t B_MOD1 = B_MOD0 + alb((size_t)3 * NMOD * 4);
constexpr size_t B_MODP = B_MOD1 + alb((size_t)2 * NMOD * 4);
constexpr size_t MB_ROPE = B_MODP + alb((size_t)2 * 32 * 3 * NMOD * 4);
constexpr size_t B_H = MB_ROPE + 8192;
constexpr size_t MB_XNB = B_H + alb((size_t)NL * D * 4);
constexpr size_t MB_WIN0 = MB_XNB + alb((size_t)MALL * D * 2);
constexpr size_t MB_WO0 = MB_WIN0 + alb((size_t)ZLD * D * 2);
constexpr size_t MB_W13 = MB_WO0 + alb((size_t)D * D * 2);
constexpr size_t MB_W2 = MB_W13 + alb((size_t)2 * DFF * D * 2);
constexpr size_t MB_WUQ = MB_W2 + alb((size_t)D * DFF * 2);
constexpr size_t MB_WKN = MB_WUQ + alb((size_t)QW * 512 * 2);
constexpr size_t MB_WV = MB_WKN + alb((size_t)1024 * 512 * 2);
constexpr size_t MB_WLORA = MB_WV + alb((size_t)1024 * 512 * 2);
constexpr size_t MB_WIN1 = MB_WLORA + alb((size_t)5120 * 512 * 2);
constexpr size_t MB_WO1 = MB_WIN1 + alb((size_t)4096 * D * 2);
constexpr size_t MB_WSB = MB_WO1 + alb((size_t)D * D * 2);
constexpr size_t MB_W13E = MB_WSB + alb((size_t)16 * 128 * 128 * 2);
constexpr size_t MB_W2E = MB_W13E + alb((size_t)NE * 2 * DFF * D);
constexpr size_t B_ACTS = MB_W2E + alb((size_t)NE * D * DFF);
constexpr size_t B_Z = B_ACTS;
constexpr size_t MB_CQNB = B_Z + alb((size_t)MALL * ZLD * 4);
constexpr size_t MB_CKVNB = MB_CQNB + alb((size_t)MALL * 512 * 2);
constexpr size_t MB_LA = MB_CKVNB + alb((size_t)MALL * 512 * 2);
constexpr size_t MB_QB = MB_LA + alb((size_t)MALL * 512 * 2);
constexpr size_t MB_KNB = MB_QB + alb((size_t)NL * QW * 2);
constexpr size_t MB_VTB = MB_KNB + alb((size_t)MALL * KLD * 2);
constexpr size_t B_RR = MB_VTB + alb((size_t)RD * MALL * 2);
constexpr size_t B_KR = B_RR + alb((size_t)MALL * RD * 4);
constexpr size_t B_VR = B_KR + alb((size_t)MALL * RD * 4);
constexpr size_t B_AA = B_VR + alb((size_t)MALL * RD * 4);
constexpr size_t B_WW = B_AA + alb((size_t)MALL * RD * 4);
constexpr size_t B_KD = B_WW + alb((size_t)2 * MALL * RD * 4);
constexpr size_t B_BD = B_KD + alb((size_t)2 * MALL * RD * 4);
constexpr size_t B_GG = B_BD + alb((size_t)2 * MALL * RD * 4);
constexpr size_t MB_YP = B_GG + alb((size_t)MALL * RD * 4);
constexpr size_t MB_QP = MB_YP + alb((size_t)4 * NL * RD * 4);
constexpr size_t MB_SS = MB_QP + alb((size_t)2 * 64 * 16 * 4096 * 4);
constexpr size_t MB_MIXB = MB_SS + alb((size_t)64 * 16 * 4096 * 4);
constexpr size_t MB_ACT = MB_MIXB + alb((size_t)NL * D * 2);
constexpr size_t B_L0END = MB_ACT + alb((size_t)NL * DFF * 2);
constexpr size_t MB_U = B_ACTS;
constexpr size_t MB_VG = MB_U + alb((size_t)NL * D * 2);
constexpr size_t MB_VT = MB_VG + alb((size_t)NL * D * 4);
constexpr size_t MB_GATED = MB_VT + alb((size_t)NL * D * 2);
constexpr size_t MB_XG = MB_GATED + alb((size_t)NL * D * 2);
constexpr size_t MB_ACT2 = MB_XG + alb((size_t)NSLOT * D);
constexpr size_t MB_OUT2 = MB_ACT2 + alb((size_t)NSLOT * DFF);
constexpr size_t MB_ROUTE = MB_OUT2 + alb((size_t)NSLOT * D * 4);
constexpr size_t B_L1END = MB_ROUTE + 262144;
constexpr size_t MB_END = B_L0END > B_L1END ? B_L0END : B_L1END;
constexpr size_t O_MOD0 = B_MOD0 / 4, O_MOD1 = B_MOD1 / 4, O_MODP = B_MODP / 4, O_H = B_H / 4, O_Z = B_Z / 4, O_RR = B_RR / 4, O_KR = B_KR / 4, O_VR = B_VR / 4, O_AA = B_AA / 4,
                 O_WW = B_WW / 4, O_KD = B_KD / 4, O_BD = B_BD / 4, O_GG = B_GG / 4;

struct MP { const float* in[44]; float* out; unsigned char* ws; int ph_lo, ph_hi; };

enum { PH_CVT = 0, PH_XN1, PH_GEMM_Z, PH_PREP, PH_GEMM4, PH_ATTN, PH_CARRY, PH_FIX, PH_GEMM_O0, PH_XN2, PH_FFN_UP, PH_FFN_DOWN, PH_XN3, PH_GEMM_IN1, PH_LNT, PH_SPATIAL, PH_GEMM_O1, PH_XN4, PH_PLAN, PH_MOE_UP, PH_MOE_DOWN, PH_FINAL, PH_N };

__global__ void __launch_bounds__(512, 2) mega(MP p) {
    extern __shared__ __attribute__((aligned(16))) unsigned char lds_raw[];
    LAS unsigned char* lds = (LAS unsigned char*)lds_raw;
    const int tid = threadIdx.x, G = gridDim.x, bid = blockIdx.x;
    for (int u = tid; u < (LDS_BYTES - LDS_CTL) / 4; u += 512) ((LAS unsigned*)(lds + LDS_CTL))[u] = 0u;
    __syncthreads();
    XcdBarrier bar = xcd_barrier_post((unsigned*)(p.ws + MB_CTL), (volatile LAS unsigned*)(lds + LDS_CTL + 64));
    float* wsf = (float*)p.ws;
    const int lo = p.ph_lo, hi = p.ph_hi;
#define IN(k) (lo <= (k) && (k) < hi)
#define SEAM(k) do { if (IN(k) && IN((k) + 1)) xcd_barrier(bar); } while (0)
    bf16_t* W13 = (bf16_t*)(p.ws + MB_W13); bf16_t* W2 = (bf16_t*)(p.ws + MB_W2); bf16_t* XNB = (bf16_t*)(p.ws + MB_XNB); bf16_t* ACT = (bf16_t*)(p.ws + MB_ACT);

    bf16_t* WIN0 = (bf16_t*)(p.ws + MB_WIN0); bf16_t* WO0 = (bf16_t*)(p.ws + MB_WO0); bf16_t* MIXB = (bf16_t*)(p.ws + MB_MIXB);
    bf16_t* CQNB = (bf16_t*)(p.ws + MB_CQNB); bf16_t* CKVNB = (bf16_t*)(p.ws + MB_CKVNB); bf16_t* LA = (bf16_t*)(p.ws + MB_LA);
    bf16_t* WLORA = (bf16_t*)(p.ws + MB_WLORA); bf16_t* WUQ = (bf16_t*)(p.ws + MB_WUQ); bf16_t* WKN = (bf16_t*)(p.ws + MB_WKN); bf16_t* WV = (bf16_t*)(p.ws + MB_WV);
    bf16_t* QB = (bf16_t*)(p.ws + MB_QB); bf16_t* KNB = (bf16_t*)(p.ws + MB_KNB); bf16_t* VTB = (bf16_t*)(p.ws + MB_VTB); float* ROPEC = (float*)(p.ws + MB_ROPE); float* ROPES = ROPEC + 1024;
    bf16_t* W13E = (bf16_t*)(p.ws + MB_W13E); bf16_t* W2E = (bf16_t*)(p.ws + MB_W2E); bf16_t* WIN1 = (bf16_t*)(p.ws + MB_WIN1); bf16_t* WO1 = (bf16_t*)(p.ws + MB_WO1); bf16_t* WSB = (bf16_t*)(p.ws + MB_WSB);
    bf16_t* Ub = (bf16_t*)(p.ws + MB_U); float* VG = (float*)(p.ws + MB_VG); bf16_t* VT = (bf16_t*)(p.ws + MB_VT); bf16_t* GATED = (bf16_t*)(p.ws + MB_GATED); bf16_t* XNB2 = (bf16_t*)(p.ws + MB_XNB);
    bf16_t* XG = (bf16_t*)(p.ws + MB_XG); float* OUT2 = (float*)(p.ws + MB_OUT2); bf16_t* ACT2 = (bf16_t*)(p.ws + MB_ACT2);
    int* R_TOPE = (int*)(p.ws + MB_ROUTE); int* R_SLOT = R_TOPE + 16384; float* R_TOPG = (float*)(R_TOPE + 32768); int* R_BCNT = R_TOPE + 49152; int* R_CNTOFF = R_TOPE + 49152 + 4096;
    if (IN(PH_CVT)) {
        ph_small_cvt(p.in[16], p.in[18], p.in[19], WLORA, ROPEC, ROPES, G, bid);
        { MapPlain m{p.in[10], QW, QW}; cvt_T(lds, m, WUQ, QW, 512, G, bid); }
        { MapKV m{p.in[12], 0}; cvt_T(lds, m, WKN, 1024, 512, G, (bid + G - 96) % G); }
        { MapKV m{p.in[12], 1}; cvt_T(lds, m, WV, 1024, 512, G, (bid + G - 160) % G); }
        ph_ada(lds, p.in[4], p.in[29], p.in[5], p.in[30], p.in[1], p.in[3], wsf + O_MOD0, wsf + O_MOD1, G, bid);
        { MapPlain m{p.in[8], ZW, ZW}; cvt_T(lds, m, WIN0, ZLD, D, G, bid); }
        { MapPlain m{p.in[25], D, D}; cvt_T(lds, m, WO0, D, D, G, bid); }
        { MapIl m{p.in[26], (long)(p.in[27] - p.in[26]), DFF}; cvt_T(lds, m, W13, 2 * DFF, D, G, bid); }
        { MapPlain m{p.in[28], D, D}; cvt_T(lds, m, W2, D, DFF, G, bid); }
        { MapPlain m{p.in[33], 4096, 4096}; cvt_T(lds, m, WIN1, 4096, D, G, bid); }
        { MapPlain m{p.in[38], D, D}; cvt_T(lds, m, WO1, D, D, G, bid); }
        cvt_copy(p.in[36], WSB, (size_t)16 * 128 * 128, G, bid);
        __syncthreads();
    }
    SEAM(PH_CVT);
    if (IN(PH_XN1)) ph_norm_mod<false>(lds, p.in[0], p.in[2], p.in[6], wsf + O_MOD0, 0, 1, XNB, MALL, nullptr, nullptr, nullptr, nullptr, G, bid);
    SEAM(PH_XN1);
    if (IN(PH_GEMM_Z)) {
        pg8::DenseOrder S; S.init(XNB, D, WIN0, D, MALL, ZLD, G, bid);
        EpiF32 E{wsf + O_Z, ZLD};
        pg8::gemm_phase<EpiF32, pg8::DenseOrder, true, true>(lds, D, D, D, S, E);
    }
    SEAM(PH_GEMM_Z);
    if (IN(PH_PREP)) {
        ph_prep(wsf + O_Z, p.in[9], p.in[11], p.in[13], p.in[14], p.in[20], CQNB, CKVNB, KNB, LA, wsf + O_RR, wsf + O_KR, wsf + O_VR, wsf + O_AA, ROPEC, ROPES, G, bid);
    }
    SEAM(PH_PREP);
    if (IN(PH_GEMM4)) {
#pragma unroll 1
        for (int q = 0; q < 3; ++q) {
            const int kof = q * 128, kk = q < 2 ? 128 : 256, nn = q < 2 ? 2048 : 1024;
            pg8::DenseOrder S; S.init(LA + kof, 512, WLORA + (size_t)(q * 2048) * 512 + kof, 512, MALL, nn, G, (bid + G - 16 * q) % G);
            EpiLora E{p.in[15], p.in[17], p.in[21], wsf + O_KR, wsf + O_AA, wsf + O_WW, wsf + O_KD, wsf + O_BD, wsf + O_GG, q * 8};
            pg8::gemm_phase<EpiLora, pg8::DenseOrder, true, true>(lds, kk, 512, 512, S, E); }
        { pg8::DenseOrder S; S.init(CQNB, 512, WUQ, 512, NL, QW, G, (bid + 168) % G);
          EpiQ E{QB, ROPEC, ROPES};
          pg8::gemm_phase<EpiQ, pg8::DenseOrder, true, true>(lds, 512, 512, 512, S, E);
 }
        { pg8::DenseOrder S; S.init(CKVNB, 512, WKN, 512, MALL, 1024, G, (bid + 104) % G);
          EpiBf16 E{KNB, KLD};
          pg8::gemm_phase<EpiBf16, pg8::DenseOrder, true, true>(lds, 512, 512, 512, S, E); }
        { pg8::DenseOrder S; S.init(WV, 512, CKVNB, 512, 1024, MALL, G, (bid + 224) % G);
          EpiVT E{VTB};
          pg8::gemm_phase<EpiVT, pg8::DenseOrder, true, true>(lds, 512, 512, 512, S, E); }
    }
    SEAM(PH_GEMM4);
    float* YP = (float*)(p.ws + MB_YP); float* QP = (float*)(p.ws + MB_QP); float* SS = (float*)(p.ws + MB_SS);
    if (IN(PH_ATTN)) {
        ph_attn(lds, QB, KNB, VTB, MIXB, G, bid);
        { const MoeCv mc{p.in[40], (long)(p.in[41] - p.in[40]), p.in[42], (unsigned char*)W13E, (unsigned char*)W2E};
          ph_scan1(lds, wsf, (unsigned)O_AA, (unsigned)O_WW, (unsigned)O_BD, (unsigned)O_KD, (unsigned)O_RR, (unsigned)O_VR, YP, QP, mc, G, bid); }
        __syncthreads();
    }
    SEAM(PH_ATTN);
    if (IN(PH_CARRY)) ph_scan_carry(QP, SS, G, bid);
    SEAM(PH_CARRY);
    if (IN(PH_FIX)) ph_scan_fix(YP, SS, wsf + O_RR, wsf + O_KD, wsf + O_VR, wsf + O_GG, p.in[22], p.in[23], p.in[24], MIXB, G, bid);
    SEAM(PH_FIX);
    if (IN(PH_GEMM_O0)) {
        pg8::DenseOrder S; S.init(MIXB, D, WO0, D, NL, D, G, bid);
        EpiRes E{wsf + O_H, p.in[0], wsf + O_MOD0 + 2 * D};
        pg8::gemm_phase<EpiRes, pg8::DenseOrder, true, true>(lds, D, D, D, S, E);
    }
    SEAM(PH_GEMM_O0);
    if (IN(PH_XN2)) ph_norm_mod<false>(lds, wsf + O_H, nullptr, p.in[7], wsf + O_MOD0, 3, 4, XNB, NL, nullptr, nullptr, nullptr, nullptr, G, bid);
    SEAM(PH_XN2);
    if (IN(PH_FFN_UP)) {
        pg8::DenseOrder S; S.init(XNB, D, W13, D, NL, 2 * DFF, G, bid);
        EpiSwiglu E{ACT, DFF};
        pg8::gemm_phase<EpiSwiglu, pg8::DenseOrder, false, true>(lds, D, D, D, S, E);
    }
    SEAM(PH_FFN_UP);
    if (IN(PH_FFN_DOWN)) {
        pg8::DenseOrder S; S.init(ACT, DFF, W2, DFF, NL, D, G, bid);
        EpiRes E{wsf + O_H, wsf + O_H, wsf + O_MOD0 + 5 * D};
        pg8::gemm_phase<EpiRes, pg8::DenseOrder, true, true>(lds, DFF, DFF, DFF, S, E);
    }
    SEAM(PH_FFN_DOWN);
    if (IN(PH_XN3)) ph_norm_mod<false>(lds, wsf + O_H, nullptr, p.in[31], wsf + O_MOD1, 0, 1, XNB2, NL, nullptr, nullptr, nullptr, nullptr, G, bid);
    SEAM(PH_XN3);
    if (IN(PH_GEMM_IN1)) {
        pg8::DenseOrder S; S.init(XNB2, D, WIN1, D, NL, 4096, G, bid);
        EpiGelu E{Ub, VG};
        pg8::gemm_phase<EpiGelu, pg8::DenseOrder, true, true>(lds, D, D, D, S, E);
    }
    SEAM(PH_GEMM_IN1);
    if (IN(PH_LNT)) ph_ln_transpose(lds, VG, p.in[34], p.in[35], VT, G, bid);
    SEAM(PH_LNT);
    if (IN(PH_SPATIAL)) ph_spatial(WSB, VT, Ub, p.in[37], GATED, G, bid);
    SEAM(PH_SPATIAL);
    if (IN(PH_GEMM_O1)) {
        pg8::DenseOrder S; S.init(GATED, D, WO1, D, NL, D, G, bid);
        EpiRes E{wsf + O_H, wsf + O_H, wsf + O_MOD1 + 2 * D};
        pg8::gemm_phase<EpiRes, pg8::DenseOrder, true, true>(lds, D, D, D, S, E);
    }
    SEAM(PH_GEMM_O1);
    if (IN(PH_XN4)) ph_norm_mod<true>(lds, wsf + O_H, nullptr, p.in[32], wsf + O_MOD1, 3, 4, XNB2, NL, p.in[39], R_TOPE, R_TOPG, R_BCNT, G, bid);
    SEAM(PH_XN4);
    if (IN(PH_PLAN)) ph_moe_plan(lds, R_BCNT, R_TOPE, R_SLOT, R_CNTOFF, XNB2, XG, G, bid);
    SEAM(PH_PLAN);
    if (IN(PH_MOE_UP)) {
        pg8::MoeOrder S; S.init(R_CNTOFF, R_CNTOFF + 8, XG, D / 2, W13E, D / 2, (size_t)2 * DFF * D, 2 * DFF, G, bid);
        EpiSwigluF8 E{(unsigned char*)ACT2, DFF, 1.0f / 64.f};
        pg8::gemm_phase<EpiSwigluF8, pg8::MoeOrder, false, true, true>(lds, D / 2, D / 2, D / 2, S, E);
    }
    SEAM(PH_MOE_UP);
    if (IN(PH_MOE_DOWN)) {
        pg8::MoeOrder S; S.init(R_CNTOFF, R_CNTOFF + 8, ACT2, DFF / 2, W2E, DFF / 2, (size_t)D * DFF, D, G, bid);
        EpiBf16S E{(bf16_t*)OUT2, D, 1.0f / 128.f};
        pg8::gemm_phase<EpiBf16S, pg8::MoeOrder, true, true, true>(lds, DFF / 2, DFF / 2, DFF / 2, S, E);
    }
    SEAM(PH_MOE_DOWN);
    if (IN(PH_FINAL)) ph_final(wsf + O_H, (const bf16_t*)OUT2, R_SLOT, R_TOPG, wsf + O_MOD1 + 5 * D, p.in[43], p.out, G, bid);
#undef IN
#undef SEAM
}

static void launch_mega(hipStream_t stream, MP mp, int lo, int hi) {
    static int grid = 0;
    if (grid == 0) {
        int dev = 0, cus = 0;
        hipGetDevice(&dev); hipDeviceGetAttribute(&cus, hipDeviceAttributeMultiprocessorCount, dev);
        hipFuncSetAttribute((const void*)mega, hipFuncAttributeMaxDynamicSharedMemorySize, LDS_BYTES);
        int per_cu = 0; hipOccupancyMaxActiveBlocksPerMultiprocessor(&per_cu, (const void*)mega, 512, LDS_BYTES);
        if (per_cu < 1) fprintf(stderr, "mega: occupancy query says %d\n", per_cu);
        (void)hipGetLastError();
        grid = cus > 0 ? cus : 256;
    }
    hipMemsetAsync(mp.ws + MB_CTL, 0, CTL_BYTES, stream);
    mp.ph_lo = lo; mp.ph_hi = hi;
    hipLaunchKernelGGL(mega, dim3(grid), dim3(512), LDS_BYTES, stream, mp);
}
extern "C" void kernel_launch(void* const* d_in, const int* in_sizes, int n_in, void* d_out, int out_size, void* d_ws, size_t ws_size, hipStream_t stream) {
    if (n_in != 44 || ws_size < MB_END) { fprintf(stderr, "kernel_launch: bad n_in %d or ws %zu < %zu\n", n_in, ws_size, (size_t)MB_END); return; }
    MP mp{};
    for (int i = 0; i < 44; ++i) mp.in[i] = (const float*)d_in[i];
    mp.out = (float*)d_out; mp.ws = (unsigned char*)d_ws;
    launch_mega(stream, mp, 0, PH_N);
}
```
